# Optimizing an MI355X kernel written in HIP

```python
import math
import jax, jax.numpy as jnp
from jax import lax
import numpy as np

D_MODEL = 1024
BATCH = 4
SEQ = 8192
DEPTH = 2

D_MIX = D_MODEL
M_HEADS = 4
M_HEAD_DIM = D_MIX // 16
M_WIDTH = M_HEADS * M_HEAD_DIM
M_CHUNK = 64
M_QK_CONV = 4
C_WIDTH = D_MIX // 4
C_KERNEL = 31
A_HEADS = 4
A_HEAD_DIM = D_MIX // 16
A_WIDTH = A_HEADS * 2 * A_HEAD_DIM
Q_BLOCK = 128
SPLIT_SIZES = (M_WIDTH, M_WIDTH, M_WIDTH, M_WIDTH, M_HEADS, M_HEADS,
               C_WIDTH, C_WIDTH, A_WIDTH, A_WIDTH, A_WIDTH)
D_IN = 4 * M_WIDTH + 2 * M_HEADS + 2 * C_WIDTH + 3 * A_WIDTH
FF_DENSE = ((8 * D_MODEL // 3 + 127) // 128) * 128
N_EXPERTS = 8
TOP_K = 2
FF_EXPERT = 7 * D_MODEL // 2
N_DENSE = (DEPTH + 1) // 2
N_MOE = DEPTH // 2
PLE_DIM = 256
EPS = 1e-6

kernel_name = "hybrid_mlstm_conformer_diffattn_moe_trunk"


def _rmsnorm(x, g):
    xf = x.astype(jnp.float32)
    return xf * lax.rsqrt(jnp.mean(xf * xf, axis=-1, keepdims=True) + EPS) * g.astype(jnp.float32)


def _layernorm(x, g, b):
    xf = x.astype(jnp.float32)
    mu = jnp.mean(xf, axis=-1, keepdims=True)
    var = jnp.mean(jnp.square(xf - mu), axis=-1, keepdims=True)
    return (xf - mu) * lax.rsqrt(var + EPS) * g.astype(jnp.float32) + b.astype(jnp.float32)


def _causal_depthwise_conv(x, w):
    k = w.shape[0]
    return lax.conv_general_dilated(
        x.astype(jnp.float32), w.astype(jnp.float32)[:, None, :],
        window_strides=(1,), padding=[(k - 1, 0)],
        dimension_numbers=('NWC', 'WIO', 'NWC'), feature_group_count=x.shape[-1])


def _mlstm_chunkwise(q, k, v, i_pre, f_pre):
    b, s, h, dh = q.shape
    nc = s // M_CHUNK
    q = q.astype(jnp.float32).reshape(b, nc, M_CHUNK, h, dh) * dh ** -0.5
    k = k.astype(jnp.float32).reshape(b, nc, M_CHUNK, h, dh)
    v = v.astype(jnp.float32).reshape(b, nc, M_CHUNK, h, dh)
    logf = jax.nn.log_sigmoid(f_pre.astype(jnp.float32)).reshape(b, nc, M_CHUNK, h)
    ig = i_pre.astype(jnp.float32).reshape(b, nc, M_CHUNK, h)
    bcum = jnp.cumsum(logf, axis=2)
    g = bcum[:, :, -1]
    w_loc = g[:, :, None] - bcum + ig
    m_loc = jnp.max(w_loc, axis=2)
    e_loc = jnp.exp(w_loc - m_loc[:, :, None])
    c_loc = jnp.einsum('bclh,bclhd,bclhe->bchde', e_loc, k, v)
    n_loc = jnp.einsum('bclh,bclhd->bchd', e_loc, k)

    def step(carry, inp):
        c_st, n_st, m_st = carry
        cl, nl, ml, gc = inp
        m_new = jnp.maximum(gc + m_st, ml)
        a = jnp.exp(gc + m_st - m_new)
        bb = jnp.exp(ml - m_new)
        c_new = a[..., None, None] * c_st + bb[..., None, None] * cl
        n_new = a[..., None] * n_st + bb[..., None] * nl
        return (c_new, n_new, m_new), (c_st, n_st, m_st)

    init = (jnp.zeros((b, h, dh, dh), jnp.float32), jnp.zeros((b, h, dh), jnp.float32),
            jnp.zeros((b, h), jnp.float32))
    xs = (jnp.moveaxis(c_loc, 1, 0), jnp.moveaxis(n_loc, 1, 0), jnp.moveaxis(m_loc, 1, 0), jnp.moveaxis(g, 1, 0))
    _, (c_prev, n_prev, m_prev) = lax.scan(step, init, xs)
    c_prev = jnp.moveaxis(c_prev, 0, 1)
    n_prev = jnp.moveaxis(n_prev, 0, 1)
    m_prev = jnp.moveaxis(m_prev, 0, 1)

    bt = jnp.moveaxis(bcum, -1, 2)
    it = jnp.moveaxis(ig, -1, 2)
    causal = jnp.tril(jnp.ones((M_CHUNK, M_CHUNK), dtype=bool))
    dmat = jnp.where(causal, bt[..., :, None] - bt[..., None, :] + it[..., None, :], -jnp.inf)
    m_inter = bt + m_prev[..., None]
    m_out = jnp.maximum(m_inter, jnp.max(dmat, axis=-1))
    wts = jnp.exp(dmat - m_out[..., None]) * jnp.einsum('bclhd,bcshd->bchls', q, k)
    inter_scale = jnp.exp(m_inter - m_out)
    num = (jnp.einsum('bchls,bcshe->bchle', wts, v)
           + inter_scale[..., None] * jnp.einsum('bclhd,bchde->bchle', q, c_prev))
    den = jnp.sum(wts, axis=-1) + inter_scale * jnp.einsum('bclhd,bchd->bchl', q, n_prev)
    out = num / jnp.maximum(jnp.abs(den), jnp.exp(-m_out))[..., None]
    return jnp.moveaxis(out, 2, 3).reshape(b, s, h, dh)


def _diff_attention(q, k, v, lam):
    b, s, _, dh = q.shape
    slopes = 2.0 ** (-8.0 * jnp.arange(1, A_HEADS + 1, dtype=jnp.float32) / A_HEADS)
    outs = []
    for blk in range(s // Q_BLOCK):
        s0 = blk * Q_BLOCK
        e = s0 + Q_BLOCK
        logits = jnp.einsum('bqhd,bkhd->bhqk', q[:, s0:e], k[:, :e]) * dh ** -0.5
        logits = logits.reshape(b, A_HEADS, 2, Q_BLOCK, e)
        dist = (jnp.arange(s0, e)[:, None] - jnp.arange(e)[None, :]).astype(jnp.float32)
        bias = jnp.where(dist >= 0, -slopes[:, None, None, None] * dist, -jnp.inf)
        probs = jax.nn.softmax(logits + bias, axis=-1)
        attn = probs[:, :, 0] - lam * probs[:, :, 1]
        outs.append(jnp.einsum('bhqk,bkhe->bqhe', attn, v[:, :e].astype(jnp.float32)))
    return jnp.concatenate(outs, axis=1)


def _swiglu(x, wg, wu, wd):
    return (jax.nn.silu(x @ wg) * (x @ wu)) @ wd


def _moe_swiglu(x, router_w, wg, wu, wd):
    b, s, d = x.shape
    xt = x.reshape(b * s, d)
    logits = (xt @ router_w).astype(jnp.float32)
    top_val, top_idx = lax.top_k(logits, TOP_K)
    gates = jax.nn.softmax(top_val, axis=-1)
    combine = jnp.einsum('nk,nke->ne', gates, jax.nn.one_hot(top_idx, N_EXPERTS, dtype=jnp.float32))
    out = jnp.zeros((b * s, d), jnp.float32)
    for e in range(N_EXPERTS):
        out = out + combine[:, e:e + 1] * _swiglu(xt, wg[e], wu[e], wd[e])
    return out.reshape(b, s, d)


def setup_inputs(seed: int = 0) -> dict:
    key = jax.random.key(seed)
    ks = jax.random.split(key, 40)
    f32 = jnp.float32

    def nrm(k, shape, scale):
        return jax.random.normal(k, shape, f32) * scale

    def gain(k, shape):
        return 1.0 + 0.02 * jax.random.normal(k, shape, f32)

    return {
        'x': nrm(ks[0], (BATCH, SEQ, D_MODEL), 1.0),
        'p': nrm(ks[1], (DEPTH, BATCH, SEQ, PLE_DIM), 1.0),
        'mix_norm_g': gain(ks[2], (DEPTH, D_MODEL)),
        'w_in': nrm(ks[3], (DEPTH, D_MODEL, D_IN), D_MODEL ** -0.5),
        'b_igate': nrm(ks[4], (DEPTH, M_HEADS), 0.1),
        'b_fgate': jnp.linspace(3.0, 6.0, M_HEADS, dtype=f32)[None, :] + nrm(ks[5], (DEPTH, M_HEADS), 0.1),
        'm_qk_conv_w': nrm(ks[6], (DEPTH, M_QK_CONV, 2 * M_WIDTH), M_QK_CONV ** -0.5),
        'm_out_norm_g': gain(ks[7], (DEPTH, M_WIDTH)),
        'c_conv_w': nrm(ks[8], (DEPTH, C_KERNEL, C_WIDTH), C_KERNEL ** -0.5),
        'c_conv_b': nrm(ks[9], (DEPTH, C_WIDTH), 0.02),
        'c_ln_g': gain(ks[10], (DEPTH, C_WIDTH)),
        'c_ln_b': nrm(ks[11], (DEPTH, C_WIDTH), 0.02),
        'a_q_norm_g': gain(ks[12], (DEPTH, A_HEAD_DIM)),
        'a_k_norm_g': gain(ks[13], (DEPTH, A_HEAD_DIM)),
        'a_lambda_q1': nrm(ks[14], (DEPTH, A_HEAD_DIM), 0.1),
        'a_lambda_k1': nrm(ks[15], (DEPTH, A_HEAD_DIM), 0.1),
        'a_lambda_q2': nrm(ks[16], (DEPTH, A_HEAD_DIM), 0.1),
        'a_lambda_k2': nrm(ks[17], (DEPTH, A_HEAD_DIM), 0.1),
        'a_subln_g': gain(ks[18], (DEPTH, 2 * A_HEAD_DIM)),
        'w_out': nrm(ks[19], (DEPTH, D_MIX, D_MODEL), D_MIX ** -0.5),
        'ffn_norm_g': gain(ks[20], (DEPTH, D_MODEL)),
        'dense_w_gate': nrm(ks[21], (N_DENSE, D_MODEL, FF_DENSE), D_MODEL ** -0.5),
        'dense_w_up': nrm(ks[22], (N_DENSE, D_MODEL, FF_DENSE), D_MODEL ** -0.5),
        'dense_w_down': nrm(ks[23], (N_DENSE, FF_DENSE, D_MODEL), FF_DENSE ** -0.5),
        'router_w': nrm(ks[24], (N_MOE, D_MODEL, N_EXPERTS), D_MODEL ** -0.5),
        'moe_w_gate': nrm(ks[25], (N_MOE, N_EXPERTS, D_MODEL, FF_EXPERT), D_MODEL ** -0.5),
        'moe_w_up': nrm(ks[26], (N_MOE, N_EXPERTS, D_MODEL, FF_EXPERT), D_MODEL ** -0.5),
        'moe_w_down': nrm(ks[27], (N_MOE, N_EXPERTS, FF_EXPERT, D_MODEL), FF_EXPERT ** -0.5),
        'ple_norm_g': gain(ks[28], (DEPTH, D_MODEL)),
        'w_ple_gate': nrm(ks[29], (DEPTH, D_MODEL, D_MODEL), D_MODEL ** -0.5),
        'w_ple_proj': nrm(ks[30], (DEPTH, PLE_DIM, D_MODEL), PLE_DIM ** -0.5),
    }


def reference(x, p, mix_norm_g, w_in, b_igate, b_fgate, m_qk_conv_w, m_out_norm_g,
              c_conv_w, c_conv_b, c_ln_g, c_ln_b, a_q_norm_g, a_k_norm_g,
              a_lambda_q1, a_lambda_k1, a_lambda_q2, a_lambda_k2, a_subln_g, w_out,
              ffn_norm_g, dense_w_gate, dense_w_up, dense_w_down, router_w,
              moe_w_gate, moe_w_up, moe_w_down, ple_norm_g, w_ple_gate, w_ple_proj):
    b, s, _ = x.shape
    split_idx = np.cumsum(SPLIT_SIZES)[:-1].tolist()
    h = x.astype(jnp.float32)
    for layer in range(DEPTH):
        a = _rmsnorm(h, mix_norm_g[layer])
        u = a @ w_in[layer]
        mq, mk, mv, mo, mi, mf, ca, cg, aq, ak, av = jnp.split(u, split_idx, axis=-1)

        qk = jax.nn.silu(_causal_depthwise_conv(jnp.concatenate([mq, mk], axis=-1), m_qk_conv_w[layer]))
        mq, mk = jnp.split(qk, 2, axis=-1)
        hm = _mlstm_chunkwise(mq.reshape(b, s, M_HEADS, M_HEAD_DIM), mk.reshape(b, s, M_HEADS, M_HEAD_DIM),
                              mv.reshape(b, s, M_HEADS, M_HEAD_DIM),
                              mi + b_igate[layer], mf + b_fgate[layer])
        hm = _rmsnorm(hm, m_out_norm_g[layer].reshape(M_HEADS, M_HEAD_DIM))
        y_m = (hm * jax.nn.sigmoid(mo.astype(jnp.float32)).reshape(b, s, M_HEADS, M_HEAD_DIM)).reshape(b, s, M_WIDTH)

        z = ca * jax.nn.sigmoid(cg)
        z = _causal_depthwise_conv(z, c_conv_w[layer]) + c_conv_b[layer]
        y_c = jax.nn.silu(_layernorm(z, c_ln_g[layer], c_ln_b[layer]))

        lam_init = 0.8 - 0.6 * math.exp(-0.3 * layer)
        lam = (jnp.exp(jnp.sum(a_lambda_q1[layer].astype(jnp.float32) * a_lambda_k1[layer].astype(jnp.float32)))
               - jnp.exp(jnp.sum(a_lambda_q2[layer].astype(jnp.float32) * a_lambda_k2[layer].astype(jnp.float32)))
               + lam_init)
        qa = _rmsnorm(aq.reshape(b, s, 2 * A_HEADS, A_HEAD_DIM), a_q_norm_g[layer])
        ka = _rmsnorm(ak.reshape(b, s, 2 * A_HEADS, A_HEAD_DIM), a_k_norm_g[layer])
        ya = _diff_attention(qa, ka, av.reshape(b, s, A_HEADS, 2 * A_HEAD_DIM), lam)
        y_a = (_rmsnorm(ya, a_subln_g[layer]) * (1.0 - lam_init)).reshape(b, s, A_WIDTH)

        y = jnp.concatenate([y_m, y_c, y_a], axis=-1)
        h = h + y @ w_out[layer]

        c = _rmsnorm(h, ffn_norm_g[layer])
        if layer % 2 == 0:
            j = layer // 2
            f = _swiglu(c, dense_w_gate[j], dense_w_up[j], dense_w_down[j])
        else:
            j = layer // 2
            f = _moe_swiglu(c, router_w[j], moe_w_gate[j], moe_w_up[j], moe_w_down[j])
        h = h + f

        gate = jax.nn.sigmoid(_rmsnorm(h, ple_norm_g[layer]) @ w_ple_gate[layer])
        h = h + gate * (p[layer] @ w_ple_proj[layer])
    return h.astype(x.dtype)
```

```cpp
#include <hip/hip_runtime.h>
#include <cstdio>
#include <cstdint>
#include <cmath>
namespace nv {
constexpr int S = 8192, D = 1024, DIN = 3080, NB = 4;
constexpr int FFD = 2816, FFE = 3584, NE = 8, PLE = 256;
constexpr int OFF_MQ = 0, OFF_MK = 256, OFF_MV = 512, OFF_MO = 768, OFF_MI = 1024, OFF_MF = 1028, OFF_CA = 1032, OFF_CG = 1288, OFF_AQ = 1544, OFF_AK = 2056, OFF_AV = 2568;

__device__ __forceinline__ float sigmoidf_(float x) { return 1.f / (1.f + expf(-x)); }
__device__ __forceinline__ float siluf_(float x) { return x / (1.f + expf(-x)); }
__device__ __forceinline__ float wsum(float v) { for (int o = 32; o > 0; o >>= 1) v += __shfl_xor(v, o); return v; }
__device__ __forceinline__ float wmax(float v) { for (int o = 32; o > 0; o >>= 1) v = fmaxf(v, __shfl_xor(v, o)); return v; }

__global__ void groupnorm(const float* in, int ldi, float* out, int ldo, int ngroups, int gdim, const float* gain, int gain_stride, float scale) {
    const int rg = blockIdx.x, row = rg / ngroups, g = rg % ngroups, lane = threadIdx.x;
    const float* x = in + (size_t)row * ldi + g * gdim;
    float s = 0.f;
    for (int i = lane; i < gdim; i += 64) s += x[i] * x[i];
    s = wsum(s);
    const float r = rsqrtf(s / (float)gdim + 1e-6f);
    float* o = out + (size_t)row * ldo + g * gdim;
    for (int i = lane; i < gdim; i += 64) o[i] = x[i] * r * gain[g * gain_stride + i] * scale;
}

template <bool ACC>
__global__ void gemm(const float* A, int lda, const float* B, int ldb, float* C, int ldc, int M, int N, int K, const int* rowlist, const int* nrows_dev) {
    __shared__ float As[16][65];
    __shared__ float Bs[16][64];
    const int Meff = nrows_dev ? *nrows_dev : M;
    const int m0 = blockIdx.y * 64, n0 = blockIdx.x * 64;
    if (m0 >= Meff) return;
    const int tid = threadIdx.x, ty = tid >> 4, tx = tid & 15;
    float acc[4][4];
    for (int i = 0; i < 4; ++i) for (int j = 0; j < 4; ++j) acc[i][j] = 0.f;
    for (int k0 = 0; k0 < K; k0 += 16) {
        for (int i = 0; i < 4; ++i) {
            const int idx = tid + i * 256, r = idx >> 4, kk = idx & 15;
            float v = 0.f;
            if (m0 + r < Meff) { const int ar = rowlist ? rowlist[m0 + r] : (m0 + r); v = A[(size_t)ar * lda + k0 + kk]; }
            As[kk][r] = v;
        }
        for (int i = 0; i < 4; ++i) {
            const int idx = tid + i * 256, kk = idx >> 6, c = idx & 63;
            Bs[kk][c] = (n0 + c < N) ? B[(size_t)(k0 + kk) * ldb + n0 + c] : 0.f;
        }
        __syncthreads();
#pragma unroll
        for (int kk = 0; kk < 16; ++kk) {
            float a[4], b[4];
            for (int i = 0; i < 4; ++i) a[i] = As[kk][ty * 4 + i];
            for (int j = 0; j < 4; ++j) b[j] = Bs[kk][tx * 4 + j];
            for (int i = 0; i < 4; ++i) for (int j = 0; j < 4; ++j) acc[i][j] += a[i] * b[j];
        }
        __syncthreads();
    }
    for (int i = 0; i < 4; ++i) {
        const int r = m0 + ty * 4 + i;
        if (r >= Meff) continue;
        for (int j = 0; j < 4; ++j) {
            const int c = n0 + tx * 4 + j;
            if (c < N) { float* p = C + (size_t)r * ldc + c; *p = ACC ? (*p + acc[i][j]) : acc[i][j]; }
        }
    }
}

__global__ void mprep(const float* U, const float* cw  , const float* bi, const float* bf, float* QK, float* IG, float* LF) {
    const int t = blockIdx.x, c = threadIdx.x;
    float acc = 0.f;
    for (int j = 0; j < 4; ++j) { const int tt = t - 3 + j; if (tt >= 0) acc += cw[j * 512 + c] * U[(size_t)tt * DIN + c]; }
    QK[(size_t)t * 512 + c] = siluf_(acc);
    if (c < 4) {
        IG[t * 4 + c] = U[(size_t)t * DIN + OFF_MI + c] + bi[c];
        const float f = U[(size_t)t * DIN + OFF_MF + c] + bf[c];
        LF[t * 4 + c] = fminf(f, 0.f) - log1pf(expf(-fabsf(f)));
    }
}

__global__ void mlstm_rec(const float* QK, const float* U, const float* IG, const float* LF, float* HM) {
    __shared__ float sq[64][64], sk[64][64], sv[64][64];
    __shared__ float sig[64], slf[64];
    __shared__ float red[2][4][64], redd[2][4][64];
    const int h = blockIdx.x, tid = threadIdx.x, e = tid & 63, dq = tid >> 6;
    float C[16], n[16]; float m = 0.f;
    for (int i = 0; i < 16; ++i) { C[i] = 0.f; n[i] = 0.f; }
    for (int t0 = 0; t0 < S; t0 += 64) {
        __syncthreads();
        for (int i = tid; i < 64 * 64; i += 256) {
            const int tt = i >> 6, d = i & 63;
            sq[tt][d] = QK[(size_t)(t0 + tt) * 512 + h * 64 + d] * 0.125f;
            sk[tt][d] = QK[(size_t)(t0 + tt) * 512 + 256 + h * 64 + d];
            sv[tt][d] = U[(size_t)(t0 + tt) * DIN + OFF_MV + h * 64 + d];
        }
        if (tid < 64) { sig[tid] = IG[(t0 + tid) * 4 + h]; slf[tid] = LF[(t0 + tid) * 4 + h]; }
        __syncthreads();
        for (int tt = 0; tt < 64; ++tt) {
            const float ig = sig[tt], lf = slf[tt];
            const float mn = fmaxf(lf + m, ig), a = expf(lf + m - mn), bb = expf(ig - mn);
            m = mn;
            const float v = sv[tt][e];
            float num = 0.f, den = 0.f;
#pragma unroll
            for (int i = 0; i < 16; ++i) {
                const int d = dq * 16 + i; const float k = sk[tt][d], q = sq[tt][d];
                C[i] = a * C[i] + bb * k * v; n[i] = a * n[i] + bb * k;
                num += q * C[i]; den += q * n[i];
            }
            red[tt & 1][dq][e] = num; redd[tt & 1][dq][e] = den;
            __syncthreads();
            if (dq == 0) {
                const float nu = red[tt & 1][0][e] + red[tt & 1][1][e] + red[tt & 1][2][e] + red[tt & 1][3][e];
                const float de = redd[tt & 1][0][e] + redd[tt & 1][1][e] + redd[tt & 1][2][e] + redd[tt & 1][3][e];
                HM[(size_t)(t0 + tt) * 256 + h * 64 + e] = nu / fmaxf(fabsf(de), expf(-m));
            }
        }
    }
}

__global__ void mgate(const float* HMN, const float* U, float* Y) {
    const int t = blockIdx.x, c = threadIdx.x;
    Y[(size_t)t * D + c] = HMN[(size_t)t * 256 + c] * sigmoidf_(U[(size_t)t * DIN + OFF_MO + c]);
}

__global__ void cglu(const float* U, float* Z) {
    const int t = blockIdx.x, c = threadIdx.x;
    Z[(size_t)t * 256 + c] = U[(size_t)t * DIN + OFF_CA + c] * sigmoidf_(U[(size_t)t * DIN + OFF_CG + c]);
}
__global__ void cconv(const float* Z, const float* w  , const float* b, const float* lg, const float* lb, float* Y) {
    __shared__ float sm[4], sv2[4];
    const int t = blockIdx.x, c = threadIdx.x;
    float acc = b[c];
    for (int j = 0; j < 31; ++j) { const int tt = t - 30 + j; if (tt >= 0) acc += w[j * 256 + c] * Z[(size_t)tt * 256 + c]; }
    float s = wsum(acc);
    if ((c & 63) == 0) sm[c >> 6] = s;
    __syncthreads();
    const float mu = (sm[0] + sm[1] + sm[2] + sm[3]) * (1.f / 256.f);
    const float dv = acc - mu;
    float s2 = wsum(dv * dv);
    if ((c & 63) == 0) sv2[c >> 6] = s2;
    __syncthreads();
    const float var = (sv2[0] + sv2[1] + sv2[2] + sv2[3]) * (1.f / 256.f);
    const float yv = dv * rsqrtf(var + 1e-6f) * lg[c] + lb[c];
    Y[(size_t)t * D + 256 + c] = siluf_(yv);
}

__global__ void attn(const float* QN  , const float* KN  , const float* U, float* O  ) {
    __shared__ float sK[64][65];
    __shared__ float sV[64][128];
    __shared__ float sQ[16][64];
    __shared__ float sP[16][64];
    const int j = blockIdx.y, hd = j >> 1, q0 = blockIdx.x * 16, tid = threadIdx.x, w = tid >> 6, lane = tid & 63;
    const int qpos = q0 + w;
    const float slope = exp2f(-8.f * (float)(hd + 1) / 4.f);
    sQ[w][lane] = QN[(size_t)qpos * 512 + j * 64 + lane];
    float m = -INFINITY, l = 0.f, o0 = 0.f, o1 = 0.f;
    const int ntile = (q0 + 15) / 64 + 1;
    for (int kt = 0; kt < ntile; ++kt) {
        __syncthreads();
        for (int i = tid; i < 64 * 64; i += 1024) { const int r = i >> 6, d = i & 63; sK[r][d] = KN[(size_t)(kt * 64 + r) * 512 + j * 64 + d]; }
        for (int i = tid; i < 64 * 128; i += 1024) { const int r = i >> 7, d = i & 127; sV[r][d] = U[(size_t)(kt * 64 + r) * DIN + OFF_AV + hd * 128 + d]; }
        __syncthreads();
        const int kpos = kt * 64 + lane;
        float s = 0.f;
        for (int d = 0; d < 64; ++d) s += sQ[w][d] * sK[lane][d];
        s = s * 0.125f - slope * (float)(qpos - kpos);
        if (kpos > qpos) s = -INFINITY;
        const float tm = wmax(s), mn = fmaxf(m, tm), corr = expf(m - mn), p = expf(s - mn);
        l = l * corr + wsum(p); o0 *= corr; o1 *= corr; m = mn;
        sP[w][lane] = p;
        __syncthreads();
        for (int k = 0; k < 64; ++k) { const float pk = sP[w][k]; o0 += pk * sV[k][lane]; o1 += pk * sV[k][64 + lane]; }
    }
    O[((size_t)qpos * 8 + j) * 128 + lane] = o0 / l;
    O[((size_t)qpos * 8 + j) * 128 + 64 + lane] = o1 / l;
}
__device__ __forceinline__ float lam_of(const float* q1, const float* k1, const float* q2, const float* k2, float lam_init) {
    float a = 0.f, b = 0.f;
    for (int i = 0; i < 64; ++i) { a += q1[i] * k1[i]; b += q2[i] * k2[i]; }
    return expf(a) - expf(b) + lam_init;
}
__global__ void acomb(const float* O, const float* q1, const float* k1, const float* q2, const float* k2, float lam_init, float* YA  ) {
    const int t = blockIdx.x, c = threadIdx.x;
    const float lam = lam_of(q1, k1, q2, k2, lam_init);
    const int hd = c >> 7, e = c & 127;
    YA[(size_t)t * 512 + c] = O[((size_t)t * 8 + 2 * hd) * 128 + e] - lam * O[((size_t)t * 8 + 2 * hd + 1) * 128 + e];
}
__global__ void swiglu_act(float* G, const float* Uu, int ld, const int* nrows_dev) {
    const int r = blockIdx.x; if (nrows_dev && r >= *nrows_dev) return;
    for (int c = threadIdx.x; c < ld; c += blockDim.x) { const size_t i = (size_t)r * ld + c; G[i] = siluf_(G[i]) * Uu[i]; }
}
__global__ void route(const float* LG  , int* cnt  , int* list  , float* gl  ) {
    const int t = blockIdx.x * blockDim.x + threadIdx.x; if (t >= S) return;
    float v[8]; for (int e = 0; e < 8; ++e) v[e] = LG[t * 8 + e];
    int i0 = 0; for (int e = 1; e < 8; ++e) if (v[e] > v[i0]) i0 = e;
    int i1 = (i0 == 0) ? 1 : 0; for (int e = 0; e < 8; ++e) if (e != i0 && v[e] > v[i1]) i1 = e;
    const float e1 = expf(v[i1] - v[i0]), g0 = 1.f / (1.f + e1), g1 = e1 / (1.f + e1);
    int p0 = atomicAdd(&cnt[i0], 1); list[i0 * S + p0] = t; gl[i0 * S + p0] = g0;
    int p1 = atomicAdd(&cnt[i1], 1); list[i1 * S + p1] = t; gl[i1 * S + p1] = g1;
}
__global__ void scatter_add(const float* Dn  , const int* list, const float* gl, const int* nrows_dev, float* H) {
    const int r = blockIdx.x; if (r >= *nrows_dev) return;
    const int t = list[r]; const float g = gl[r];
    for (int c = threadIdx.x; c < D; c += blockDim.x) H[(size_t)t * D + c] += g * Dn[(size_t)r * D + c];
}
__global__ void ple_apply(const float* GT, const float* PE, float* H) {
    const int t = blockIdx.x;
    for (int c = threadIdx.x; c < D; c += blockDim.x) H[(size_t)t * D + c] += sigmoidf_(GT[(size_t)t * D + c]) * PE[(size_t)t * D + c];
}

static void gemm_l(hipStream_t st, bool acc, const float* A, int lda, const float* B, int ldb, float* C, int ldc, int M, int N, int K, const int* rowlist = nullptr, const int* nrows = nullptr) {
    dim3 g((N + 63) / 64, M / 64);
    if (acc) hipLaunchKernelGGL(gemm<true>, g, dim3(256), 0, st, A, lda, B, ldb, C, ldc, M, N, K, rowlist, nrows);
    else hipLaunchKernelGGL(gemm<false>, g, dim3(256), 0, st, A, lda, B, ldb, C, ldc, M, N, K, rowlist, nrows);
}

static void forward(void* const* d_in, float* out, unsigned char* ws, hipStream_t st) {
    const float* const* in = (const float* const*)d_in;
    size_t off = 0;
    auto take = [&](size_t bytes) { unsigned char* p = ws + off; off += (bytes + 255) & ~(size_t)255; return p; };
    float* A = (float*)take((size_t)S * D * 4);
    float* U = (float*)take((size_t)S * DIN * 4);
    float* QK = (float*)take((size_t)S * 512 * 4);
    float* Y = (float*)take((size_t)S * D * 4);
    float* G = (float*)take((size_t)S * FFE * 4);
    float* U2 = (float*)take((size_t)S * FFE * 4);
    float* IG = (float*)take((size_t)S * 4 * 4);
    float* LF = (float*)take((size_t)S * 4 * 4);
    int* cnt = (int*)take(256);
    int* list = (int*)take((size_t)NE * S * 4);
    float* gl = (float*)take((size_t)NE * S * 4);
    float* HM = G;
    float* HMN = G + (size_t)S * 256;
    float* Z = G + (size_t)S * 512;
    float* QN = G + (size_t)S * 768;
    float* KN = G + (size_t)S * 1280;
    float* YA = G + (size_t)S * 1792;
    float* AO = U2;
    hipMemcpyAsync(out, in[0], (size_t)NB * S * D * 4, hipMemcpyDeviceToDevice, st);
    for (int b = 0; b < NB; ++b) {
        float* H = out + (size_t)b * S * D;
        for (int L = 0; L < 2; ++L) {
            const float lam_init = 0.8f - 0.6f * expf(-0.3f * (float)L);
            hipLaunchKernelGGL(groupnorm, dim3(S), dim3(64), 0, st, H, D, A, D, 1, D, in[2] + L * D, 0, 1.f);
            gemm_l(st, false, A, D, in[3] + (size_t)L * D * DIN, DIN, U, DIN, S, DIN, D);
            hipLaunchKernelGGL(mprep, dim3(S), dim3(512), 0, st, U, in[6] + L * 2048, in[4] + L * 4, in[5] + L * 4, QK, IG, LF);
            hipLaunchKernelGGL(mlstm_rec, dim3(4), dim3(256), 0, st, QK, U, IG, LF, HM);
            hipLaunchKernelGGL(groupnorm, dim3(S * 4), dim3(64), 0, st, HM, 256, HMN, 256, 4, 64, in[7] + L * 256, 64, 1.f);
            hipLaunchKernelGGL(mgate, dim3(S), dim3(256), 0, st, HMN, U, Y);
            hipLaunchKernelGGL(cglu, dim3(S), dim3(256), 0, st, U, Z);
            hipLaunchKernelGGL(cconv, dim3(S), dim3(256), 0, st, Z, in[8] + L * 31 * 256, in[9] + L * 256, in[10] + L * 256, in[11] + L * 256, Y);
            hipLaunchKernelGGL(groupnorm, dim3(S * 8), dim3(64), 0, st, U + OFF_AQ, DIN, QN, 512, 8, 64, in[12] + L * 64, 0, 1.f);
            hipLaunchKernelGGL(groupnorm, dim3(S * 8), dim3(64), 0, st, U + OFF_AK, DIN, KN, 512, 8, 64, in[13] + L * 64, 0, 1.f);
            hipLaunchKernelGGL(attn, dim3(S / 16, 8), dim3(1024), 0, st, QN, KN, U, AO);
            hipLaunchKernelGGL(acomb, dim3(S), dim3(512), 0, st, AO, in[14] + L * 64, in[15] + L * 64, in[16] + L * 64, in[17] + L * 64, lam_init, YA);
            hipLaunchKernelGGL(groupnorm, dim3(S * 4), dim3(64), 0, st, YA, 512, Y + 512, D, 4, 128, in[18] + L * 128, 0, 1.f - lam_init);
            gemm_l(st, true, Y, D, in[19] + (size_t)L * D * D, D, H, D, S, D, D);
            hipLaunchKernelGGL(groupnorm, dim3(S), dim3(64), 0, st, H, D, A, D, 1, D, in[20] + L * D, 0, 1.f);
            if (L == 0) {
                gemm_l(st, false, A, D, in[21], FFD, G, FFD, S, FFD, D);
                gemm_l(st, false, A, D, in[22], FFD, U2, FFD, S, FFD, D);
                hipLaunchKernelGGL(swiglu_act, dim3(S), dim3(256), 0, st, G, U2, FFD, (const int*)nullptr);
                gemm_l(st, true, G, FFD, in[23], D, H, D, S, D, FFD);
            } else {
                float* LG = Y;
                gemm_l(st, false, A, D, in[24], NE, LG, NE, S, NE, D);
                hipMemsetAsync(cnt, 0, 256, st);
                hipLaunchKernelGGL(route, dim3(S / 256), dim3(256), 0, st, LG, cnt, list, gl);
                float* Dn = Y;
                for (int e = 0; e < NE; ++e) {
                    gemm_l(st, false, A, D, in[25] + (size_t)e * D * FFE, FFE, G, FFE, S, FFE, D, list + e * S, cnt + e);
                    gemm_l(st, false, A, D, in[26] + (size_t)e * D * FFE, FFE, U2, FFE, S, FFE, D, list + e * S, cnt + e);
                    hipLaunchKernelGGL(swiglu_act, dim3(S), dim3(256), 0, st, G, U2, FFE, (const int*)(cnt + e));
                    gemm_l(st, false, G, FFE, in[27] + (size_t)e * FFE * D, D, Dn, D, S, D, FFE, nullptr, cnt + e);
                    hipLaunchKernelGGL(scatter_add, dim3(S), dim3(256), 0, st, Dn, list + e * S, gl + e * S, (const int*)(cnt + e), H);
                }
            }
            hipLaunchKernelGGL(groupnorm, dim3(S), dim3(64), 0, st, H, D, A, D, 1, D, in[28] + L * D, 0, 1.f);
            gemm_l(st, false, A, D, in[29] + (size_t)L * D * D, D, G, D, S, D, D);
            gemm_l(st, false, in[1] + ((size_t)L * NB + b) * S * PLE, PLE, in[30] + (size_t)L * PLE * D, D, U2, D, S, D, PLE);
            hipLaunchKernelGGL(ple_apply, dim3(S), dim3(256), 0, st, G, U2, H);
        }
    }
}
}
extern "C" void kernel_launch(void* const* d_in, const int* in_sizes, int n_in, void* d_out, int out_size, void* d_ws, size_t ws_size, hipStream_t stream) {
    nv::forward(d_in, (float*)d_out, (unsigned char*)d_ws, stream);
}
```

```cpp
#include <hip/hip_runtime.h>
#include <cstdio>
#include <cstdint>
#include <cmath>
namespace nv {
constexpr int S = 8192, D = 1024, DIN = 3080, NB = 4;
constexpr int FFD = 2816, FFE = 3584, NE = 8, PLE = 256;
constexpr int OFF_MQ = 0, OFF_MK = 256, OFF_MV = 512, OFF_MO = 768, OFF_MI = 1024, OFF_MF = 1028, OFF_CA = 1032, OFF_CG = 1288, OFF_AQ = 1544, OFF_AK = 2056, OFF_AV = 2568;

__device__ __forceinline__ float sigmoidf_(float x) { return 1.f / (1.f + expf(-x)); }
__device__ __forceinline__ float siluf_(float x) { return x / (1.f + expf(-x)); }
__device__ __forceinline__ float wsum(float v) { for (int o = 32; o > 0; o >>= 1) v += __shfl_xor(v, o); return v; }
__device__ __forceinline__ float wmax(float v) { for (int o = 32; o > 0; o >>= 1) v = fmaxf(v, __shfl_xor(v, o)); return v; }

__global__ void groupnorm(const float* in, int ldi, float* out, int ldo, int ngroups, int gdim, const float* gain, int gain_stride, float scale) {
    const int rg = blockIdx.x, row = rg / ngroups, g = rg % ngroups, lane = threadIdx.x;
    const float* x = in + (size_t)row * ldi + g * gdim;
    float s = 0.f;
    for (int i = lane; i < gdim; i += 64) s += x[i] * x[i];
    s = wsum(s);
    const float r = rsqrtf(s / (float)gdim + 1e-6f);
    float* o = out + (size_t)row * ldo + g * gdim;
    for (int i = lane; i < gdim; i += 64) o[i] = x[i] * r * gain[g * gain_stride + i] * scale;
}

template <bool ACC>
__global__ void gemm(const float* A, int lda, const float* B, int ldb, float* C, int ldc, int M, int N, int K, const int* rowlist, const int* nrows_dev) {
    __shared__ float As[16][65];
    __shared__ float Bs[16][64];
    const int Meff = nrows_dev ? *nrows_dev : M;
    const int m0 = blockIdx.y * 64, n0 = blockIdx.x * 64;
    if (m0 >= Meff) return;
    const int tid = threadIdx.x, ty = tid >> 4, tx = tid & 15;
    float acc[4][4];
    for (int i = 0; i < 4; ++i) for (int j = 0; j < 4; ++j) acc[i][j] = 0.f;
    for (int k0 = 0; k0 < K; k0 += 16) {
        for (int i = 0; i < 4; ++i) {
            const int idx = tid + i * 256, r = idx >> 4, kk = idx & 15;
            float v = 0.f;
            if (m0 + r < Meff) { const int ar = rowlist ? rowlist[m0 + r] : (m0 + r); v = A[(size_t)ar * lda + k0 + kk]; }
            As[kk][r] = v;
        }
        for (int i = 0; i < 4; ++i) {
            const int idx = tid + i * 256, kk = idx >> 6, c = idx & 63;
            Bs[kk][c] = (n0 + c < N) ? B[(size_t)(k0 + kk) * ldb + n0 + c] : 0.f;
        }
        __syncthreads();
#pragma unroll
        for (int kk = 0; kk < 16; ++kk) {
            float a[4], b[4];
            for (int i = 0; i < 4; ++i) a[i] = As[kk][ty * 4 + i];
            for (int j = 0; j < 4; ++j) b[j] = Bs[kk][tx * 4 + j];
            for (int i = 0; i < 4; ++i) for (int j = 0; j < 4; ++j) acc[i][j] += a[i] * b[j];
        }
        __syncthreads();
    }
    for (int i = 0; i < 4; ++i) {
        const int r = m0 + ty * 4 + i;
        if (r >= Meff) continue;
        for (int j = 0; j < 4; ++j) {
            const int c = n0 + tx * 4 + j;
            if (c < N) { float* p = C + (size_t)r * ldc + c; *p = ACC ? (*p + acc[i][j]) : acc[i][j]; }
        }
    }
}

__global__ void mprep(const float* U, const float* cw  , const float* bi, const float* bf, float* QK, float* IG, float* LF) {
    const int t = blockIdx.x, c = threadIdx.x;
    float acc = 0.f;
    for (int j = 0; j < 4; ++j) { const int tt = t - 3 + j; if (tt >= 0) acc += cw[j * 512 + c] * U[(size_t)tt * DIN + c]; }
    QK[(size_t)t * 512 + c] = siluf_(acc);
    if (c < 4) {
        IG[t * 4 + c] = U[(size_t)t * DIN + OFF_MI + c] + bi[c];
        const float f = U[(size_t)t * DIN + OFF_MF + c] + bf[c];
        LF[t * 4 + c] = fminf(f, 0.f) - log1pf(expf(-fabsf(f)));
    }
}

__global__ void mlstm_rec(const float* QK, const float* U, const float* IG, const float* LF, float* HM) {
    __shared__ float sq[64][64], sk[64][64], sv[64][64];
    __shared__ float sig[64], slf[64];
    __shared__ float red[2][4][64], redd[2][4][64];
    const int h = blockIdx.x, tid = threadIdx.x, e = tid & 63, dq = tid >> 6;
    float C[16], n[16]; float m = 0.f;
    for (int i = 0; i < 16; ++i) { C[i] = 0.f; n[i] = 0.f; }
    for (int t0 = 0; t0 < S; t0 += 64) {
        __syncthreads();
        for (int i = tid; i < 64 * 64; i += 256) {
            const int tt = i >> 6, d = i & 63;
            sq[tt][d] = QK[(size_t)(t0 + tt) * 512 + h * 64 + d] * 0.125f;
            sk[tt][d] = QK[(size_t)(t0 + tt) * 512 + 256 + h * 64 + d];
            sv[tt][d] = U[(size_t)(t0 + tt) * DIN + OFF_MV + h * 64 + d];
        }
        if (tid < 64) { sig[tid] = IG[(t0 + tid) * 4 + h]; slf[tid] = LF[(t0 + tid) * 4 + h]; }
        __syncthreads();
        for (int tt = 0; tt < 64; ++tt) {
            const float ig = sig[tt], lf = slf[tt];
            const float mn = fmaxf(lf + m, ig), a = expf(lf + m - mn), bb = expf(ig - mn);
            m = mn;
            const float v = sv[tt][e];
            float num = 0.f, den = 0.f;
#pragma unroll
            for (int i = 0; i < 16; ++i) {
                const int d = dq * 16 + i; const float k = sk[tt][d], q = sq[tt][d];
                C[i] = a * C[i] + bb * k * v; n[i] = a * n[i] + bb * k;
                num += q * C[i]; den += q * n[i];
            }
            red[tt & 1][dq][e] = num; redd[tt & 1][dq][e] = den;
            __syncthreads();
            if (dq == 0) {
                const float nu = red[tt & 1][0][e] + red[tt & 1][1][e] + red[tt & 1][2][e] + red[tt & 1][3][e];
                const float de = redd[tt & 1][0][e] + redd[tt & 1][1][e] + redd[tt & 1][2][e] + redd[tt & 1][3][e];
                HM[(size_t)(t0 + tt) * 256 + h * 64 + e] = nu / fmaxf(fabsf(de), expf(-m));
            }
        }
    }
}

__global__ void mgate(const float* HMN, const float* U, float* Y) {
    const int t = blockIdx.x, c = threadIdx.x;
    Y[(size_t)t * D + c] = HMN[(size_t)t * 256 + c] * sigmoidf_(U[(size_t)t * DIN + OFF_MO + c]);
}

__global__ void cglu(const float* U, float* Z) {
    const int t = blockIdx.x, c = threadIdx.x;
    Z[(size_t)t * 256 + c] = U[(size_t)t * DIN + OFF_CA + c] * sigmoidf_(U[(size_t)t * DIN + OFF_CG + c]);
}
__global__ void cconv(const float* Z, const float* w  , const float* b, const float* lg, const float* lb, float* Y) {
    __shared__ float sm[4], sv2[4];
    const int t = blockIdx.x, c = threadIdx.x;
    float acc = b[c];
    for (int j = 0; j < 31; ++j) { const int tt = t - 30 + j; if (tt >= 0) acc += w[j * 256 + c] * Z[(size_t)tt * 256 + c]; }
    float s = wsum(acc);
    if ((c & 63) == 0) sm[c >> 6] = s;
    __syncthreads();
    const float mu = (sm[0] + sm[1] + sm[2] + sm[3]) * (1.f / 256.f);
    const float dv = acc - mu;
    float s2 = wsum(dv * dv);
    if ((c & 63) == 0) sv2[c >> 6] = s2;
    __syncthreads();
    const float var = (sv2[0] + sv2[1] + sv2[2] + sv2[3]) * (1.f / 256.f);
    const float yv = dv * rsqrtf(var + 1e-6f) * lg[c] + lb[c];
    Y[(size_t)t * D + 256 + c] = siluf_(yv);
}

__global__ void attn(const float* QN  , const float* KN  , const float* U, float* O  ) {
    __shared__ float sK[64][65];
    __shared__ float sV[64][128];
    __shared__ float sQ[16][64];
    __shared__ float sP[16][64];
    const int j = blockIdx.y, hd = j >> 1, q0 = blockIdx.x * 16, tid = threadIdx.x, w = tid >> 6, lane = tid & 63;
    const int qpos = q0 + w;
    const float slope = exp2f(-8.f * (float)(hd + 1) / 4.f);
    sQ[w][lane] = QN[(size_t)qpos * 512 + j * 64 + lane];
    float m = -INFINITY, l = 0.f, o0 = 0.f, o1 = 0.f;
    const int ntile = (q0 + 15) / 64 + 1;
    for (int kt = 0; kt < ntile; ++kt) {
        __syncthreads();
        for (int i = tid; i < 64 * 64; i += 1024) { const int r = i >> 6, d = i & 63; sK[r][d] = KN[(size_t)(kt * 64 + r) * 512 + j * 64 + d]; }
        for (int i = tid; i < 64 * 128; i += 1024) { const int r = i >> 7, d = i & 127; sV[r][d] = U[(size_t)(kt * 64 + r) * DIN + OFF_AV + hd * 128 + d]; }
        __syncthreads();
        const int kpos = kt * 64 + lane;
        float s = 0.f;
        for (int d = 0; d < 64; ++d) s += sQ[w][d] * sK[lane][d];
        s = s * 0.125f - slope * (float)(qpos - kpos);
        if (kpos > qpos) s = -INFINITY;
        const float tm = wmax(s), mn = fmaxf(m, tm), corr = expf(m - mn), p = expf(s - mn);
        l = l * corr + wsum(p); o0 *= corr; o1 *= corr; m = mn;
        sP[w][lane] = p;
        __syncthreads();
        for (int k = 0; k < 64; ++k) { const float pk = sP[w][k]; o0 += pk * sV[k][lane]; o1 += pk * sV[k][64 + lane]; }
    }
    O[((size_t)qpos * 8 + j) * 128 + lane] = o0 / l;
    O[((size_t)qpos * 8 + j) * 128 + 64 + lane] = o1 / l;
}
__device__ __forceinline__ float lam_of(const float* q1, const float* k1, const float* q2, const float* k2, float lam_init) {
    float a = 0.f, b = 0.f;
    for (int i = 0; i < 64; ++i) { a += q1[i] * k1[i]; b += q2[i] * k2[i]; }
    return expf(a) - expf(b) + lam_init;
}
__global__ void acomb(const float* O, const float* q1, const float* k1, const float* q2, const float* k2, float lam_init, float* YA  ) {
    const int t = blockIdx.x, c = threadIdx.x;
    const float lam = lam_of(q1, k1, q2, k2, lam_init);
    const int hd = c >> 7, e = c & 127;
    YA[(size_t)t * 512 + c] = O[((size_t)t * 8 + 2 * hd) * 128 + e] - lam * O[((size_t)t * 8 + 2 * hd + 1) * 128 + e];
}
__global__ void swiglu_act(float* G, const float* Uu, int ld, const int* nrows_dev) {
    const int r = blockIdx.x; if (nrows_dev && r >= *nrows_dev) return;
    for (int c = threadIdx.x; c < ld; c += blockDim.x) { const size_t i = (size_t)r * ld + c; G[i] = siluf_(G[i]) * Uu[i]; }
}
__global__ void route(const float* LG  , int* cnt  , int* list  , float* gl  ) {
    const int t = blockIdx.x * blockDim.x + threadIdx.x; if (t >= S) return;
    float v[8]; for (int e = 0; e < 8; ++e) v[e] = LG[t * 8 + e];
    int i0 = 0; for (int e = 1; e < 8; ++e) if (v[e] > v[i0]) i0 = e;
    int i1 = (i0 == 0) ? 1 : 0; for (int e = 0; e < 8; ++e) if (e != i0 && v[e] > v[i1]) i1 = e;
    const float e1 = expf(v[i1] - v[i0]), g0 = 1.f / (1.f + e1), g1 = e1 / (1.f + e1);
    int p0 = atomicAdd(&cnt[i0], 1); list[i0 * S + p0] = t; gl[i0 * S + p0] = g0;
    int p1 = atomicAdd(&cnt[i1], 1); list[i1 * S + p1] = t; gl[i1 * S + p1] = g1;
}
__global__ void scatter_add(const float* Dn  , const int* list, const float* gl, const int* nrows_dev, float* H) {
    const int r = blockIdx.x; if (r >= *nrows_dev) return;
    const int t = list[r]; const float g = gl[r];
    for (int c = threadIdx.x; c < D; c += blockDim.x) H[(size_t)t * D + c] += g * Dn[(size_t)r * D + c];
}
__global__ void ple_apply(const float* GT, const float* PE, float* H) {
    const int t = blockIdx.x;
    for (int c = threadIdx.x; c < D; c += blockDim.x) H[(size_t)t * D + c] += sigmoidf_(GT[(size_t)t * D + c]) * PE[(size_t)t * D + c];
}

static void gemm_l(hipStream_t st, bool acc, const float* A, int lda, const float* B, int ldb, float* C, int ldc, int M, int N, int K, const int* rowlist = nullptr, const int* nrows = nullptr) {
    dim3 g((N + 63) / 64, M / 64);
    if (acc) hipLaunchKernelGGL(gemm<true>, g, dim3(256), 0, st, A, lda, B, ldb, C, ldc, M, N, K, rowlist, nrows);
    else hipLaunchKernelGGL(gemm<false>, g, dim3(256), 0, st, A, lda, B, ldb, C, ldc, M, N, K, rowlist, nrows);
}

static void forward(void* const* d_in, float* out, unsigned char* ws, hipStream_t st) {
    const float* const* in = (const float* const*)d_in;
    size_t off = 0;
    auto take = [&](size_t bytes) { unsigned char* p = ws + off; off += (bytes + 255) & ~(size_t)255; return p; };
    float* A = (float*)take((size_t)S * D * 4);
    float* U = (float*)take((size_t)S * DIN * 4);
    float* QK = (float*)take((size_t)S * 512 * 4);
    float* Y = (float*)take((size_t)S * D * 4);
    float* G = (float*)take((size_t)S * FFE * 4);
    float* U2 = (float*)take((size_t)S * FFE * 4);
    float* IG = (float*)take((size_t)S * 4 * 4);
    float* LF = (float*)take((size_t)S * 4 * 4);
    int* cnt = (int*)take(256);
    int* list = (int*)take((size_t)NE * S * 4);
    float* gl = (float*)take((size_t)NE * S * 4);
    float* HM = G;
    float* HMN = G + (size_t)S * 256;
    float* Z = G + (size_t)S * 512;
    float* QN = G + (size_t)S * 768;
    float* KN = G + (size_t)S * 1280;
    float* YA = G + (size_t)S * 1792;
    float* AO = U2;
    hipMemcpyAsync(out, in[0], (size_t)NB * S * D * 4, hipMemcpyDeviceToDevice, st);
    for (int b = 0; b < NB; ++b) {
        float* H = out + (size_t)b * S * D;
        for (int L = 0; L < 2; ++L) {
            const float lam_init = 0.8f - 0.6f * expf(-0.3f * (float)L);
            hipLaunchKernelGGL(groupnorm, dim3(S), dim3(64), 0, st, H, D, A, D, 1, D, in[2] + L * D, 0, 1.f);
            gemm_l(st, false, A, D, in[3] + (size_t)L * D * DIN, DIN, U, DIN, S, DIN, D);
            hipLaunchKernelGGL(mprep, dim3(S), dim3(512), 0, st, U, in[6] + L * 2048, in[4] + L * 4, in[5] + L * 4, QK, IG, LF);
            hipLaunchKernelGGL(mlstm_rec, dim3(4), dim3(256), 0, st, QK, U, IG, LF, HM);
            hipLaunchKernelGGL(groupnorm, dim3(S * 4), dim3(64), 0, st, HM, 256, HMN, 256, 4, 64, in[7] + L * 256, 64, 1.f);
            hipLaunchKernelGGL(mgate, dim3(S), dim3(256), 0, st, HMN, U, Y);
            hipLaunchKernelGGL(cglu, dim3(S), dim3(256), 0, st, U, Z);
            hipLaunchKernelGGL(cconv, dim3(S), dim3(256), 0, st, Z, in[8] + L * 31 * 256, in[9] + L * 256, in[10] + L * 256, in[11] + L * 256, Y);
            hipLaunchKernelGGL(groupnorm, dim3(S * 8), dim3(64), 0, st, U + OFF_AQ, DIN, QN, 512, 8, 64, in[12] + L * 64, 0, 1.f);
            hipLaunchKernelGGL(groupnorm, dim3(S * 8), dim3(64), 0, st, U + OFF_AK, DIN, KN, 512, 8, 64, in[13] + L * 64, 0, 1.f);
            hipLaunchKernelGGL(attn, dim3(S / 16, 8), dim3(1024), 0, st, QN, KN, U, AO);
            hipLaunchKernelGGL(acomb, dim3(S), dim3(512), 0, st, AO, in[14] + L * 64, in[15] + L * 64, in[16] + L * 64, in[17] + L * 64, lam_init, YA);
            hipLaunchKernelGGL(groupnorm, dim3(S * 4), dim3(64), 0, st, YA, 512, Y + 512, D, 4, 128, in[18] + L * 128, 0, 1.f - lam_init);
            gemm_l(st, true, Y, D, in[19] + (size_t)L * D * D, D, H, D, S, D, D);
            hipLaunchKernelGGL(groupnorm, dim3(S), dim3(64), 0, st, H, D, A, D, 1, D, in[20] + L * D, 0, 1.f);
            if (L == 0) {
                gemm_l(st, false, A, D, in[21], FFD, G, FFD, S, FFD, D);
                gemm_l(st, false, A, D, in[22], FFD, U2, FFD, S, FFD, D);
                hipLaunchKernelGGL(swiglu_act, dim3(S), dim3(256), 0, st, G, U2, FFD, (const int*)nullptr);
                gemm_l(st, true, G, FFD, in[23], D, H, D, S, D, FFD);
            } else {
                float* LG = Y;
                gemm_l(st, false, A, D, in[24], NE, LG, NE, S, NE, D);
                hipMemsetAsync(cnt, 0, 256, st);
                hipLaunchKernelGGL(route, dim3(S / 256), dim3(256), 0, st, LG, cnt, list, gl);
                float* Dn = Y;
                for (int e = 0; e < NE; ++e) {
                    gemm_l(st, false, A, D, in[25] + (size_t)e * D * FFE, FFE, G, FFE, S, FFE, D, list + e * S, cnt + e);
                    gemm_l(st, false, A, D, in[26] + (size_t)e * D * FFE, FFE, U2, FFE, S, FFE, D, list + e * S, cnt + e);
                    hipLaunchKernelGGL(swiglu_act, dim3(S), dim3(256), 0, st, G, U2, FFE, (const int*)(cnt + e));
                    gemm_l(st, false, G, FFE, in[27] + (size_t)e * FFE * D, D, Dn, D, S, D, FFE, nullptr, cnt + e);
                    hipLaunchKernelGGL(scatter_add, dim3(S), dim3(256), 0, st, Dn, list + e * S, gl + e * S, (const int*)(cnt + e), H);
                }
            }
            hipLaunchKernelGGL(groupnorm, dim3(S), dim3(64), 0, st, H, D, A, D, 1, D, in[28] + L * D, 0, 1.f);
            gemm_l(st, false, A, D, in[29] + (size_t)L * D * D, D, G, D, S, D, D);
            gemm_l(st, false, in[1] + ((size_t)L * NB + b) * S * PLE, PLE, in[30] + (size_t)L * PLE * D, D, U2, D, S, D, PLE);
            hipLaunchKernelGGL(ple_apply, dim3(S), dim3(256), 0, st, G, U2, H);
        }
    }
}
}
#define GAS __attribute__((address_space(1)))
#define LAS __attribute__((address_space(3)))
typedef unsigned short bf16_t;
typedef unsigned u32x4 __attribute__((ext_vector_type(4)));
typedef unsigned u32x2 __attribute__((ext_vector_type(2)));
typedef float f32x4 __attribute__((ext_vector_type(4)));
typedef float f32x2 __attribute__((ext_vector_type(2)));
typedef short bf16x8 __attribute__((ext_vector_type(8)));
typedef GAS unsigned gu32;
#define RLX_AGENT __ATOMIC_RELAXED, __HIP_MEMORY_SCOPE_AGENT

constexpr int NB = 4, SEQ = 8192, M = NB * SEQ, D = 1024, DIN = 3080;
constexpr int FFD = 2816, FFE = 3584, NE = 8, PLE = 256;
constexpr int UW = 2816;
constexpr int UC_MQ = 0, UC_MK = 256, UC_MV = 512, UC_MO = 768, UC_Z = 1024, UC_Q = 1280, UC_K = 1792, UC_V = 2304;
constexpr int NIN = 3072;
constexpr float EPS = 1e-6f;
constexpr float C2 = 0.125f * 1.4426950408889634f;
constexpr int MOE_MAXROWS = M + NE * 256;

constexpr size_t MiB = 1u << 20;
constexpr size_t WS_CTL = 0, CTL_ZERO_BYTES = 1 * MiB;
constexpr size_t WS_WIN = 1 * MiB;
constexpr size_t WS_WOUT = WS_WIN + 12 * MiB;
constexpr size_t WS_WDGU = WS_WOUT + 4 * MiB;
constexpr size_t WS_WDD = WS_WDGU + 11 * MiB;
constexpr size_t WS_WMGU = WS_WDD + 6 * MiB;
constexpr size_t WS_WMD = WS_WMGU + 112 * MiB;
constexpr size_t WS_WPG = WS_WMD + 56 * MiB;
constexpr size_t WS_WPP = WS_WPG + 4 * MiB;
constexpr size_t WS_WSM = WS_WPP + 1 * MiB;
constexpr size_t WS_GATE = WS_WSM + 1 * MiB;
constexpr size_t WS_MOE = WS_GATE + 1 * MiB;
constexpr size_t WS_MST = WS_MOE + 3 * MiB;
constexpr size_t WS_AY = WS_MST + 34 * MiB;
constexpr size_t WS_BIG = WS_AY + 64 * MiB;
constexpr size_t WS_END = WS_BIG + 238 * MiB;
static_assert((size_t)MOE_MAXROWS * FFE * 2 <= 238 * MiB, "act fits");
static_assert((size_t)M * UW * 2 <= 176 * MiB, "u fits");

constexpr int CW_TMO = 0, CW_CODE = 1;
constexpr int CW_BAR = 4096;
constexpr int CW_CNT = 16384;
constexpr size_t MOE_GATEV = 0;
constexpr size_t MOE_EIDX = 2 * (size_t)M * 4;
constexpr size_t MOE_LIST = 4 * (size_t)M * 4;
static_assert(MOE_LIST + 16 * (size_t)M * 4 <= 3 * MiB, "moe region");

constexpr int RING_BYTES = 131072;
constexpr int LDSCTL_OFF = RING_BYTES, MISC_OFF = LDSCTL_OFF + 320;
constexpr int TAB_OFF = RING_BYTES + 1024;
constexpr int LDS_BYTES = 163840;
constexpr int NWAVES = 8;

__device__ __forceinline__ unsigned f2bf(float f) { unsigned u = __builtin_bit_cast(unsigned, f); return (u + 0x7fffu + ((u >> 16) & 1u)) >> 16; }
__device__ __forceinline__ unsigned pk2(float lo, float hi) { return f2bf(lo) | (f2bf(hi) << 16); }
__device__ __forceinline__ float bf2f(unsigned short b) { return __builtin_bit_cast(float, (unsigned)b << 16); }
__device__ __forceinline__ float bflo(unsigned w) { return __builtin_bit_cast(float, w << 16); }
__device__ __forceinline__ float bfhi(unsigned w) { return __builtin_bit_cast(float, w & 0xffff0000u); }
__device__ __forceinline__ unsigned cvt_pk_bf16(float lo, float hi) { unsigned r; asm volatile("v_cvt_pk_bf16_f32 %0, %1, %2" : "=v"(r) : "v"(lo), "v"(hi)); return r; }
__device__ __forceinline__ float fast_sigmoid(float x) { return __builtin_amdgcn_rcpf(1.f + __builtin_amdgcn_exp2f(-1.4426950408889634f * x)); }
__device__ __forceinline__ float wave_sum(float v) {
#pragma unroll
    for (int o = 1; o < 64; o <<= 1) v += __shfl_xor(v, o);
    return v;
}
__device__ __forceinline__ float wave_max(float v) {
#pragma unroll
    for (int o = 1; o < 64; o <<= 1) v = fmaxf(v, __shfl_xor(v, o));
    return v;
}

#define XB_TMO      128
#define XB_XCNT(j)  (256  + 64 * (j))
#define XB_XSUB(j)  (1280 + 64 * (j))
#define XB_XGEN(j)  (2304 + 64 * (j))
#define XB_TOP      3328
#define XB_TOPGEN   3392
#define XCD_BAR_WORDS 3456
#define XB_SPIN_CAP (1u << 22)
__device__ __forceinline__ unsigned xb_ld(unsigned* p)              { return __hip_atomic_load(p, __ATOMIC_RELAXED, __HIP_MEMORY_SCOPE_AGENT); }
__device__ __forceinline__ unsigned xb_add(unsigned* p, unsigned v) { return __hip_atomic_fetch_add(p, v, __ATOMIC_RELAXED, __HIP_MEMORY_SCOPE_AGENT); }
__device__ __forceinline__ unsigned xb_xcc_id() { return (unsigned)__builtin_amdgcn_s_getreg((3 << 11) | 20) & 0xFu; }
#define XB_SPIN(cond, bar) do { unsigned _sp = 0; while (cond) { __builtin_amdgcn_s_sleep(1); \
    if ((++_sp & 255u) == 0u) { if (xb_ld(&(bar)[XB_TMO])) break; if (_sp > XB_SPIN_CAP) { atomicAdd(&(bar)[XB_TMO], 1u); break; } } } } while (0)
struct XcdBarrier { unsigned* bar; unsigned x; volatile LAS unsigned* st; };
__device__ __forceinline__ XcdBarrier xcd_barrier_post(unsigned* bar, volatile LAS unsigned* st) {
    XcdBarrier b; b.bar = bar; b.x = xb_xcc_id(); b.st = st;
    if (threadIdx.x == 0) (void)xb_add(&bar[XB_XCNT(b.x)], 1u);
    return b;
}
__device__ __forceinline__ void xcd_barrier_complete(unsigned* bar, unsigned x, unsigned& nloc, unsigned& nx) {
    const unsigned G = gridDim.x * gridDim.y * gridDim.z;
    unsigned sum, cnt, mine, sp = 0u;
    for (;;) {
        sum = 0u; cnt = 0u; mine = 0u;
#pragma unroll
        for (unsigned j = 0; j < 16; ++j) { const unsigned c = xb_ld(&bar[XB_XCNT(j)]); sum += c; cnt += (c > 0u) ? 1u : 0u; mine = (j == x) ? c : mine; }
        if (sum == G) break;
        __builtin_amdgcn_s_sleep(1);
        if ((++sp & 255u) == 0u) { if (xb_ld(&bar[XB_TMO])) break; if (sp > XB_SPIN_CAP) { atomicAdd(&bar[XB_TMO], 1u); break; } }
    }
    nloc = mine > 0u ? mine : 1u; nx = cnt > 0u ? cnt : 1u;
}
__device__ __forceinline__ void xcd_barrier(const XcdBarrier& b) {
    asm volatile("s_waitcnt vmcnt(0)" ::: "memory");
    __syncthreads();
    if (threadIdx.x == 0) {
        unsigned* bar = b.bar;
        __builtin_amdgcn_s_waitcnt(0);
        unsigned nloc = b.st[0], nx = b.st[1];
        if (nloc == 0u) { xcd_barrier_complete(bar, b.x, nloc, nx); b.st[0] = nloc; b.st[1] = nx; }
        const unsigned old = xb_add(&bar[XB_XSUB(b.x)], 1u);
        const unsigned gen = old / nloc;
        if (old + 1u == (gen + 1u) * nloc) {
            __builtin_amdgcn_fence(__ATOMIC_RELEASE, "agent");
            asm volatile("s_waitcnt vmcnt(0)" ::: "memory");
            const unsigned og = xb_add(&bar[XB_TOP], 1u);
            const unsigned tg = og / nx;
            if (og + 1u == (tg + 1u) * nx) xb_add(&bar[XB_TOPGEN], 1u);
            else XB_SPIN(xb_ld(&bar[XB_TOPGEN]) == tg, bar);
            __builtin_amdgcn_fence(__ATOMIC_ACQUIRE, "agent");
            xb_add(&bar[XB_XGEN(b.x)], 1u);
            asm volatile("s_waitcnt vmcnt(0)" ::: "memory");
        } else {
            XB_SPIN(xb_ld(&bar[XB_XGEN(b.x)]) == gen, bar);
            __builtin_amdgcn_fence(__ATOMIC_ACQUIRE, "agent");
            asm volatile("s_waitcnt vmcnt(0)" ::: "memory");
        }
    }
    __syncthreads();
}

namespace pg8 {
constexpr int BM = 256, BK = 64, HALF = 128, HTB = HALF * BK * 2, STAGE_BYTES = 8 * HTB, NXCD = 8, WGM = 8;
__host__ __device__ __forceinline__ int lds_byte(int r, int c) { const int st = (r >> 4) * 2 + (c >> 5), rr = r & 15, cc = c & 31, ob = rr * 64 + cc * 2; return st * 1024 + (ob ^ (((ob >> 9) & 1) << 5)); }
__host__ __device__ __forceinline__ void stage_rc(int b, int& R, int& C) { const int st = b / 1024, sb = b % 1024, swz = sb ^ (((sb >> 9) & 1) << 5); R = (st >> 1) * 16 + swz / 64; C = (st & 1) * 32 + (swz % 64) / 2; }
__host__ __device__ __forceinline__ int perm32(int rho) { const int n = rho >> 4, i = rho & 15; return 8 * (i >> 2) + 4 * n + (i & 3); }

struct Unit { int pm, pn, pb; };

struct StaticOrder {
    int nM, nN, nwg, G, c;
    __device__ void init(int nM_, int nN_, int G_, int c_) { nM = nM_; nN = nN_; nwg = nM * nN; G = G_; c = c_; }
    __device__ __forceinline__ bool tile(int i, int& pm, int& pn) const {
        const long L = (long)i * G + c; if (L >= nwg) return false;
        int wgid = (int)L; { const int q = nwg / NXCD, r = nwg % NXCD, xcd = wgid % NXCD, off = wgid / NXCD; wgid = (xcd < r ? xcd * (q + 1) : r * (q + 1) + (xcd - r) * q) + off; }
        const int nig = WGM * nN, gid = wgid / nig, fm = gid * WGM, gsz = (nM - fm) < WGM ? (nM - fm) : WGM;
        pm = fm + ((wgid % nig) % gsz); pn = (wgid % nig) / gsz; return true;
    }
    __device__ __forceinline__ bool next(int i, Unit& u) const { if (!tile(i, u.pm, u.pn)) return false; u.pb = u.pn; return true; }
};

template <class Epi, class Sched, class AOff, bool ALIGN_EPI>
__device__ __forceinline__ void gemm_phase(LAS unsigned char* lds, const bf16_t* A, const bf16_t* Bt, int K, const Sched& S, const Epi& E, const AOff& AO) {
    int tid_ = threadIdx.x; asm volatile("" : "+v"(tid_));
    asm volatile("" : "+s"(A), "+s"(Bt), "+s"(K));
    const int tid = tid_, wid = __builtin_amdgcn_readfirstlane(tid >> 6), lane = tid & 63, wr = wid >> 2, wc = wid & 3, fr = lane & 15, fq = lane >> 4;
    const int nt = K / BK;
    int R0, C0, R1, C1; stage_rc(tid * 16, R0, C0); stage_rc(tid * 16 + 8192, R1, C1);
    unsigned voffB[2]; voffB[0] = (unsigned)(R0 * K + C0) * 2u; voffB[1] = (unsigned)(R1 * K + C1) * 2u;
    const size_t kstep = (size_t)(BK * 2);
    const size_t hstep = (size_t)HALF * K * 2;
    const size_t tstep = 2 * hstep;
    const unsigned ldsw = (unsigned)wid * 1024u;
    const int aoff = lds_byte(wr * 64 + fr, fq * 8), boff = lds_byte(wc * 32 + fr, fq * 8);
    const char* Ab = (const char*)A;
#define PG8_SA(b, h) (((b) * 2 + (h)) * HTB)
#define PG8_SB(b, h) ((4 + (b) * 2 + (h)) * HTB)
#define PG8_STAGE(bufoff, gbase, voff) do { _Pragma("unroll") for (int _i = 0; _i < 2; ++_i) \
        __builtin_amdgcn_global_load_lds((const unsigned*)((const char*)(gbase) + (voff)[_i]), (LAS unsigned*)(lds + (bufoff) + ldsw + _i * 8192), 16, 0, 0); } while (0)
#define PG8_LDA(dst, b, h) do { _Pragma("unroll") for (int m = 0; m < 4; ++m) _Pragma("unroll") for (int k = 0; k < 2; ++k) dst[m][k] = *(const LAS bf16x8*)(lds + PG8_SA(b, h) + aoff + m * 2048 + k * 1024); } while (0)
#define PG8_LDB(dst, b, h) do { _Pragma("unroll") for (int n = 0; n < 2; ++n) _Pragma("unroll") for (int k = 0; k < 2; ++k) dst[n][k] = *(const LAS bf16x8*)(lds + PG8_SB(b, h) + boff + n * 2048 + k * 1024); } while (0)
#define PG8_MMA(ai, bj, At, Bt_) do { __builtin_amdgcn_s_setprio(1); _Pragma("unroll") for (int m = 0; m < 4; ++m) _Pragma("unroll") for (int n = 0; n < 2; ++n) _Pragma("unroll") for (int k = 0; k < 2; ++k) \
        acc[ai][bj][m][n] = __builtin_amdgcn_mfma_f32_16x16x32_bf16(Bt_[n][k], At[m][k], acc[ai][bj][m][n], 0, 0, 0); __builtin_amdgcn_s_setprio(0); } while (0)
#define PG8_WAIT_V(n) asm volatile("s_waitcnt vmcnt(" #n ")" ::: "memory")
#define PG8_WAIT_L(n) asm volatile("s_waitcnt lgkmcnt(" #n ")" ::: "memory")
#define PG8_BAR __builtin_amdgcn_s_barrier()
#define PG8_SCHED __builtin_amdgcn_sched_barrier(0)
    Unit cur, nxt; int ui = 0;
    if (!S.next(0, cur)) return;
    f32x4 acc[2][2][4][2];
#pragma unroll
    for (int a = 0; a < 2; ++a)
#pragma unroll
        for (int b = 0; b < 2; ++b)
#pragma unroll
            for (int m = 0; m < 4; ++m)
#pragma unroll
                for (int n = 0; n < 2; ++n) acc[a][b][m][n] = (f32x4){0.f, 0.f, 0.f, 0.f};
    bf16x8 At[4][2], B0[2][2], B1[2][2];
    unsigned va[2][2], vn[2][2];
    AO(cur, 0, R0, C0, R1, C1, va);
    const char* cB = (const char*)Bt + (size_t)cur.pb * tstep;
    PG8_STAGE(PG8_SB(0, 0), cB, voffB); PG8_STAGE(PG8_SB(0, 1), cB + hstep, voffB); PG8_STAGE(PG8_SA(0, 0), Ab, va[0]); PG8_STAGE(PG8_SA(0, 1), Ab, va[1]);
    if (wr == 1) PG8_BAR;
    PG8_WAIT_V(2); PG8_BAR;
    PG8_STAGE(PG8_SB(1, 0), cB + kstep, voffB); PG8_STAGE(PG8_SA(1, 0), Ab + kstep, va[0]); PG8_STAGE(PG8_SB(1, 1), cB + hstep + kstep, voffB);
    PG8_WAIT_V(6); PG8_BAR;
    for (;;) {
        const bool has_next = S.next(ui + 1, nxt);
        if (has_next) AO(nxt, ui + 1, R0, C0, R1, C1, vn);
        else { vn[0][0] = va[0][0]; vn[0][1] = va[0][1]; vn[1][0] = va[1][0]; vn[1][1] = va[1][1]; }
        const char* nB = has_next ? (const char*)Bt + (size_t)nxt.pb * tstep : cB;
        for (int t = 0; t < nt; t += 2) {
            const bool last = (t == nt - 2);
            const size_t ka1 = (size_t)(t + 1) * kstep;
            const size_t ka2 = last ? 0 : (size_t)(t + 2) * kstep, ka3 = ka2 + kstep;
            const char* b2 = last ? nB : cB + (size_t)(t + 2) * kstep; const char* b3 = b2 + kstep;
            unsigned w0[2], w1[2];
            w0[0] = last ? vn[0][0] : va[0][0]; w0[1] = last ? vn[0][1] : va[0][1]; w1[0] = last ? vn[1][0] : va[1][0]; w1[1] = last ? vn[1][1] : va[1][1];
            PG8_LDB(B0, 0, 0); PG8_LDB(B1, 0, 1); PG8_SCHED; PG8_LDA(At, 0, 0); PG8_STAGE(PG8_SA(1, 1), Ab + ka1, va[1]);
            PG8_WAIT_V(8); PG8_WAIT_L(0); PG8_BAR; PG8_MMA(0, 0, At, B0); PG8_MMA(0, 1, At, B1); PG8_BAR; PG8_SCHED;
            PG8_LDA(At, 0, 1); PG8_STAGE(PG8_SB(0, 0), b2, voffB); PG8_STAGE(PG8_SB(0, 1), b2 + hstep, voffB); PG8_STAGE(PG8_SA(0, 0), Ab + ka2, w0);
            PG8_WAIT_V(8); PG8_WAIT_L(0); PG8_BAR; PG8_MMA(1, 0, At, B0); PG8_MMA(1, 1, At, B1); PG8_BAR; PG8_SCHED;
            PG8_LDB(B0, 1, 0); PG8_LDB(B1, 1, 1); PG8_SCHED; PG8_LDA(At, 1, 0); PG8_STAGE(PG8_SA(0, 1), Ab + ka2, w1);
            PG8_WAIT_V(8); PG8_WAIT_L(0); PG8_BAR; PG8_MMA(0, 0, At, B0); PG8_MMA(0, 1, At, B1); PG8_BAR; PG8_SCHED;
            PG8_LDA(At, 1, 1); PG8_STAGE(PG8_SB(1, 0), b3, voffB); PG8_STAGE(PG8_SB(1, 1), b3 + hstep, voffB); PG8_STAGE(PG8_SA(1, 0), Ab + ka3, w0);
            PG8_WAIT_V(8); PG8_WAIT_L(0); PG8_BAR; PG8_MMA(1, 0, At, B0); PG8_MMA(1, 1, At, B1); PG8_BAR; PG8_SCHED;
        }
        if constexpr (ALIGN_EPI) { if (wr == 0) PG8_BAR; }
        E(acc, cur, wr, wc, fr, fq);
        if (!has_next) break;
#pragma unroll
        for (int a = 0; a < 2; ++a)
#pragma unroll
            for (int b = 0; b < 2; ++b)
#pragma unroll
                for (int m = 0; m < 4; ++m)
#pragma unroll
                    for (int n = 0; n < 2; ++n) acc[a][b][m][n] = (f32x4){0.f, 0.f, 0.f, 0.f};
        cur = nxt; cB = nB; ++ui;
        va[0][0] = vn[0][0]; va[0][1] = vn[0][1]; va[1][0] = vn[1][0]; va[1][1] = vn[1][1];
        if constexpr (ALIGN_EPI) { if (wr == 1) PG8_BAR; }
    }
    PG8_WAIT_V(0);
    if constexpr (!ALIGN_EPI) { if (wr == 0) PG8_BAR; }
    PG8_BAR;
#undef PG8_SA
#undef PG8_SB
#undef PG8_STAGE
#undef PG8_LDA
#undef PG8_LDB
#undef PG8_MMA
#undef PG8_WAIT_V
#undef PG8_WAIT_L
#undef PG8_BAR
#undef PG8_SCHED
}

struct AOffDense { int K; __device__ __forceinline__ void operator()(const Unit& u, int, int R0, int C0, int R1, int C1, unsigned (&vo)[2][2]) const {
#pragma unroll
    for (int h = 0; h < 2; ++h) { vo[h][0] = (unsigned)((u.pm * 256 + h * 128 + R0) * K + C0) * 2u; vo[h][1] = (unsigned)((u.pm * 256 + h * 128 + R1) * K + C1) * 2u; } } };
struct AOffGather { int K; const LAS int* tab; __device__ __forceinline__ void operator()(const Unit&, int ui, int R0, int C0, int R1, int C1, unsigned (&vo)[2][2]) const {
#pragma unroll
    for (int h = 0; h < 2; ++h) { vo[h][0] = (unsigned)(tab[ui * 256 + h * 128 + R0] * K + C0) * 2u; vo[h][1] = (unsigned)(tab[ui * 256 + h * 128 + R1] * K + C1) * 2u; } } };
}
struct Frame {
    LAS unsigned char* lds;
    volatile LAS unsigned* MISC;
    gu32* ctl;
    int tid, lane, wave, vcu, G;
    const float* in[31];
    float* out;
    unsigned char* ws;
};
#define LDS_WAIT() asm volatile("s_waitcnt lgkmcnt(0)" ::: "memory")
#define VM_WAIT() asm volatile("s_waitcnt vmcnt(0)" ::: "memory")

__device__ __forceinline__ void prep_item(const float* W, int ldw, int c0s, const float* gain, bf16_t* WT, int K, int n0d, int k0, bool perm, LAS float* scr, int lane) {
#pragma unroll 8
    for (int i = 0; i < 32; ++i) { const int kk = 2 * i + (lane >> 5); float v = W[(size_t)(k0 + kk) * ldw + c0s + (lane & 31)]; if (gain) v *= gain[k0 + kk]; scr[kk * 33 + (lane & 31)] = v; }
    LDS_WAIT(); asm volatile("" ::: "memory");
    const int c = lane & 7;
#pragma unroll
    for (int j = 0; j < 4; ++j) { const int n = (lane >> 3) + 8 * j; const int ns = perm ? pg8::perm32(n) : n; const LAS float* s = scr + (8 * c) * 33 + ns;
        u32x4 o; o.x = pk2(s[0 * 33], s[1 * 33]); o.y = pk2(s[2 * 33], s[3 * 33]); o.z = pk2(s[4 * 33], s[5 * 33]); o.w = pk2(s[6 * 33], s[7 * 33]);
        *(GAS u32x4*)(WT + (size_t)(n0d + n) * K + k0 + 8 * c) = o; }
    LDS_WAIT(); asm volatile("" ::: "memory");
}
__device__ __forceinline__ int win_src_col(int gd) {
    const int tile = gd >> 3, bj = (gd >> 2) & 1, wc = gd & 3;
    if (tile < 4) return 256 * tile + 128 * bj + 32 * wc;
    if (tile < 6) return (bj ? 1288 : 1032) + 128 * (tile - 4) + 32 * wc;
    if (tile < 8) return 1544 + 256 * (tile - 6) + 64 * wc + 32 * bj;
    if (tile < 10) return 2056 + 256 * (tile - 8) + 64 * wc + 32 * bj;
    return 2568 + 256 * (tile - 10) + 128 * bj + 32 * wc;
}
__device__ __forceinline__ void p0_prologue(Frame& F) {
    LAS float* scr = (LAS float*)(F.lds + F.wave * 16384);
    const int gw = F.vcu * NWAVES + F.wave, NGW = F.G * NWAVES, lane = F.lane;
    bf16_t* ws16 = (bf16_t*)F.ws;
    constexpr int I_IN = 16 * 96, I_OUT = 16 * 32, I_DGU = 16 * 176, I_DD = 44 * 32, I_MGU = 16 * 224, I_MD = 56 * 32, I_PG = 16 * 32, I_PP = 4 * 32;
    constexpr int NITEMS = 2 * I_IN + 2 * I_OUT + I_DGU + I_DD + 8 * I_MGU + 8 * I_MD + 2 * I_PG + 2 * I_PP;
    for (int it = gw; it < NITEMS; it += NGW) {
        int r = it;
        const float* W; const float* gain = nullptr; bf16_t* WT; int ldw, c0s, K, gd, kb; bool perm = false;
        if (r < 2 * I_IN) { const int L = r / I_IN; r %= I_IN; gd = r % 96; kb = r / 96;
            W = F.in[3] + (size_t)L * D * DIN; ldw = DIN; c0s = win_src_col(gd); gain = F.in[2] + L * D; WT = (bf16_t*)(F.ws + WS_WIN) + (size_t)L * NIN * D; K = D; perm = true; }
        else if ((r -= 2 * I_IN) < 2 * I_OUT) { const int L = r / I_OUT; r %= I_OUT; gd = r % 32; kb = r / 32;
            W = F.in[19] + (size_t)L * D * D; ldw = D; c0s = 32 * gd; WT = (bf16_t*)(F.ws + WS_WOUT) + (size_t)L * D * D; K = D; }
        else if ((r -= 2 * I_OUT) < I_DGU) { gd = r % 176; kb = r / 176; const int tile = gd >> 3, bj = (gd >> 2) & 1, wc = gd & 3;
            W = bj ? F.in[22] : F.in[21]; ldw = FFD; c0s = 128 * tile + 32 * wc; gain = F.in[20]; WT = (bf16_t*)(F.ws + WS_WDGU); K = D; perm = true; }
        else if ((r -= I_DGU) < I_DD) { gd = r % 32; kb = r / 32;
            W = F.in[23]; ldw = D; c0s = 32 * gd; WT = (bf16_t*)(F.ws + WS_WDD); K = FFD; }
        else if ((r -= I_DD) < 8 * I_MGU) { const int e = r / I_MGU; r %= I_MGU; gd = r % 224; kb = r / 224; const int tile = gd >> 3, bj = (gd >> 2) & 1, wc = gd & 3;
            W = (bj ? F.in[26] : F.in[25]) + (size_t)e * D * FFE; ldw = FFE; c0s = 128 * tile + 32 * wc; gain = F.in[20] + D; WT = (bf16_t*)(F.ws + WS_WMGU) + (size_t)e * 2 * FFE * D; K = D; perm = true; }
        else if ((r -= 8 * I_MGU) < 8 * I_MD) { const int e = r / I_MD; r %= I_MD; gd = r % 32; kb = r / 32;
            W = F.in[27] + (size_t)e * FFE * D; ldw = D; c0s = 32 * gd; WT = (bf16_t*)(F.ws + WS_WMD) + (size_t)e * D * FFE; K = FFE; }
        else if ((r -= 8 * I_MD) < 2 * I_PG) { const int L = r / I_PG; r %= I_PG; gd = r % 32; kb = r / 32;
            W = F.in[29] + (size_t)L * D * D; ldw = D; c0s = 32 * gd; gain = F.in[28] + L * D; WT = (bf16_t*)(F.ws + WS_WPG) + (size_t)L * D * D; K = D; }
        else { r -= 2 * I_PG; const int L = r / I_PP; r %= I_PP; gd = r % 32; kb = r / 32;
            W = F.in[30] + (size_t)L * PLE * D; ldw = D; c0s = 32 * gd; WT = (bf16_t*)(F.ws + WS_WPP) + (size_t)L * D * PLE; K = PLE; }
        prep_item(W, ldw, c0s, gain, WT, K, 32 * gd, 64 * kb, perm, scr, lane);
    }
    (void)ws16;
    float* wsm = (float*)(F.ws + WS_WSM);
    const int gt = F.vcu * (NWAVES * 64) + F.tid, NGT = F.G * NWAVES * 64;
    for (int i = gt; i < 3 * 8 * D; i += NGT) {
        const int which = i / (8 * D), j = (i / D) % 8, k = i % D;
        float v;
        if (which < 2) v = F.in[2][which * D + k] * F.in[3][(size_t)which * D * DIN + (size_t)k * DIN + 1024 + j];
        else v = F.in[20][D + k] * F.in[24][k * NE + j];
        wsm[i] = v;
    }
}

template <int MODE>
__device__ __forceinline__ void norm_phase(Frame& F, const float* src, const float* wx, const float* pconv, bf16_t* pconv_out) {
    bf16_t* AY = (bf16_t*)(F.ws + WS_AY);
    LAS float* wl = (LAS float*)F.lds;
    LAS int* rinfo = (LAS int*)(F.lds + 32768);
    if (MODE != 0) { for (int i = F.tid; i < 8 * D; i += NWAVES * 64) wl[i] = wx[i]; __syncthreads(); }
    const int gw = F.vcu * NWAVES + F.wave, NGW = F.G * NWAVES, lane = F.lane;
    int nrow = 0;
    for (int m = gw; m < M; m += NGW, ++nrow) {
        const GAS f32x4* xr = (const GAS f32x4*)(src + (size_t)m * D) + lane;
        f32x4 v[4]; float s = 0.f;
#pragma unroll
        for (int j = 0; j < 4; ++j) { v[j] = xr[64 * j]; s += (v[j].x * v[j].x + v[j].y * v[j].y) + (v[j].z * v[j].z + v[j].w * v[j].w); }
        const float rs = 1.0f / sqrtf(wave_sum(s) * (1.f / D) + EPS);
#pragma unroll
        for (int j = 0; j < 4; ++j) v[j] = v[j] * rs;
        GAS unsigned long long* o8 = (GAS unsigned long long*)(AY + (size_t)m * D) + lane;
#pragma unroll
        for (int j = 0; j < 4; ++j) o8[64 * j] = (unsigned long long)pk2(v[j].x, v[j].y) | ((unsigned long long)pk2(v[j].z, v[j].w) << 32);
        if (MODE != 0) {
            float dt[8];
#pragma unroll
            for (int c = 0; c < 8; ++c) { float a = 0.f;
#pragma unroll
                for (int j = 0; j < 4; ++j) { const f32x4 w = *(const LAS f32x4*)(wl + c * D + 256 * j + 4 * lane); a += (v[j].x * w.x + v[j].y * w.y) + (v[j].z * w.z + v[j].w * w.w); }
                dt[c] = wave_sum(a); }
            if (MODE == 1) { if (lane == 0) { GAS f32x4* g = (GAS f32x4*)((float*)(F.ws + WS_GATE) + (size_t)m * 8); g[0] = (f32x4){dt[0], dt[1], dt[2], dt[3]}; g[1] = (f32x4){dt[4], dt[5], dt[6], dt[7]}; } }
            if (MODE == 2) {
                int i0 = 0;
#pragma unroll
                for (int e = 1; e < 8; ++e) if (dt[e] > dt[i0]) i0 = e;
                int i1 = (i0 == 0) ? 1 : 0;
#pragma unroll
                for (int e = 0; e < 8; ++e) if (e != i0 && dt[e] > dt[i1]) i1 = e;
                float v0 = dt[0], v1 = dt[0];
#pragma unroll
                for (int e = 0; e < 8; ++e) { v0 = (e == i0) ? dt[e] : v0; v1 = (e == i1) ? dt[e] : v1; }
                const float e1 = __expf(v1 - v0), g0 = 1.f / (1.f + e1), g1 = e1 / (1.f + e1);
                if (lane == 0) {
                    float* gv = (float*)(F.ws + WS_MOE + MOE_GATEV); gv[m] = g0; gv[M + m] = g1;
                    rinfo[(F.wave * 16 + nrow) * 2] = i0; rinfo[(F.wave * 16 + nrow) * 2 + 1] = i1;
                }
            }
        }
    }
    if (MODE == 2) {
        __syncthreads();
        if (F.tid < 16) {
            const int s = F.tid >> 3, e = F.tid & 7; int n = 0;
#pragma unroll 1
            for (int wr_ = 0; wr_ < 128; ++wr_) n += (rinfo[wr_ * 2 + s] == e) ? 1 : 0;
            unsigned base = 0; if (n) base = __hip_atomic_fetch_add((unsigned*)(F.ctl + CW_CNT + s * 8 + e), (unsigned)n, RLX_AGENT);
            int* list = (int*)(F.ws + WS_MOE + MOE_LIST) + ((size_t)(s * 8 + e)) * M;
            int k = 0;
#pragma unroll 1
            for (int wr_ = 0; wr_ < 128; ++wr_) if (rinfo[wr_ * 2 + s] == e) { list[base + k] = (F.vcu * NWAVES + (wr_ >> 4)) + (wr_ & 15) * NGW; ++k; }
        }
        __syncthreads();
    }
    if (pconv) {
        const size_t n4 = (size_t)M * PLE / 4, gt = (size_t)F.vcu * (NWAVES * 64) + F.tid, NGT = (size_t)F.G * NWAVES * 64;
        for (size_t i = gt; i < n4; i += NGT) { const f32x4 x = ((const GAS f32x4*)pconv)[i]; ((GAS unsigned long long*)pconv_out)[i] = (unsigned long long)pk2(x.x, x.y) | ((unsigned long long)pk2(x.z, x.w) << 32); }
    }
}

typedef f32x4 AccT[2][2][4][2];
__device__ __forceinline__ u32x4 pack8(const f32x4& a, const f32x4& b) { u32x4 w; w.x = cvt_pk_bf16(a[0], a[1]); w.y = cvt_pk_bf16(a[2], a[3]); w.z = cvt_pk_bf16(b[0], b[1]); w.w = cvt_pk_bf16(b[2], b[3]); return w; }

struct EpiIn {
    bf16_t* U; const float* gq; const float* gk;
    __device__ __forceinline__ void operator()(const AccT& acc, const pg8::Unit& u, int wr, int wc, int fr, int fq) const {
        const int row0 = u.pm * 256 + wr * 64 + fr, pn = u.pn;
        if (pn < 4 || pn >= 10) {
            const int cb = (pn < 4 ? 256 * pn : UC_V + 256 * (pn - 10)) + wc * 32 + 8 * fq;
#pragma unroll
            for (int ai = 0; ai < 2; ++ai)
#pragma unroll
                for (int m = 0; m < 4; ++m) { bf16_t* rp = U + (size_t)(row0 + ai * 128 + m * 16) * UW + cb;
#pragma unroll
                    for (int bj = 0; bj < 2; ++bj) *(u32x4*)(rp + bj * 128) = pack8(acc[ai][bj][m][0], acc[ai][bj][m][1]); }
        } else if (pn < 6) {
            const int cb = UC_Z + 128 * (pn - 4) + wc * 32 + 8 * fq;
#pragma unroll
            for (int ai = 0; ai < 2; ++ai)
#pragma unroll
                for (int m = 0; m < 4; ++m) { f32x4 z0, z1;
#pragma unroll
                    for (int i = 0; i < 4; ++i) { z0[i] = acc[ai][0][m][0][i] * fast_sigmoid(acc[ai][1][m][0][i]); z1[i] = acc[ai][0][m][1][i] * fast_sigmoid(acc[ai][1][m][1][i]); }
                    *(u32x4*)(U + (size_t)(row0 + ai * 128 + m * 16) * UW + cb) = pack8(z0, z1); }
        } else {
            const bool isq = pn < 8; const int j = 4 * (pn - (isq ? 6 : 8)) + wc;
            const float* g = isq ? gq : gk; const float sc = isq ? C2 : 1.f;
            f32x4 gv[2][2];
#pragma unroll
            for (int bj = 0; bj < 2; ++bj)
#pragma unroll
                for (int n = 0; n < 2; ++n) gv[bj][n] = *(const f32x4*)(g + 32 * bj + 8 * fq + 4 * n) * sc;
            const int cb = (isq ? UC_Q : UC_K) + 64 * j + 8 * fq;
#pragma unroll
            for (int ai = 0; ai < 2; ++ai)
#pragma unroll
                for (int m = 0; m < 4; ++m) { float ss = 0.f;
#pragma unroll
                    for (int bj = 0; bj < 2; ++bj)
#pragma unroll
                        for (int n = 0; n < 2; ++n) { const f32x4 x = acc[ai][bj][m][n]; ss += (x[0] * x[0] + x[1] * x[1]) + (x[2] * x[2] + x[3] * x[3]); }
                    ss += __shfl_xor(ss, 16); ss += __shfl_xor(ss, 32);
                    const float rs = 1.0f / sqrtf(ss * (1.f / 64.f) + EPS);
                    bf16_t* rp = U + (size_t)(row0 + ai * 128 + m * 16) * UW + cb;
#pragma unroll
                    for (int bj = 0; bj < 2; ++bj) *(u32x4*)(rp + 32 * bj) = pack8(acc[ai][bj][m][0] * gv[bj][0] * rs, acc[ai][bj][m][1] * gv[bj][1] * rs); }
        }
    }
};
struct EpiRes {
    const float* res; float* out;
    __device__ __forceinline__ void operator()(const AccT& acc, const pg8::Unit& u, int wr, int wc, int fr, int fq) const {
        const int row0 = u.pm * 256 + wr * 64 + fr, col0 = u.pn * 256 + wc * 32 + 4 * fq;
#pragma unroll
        for (int ai = 0; ai < 2; ++ai)
#pragma unroll
            for (int m = 0; m < 4; ++m) { const size_t ro = (size_t)(row0 + ai * 128 + m * 16) * D + col0;
#pragma unroll
                for (int bj = 0; bj < 2; ++bj)
#pragma unroll
                    for (int n = 0; n < 2; ++n) { const size_t o = ro + bj * 128 + n * 16; *(f32x4*)(out + o) = *(const f32x4*)(res + o) + acc[ai][bj][m][n]; } }
    }
};
struct EpiGlu {
    bf16_t* O; int ldc;
    __device__ __forceinline__ void operator()(const AccT& acc, const pg8::Unit& u, int wr, int wc, int fr, int fq) const {
        const int row0 = u.pm * 256 + wr * 64 + fr, cb = 128 * u.pn + wc * 32 + 8 * fq;
#pragma unroll
        for (int ai = 0; ai < 2; ++ai)
#pragma unroll
            for (int m = 0; m < 4; ++m) { f32x4 z0, z1;
#pragma unroll
                for (int i = 0; i < 4; ++i) { const float g0 = acc[ai][0][m][0][i], g1 = acc[ai][0][m][1][i]; z0[i] = g0 * fast_sigmoid(g0) * acc[ai][1][m][0][i]; z1[i] = g1 * fast_sigmoid(g1) * acc[ai][1][m][1][i]; }
                *(u32x4*)(O + (size_t)(row0 + ai * 128 + m * 16) * ldc + cb) = pack8(z0, z1); }
    }
};
struct EpiScatter {
    float* out; const int* list_s; const float* gatev_s; const LAS int* rt_info;
    __device__ __forceinline__ void operator()(const AccT& acc, const pg8::Unit& u, int wr, int wc, int fr, int fq) const {
        const int e = rt_info[3 * u.pm], i0 = rt_info[3 * u.pm + 1], nv = rt_info[3 * u.pm + 2];
        const int col0 = u.pn * 256 + wc * 32 + 4 * fq;
        const int* lst = list_s + (size_t)e * M + i0;
#pragma unroll
        for (int ai = 0; ai < 2; ++ai)
#pragma unroll
            for (int m = 0; m < 4; ++m) { const int r = ai * 128 + wr * 64 + m * 16 + fr;
                if (r < nv) { const int tok = lst[r]; const float g = gatev_s[tok]; const size_t ro = (size_t)tok * D + col0;
#pragma unroll
                    for (int bj = 0; bj < 2; ++bj)
#pragma unroll
                        for (int n = 0; n < 2; ++n) { const size_t o = ro + bj * 128 + n * 16; *(f32x4*)(out + o) = *(const f32x4*)(out + o) + acc[ai][bj][m][n] * g; } } }
    }
};
struct EpiPe {
    bf16_t* O;
    __device__ __forceinline__ void operator()(const AccT& acc, const pg8::Unit& u, int wr, int wc, int fr, int fq) const {
        const int row0 = u.pm * 256 + wr * 64 + fr, col0 = u.pn * 256 + wc * 32 + 4 * fq;
#pragma unroll
        for (int ai = 0; ai < 2; ++ai)
#pragma unroll
            for (int m = 0; m < 4; ++m) { const size_t ro = (size_t)(row0 + ai * 128 + m * 16) * D + col0;
#pragma unroll
                for (int bj = 0; bj < 2; ++bj)
#pragma unroll
                    for (int n = 0; n < 2; ++n) { const f32x4 x = acc[ai][bj][m][n]; u32x2 w; w.x = cvt_pk_bf16(x[0], x[1]); w.y = cvt_pk_bf16(x[2], x[3]); *(u32x2*)(O + ro + bj * 128 + n * 16) = w; } }
    }
};
struct EpiPle {
    float* out; const bf16_t* PE;
    __device__ __forceinline__ void operator()(const AccT& acc, const pg8::Unit& u, int wr, int wc, int fr, int fq) const {
        const int row0 = u.pm * 256 + wr * 64 + fr, col0 = u.pn * 256 + wc * 32 + 4 * fq;
#pragma unroll
        for (int ai = 0; ai < 2; ++ai)
#pragma unroll
            for (int m = 0; m < 4; ++m) { const size_t ro = (size_t)(row0 + ai * 128 + m * 16) * D + col0;
#pragma unroll
                for (int bj = 0; bj < 2; ++bj)
#pragma unroll
                    for (int n = 0; n < 2; ++n) { const size_t o = ro + bj * 128 + n * 16; const u32x2 w = *(const u32x2*)(PE + o); const f32x4 x = acc[ai][bj][m][n]; f32x4 h = *(const f32x4*)(out + o);
                        h[0] += fast_sigmoid(x[0]) * bflo(w.x); h[1] += fast_sigmoid(x[1]) * bfhi(w.x); h[2] += fast_sigmoid(x[2]) * bflo(w.y); h[3] += fast_sigmoid(x[3]) * bfhi(w.y);
                        *(f32x4*)(out + o) = h; } }
    }
};

struct MoeSched {
    pg8::StaticOrder so; const LAS int* rt_info; int ntn;
    __device__ __forceinline__ bool next(int i, pg8::Unit& u) const { if (!so.tile(i, u.pm, u.pn)) return false; u.pb = rt_info[3 * u.pm] * ntn + u.pn; return true; }
};
__device__ __forceinline__ int moe_build_tiles(Frame& F, int s, LAS int* rt_info) {
    int RT = 0;
    int cnt[8];
#pragma unroll
    for (int e = 0; e < 8; ++e) cnt[e] = (int)__hip_atomic_load((unsigned*)(F.ctl + CW_CNT + s * 8 + e), RLX_AGENT);
    if (F.tid == 0) { int rt = 0; for (int e = 0; e < 8; ++e) for (int i0 = 0; i0 < cnt[e]; i0 += 256) { rt_info[3 * rt] = e; rt_info[3 * rt + 1] = i0; rt_info[3 * rt + 2] = (cnt[e] - i0) < 256 ? (cnt[e] - i0) : 256; ++rt; } }
#pragma unroll
    for (int e = 0; e < 8; ++e) RT += (cnt[e] + 255) >> 8;
    __syncthreads();
    return RT;
}
namespace nvb {
using nv::sigmoidf_; using nv::siluf_; using nv::wsum; using nv::wmax;
__global__ void mprep(const bf16_t* U, const float* GATE, const float* cw, const float* bi, const float* bf, float* QK, float* IG, float* LF) {
    const int t = blockIdx.x, c = threadIdx.x;
    float acc = 0.f;
    for (int j = 0; j < 4; ++j) { const int tt = t - 3 + j; if (tt >= 0) acc += cw[j * 512 + c] * bf2f(U[(size_t)tt * UW + c]); }
    QK[(size_t)t * 512 + c] = siluf_(acc);
    if (c < 4) {
        IG[t * 4 + c] = GATE[(size_t)t * 8 + c] + bi[c];
        const float f = GATE[(size_t)t * 8 + 4 + c] + bf[c];
        LF[t * 4 + c] = fminf(f, 0.f) - log1pf(expf(-fabsf(f)));
    }
}
__global__ void mlstm_rec(const float* QK, const bf16_t* U, const float* IG, const float* LF, float* HM) {
    __shared__ float sq[64][64], sk[64][64], sv[64][64];
    __shared__ float sig[64], slf[64];
    __shared__ float red[2][4][64], redd[2][4][64];
    const int h = blockIdx.x, tid = threadIdx.x, e = tid & 63, dq = tid >> 6;
    float C[16], n[16]; float m = 0.f;
    for (int i = 0; i < 16; ++i) { C[i] = 0.f; n[i] = 0.f; }
    for (int t0 = 0; t0 < SEQ; t0 += 64) {
        __syncthreads();
        for (int i = tid; i < 64 * 64; i += 256) {
            const int tt = i >> 6, d = i & 63;
            sq[tt][d] = QK[(size_t)(t0 + tt) * 512 + h * 64 + d] * 0.125f;
            sk[tt][d] = QK[(size_t)(t0 + tt) * 512 + 256 + h * 64 + d];
            sv[tt][d] = bf2f(U[(size_t)(t0 + tt) * UW + UC_MV + h * 64 + d]);
        }
        if (tid < 64) { sig[tid] = IG[(t0 + tid) * 4 + h]; slf[tid] = LF[(t0 + tid) * 4 + h]; }
        __syncthreads();
        for (int tt = 0; tt < 64; ++tt) {
            const float ig = sig[tt], lf = slf[tt];
            const float mn = fmaxf(lf + m, ig), a = expf(lf + m - mn), bb = expf(ig - mn);
            m = mn;
            const float v = sv[tt][e];
            float num = 0.f, den = 0.f;
#pragma unroll
            for (int i = 0; i < 16; ++i) {
                const int d = dq * 16 + i; const float k = sk[tt][d], q = sq[tt][d];
                C[i] = a * C[i] + bb * k * v; n[i] = a * n[i] + bb * k;
                num += q * C[i]; den += q * n[i];
            }
            red[tt & 1][dq][e] = num; redd[tt & 1][dq][e] = den;
            __syncthreads();
            if (dq == 0) {
                const float nu = red[tt & 1][0][e] + red[tt & 1][1][e] + red[tt & 1][2][e] + red[tt & 1][3][e];
                const float de = redd[tt & 1][0][e] + redd[tt & 1][1][e] + redd[tt & 1][2][e] + redd[tt & 1][3][e];
                HM[(size_t)(t0 + tt) * 256 + h * 64 + e] = nu / fmaxf(fabsf(de), expf(-m));
            }
        }
    }
}
__global__ void mgate(const float* HMN, const bf16_t* U, bf16_t* Y) {
    const int t = blockIdx.x, c = threadIdx.x;
    Y[(size_t)t * D + c] = (bf16_t)f2bf(HMN[(size_t)t * 256 + c] * sigmoidf_(bf2f(U[(size_t)t * UW + UC_MO + c])));
}
__global__ void cconv(const bf16_t* U, const float* w, const float* b, const float* lg, const float* lb, bf16_t* Y) {
    __shared__ float sm[4], sv2[4];
    const int t = blockIdx.x, c = threadIdx.x;
    float acc = b[c];
    for (int j = 0; j < 31; ++j) { const int tt = t - 30 + j; if (tt >= 0) acc += w[j * 256 + c] * bf2f(U[(size_t)tt * UW + UC_Z + c]); }
    float s = wsum(acc);
    if ((c & 63) == 0) sm[c >> 6] = s;
    __syncthreads();
    const float mu = (sm[0] + sm[1] + sm[2] + sm[3]) * (1.f / 256.f);
    const float dv = acc - mu;
    float s2 = wsum(dv * dv);
    if ((c & 63) == 0) sv2[c >> 6] = s2;
    __syncthreads();
    const float var = (sv2[0] + sv2[1] + sv2[2] + sv2[3]) * (1.f / 256.f);
    const float yv = dv * rsqrtf(var + 1e-6f) * lg[c] + lb[c];
    Y[(size_t)t * D + 256 + c] = (bf16_t)f2bf(siluf_(yv));
}
__global__ void attn(const bf16_t* U, float* O) {
    __shared__ float sK[64][65];
    __shared__ float sV[64][128];
    __shared__ float sQ[16][64];
    __shared__ float sP[16][64];
    const int j = blockIdx.y, hd = j >> 1, q0 = blockIdx.x * 16, tid = threadIdx.x, w = tid >> 6, lane = tid & 63;
    const int qpos = q0 + w;
    const float slope2 = exp2f(-8.f * (float)(hd + 1) / 4.f) * 1.4426950408889634f;
    sQ[w][lane] = bf2f(U[(size_t)qpos * UW + UC_Q + j * 64 + lane]);
    float m = -INFINITY, l = 0.f, o0 = 0.f, o1 = 0.f;
    const int ntile = (q0 + 15) / 64 + 1;
    for (int kt = 0; kt < ntile; ++kt) {
        __syncthreads();
        for (int i = tid; i < 64 * 64; i += 1024) { const int r = i >> 6, d = i & 63; sK[r][d] = bf2f(U[(size_t)(kt * 64 + r) * UW + UC_K + j * 64 + d]); }
        for (int i = tid; i < 64 * 128; i += 1024) { const int r = i >> 7, d = i & 127; sV[r][d] = bf2f(U[(size_t)(kt * 64 + r) * UW + UC_V + hd * 128 + d]); }
        __syncthreads();
        const int kpos = kt * 64 + lane;
        float s = 0.f;
        for (int d = 0; d < 64; ++d) s += sQ[w][d] * sK[lane][d];
        s = s - slope2 * (float)(qpos - kpos);
        if (kpos > qpos) s = -INFINITY;
        const float tm = wmax(s), mn = fmaxf(m, tm), corr = exp2f(m - mn), p = exp2f(s - mn);
        l = l * corr + wsum(p); o0 *= corr; o1 *= corr; m = mn;
        sP[w][lane] = p;
        __syncthreads();
        for (int k = 0; k < 64; ++k) { const float pk = sP[w][k]; o0 += pk * sV[k][lane]; o1 += pk * sV[k][64 + lane]; }
    }
    O[((size_t)qpos * 8 + j) * 128 + lane] = o0 / l;
    O[((size_t)qpos * 8 + j) * 128 + 64 + lane] = o1 / l;
}
__global__ void subln(const float* YA, const float* gain, float scale, bf16_t* Y) {
    const int rg = blockIdx.x, row = rg >> 2, g = rg & 3, lane = threadIdx.x;
    const float* x = YA + (size_t)row * 512 + g * 128;
    const float a = x[lane], b = x[64 + lane];
    const float r = rsqrtf(wsum(a * a + b * b) / 128.f + 1e-6f);
    Y[(size_t)row * D + 512 + g * 128 + lane] = (bf16_t)f2bf(a * r * gain[lane] * scale);
    Y[(size_t)row * D + 512 + g * 128 + 64 + lane] = (bf16_t)f2bf(b * r * gain[64 + lane] * scale);
}
static void mixers(void* const* d_in, unsigned char* ws, int L, hipStream_t st) {
    const float* const* in = (const float* const*)d_in;
    unsigned char* tail = ws + WS_BIG + 176 * MiB;
    float* QK = (float*)tail; float* HM = (float*)(tail + 16 * MiB); float* HMN = (float*)(tail + 24 * MiB); float* AO = (float*)tail;
    float* YA = (float*)(tail + 32 * MiB); float* IG = (float*)(tail + 48 * MiB); float* LF = (float*)(tail + 49 * MiB);
    const float lam_init = 0.8f - 0.6f * expf(-0.3f * (float)L);
    for (int b = 0; b < NB; ++b) {
        const bf16_t* U = (const bf16_t*)(ws + WS_BIG) + (size_t)b * SEQ * UW;
        const float* GATE = (const float*)(ws + WS_GATE) + (size_t)b * SEQ * 8;
        bf16_t* Y = (bf16_t*)(ws + WS_AY) + (size_t)b * SEQ * D;
        hipLaunchKernelGGL(mprep, dim3(SEQ), dim3(512), 0, st, U, GATE, in[6] + L * 2048, in[4] + L * 4, in[5] + L * 4, QK, IG, LF);
        hipLaunchKernelGGL(mlstm_rec, dim3(4), dim3(256), 0, st, (const float*)QK, U, (const float*)IG, (const float*)LF, HM);
        hipLaunchKernelGGL(nv::groupnorm, dim3(SEQ * 4), dim3(64), 0, st, (const float*)HM, 256, HMN, 256, 4, 64, in[7] + L * 256, 64, 1.f);
        hipLaunchKernelGGL(mgate, dim3(SEQ), dim3(256), 0, st, (const float*)HMN, U, Y);
        hipLaunchKernelGGL(cconv, dim3(SEQ), dim3(256), 0, st, U, in[8] + L * 31 * 256, in[9] + L * 256, in[10] + L * 256, in[11] + L * 256, Y);
        hipLaunchKernelGGL(attn, dim3(SEQ / 16, 8), dim3(1024), 0, st, U, AO);
        hipLaunchKernelGGL(nv::acomb, dim3(SEQ), dim3(512), 0, st, (const float*)AO, in[14] + L * 64, in[15] + L * 64, in[16] + L * 64, in[17] + L * 64, lam_init, YA);
        hipLaunchKernelGGL(subln, dim3(SEQ * 4), dim3(64), 0, st, (const float*)YA, in[18] + L * 128, 1.f - lam_init, Y);
    }
}
}
#define ONE_LAUNCH 0
#define NAIVE_MIXERS 1
#define MIX_PHASE_A do {} while (0)
#define MIX_PHASE_B do {} while (0)
#define MIX_PHASE_C do {} while (0)
__device__ __forceinline__ int bxl() { int b = blockIdx.x; asm volatile("" : "+s"(b)); return b; }
constexpr int PH_PER_LAYER = 13, NPHASE = 1 + 2 * PH_PER_LAYER;
struct Args { const float* in[31]; float* out; unsigned char* ws; int ph_lo, ph_hi; };

#define PH(k) (lo <= (k) && (k) < hi)
#define SEAM(k) do { if ((k) + 1 < hi) xcd_barrier(bar); } while (0)
template <int L>
__device__ __forceinline__ void layer_phases(Frame& F, const XcdBarrier& bar, int lo, int hi) {
    bf16_t* const AY = (bf16_t*)(F.ws + WS_AY);
    bf16_t* const BIGB = (bf16_t*)(F.ws + WS_BIG);
    float* const wsm = (float*)(F.ws + WS_WSM);
        const int pb = 1 + PH_PER_LAYER * L;
        if (pb + PH_PER_LAYER <= lo || pb >= hi) return;
        const float* hsrc = (L == 0) ? F.in[0] : F.out;
        if (PH(pb + 0)) { norm_phase<1>(F, hsrc, wsm + L * 8 * D, nullptr, nullptr); SEAM(pb + 0); }
        if (PH(pb + 1)) {
            pg8::StaticOrder S; S.init(M / 256, NIN / 256, F.G, bxl());
            EpiIn E{BIGB, F.in[12] + L * 64, F.in[13] + L * 64};
            pg8::gemm_phase<EpiIn, pg8::StaticOrder, pg8::AOffDense, true>(F.lds, AY, (const bf16_t*)(F.ws + WS_WIN) + (size_t)L * NIN * D, D, S, E, pg8::AOffDense{D});
            SEAM(pb + 1);
        }
        if (PH(pb + 2)) { MIX_PHASE_A; SEAM(pb + 2); }
        if (PH(pb + 3)) { MIX_PHASE_B; SEAM(pb + 3); }
        if (PH(pb + 4)) { MIX_PHASE_C; SEAM(pb + 4); }
        if (PH(pb + 5)) {
            pg8::StaticOrder S; S.init(M / 256, D / 256, F.G, bxl());
            EpiRes E{hsrc, F.out};
            pg8::gemm_phase<EpiRes, pg8::StaticOrder, pg8::AOffDense, true>(F.lds, AY, (const bf16_t*)(F.ws + WS_WOUT) + (size_t)L * D * D, D, S, E, pg8::AOffDense{D});
            SEAM(pb + 5);
        }
        if (L == 0) {
            if (PH(pb + 6)) { norm_phase<0>(F, F.out, nullptr, nullptr, nullptr); SEAM(pb + 6); }
            if (PH(pb + 7)) {
                pg8::StaticOrder S; S.init(M / 256, 2 * FFD / 256, F.G, bxl());
                EpiGlu E{BIGB, FFD};
                pg8::gemm_phase<EpiGlu, pg8::StaticOrder, pg8::AOffDense, true>(F.lds, AY, (const bf16_t*)(F.ws + WS_WDGU), D, S, E, pg8::AOffDense{D});
                SEAM(pb + 7);
            }
            if (PH(pb + 8)) {
                pg8::StaticOrder S; S.init(M / 256, D / 256, F.G, bxl());
                EpiRes E{F.out, F.out};
                pg8::gemm_phase<EpiRes, pg8::StaticOrder, pg8::AOffDense, true>(F.lds, BIGB, (const bf16_t*)(F.ws + WS_WDD), FFD, S, E, pg8::AOffDense{FFD});
                SEAM(pb + 8);
            }
        } else {
            if (PH(pb + 6)) { norm_phase<2>(F, F.out, wsm + 2 * 8 * D, nullptr, nullptr); SEAM(pb + 6); }
            for (int s = 0; s < 2; ++s) {
                LAS int* rt_info = (LAS int*)(F.lds + TAB_OFF); LAS int* rowtab = (LAS int*)(F.lds + TAB_OFF + 2048);
                const int* list_s = (const int*)(F.ws + WS_MOE + MOE_LIST) + (size_t)s * 8 * M;
                const float* gatev_s = (const float*)(F.ws + WS_MOE + MOE_GATEV) + (size_t)s * M;
                if (PH(pb + 7 + 2 * s)) {
                    const int RT = moe_build_tiles(F, s, rt_info);
                    MoeSched S; S.so.init(RT, 2 * FFE / 256, F.G, bxl()); S.rt_info = rt_info; S.ntn = 2 * FFE / 256;
                    { pg8::Unit u; for (int i = 0; S.next(i, u); ++i) { if (F.tid < 256) { const int e = rt_info[3 * u.pm], i0 = rt_info[3 * u.pm + 1], nv = rt_info[3 * u.pm + 2];
                        rowtab[i * 256 + F.tid] = F.tid < nv ? list_s[(size_t)e * M + i0 + F.tid] : 0; } } }
                    __syncthreads();
                    EpiGlu E{BIGB, FFE};
                    pg8::gemm_phase<EpiGlu, MoeSched, pg8::AOffGather, true>(F.lds, AY, (const bf16_t*)(F.ws + WS_WMGU), D, S, E, pg8::AOffGather{D, rowtab});
                    SEAM(pb + 7 + 2 * s);
                }
                if (PH(pb + 8 + 2 * s)) {
                    const int RT = moe_build_tiles(F, s, rt_info);
                    MoeSched S; S.so.init(RT, D / 256, F.G, bxl()); S.rt_info = rt_info; S.ntn = D / 256;
                    EpiScatter E{F.out, list_s, gatev_s, rt_info};
                    pg8::gemm_phase<EpiScatter, MoeSched, pg8::AOffDense, true>(F.lds, BIGB, (const bf16_t*)(F.ws + WS_WMD), FFE, S, E, pg8::AOffDense{FFE});
                    SEAM(pb + 8 + 2 * s);
                }
            }
        }
        bf16_t* const PB = BIGB;
        bf16_t* const PEB = BIGB + (size_t)16 * MiB;
        if (PH(pb + 11)) { norm_phase<0>(F, F.out, nullptr, F.in[1] + (size_t)L * M * PLE, PB); SEAM(pb + 11); }
        if (PH(pb + 12)) {
            pg8::StaticOrder S; S.init(M / 256, D / 256, F.G, bxl());
            EpiPe E1{PEB};
            pg8::gemm_phase<EpiPe, pg8::StaticOrder, pg8::AOffDense, true>(F.lds, PB, (const bf16_t*)(F.ws + WS_WPP) + (size_t)L * D * PLE, PLE, S, E1, pg8::AOffDense{PLE});
            EpiPle E2{F.out, PEB};
            pg8::gemm_phase<EpiPle, pg8::StaticOrder, pg8::AOffDense, true>(F.lds, AY, (const bf16_t*)(F.ws + WS_WPG) + (size_t)L * D * D, D, S, E2, pg8::AOffDense{D});
            SEAM(pb + 12);
        }
    }
__global__ void __launch_bounds__(NWAVES * 64, 2) fwd(Args args) {
    extern __shared__ __attribute__((aligned(16))) unsigned char lds[];
    Frame F;
    F.lds = (LAS unsigned char*)lds;
    F.MISC = (volatile LAS unsigned*)(F.lds + MISC_OFF);
    F.tid = threadIdx.x; F.lane = F.tid & 63; F.wave = __builtin_amdgcn_readfirstlane(F.tid >> 6);
    F.G = gridDim.x; { const int bx = blockIdx.x; F.vcu = (F.G % 8 == 0) ? (bx % 8) * (F.G / 8) + bx / 8 : bx; }
    F.ws = args.ws; F.ctl = (gu32*)(args.ws + WS_CTL); F.out = args.out;
#pragma unroll
    for (int i = 0; i < 31; ++i) F.in[i] = args.in[i];
    for (int u = F.tid; u < 256; u += NWAVES * 64) ((LAS unsigned*)(F.lds + LDSCTL_OFF))[u] = 0u;
    __syncthreads();
    const int lo = args.ph_lo, hi = args.ph_hi;
    XcdBarrier bar; bar.bar = (unsigned*)(F.ctl + CW_BAR); bar.x = 0; bar.st = nullptr;
    if (hi - lo > 1) bar = xcd_barrier_post((unsigned*)(F.ctl + CW_BAR), F.MISC + 8);

    bf16_t* const AY = (bf16_t*)(F.ws + WS_AY);
    bf16_t* const BIGB = (bf16_t*)(F.ws + WS_BIG);
    float* const wsm = (float*)(F.ws + WS_WSM);

    if (PH(0)) { p0_prologue(F); SEAM(0); }

    layer_phases<0>(F, bar, lo, hi);
    layer_phases<1>(F, bar, lo, hi);
#undef PH
#undef SEAM
}

extern "C" void kernel_launch(void* const* d_in, const int* in_sizes, int n_in, void* d_out, int out_size, void* d_ws, size_t ws_size, hipStream_t stream) {
    static int grid = 0;
    if (grid == 0) {
        int dev = 0, cus = 0;
        grid = -1;
        if (hipGetDevice(&dev) == hipSuccess && hipDeviceGetAttribute(&cus, hipDeviceAttributeMultiprocessorCount, dev) == hipSuccess && cus == 256 && ws_size >= WS_END && n_in == 31 &&
            hipFuncSetAttribute((const void*)fwd, hipFuncAttributeMaxDynamicSharedMemorySize, LDS_BYTES) == hipSuccess) grid = cus;
        (void)hipGetLastError();
    }
    if (grid < 0) { nv::forward(d_in, (float*)d_out, (unsigned char*)d_ws, stream); return; }
    (void)hipMemsetAsync((char*)d_ws + WS_CTL, 0, CTL_ZERO_BYTES, stream);
    Args a{};
    for (int i = 0; i < 31; ++i) a.in[i] = (const float*)d_in[i];
    a.out = (float*)d_out; a.ws = (unsigned char*)d_ws;
#if ONE_LAUNCH
    a.ph_lo = 0; a.ph_hi = NPHASE;
    hipLaunchKernelGGL(fwd, dim3(grid), dim3(NWAVES * 64), LDS_BYTES, stream, a);
#else
    for (int p = 0; p < NPHASE; ++p) {
        const int L = (p - 1) / PH_PER_LAYER, k = (p - 1) % PH_PER_LAYER;
        if (p > 0 && L == 0 && (k == 9 || k == 10)) continue;
#if NAIVE_MIXERS
        if (p > 0 && k == 2) { nvb::mixers(d_in, (unsigned char*)d_ws, L, stream); continue; }
        if (p > 0 && (k == 3 || k == 4)) continue;
#endif
        a.ph_lo = p; a.ph_hi = p + 1;
        hipLaunchKernelGGL(fwd, dim3(grid), dim3(NWAVES * 64), LDS_BYTES, stream, a);
    }
#endif
}
```

```cpp
#include <hip/hip_runtime.h>
#include <cstdio>
#include <cstdint>
#include <cmath>
#define NAIVE_MASK 0
namespace nv {
constexpr int S = 8192, D = 1024, DIN = 3080, NB = 4;
constexpr int FFD = 2816, FFE = 3584, NE = 8, PLE = 256;
constexpr int OFF_MQ = 0, OFF_MK = 256, OFF_MV = 512, OFF_MO = 768, OFF_MI = 1024, OFF_MF = 1028, OFF_CA = 1032, OFF_CG = 1288, OFF_AQ = 1544, OFF_AK = 2056, OFF_AV = 2568;

__device__ __forceinline__ float sigmoidf_(float x) { return 1.f / (1.f + expf(-x)); }
__device__ __forceinline__ float siluf_(float x) { return x / (1.f + expf(-x)); }
__device__ __forceinline__ float wsum(float v) { for (int o = 32; o > 0; o >>= 1) v += __shfl_xor(v, o); return v; }
__device__ __forceinline__ float wmax(float v) { for (int o = 32; o > 0; o >>= 1) v = fmaxf(v, __shfl_xor(v, o)); return v; }

__global__ void groupnorm(const float* in, int ldi, float* out, int ldo, int ngroups, int gdim, const float* gain, int gain_stride, float scale) {
    const int rg = blockIdx.x, row = rg / ngroups, g = rg % ngroups, lane = threadIdx.x;
    const float* x = in + (size_t)row * ldi + g * gdim;
    float s = 0.f;
    for (int i = lane; i < gdim; i += 64) s += x[i] * x[i];
    s = wsum(s);
    const float r = rsqrtf(s / (float)gdim + 1e-6f);
    float* o = out + (size_t)row * ldo + g * gdim;
    for (int i = lane; i < gdim; i += 64) o[i] = x[i] * r * gain[g * gain_stride + i] * scale;
}

template <bool ACC>
__global__ void gemm(const float* A, int lda, const float* B, int ldb, float* C, int ldc, int M, int N, int K, const int* rowlist, const int* nrows_dev) {
    __shared__ float As[16][65];
    __shared__ float Bs[16][64];
    const int Meff = nrows_dev ? *nrows_dev : M;
    const int m0 = blockIdx.y * 64, n0 = blockIdx.x * 64;
    if (m0 >= Meff) return;
    const int tid = threadIdx.x, ty = tid >> 4, tx = tid & 15;
    float acc[4][4];
    for (int i = 0; i < 4; ++i) for (int j = 0; j < 4; ++j) acc[i][j] = 0.f;
    for (int k0 = 0; k0 < K; k0 += 16) {
        for (int i = 0; i < 4; ++i) {
            const int idx = tid + i * 256, r = idx >> 4, kk = idx & 15;
            float v = 0.f;
            if (m0 + r < Meff) { const int ar = rowlist ? rowlist[m0 + r] : (m0 + r); v = A[(size_t)ar * lda + k0 + kk]; }
            As[kk][r] = v;
        }
        for (int i = 0; i < 4; ++i) {
            const int idx = tid + i * 256, kk = idx >> 6, c = idx & 63;
            Bs[kk][c] = (n0 + c < N) ? B[(size_t)(k0 + kk) * ldb + n0 + c] : 0.f;
        }
        __syncthreads();
#pragma unroll
        for (int kk = 0; kk < 16; ++kk) {
            float a[4], b[4];
            for (int i = 0; i < 4; ++i) a[i] = As[kk][ty * 4 + i];
            for (int j = 0; j < 4; ++j) b[j] = Bs[kk][tx * 4 + j];
            for (int i = 0; i < 4; ++i) for (int j = 0; j < 4; ++j) acc[i][j] += a[i] * b[j];
        }
        __syncthreads();
    }
    for (int i = 0; i < 4; ++i) {
        const int r = m0 + ty * 4 + i;
        if (r >= Meff) continue;
        for (int j = 0; j < 4; ++j) {
            const int c = n0 + tx * 4 + j;
            if (c < N) { float* p = C + (size_t)r * ldc + c; *p = ACC ? (*p + acc[i][j]) : acc[i][j]; }
        }
    }
}

__global__ void mprep(const float* U, const float* cw  , const float* bi, const float* bf, float* QK, float* IG, float* LF) {
    const int t = blockIdx.x, c = threadIdx.x;
    float acc = 0.f;
    for (int j = 0; j < 4; ++j) { const int tt = t - 3 + j; if (tt >= 0) acc += cw[j * 512 + c] * U[(size_t)tt * DIN + c]; }
    QK[(size_t)t * 512 + c] = siluf_(acc);
    if (c < 4) {
        IG[t * 4 + c] = U[(size_t)t * DIN + OFF_MI + c] + bi[c];
        const float f = U[(size_t)t * DIN + OFF_MF + c] + bf[c];
        LF[t * 4 + c] = fminf(f, 0.f) - log1pf(expf(-fabsf(f)));
    }
}

__global__ void mlstm_rec(const float* QK, const float* U, const float* IG, const float* LF, float* HM) {
    __shared__ float sq[64][64], sk[64][64], sv[64][64];
    __shared__ float sig[64], slf[64];
    __shared__ float red[2][4][64], redd[2][4][64];
    const int h = blockIdx.x, tid = threadIdx.x, e = tid & 63, dq = tid >> 6;
    float C[16], n[16]; float m = 0.f;
    for (int i = 0; i < 16; ++i) { C[i] = 0.f; n[i] = 0.f; }
    for (int t0 = 0; t0 < S; t0 += 64) {
        __syncthreads();
        for (int i = tid; i < 64 * 64; i += 256) {
            const int tt = i >> 6, d = i & 63;
            sq[tt][d] = QK[(size_t)(t0 + tt) * 512 + h * 64 + d] * 0.125f;
            sk[tt][d] = QK[(size_t)(t0 + tt) * 512 + 256 + h * 64 + d];
            sv[tt][d] = U[(size_t)(t0 + tt) * DIN + OFF_MV + h * 64 + d];
        }
        if (tid < 64) { sig[tid] = IG[(t0 + tid) * 4 + h]; slf[tid] = LF[(t0 + tid) * 4 + h]; }
        __syncthreads();
        for (int tt = 0; tt < 64; ++tt) {
            const float ig = sig[tt], lf = slf[tt];
            const float mn = fmaxf(lf + m, ig), a = expf(lf + m - mn), bb = expf(ig - mn);
            m = mn;
            const float v = sv[tt][e];
            float num = 0.f, den = 0.f;
#pragma unroll
            for (int i = 0; i < 16; ++i) {
                const int d = dq * 16 + i; const float k = sk[tt][d], q = sq[tt][d];
                C[i] = a * C[i] + bb * k * v; n[i] = a * n[i] + bb * k;
                num += q * C[i]; den += q * n[i];
            }
            red[tt & 1][dq][e] = num; redd[tt & 1][dq][e] = den;
            __syncthreads();
            if (dq == 0) {
                const float nu = red[tt & 1][0][e] + red[tt & 1][1][e] + red[tt & 1][2][e] + red[tt & 1][3][e];
                const float de = redd[tt & 1][0][e] + redd[tt & 1][1][e] + redd[tt & 1][2][e] + redd[tt & 1][3][e];
                HM[(size_t)(t0 + tt) * 256 + h * 64 + e] = nu / fmaxf(fabsf(de), expf(-m));
            }
        }
    }
}

__global__ void mgate(const float* HMN, const float* U, float* Y) {
    const int t = blockIdx.x, c = threadIdx.x;
    Y[(size_t)t * D + c] = HMN[(size_t)t * 256 + c] * sigmoidf_(U[(size_t)t * DIN + OFF_MO + c]);
}

__global__ void cglu(const float* U, float* Z) {
    const int t = blockIdx.x, c = threadIdx.x;
    Z[(size_t)t * 256 + c] = U[(size_t)t * DIN + OFF_CA + c] * sigmoidf_(U[(size_t)t * DIN + OFF_CG + c]);
}
__global__ void cconv(const float* Z, const float* w  , const float* b, const float* lg, const float* lb, float* Y) {
    __shared__ float sm[4], sv2[4];
    const int t = blockIdx.x, c = threadIdx.x;
    float acc = b[c];
    for (int j = 0; j < 31; ++j) { const int tt = t - 30 + j; if (tt >= 0) acc += w[j * 256 + c] * Z[(size_t)tt * 256 + c]; }
    float s = wsum(acc);
    if ((c & 63) == 0) sm[c >> 6] = s;
    __syncthreads();
    const float mu = (sm[0] + sm[1] + sm[2] + sm[3]) * (1.f / 256.f);
    const float dv = acc - mu;
    float s2 = wsum(dv * dv);
    if ((c & 63) == 0) sv2[c >> 6] = s2;
    __syncthreads();
    const float var = (sv2[0] + sv2[1] + sv2[2] + sv2[3]) * (1.f / 256.f);
    const float yv = dv * rsqrtf(var + 1e-6f) * lg[c] + lb[c];
    Y[(size_t)t * D + 256 + c] = siluf_(yv);
}

__global__ void attn(const float* QN  , const float* KN  , const float* U, float* O  ) {
    __shared__ float sK[64][65];
    __shared__ float sV[64][128];
    __shared__ float sQ[16][64];
    __shared__ float sP[16][64];
    const int j = blockIdx.y, hd = j >> 1, q0 = blockIdx.x * 16, tid = threadIdx.x, w = tid >> 6, lane = tid & 63;
    const int qpos = q0 + w;
    const float slope = exp2f(-8.f * (float)(hd + 1) / 4.f);
    sQ[w][lane] = QN[(size_t)qpos * 512 + j * 64 + lane];
    float m = -INFINITY, l = 0.f, o0 = 0.f, o1 = 0.f;
    const int ntile = (q0 + 15) / 64 + 1;
    for (int kt = 0; kt < ntile; ++kt) {
        __syncthreads();
        for (int i = tid; i < 64 * 64; i += 1024) { const int r = i >> 6, d = i & 63; sK[r][d] = KN[(size_t)(kt * 64 + r) * 512 + j * 64 + d]; }
        for (int i = tid; i < 64 * 128; i += 1024) { const int r = i >> 7, d = i & 127; sV[r][d] = U[(size_t)(kt * 64 + r) * DIN + OFF_AV + hd * 128 + d]; }
        __syncthreads();
        const int kpos = kt * 64 + lane;
        float s = 0.f;
        for (int d = 0; d < 64; ++d) s += sQ[w][d] * sK[lane][d];
        s = s * 0.125f - slope * (float)(qpos - kpos);
        if (kpos > qpos) s = -INFINITY;
        const float tm = wmax(s), mn = fmaxf(m, tm), corr = expf(m - mn), p = expf(s - mn);
        l = l * corr + wsum(p); o0 *= corr; o1 *= corr; m = mn;
        sP[w][lane] = p;
        __syncthreads();
        for (int k = 0; k < 64; ++k) { const float pk = sP[w][k]; o0 += pk * sV[k][lane]; o1 += pk * sV[k][64 + lane]; }
    }
    O[((size_t)qpos * 8 + j) * 128 + lane] = o0 / l;
    O[((size_t)qpos * 8 + j) * 128 + 64 + lane] = o1 / l;
}
__device__ __forceinline__ float lam_of(const float* q1, const float* k1, const float* q2, const float* k2, float lam_init) {
    float a = 0.f, b = 0.f;
    for (int i = 0; i < 64; ++i) { a += q1[i] * k1[i]; b += q2[i] * k2[i]; }
    return expf(a) - expf(b) + lam_init;
}
__global__ void acomb(const float* O, const float* q1, const float* k1, const float* q2, const float* k2, float lam_init, float* YA  ) {
    const int t = blockIdx.x, c = threadIdx.x;
    const float lam = lam_of(q1, k1, q2, k2, lam_init);
    const int hd = c >> 7, e = c & 127;
    YA[(size_t)t * 512 + c] = O[((size_t)t * 8 + 2 * hd) * 128 + e] - lam * O[((size_t)t * 8 + 2 * hd + 1) * 128 + e];
}
__global__ void swiglu_act(float* G, const float* Uu, int ld, const int* nrows_dev) {
    const int r = blockIdx.x; if (nrows_dev && r >= *nrows_dev) return;
    for (int c = threadIdx.x; c < ld; c += blockDim.x) { const size_t i = (size_t)r * ld + c; G[i] = siluf_(G[i]) * Uu[i]; }
}
__global__ void route(const float* LG  , int* cnt  , int* list  , float* gl  ) {
    const int t = blockIdx.x * blockDim.x + threadIdx.x; if (t >= S) return;
    float v[8]; for (int e = 0; e < 8; ++e) v[e] = LG[t * 8 + e];
    int i0 = 0; for (int e = 1; e < 8; ++e) if (v[e] > v[i0]) i0 = e;
    int i1 = (i0 == 0) ? 1 : 0; for (int e = 0; e < 8; ++e) if (e != i0 && v[e] > v[i1]) i1 = e;
    const float e1 = expf(v[i1] - v[i0]), g0 = 1.f / (1.f + e1), g1 = e1 / (1.f + e1);
    int p0 = atomicAdd(&cnt[i0], 1); list[i0 * S + p0] = t; gl[i0 * S + p0] = g0;
    int p1 = atomicAdd(&cnt[i1], 1); list[i1 * S + p1] = t; gl[i1 * S + p1] = g1;
}
__global__ void scatter_add(const float* Dn  , const int* list, const float* gl, const int* nrows_dev, float* H) {
    const int r = blockIdx.x; if (r >= *nrows_dev) return;
    const int t = list[r]; const float g = gl[r];
    for (int c = threadIdx.x; c < D; c += blockDim.x) H[(size_t)t * D + c] += g * Dn[(size_t)r * D + c];
}
__global__ void ple_apply(const float* GT, const float* PE, float* H) {
    const int t = blockIdx.x;
    for (int c = threadIdx.x; c < D; c += blockDim.x) H[(size_t)t * D + c] += sigmoidf_(GT[(size_t)t * D + c]) * PE[(size_t)t * D + c];
}

static void gemm_l(hipStream_t st, bool acc, const float* A, int lda, const float* B, int ldb, float* C, int ldc, int M, int N, int K, const int* rowlist = nullptr, const int* nrows = nullptr) {
    dim3 g((N + 63) / 64, M / 64);
    if (acc) hipLaunchKernelGGL(gemm<true>, g, dim3(256), 0, st, A, lda, B, ldb, C, ldc, M, N, K, rowlist, nrows);
    else hipLaunchKernelGGL(gemm<false>, g, dim3(256), 0, st, A, lda, B, ldb, C, ldc, M, N, K, rowlist, nrows);
}

static void forward(void* const* d_in, float* out, unsigned char* ws, hipStream_t st) {
    const float* const* in = (const float* const*)d_in;
    size_t off = 0;
    auto take = [&](size_t bytes) { unsigned char* p = ws + off; off += (bytes + 255) & ~(size_t)255; return p; };
    float* A = (float*)take((size_t)S * D * 4);
    float* U = (float*)take((size_t)S * DIN * 4);
    float* QK = (float*)take((size_t)S * 512 * 4);
    float* Y = (float*)take((size_t)S * D * 4);
    float* G = (float*)take((size_t)S * FFE * 4);
    float* U2 = (float*)take((size_t)S * FFE * 4);
    float* IG = (float*)take((size_t)S * 4 * 4);
    float* LF = (float*)take((size_t)S * 4 * 4);
    int* cnt = (int*)take(256);
    int* list = (int*)take((size_t)NE * S * 4);
    float* gl = (float*)take((size_t)NE * S * 4);
    float* HM = G;
    float* HMN = G + (size_t)S * 256;
    float* Z = G + (size_t)S * 512;
    float* QN = G + (size_t)S * 768;
    float* KN = G + (size_t)S * 1280;
    float* YA = G + (size_t)S * 1792;
    float* AO = U2;
    hipMemcpyAsync(out, in[0], (size_t)NB * S * D * 4, hipMemcpyDeviceToDevice, st);
    for (int b = 0; b < NB; ++b) {
        float* H = out + (size_t)b * S * D;
        for (int L = 0; L < 2; ++L) {
            const float lam_init = 0.8f - 0.6f * expf(-0.3f * (float)L);
            hipLaunchKernelGGL(groupnorm, dim3(S), dim3(64), 0, st, H, D, A, D, 1, D, in[2] + L * D, 0, 1.f);
            gemm_l(st, false, A, D, in[3] + (size_t)L * D * DIN, DIN, U, DIN, S, DIN, D);
            hipLaunchKernelGGL(mprep, dim3(S), dim3(512), 0, st, U, in[6] + L * 2048, in[4] + L * 4, in[5] + L * 4, QK, IG, LF);
            hipLaunchKernelGGL(mlstm_rec, dim3(4), dim3(256), 0, st, QK, U, IG, LF, HM);
            hipLaunchKernelGGL(groupnorm, dim3(S * 4), dim3(64), 0, st, HM, 256, HMN, 256, 4, 64, in[7] + L * 256, 64, 1.f);
            hipLaunchKernelGGL(mgate, dim3(S), dim3(256), 0, st, HMN, U, Y);
            hipLaunchKernelGGL(cglu, dim3(S), dim3(256), 0, st, U, Z);
            hipLaunchKernelGGL(cconv, dim3(S), dim3(256), 0, st, Z, in[8] + L * 31 * 256, in[9] + L * 256, in[10] + L * 256, in[11] + L * 256, Y);
            hipLaunchKernelGGL(groupnorm, dim3(S * 8), dim3(64), 0, st, U + OFF_AQ, DIN, QN, 512, 8, 64, in[12] + L * 64, 0, 1.f);
            hipLaunchKernelGGL(groupnorm, dim3(S * 8), dim3(64), 0, st, U + OFF_AK, DIN, KN, 512, 8, 64, in[13] + L * 64, 0, 1.f);
            hipLaunchKernelGGL(attn, dim3(S / 16, 8), dim3(1024), 0, st, QN, KN, U, AO);
            hipLaunchKernelGGL(acomb, dim3(S), dim3(512), 0, st, AO, in[14] + L * 64, in[15] + L * 64, in[16] + L * 64, in[17] + L * 64, lam_init, YA);
            hipLaunchKernelGGL(groupnorm, dim3(S * 4), dim3(64), 0, st, YA, 512, Y + 512, D, 4, 128, in[18] + L * 128, 0, 1.f - lam_init);
            gemm_l(st, true, Y, D, in[19] + (size_t)L * D * D, D, H, D, S, D, D);
            hipLaunchKernelGGL(groupnorm, dim3(S), dim3(64), 0, st, H, D, A, D, 1, D, in[20] + L * D, 0, 1.f);
            if (L == 0) {
                gemm_l(st, false, A, D, in[21], FFD, G, FFD, S, FFD, D);
                gemm_l(st, false, A, D, in[22], FFD, U2, FFD, S, FFD, D);
                hipLaunchKernelGGL(swiglu_act, dim3(S), dim3(256), 0, st, G, U2, FFD, (const int*)nullptr);
                gemm_l(st, true, G, FFD, in[23], D, H, D, S, D, FFD);
            } else {
                float* LG = Y;
                gemm_l(st, false, A, D, in[24], NE, LG, NE, S, NE, D);
                hipMemsetAsync(cnt, 0, 256, st);
                hipLaunchKernelGGL(route, dim3(S / 256), dim3(256), 0, st, LG, cnt, list, gl);
                float* Dn = Y;
                for (int e = 0; e < NE; ++e) {
                    gemm_l(st, false, A, D, in[25] + (size_t)e * D * FFE, FFE, G, FFE, S, FFE, D, list + e * S, cnt + e);
                    gemm_l(st, false, A, D, in[26] + (size_t)e * D * FFE, FFE, U2, FFE, S, FFE, D, list + e * S, cnt + e);
                    hipLaunchKernelGGL(swiglu_act, dim3(S), dim3(256), 0, st, G, U2, FFE, (const int*)(cnt + e));
                    gemm_l(st, false, G, FFE, in[27] + (size_t)e * FFE * D, D, Dn, D, S, D, FFE, nullptr, cnt + e);
                    hipLaunchKernelGGL(scatter_add, dim3(S), dim3(256), 0, st, Dn, list + e * S, gl + e * S, (const int*)(cnt + e), H);
                }
            }
            hipLaunchKernelGGL(groupnorm, dim3(S), dim3(64), 0, st, H, D, A, D, 1, D, in[28] + L * D, 0, 1.f);
            gemm_l(st, false, A, D, in[29] + (size_t)L * D * D, D, G, D, S, D, D);
            gemm_l(st, false, in[1] + ((size_t)L * NB + b) * S * PLE, PLE, in[30] + (size_t)L * PLE * D, D, U2, D, S, D, PLE);
            hipLaunchKernelGGL(ple_apply, dim3(S), dim3(256), 0, st, G, U2, H);
        }
    }
}
}
#define GAS __attribute__((address_space(1)))
#define LAS __attribute__((address_space(3)))
typedef unsigned short bf16_t;
typedef unsigned u32x4 __attribute__((ext_vector_type(4)));
typedef unsigned u32x2 __attribute__((ext_vector_type(2)));
typedef float f32x4 __attribute__((ext_vector_type(4)));
typedef float f32x2 __attribute__((ext_vector_type(2)));
typedef short bf16x8 __attribute__((ext_vector_type(8)));
typedef GAS unsigned gu32;
#define RLX_AGENT __ATOMIC_RELAXED, __HIP_MEMORY_SCOPE_AGENT

constexpr int NB = 4, SEQ = 8192, M = NB * SEQ, D = 1024, DIN = 3080;
constexpr int FFD = 2816, FFE = 3584, NE = 8, PLE = 256;
constexpr int UW = 2816;
constexpr int UC_MQ = 0, UC_MK = 256, UC_MV = 512, UC_MO = 768, UC_Z = 1024, UC_Q = 1280, UC_K = 1792, UC_V = 2304;
constexpr int NIN = 3072;
constexpr float EPS = 1e-6f;
constexpr float C2 = 0.125f * 1.4426950408889634f;
constexpr int MOE_MAXROWS = M + NE * 256;

constexpr size_t MiB = 1u << 20;
constexpr size_t WS_CTL = 0, CTL_ZERO_BYTES = 1 * MiB;
constexpr size_t WS_WIN = 1 * MiB;
constexpr size_t WS_WOUT = WS_WIN + 12 * MiB;
constexpr size_t WS_WDGU = WS_WOUT + 4 * MiB;
constexpr size_t WS_WDD = WS_WDGU + 11 * MiB;
constexpr size_t WS_WMGU = WS_WDD + 6 * MiB;
constexpr size_t WS_WMD = WS_WMGU + 112 * MiB;
constexpr size_t WS_WPG = WS_WMD + 56 * MiB;
constexpr size_t WS_WPP = WS_WPG + 4 * MiB;
constexpr size_t WS_WSM = WS_WPP + 1 * MiB;
constexpr size_t WS_GATE = WS_WSM + 1 * MiB;
constexpr size_t WS_MOE = WS_GATE + 1 * MiB;
constexpr size_t WS_MST = WS_MOE + 3 * MiB;
constexpr size_t WS_AY = WS_MST + 34 * MiB;
constexpr size_t WS_BIG = WS_AY + 64 * MiB;
constexpr size_t WS_END = WS_BIG + 238 * MiB;
static_assert((size_t)MOE_MAXROWS * FFE * 2 <= 238 * MiB, "act fits");
static_assert((size_t)M * UW * 2 <= 176 * MiB, "u fits");

constexpr int CW_TMO = 0, CW_CODE = 1;
constexpr int CW_BAR = 4096;
constexpr int CW_CNT = 16384;
constexpr size_t MOE_GATEV = 0;
constexpr size_t MOE_EIDX = 2 * (size_t)M * 4;
constexpr size_t MOE_LIST = 4 * (size_t)M * 4;
static_assert(MOE_LIST + 16 * (size_t)M * 4 <= 3 * MiB, "moe region");

constexpr int RING_BYTES = 131072;
constexpr int LDSCTL_OFF = RING_BYTES, MISC_OFF = LDSCTL_OFF + 320;
constexpr int TAB_OFF = RING_BYTES + 1024;
constexpr int LDS_BYTES = 163840;
constexpr int NWAVES = 8;

__device__ __forceinline__ unsigned f2bf(float f) { unsigned u = __builtin_bit_cast(unsigned, f); return (u + 0x7fffu + ((u >> 16) & 1u)) >> 16; }
__device__ __forceinline__ unsigned pk2(float lo, float hi) { return f2bf(lo) | (f2bf(hi) << 16); }
__device__ __forceinline__ float bf2f(unsigned short b) { return __builtin_bit_cast(float, (unsigned)b << 16); }
__device__ __forceinline__ float bflo(unsigned w) { return __builtin_bit_cast(float, w << 16); }
__device__ __forceinline__ float bfhi(unsigned w) { return __builtin_bit_cast(float, w & 0xffff0000u); }
__device__ __forceinline__ unsigned cvt_pk_bf16(float lo, float hi) { unsigned r; asm volatile("v_cvt_pk_bf16_f32 %0, %1, %2" : "=v"(r) : "v"(lo), "v"(hi)); return r; }
__device__ __forceinline__ float fast_sigmoid(float x) { return __builtin_amdgcn_rcpf(1.f + __builtin_amdgcn_exp2f(-1.4426950408889634f * x)); }
__device__ __forceinline__ int lane_id_v() { int l; asm volatile("v_mbcnt_lo_u32_b32 %0, -1, 0\n\tv_mbcnt_hi_u32_b32 %0, -1, %0" : "=v"(l)); return l; }
__device__ __forceinline__ float wave_sum(float v) {
#pragma unroll
    for (int o = 1; o < 64; o <<= 1) v += __shfl_xor(v, o);
    return v;
}
__device__ __forceinline__ float wave_max(float v) {
#pragma unroll
    for (int o = 1; o < 64; o <<= 1) v = fmaxf(v, __shfl_xor(v, o));
    return v;
}

#define XB_TMO      128
#define XB_XCNT(j)  (256  + 64 * (j))
#define XB_XSUB(j)  (1280 + 64 * (j))
#define XB_XGEN(j)  (2304 + 64 * (j))
#define XB_TOP      3328
#define XB_TOPGEN   3392
#define XCD_BAR_WORDS 3456
#define XB_SPIN_CAP (1u << 22)
__device__ __forceinline__ unsigned xb_ld(unsigned* p)              { return __hip_atomic_load(p, __ATOMIC_RELAXED, __HIP_MEMORY_SCOPE_AGENT); }
__device__ __forceinline__ unsigned xb_add(unsigned* p, unsigned v) { return __hip_atomic_fetch_add(p, v, __ATOMIC_RELAXED, __HIP_MEMORY_SCOPE_AGENT); }
__device__ __forceinline__ unsigned xb_xcc_id() { return (unsigned)__builtin_amdgcn_s_getreg((3 << 11) | 20) & 0xFu; }
#define XB_SPIN(cond, bar) do { unsigned _sp = 0; while (cond) { __builtin_amdgcn_s_sleep(1); \
    if ((++_sp & 255u) == 0u) { if (xb_ld(&(bar)[XB_TMO])) break; if (_sp > XB_SPIN_CAP) { atomicAdd(&(bar)[XB_TMO], 1u); break; } } } } while (0)
struct XcdBarrier { unsigned* bar; unsigned x; volatile LAS unsigned* st; };
__device__ __forceinline__ XcdBarrier xcd_barrier_post(unsigned* bar, volatile LAS unsigned* st) {
    XcdBarrier b; b.bar = bar; b.x = xb_xcc_id(); b.st = st;
    if (threadIdx.x == 0) (void)xb_add(&bar[XB_XCNT(b.x)], 1u);
    return b;
}
__device__ __forceinline__ void xcd_barrier_complete(unsigned* bar, unsigned x, unsigned& nloc, unsigned& nx) {
    const unsigned G = gridDim.x * gridDim.y * gridDim.z;
    unsigned sum, cnt, mine, sp = 0u;
    for (;;) {
        sum = 0u; cnt = 0u; mine = 0u;
#pragma unroll
        for (unsigned j = 0; j < 16; ++j) { const unsigned c = xb_ld(&bar[XB_XCNT(j)]); sum += c; cnt += (c > 0u) ? 1u : 0u; mine = (j == x) ? c : mine; }
        if (sum == G) break;
        __builtin_amdgcn_s_sleep(1);
        if ((++sp & 255u) == 0u) { if (xb_ld(&bar[XB_TMO])) break; if (sp > XB_SPIN_CAP) { atomicAdd(&bar[XB_TMO], 1u); break; } }
    }
    nloc = mine > 0u ? mine : 1u; nx = cnt > 0u ? cnt : 1u;
}
__device__ __forceinline__ void xcd_barrier(const XcdBarrier& b) {
    asm volatile("s_waitcnt vmcnt(0)" ::: "memory");
    __syncthreads();
    if (threadIdx.x == 0) {
        unsigned* bar = b.bar;
        __builtin_amdgcn_s_waitcnt(0);
        unsigned nloc = b.st[0], nx = b.st[1];
        if (nloc == 0u) { xcd_barrier_complete(bar, b.x, nloc, nx); b.st[0] = nloc; b.st[1] = nx; }
        const unsigned old = xb_add(&bar[XB_XSUB(b.x)], 1u);
        const unsigned gen = old / nloc;
        if (old + 1u == (gen + 1u) * nloc) {
            __builtin_amdgcn_fence(__ATOMIC_RELEASE, "agent");
            asm volatile("s_waitcnt vmcnt(0)" ::: "memory");
            const unsigned og = xb_add(&bar[XB_TOP], 1u);
            const unsigned tg = og / nx;
            if (og + 1u == (tg + 1u) * nx) xb_add(&bar[XB_TOPGEN], 1u);
            else XB_SPIN(xb_ld(&bar[XB_TOPGEN]) == tg, bar);
            __builtin_amdgcn_fence(__ATOMIC_ACQUIRE, "agent");
            xb_add(&bar[XB_XGEN(b.x)], 1u);
            asm volatile("s_waitcnt vmcnt(0)" ::: "memory");
        } else {
            XB_SPIN(xb_ld(&bar[XB_XGEN(b.x)]) == gen, bar);
            __builtin_amdgcn_fence(__ATOMIC_ACQUIRE, "agent");
            asm volatile("s_waitcnt vmcnt(0)" ::: "memory");
        }
    }
    __syncthreads();
}

namespace pg8 {
constexpr int BM = 256, BK = 64, HALF = 128, HTB = HALF * BK * 2, STAGE_BYTES = 8 * HTB, NXCD = 8, WGM = 8;
__host__ __device__ __forceinline__ int lds_byte(int r, int c) { const int st = (r >> 4) * 2 + (c >> 5), rr = r & 15, cc = c & 31, ob = rr * 64 + cc * 2; return st * 1024 + (ob ^ (((ob >> 9) & 1) << 5)); }
__host__ __device__ __forceinline__ void stage_rc(int b, int& R, int& C) { const int st = b / 1024, sb = b % 1024, swz = sb ^ (((sb >> 9) & 1) << 5); R = (st >> 1) * 16 + swz / 64; C = (st & 1) * 32 + (swz % 64) / 2; }
__host__ __device__ __forceinline__ int perm32(int rho) { const int n = rho >> 4, i = rho & 15; return 8 * (i >> 2) + 4 * n + (i & 3); }

struct Unit { int pm, pn, pb; };

struct StaticOrder {
    int nM, nN, nwg, G, c;
    __device__ void init(int nM_, int nN_, int G_, int c_) { nM = nM_; nN = nN_; nwg = nM * nN; G = G_; c = c_; }
    __device__ __forceinline__ bool tile(int i, int& pm, int& pn) const {
        const long L = (long)i * G + c; if (L >= nwg) return false;
        int wgid = (int)L; { const int q = nwg / NXCD, r = nwg % NXCD, xcd = wgid % NXCD, off = wgid / NXCD; wgid = (xcd < r ? xcd * (q + 1) : r * (q + 1) + (xcd - r) * q) + off; }
        const int nig = WGM * nN, gid = wgid / nig, fm = gid * WGM, gsz = (nM - fm) < WGM ? (nM - fm) : WGM;
        pm = fm + ((wgid % nig) % gsz); pn = (wgid % nig) / gsz; return true;
    }
    __device__ __forceinline__ bool next(int i, Unit& u) const { if (!tile(i, u.pm, u.pn)) return false; u.pb = u.pn; return true; }
};

template <class Epi, class Sched, class AOff, bool ALIGN_EPI>
__device__ __forceinline__ void gemm_phase(LAS unsigned char* lds, int wave, const bf16_t* A, const bf16_t* Bt, int K, const Sched& S, const Epi& E, const AOff& AO) {
    asm volatile("" : "+s"(A), "+s"(Bt), "+s"(K), "+s"(wave));
    const int lane = lane_id_v(), wid = wave, tid = wid * 64 + lane, wr = wid >> 2, wc = wid & 3, fr = lane & 15, fq = lane >> 4;
    const int nt = K / BK;
    int R0, C0, R1, C1; stage_rc(tid * 16, R0, C0); stage_rc(tid * 16 + 8192, R1, C1);
    unsigned voffB[2]; voffB[0] = (unsigned)(R0 * K + C0) * 2u; voffB[1] = (unsigned)(R1 * K + C1) * 2u;
    const size_t kstep = (size_t)(BK * 2);
    const size_t hstep = (size_t)HALF * K * 2;
    const size_t tstep = 2 * hstep;
    const unsigned ldsw = (unsigned)wid * 1024u;
    const int aoff = lds_byte(wr * 64 + fr, fq * 8), boff = lds_byte(wc * 32 + fr, fq * 8);
    const char* Ab = (const char*)A;
#define PG8_SA(b, h) (((b) * 2 + (h)) * HTB)
#define PG8_SB(b, h) ((4 + (b) * 2 + (h)) * HTB)
#define PG8_STAGE(bufoff, gbase, voff) do { _Pragma("unroll") for (int _i = 0; _i < 2; ++_i) \
        __builtin_amdgcn_global_load_lds((const unsigned*)((const char*)(gbase) + (voff)[_i]), (LAS unsigned*)(lds + (bufoff) + ldsw + _i * 8192), 16, 0, 0); } while (0)
#define PG8_LDA(dst, b, h) do { _Pragma("unroll") for (int m = 0; m < 4; ++m) _Pragma("unroll") for (int k = 0; k < 2; ++k) dst[m][k] = *(const LAS bf16x8*)(lds + PG8_SA(b, h) + aoff + m * 2048 + k * 1024); } while (0)
#define PG8_LDB(dst, b, h) do { _Pragma("unroll") for (int n = 0; n < 2; ++n) _Pragma("unroll") for (int k = 0; k < 2; ++k) dst[n][k] = *(const LAS bf16x8*)(lds + PG8_SB(b, h) + boff + n * 2048 + k * 1024); } while (0)
#define PG8_MMA(ai, bj, At, Bt_) do { __builtin_amdgcn_s_setprio(1); _Pragma("unroll") for (int m = 0; m < 4; ++m) _Pragma("unroll") for (int n = 0; n < 2; ++n) _Pragma("unroll") for (int k = 0; k < 2; ++k) \
        acc[ai][bj][m][n] = __builtin_amdgcn_mfma_f32_16x16x32_bf16(Bt_[n][k], At[m][k], acc[ai][bj][m][n], 0, 0, 0); __builtin_amdgcn_s_setprio(0); } while (0)
#define PG8_WAIT_V(n) asm volatile("s_waitcnt vmcnt(" #n ")" ::: "memory")
#define PG8_WAIT_L(n) asm volatile("s_waitcnt lgkmcnt(" #n ")" ::: "memory")
#define PG8_BAR __builtin_amdgcn_s_barrier()
#define PG8_SCHED __builtin_amdgcn_sched_barrier(0)
    Unit cur, nxt; int ui = 0;
    if (!S.next(0, cur)) return;
    f32x4 acc[2][2][4][2];
#pragma unroll
    for (int a = 0; a < 2; ++a)
#pragma unroll
        for (int b = 0; b < 2; ++b)
#pragma unroll
            for (int m = 0; m < 4; ++m)
#pragma unroll
                for (int n = 0; n < 2; ++n) acc[a][b][m][n] = (f32x4){0.f, 0.f, 0.f, 0.f};
    bf16x8 At[4][2], B0[2][2], B1[2][2];
    unsigned va[2][2], vn[2][2];
    AO(cur, 0, R0, C0, R1, C1, va);
    const char* cB = (const char*)Bt + (size_t)cur.pb * tstep;
    PG8_STAGE(PG8_SB(0, 0), cB, voffB); PG8_STAGE(PG8_SB(0, 1), cB + hstep, voffB); PG8_STAGE(PG8_SA(0, 0), Ab, va[0]); PG8_STAGE(PG8_SA(0, 1), Ab, va[1]);
    if (wr == 1) PG8_BAR;
    PG8_WAIT_V(2); PG8_BAR;
    PG8_STAGE(PG8_SB(1, 0), cB + kstep, voffB); PG8_STAGE(PG8_SA(1, 0), Ab + kstep, va[0]); PG8_STAGE(PG8_SB(1, 1), cB + hstep + kstep, voffB);
    PG8_WAIT_V(6); PG8_BAR;
    for (;;) {
        const bool has_next = S.next(ui + 1, nxt);
        if (has_next) AO(nxt, ui + 1, R0, C0, R1, C1, vn);
        else { vn[0][0] = va[0][0]; vn[0][1] = va[0][1]; vn[1][0] = va[1][0]; vn[1][1] = va[1][1]; }
        const char* nB = has_next ? (const char*)Bt + (size_t)nxt.pb * tstep : cB;
        for (int t = 0; t < nt; t += 2) {
            const bool last = (t == nt - 2);
            const size_t ka1 = (size_t)(t + 1) * kstep;
            const size_t ka2 = last ? 0 : (size_t)(t + 2) * kstep, ka3 = ka2 + kstep;
            const char* b2 = last ? nB : cB + (size_t)(t + 2) * kstep; const char* b3 = b2 + kstep;
            unsigned w0[2], w1[2];
            w0[0] = last ? vn[0][0] : va[0][0]; w0[1] = last ? vn[0][1] : va[0][1]; w1[0] = last ? vn[1][0] : va[1][0]; w1[1] = last ? vn[1][1] : va[1][1];
            PG8_LDB(B0, 0, 0); PG8_LDB(B1, 0, 1); PG8_SCHED; PG8_LDA(At, 0, 0); PG8_STAGE(PG8_SA(1, 1), Ab + ka1, va[1]);
            PG8_WAIT_V(8); PG8_WAIT_L(0); PG8_BAR; PG8_MMA(0, 0, At, B0); PG8_MMA(0, 1, At, B1); PG8_BAR; PG8_SCHED;
            PG8_LDA(At, 0, 1); PG8_STAGE(PG8_SB(0, 0), b2, voffB); PG8_STAGE(PG8_SB(0, 1), b2 + hstep, voffB); PG8_STAGE(PG8_SA(0, 0), Ab + ka2, w0);
            PG8_WAIT_V(8); PG8_WAIT_L(0); PG8_BAR; PG8_MMA(1, 0, At, B0); PG8_MMA(1, 1, At, B1); PG8_BAR; PG8_SCHED;
            PG8_LDB(B0, 1, 0); PG8_LDB(B1, 1, 1); PG8_SCHED; PG8_LDA(At, 1, 0); PG8_STAGE(PG8_SA(0, 1), Ab + ka2, w1);
            PG8_WAIT_V(8); PG8_WAIT_L(0); PG8_BAR; PG8_MMA(0, 0, At, B0); PG8_MMA(0, 1, At, B1); PG8_BAR; PG8_SCHED;
            PG8_LDA(At, 1, 1); PG8_STAGE(PG8_SB(1, 0), b3, voffB); PG8_STAGE(PG8_SB(1, 1), b3 + hstep, voffB); PG8_STAGE(PG8_SA(1, 0), Ab + ka3, w0);
            PG8_WAIT_V(8); PG8_WAIT_L(0); PG8_BAR; PG8_MMA(1, 0, At, B0); PG8_MMA(1, 1, At, B1); PG8_BAR; PG8_SCHED;
        }
        if constexpr (ALIGN_EPI) { if (wr == 0) PG8_BAR; }
        E(acc, cur, wr, wc, fr, fq);
        if (!has_next) break;
#pragma unroll
        for (int a = 0; a < 2; ++a)
#pragma unroll
            for (int b = 0; b < 2; ++b)
#pragma unroll
                for (int m = 0; m < 4; ++m)
#pragma unroll
                    for (int n = 0; n < 2; ++n) acc[a][b][m][n] = (f32x4){0.f, 0.f, 0.f, 0.f};
        cur = nxt; cB = nB; ++ui;
        va[0][0] = vn[0][0]; va[0][1] = vn[0][1]; va[1][0] = vn[1][0]; va[1][1] = vn[1][1];
        if constexpr (ALIGN_EPI) { if (wr == 1) PG8_BAR; }
    }
    PG8_WAIT_V(0);
    if constexpr (!ALIGN_EPI) { if (wr == 0) PG8_BAR; }
    PG8_BAR;
#undef PG8_SA
#undef PG8_SB
#undef PG8_STAGE
#undef PG8_LDA
#undef PG8_LDB
#undef PG8_MMA
#undef PG8_WAIT_V
#undef PG8_WAIT_L
#undef PG8_BAR
#undef PG8_SCHED
}

struct AOffDense { int K; __device__ __forceinline__ void operator()(const Unit& u, int, int R0, int C0, int R1, int C1, unsigned (&vo)[2][2]) const {
#pragma unroll
    for (int h = 0; h < 2; ++h) { vo[h][0] = (unsigned)((u.pm * 256 + h * 128 + R0) * K + C0) * 2u; vo[h][1] = (unsigned)((u.pm * 256 + h * 128 + R1) * K + C1) * 2u; } } };
struct AOffGather { int K; const LAS int* tab; __device__ __forceinline__ void operator()(const Unit&, int ui, int R0, int C0, int R1, int C1, unsigned (&vo)[2][2]) const {
#pragma unroll
    for (int h = 0; h < 2; ++h) { vo[h][0] = (unsigned)(tab[ui * 256 + h * 128 + R0] * K + C0) * 2u; vo[h][1] = (unsigned)(tab[ui * 256 + h * 128 + R1] * K + C1) * 2u; } } };
}
struct Frame {
    LAS unsigned char* lds;
    volatile LAS unsigned* MISC;
    gu32* ctl;
    int tid, lane, wave, vcu, G;
    const float* in[31];
    float* out;
    unsigned char* ws;
};
#define LDS_WAIT() asm volatile("s_waitcnt lgkmcnt(0)" ::: "memory")
#define VM_WAIT() asm volatile("s_waitcnt vmcnt(0)" ::: "memory")

__device__ __forceinline__ void prep_item(const float* W, int ldw, int c0s, const float* gain, bf16_t* WT, int K, int n0d, int k0, bool perm, LAS float* scr, int lane) {
#pragma unroll 8
    for (int i = 0; i < 32; ++i) { const int kk = 2 * i + (lane >> 5); float v = W[(size_t)(k0 + kk) * ldw + c0s + (lane & 31)]; if (gain) v *= gain[k0 + kk]; scr[kk * 33 + (lane & 31)] = v; }
    LDS_WAIT(); asm volatile("" ::: "memory");
    const int c = lane & 7;
#pragma unroll
    for (int j = 0; j < 4; ++j) { const int n = (lane >> 3) + 8 * j; const int ns = perm ? pg8::perm32(n) : n; const LAS float* s = scr + (8 * c) * 33 + ns;
        u32x4 o; o.x = pk2(s[0 * 33], s[1 * 33]); o.y = pk2(s[2 * 33], s[3 * 33]); o.z = pk2(s[4 * 33], s[5 * 33]); o.w = pk2(s[6 * 33], s[7 * 33]);
        *(GAS u32x4*)(WT + (size_t)(n0d + n) * K + k0 + 8 * c) = o; }
    LDS_WAIT(); asm volatile("" ::: "memory");
}
__device__ __forceinline__ int win_src_col(int gd) {
    const int tile = gd >> 3, bj = (gd >> 2) & 1, wc = gd & 3;
    if (tile < 4) return 256 * tile + 128 * bj + 32 * wc;
    if (tile < 6) return (bj ? 1288 : 1032) + 128 * (tile - 4) + 32 * wc;
    if (tile < 8) return 1544 + 256 * (tile - 6) + 64 * wc + 32 * bj;
    if (tile < 10) return 2056 + 256 * (tile - 8) + 64 * wc + 32 * bj;
    return 2568 + 256 * (tile - 10) + 128 * bj + 32 * wc;
}
__device__ __forceinline__ void p0_prologue(Frame& F) {
    LAS float* scr = (LAS float*)(F.lds + F.wave * 16384);
    const int gw = F.vcu * NWAVES + F.wave, NGW = F.G * NWAVES, lane = F.lane;
    bf16_t* ws16 = (bf16_t*)F.ws;
    constexpr int I_IN = 16 * 96, I_OUT = 16 * 32, I_DGU = 16 * 176, I_DD = 44 * 32, I_MGU = 16 * 224, I_MD = 56 * 32, I_PG = 16 * 32, I_PP = 4 * 32;
    constexpr int NITEMS = 2 * I_IN + 2 * I_OUT + I_DGU + I_DD + 8 * I_MGU + 8 * I_MD + 2 * I_PG + 2 * I_PP;
    for (int it = gw; it < NITEMS; it += NGW) {
        int r = it;
        const float* W; const float* gain = nullptr; bf16_t* WT; int ldw, c0s, K, gd, kb; bool perm = false;
        if (r < 2 * I_IN) { const int L = r / I_IN; r %= I_IN; gd = r % 96; kb = r / 96;
            W = F.in[3] + (size_t)L * D * DIN; ldw = DIN; c0s = win_src_col(gd); gain = F.in[2] + L * D; WT = (bf16_t*)(F.ws + WS_WIN) + (size_t)L * NIN * D; K = D; perm = true; }
        else if ((r -= 2 * I_IN) < 2 * I_OUT) { const int L = r / I_OUT; r %= I_OUT; gd = r % 32; kb = r / 32;
            W = F.in[19] + (size_t)L * D * D; ldw = D; c0s = 32 * gd; WT = (bf16_t*)(F.ws + WS_WOUT) + (size_t)L * D * D; K = D; }
        else if ((r -= 2 * I_OUT) < I_DGU) { gd = r % 176; kb = r / 176; const int tile = gd >> 3, bj = (gd >> 2) & 1, wc = gd & 3;
            W = bj ? F.in[22] : F.in[21]; ldw = FFD; c0s = 128 * tile + 32 * wc; gain = F.in[20]; WT = (bf16_t*)(F.ws + WS_WDGU); K = D; perm = true; }
        else if ((r -= I_DGU) < I_DD) { gd = r % 32; kb = r / 32;
            W = F.in[23]; ldw = D; c0s = 32 * gd; WT = (bf16_t*)(F.ws + WS_WDD); K = FFD; }
        else if ((r -= I_DD) < 8 * I_MGU) { const int e = r / I_MGU; r %= I_MGU; gd = r % 224; kb = r / 224; const int tile = gd >> 3, bj = (gd >> 2) & 1, wc = gd & 3;
            W = (bj ? F.in[26] : F.in[25]) + (size_t)e * D * FFE; ldw = FFE; c0s = 128 * tile + 32 * wc; gain = F.in[20] + D; WT = (bf16_t*)(F.ws + WS_WMGU) + (size_t)e * 2 * FFE * D; K = D; perm = true; }
        else if ((r -= 8 * I_MGU) < 8 * I_MD) { const int e = r / I_MD; r %= I_MD; gd = r % 32; kb = r / 32;
            W = F.in[27] + (size_t)e * FFE * D; ldw = D; c0s = 32 * gd; WT = (bf16_t*)(F.ws + WS_WMD) + (size_t)e * D * FFE; K = FFE; }
        else if ((r -= 8 * I_MD) < 2 * I_PG) { const int L = r / I_PG; r %= I_PG; gd = r % 32; kb = r / 32;
            W = F.in[29] + (size_t)L * D * D; ldw = D; c0s = 32 * gd; gain = F.in[28] + L * D; WT = (bf16_t*)(F.ws + WS_WPG) + (size_t)L * D * D; K = D; }
        else { r -= 2 * I_PG; const int L = r / I_PP; r %= I_PP; gd = r % 32; kb = r / 32;
            W = F.in[30] + (size_t)L * PLE * D; ldw = D; c0s = 32 * gd; WT = (bf16_t*)(F.ws + WS_WPP) + (size_t)L * D * PLE; K = PLE; }
        prep_item(W, ldw, c0s, gain, WT, K, 32 * gd, 64 * kb, perm, scr, lane);
    }
    (void)ws16;
    float* wsm = (float*)(F.ws + WS_WSM);
    const int gt = F.vcu * (NWAVES * 64) + F.tid, NGT = F.G * NWAVES * 64;
    for (int i = gt; i < 3 * 8 * D; i += NGT) {
        const int which = i / (8 * D), j = (i / D) % 8, k = i % D;
        float v;
        if (which < 2) v = F.in[2][which * D + k] * F.in[3][(size_t)which * D * DIN + (size_t)k * DIN + 1024 + j];
        else v = F.in[20][D + k] * F.in[24][k * NE + j];
        wsm[i] = v;
    }
}

template <int MODE>
__device__ __forceinline__ void norm_phase(Frame& F, const float* src, const float* wx, const float* pconv, bf16_t* pconv_out) {
    bf16_t* AY = (bf16_t*)(F.ws + WS_AY);
    LAS float* wl = (LAS float*)F.lds;
    LAS int* rinfo = (LAS int*)(F.lds + 32768);
    if (MODE != 0) { for (int i = F.tid; i < 8 * D; i += NWAVES * 64) wl[i] = wx[i]; __syncthreads(); }
    const int gw = F.vcu * NWAVES + F.wave, NGW = F.G * NWAVES, lane = F.lane;
    int nrow = 0;
    for (int m = gw; m < M; m += NGW, ++nrow) {
        const GAS f32x4* xr = (const GAS f32x4*)(src + (size_t)m * D) + lane;
        f32x4 v[4]; float s = 0.f;
#pragma unroll
        for (int j = 0; j < 4; ++j) { v[j] = xr[64 * j]; s += (v[j].x * v[j].x + v[j].y * v[j].y) + (v[j].z * v[j].z + v[j].w * v[j].w); }
        const float rs = 1.0f / sqrtf(wave_sum(s) * (1.f / D) + EPS);
#pragma unroll
        for (int j = 0; j < 4; ++j) v[j] = v[j] * rs;
        GAS unsigned long long* o8 = (GAS unsigned long long*)(AY + (size_t)m * D) + lane;
#pragma unroll
        for (int j = 0; j < 4; ++j) o8[64 * j] = (unsigned long long)pk2(v[j].x, v[j].y) | ((unsigned long long)pk2(v[j].z, v[j].w) << 32);
        if (MODE != 0) {
            float dt[8];
#pragma unroll
            for (int c = 0; c < 8; ++c) { float a = 0.f;
#pragma unroll
                for (int j = 0; j < 4; ++j) { const f32x4 w = *(const LAS f32x4*)(wl + c * D + 256 * j + 4 * lane); a += (v[j].x * w.x + v[j].y * w.y) + (v[j].z * w.z + v[j].w * w.w); }
                dt[c] = wave_sum(a); }
            if (MODE == 1) { if (lane == 0) { GAS f32x4* g = (GAS f32x4*)((float*)(F.ws + WS_GATE) + (size_t)m * 8); g[0] = (f32x4){dt[0], dt[1], dt[2], dt[3]}; g[1] = (f32x4){dt[4], dt[5], dt[6], dt[7]}; } }
            if (MODE == 2) {
                int i0 = 0;
#pragma unroll
                for (int e = 1; e < 8; ++e) if (dt[e] > dt[i0]) i0 = e;
                int i1 = (i0 == 0) ? 1 : 0;
#pragma unroll
                for (int e = 0; e < 8; ++e) if (e != i0 && dt[e] > dt[i1]) i1 = e;
                float v0 = dt[0], v1 = dt[0];
#pragma unroll
                for (int e = 0; e < 8; ++e) { v0 = (e == i0) ? dt[e] : v0; v1 = (e == i1) ? dt[e] : v1; }
                const float e1 = __expf(v1 - v0), g0 = 1.f / (1.f + e1), g1 = e1 / (1.f + e1);
                if (lane == 0) {
                    float* gv = (float*)(F.ws + WS_MOE + MOE_GATEV); gv[m] = g0; gv[M + m] = g1;
                    rinfo[(F.wave * 16 + nrow) * 2] = i0; rinfo[(F.wave * 16 + nrow) * 2 + 1] = i1;
                }
            }
        }
    }
    if (MODE == 2) {
        __syncthreads();
        if (F.tid < 16) {
            const int s = F.tid >> 3, e = F.tid & 7; int n = 0;
#pragma unroll 1
            for (int wr_ = 0; wr_ < 128; ++wr_) n += (rinfo[wr_ * 2 + s] == e) ? 1 : 0;
            unsigned base = 0; if (n) base = __hip_atomic_fetch_add((unsigned*)(F.ctl + CW_CNT + s * 8 + e), (unsigned)n, RLX_AGENT);
            int* list = (int*)(F.ws + WS_MOE + MOE_LIST) + ((size_t)(s * 8 + e)) * M;
            int k = 0;
#pragma unroll 1
            for (int wr_ = 0; wr_ < 128; ++wr_) if (rinfo[wr_ * 2 + s] == e) { list[base + k] = (F.vcu * NWAVES + (wr_ >> 4)) + (wr_ & 15) * NGW; ++k; }
        }
        __syncthreads();
    }
    if (pconv) {
        const size_t n4 = (size_t)M * PLE / 4, gt = (size_t)F.vcu * (NWAVES * 64) + F.tid, NGT = (size_t)F.G * NWAVES * 64;
        for (size_t i = gt; i < n4; i += NGT) { const f32x4 x = ((const GAS f32x4*)pconv)[i]; ((GAS unsigned long long*)pconv_out)[i] = (unsigned long long)pk2(x.x, x.y) | ((unsigned long long)pk2(x.z, x.w) << 32); }
    }
}

typedef f32x4 AccT[2][2][4][2];
__device__ __forceinline__ u32x4 pack8(const f32x4& a, const f32x4& b) { u32x4 w; w.x = cvt_pk_bf16(a[0], a[1]); w.y = cvt_pk_bf16(a[2], a[3]); w.z = cvt_pk_bf16(b[0], b[1]); w.w = cvt_pk_bf16(b[2], b[3]); return w; }

struct EpiIn {
    bf16_t* U; const float* gq; const float* gk;
    __device__ __forceinline__ void operator()(const AccT& acc, const pg8::Unit& u, int wr, int wc, int fr, int fq) const {
        const int row0 = u.pm * 256 + wr * 64 + fr, pn = u.pn;
        if (pn < 4 || pn >= 10) {
            const int cb = (pn < 4 ? 256 * pn : UC_V + 256 * (pn - 10)) + wc * 32 + 8 * fq;
#pragma unroll
            for (int ai = 0; ai < 2; ++ai)
#pragma unroll
                for (int m = 0; m < 4; ++m) { bf16_t* rp = U + (size_t)(row0 + ai * 128 + m * 16) * UW + cb;
#pragma unroll
                    for (int bj = 0; bj < 2; ++bj) *(u32x4*)(rp + bj * 128) = pack8(acc[ai][bj][m][0], acc[ai][bj][m][1]); }
        } else if (pn < 6) {
            const int cb = UC_Z + 128 * (pn - 4) + wc * 32 + 8 * fq;
#pragma unroll
            for (int ai = 0; ai < 2; ++ai)
#pragma unroll
                for (int m = 0; m < 4; ++m) { f32x4 z0, z1;
#pragma unroll
                    for (int i = 0; i < 4; ++i) { z0[i] = acc[ai][0][m][0][i] * fast_sigmoid(acc[ai][1][m][0][i]); z1[i] = acc[ai][0][m][1][i] * fast_sigmoid(acc[ai][1][m][1][i]); }
                    *(u32x4*)(U + (size_t)(row0 + ai * 128 + m * 16) * UW + cb) = pack8(z0, z1); }
        } else {
            const bool isq = pn < 8; const int j = 4 * (pn - (isq ? 6 : 8)) + wc;
            const float* g = isq ? gq : gk; const float sc = isq ? C2 : 1.f;
            f32x4 gv[2][2];
#pragma unroll
            for (int bj = 0; bj < 2; ++bj)
#pragma unroll
                for (int n = 0; n < 2; ++n) gv[bj][n] = *(const f32x4*)(g + 32 * bj + 8 * fq + 4 * n) * sc;
            const int cb = (isq ? UC_Q : UC_K) + 64 * j + 8 * fq;
#pragma unroll
            for (int ai = 0; ai < 2; ++ai)
#pragma unroll
                for (int m = 0; m < 4; ++m) { float ss = 0.f;
#pragma unroll
                    for (int bj = 0; bj < 2; ++bj)
#pragma unroll
                        for (int n = 0; n < 2; ++n) { const f32x4 x = acc[ai][bj][m][n]; ss += (x[0] * x[0] + x[1] * x[1]) + (x[2] * x[2] + x[3] * x[3]); }
                    ss += __shfl_xor(ss, 16); ss += __shfl_xor(ss, 32);
                    const float rs = 1.0f / sqrtf(ss * (1.f / 64.f) + EPS);
                    bf16_t* rp = U + (size_t)(row0 + ai * 128 + m * 16) * UW + cb;
#pragma unroll
                    for (int bj = 0; bj < 2; ++bj) *(u32x4*)(rp + 32 * bj) = pack8(acc[ai][bj][m][0] * gv[bj][0] * rs, acc[ai][bj][m][1] * gv[bj][1] * rs); }
        }
    }
};
struct EpiRes {
    const float* res; float* out;
    __device__ __forceinline__ void operator()(const AccT& acc, const pg8::Unit& u, int wr, int wc, int fr, int fq) const {
        const int row0 = u.pm * 256 + wr * 64 + fr, col0 = u.pn * 256 + wc * 32 + 4 * fq;
#pragma unroll
        for (int ai = 0; ai < 2; ++ai)
#pragma unroll
            for (int m = 0; m < 4; ++m) { const size_t ro = (size_t)(row0 + ai * 128 + m * 16) * D + col0;
#pragma unroll
                for (int bj = 0; bj < 2; ++bj)
#pragma unroll
                    for (int n = 0; n < 2; ++n) { const size_t o = ro + bj * 128 + n * 16; *(f32x4*)(out + o) = *(const f32x4*)(res + o) + acc[ai][bj][m][n]; } }
    }
};
struct EpiGlu {
    bf16_t* O; int ldc;
    __device__ __forceinline__ void operator()(const AccT& acc, const pg8::Unit& u, int wr, int wc, int fr, int fq) const {
        const int row0 = u.pm * 256 + wr * 64 + fr, cb = 128 * u.pn + wc * 32 + 8 * fq;
#pragma unroll
        for (int ai = 0; ai < 2; ++ai)
#pragma unroll
            for (int m = 0; m < 4; ++m) { f32x4 z0, z1;
#pragma unroll
                for (int i = 0; i < 4; ++i) { const float g0 = acc[ai][0][m][0][i], g1 = acc[ai][0][m][1][i]; z0[i] = g0 * fast_sigmoid(g0) * acc[ai][1][m][0][i]; z1[i] = g1 * fast_sigmoid(g1) * acc[ai][1][m][1][i]; }
                *(u32x4*)(O + (size_t)(row0 + ai * 128 + m * 16) * ldc + cb) = pack8(z0, z1); }
    }
};
struct EpiScatter {
    float* out; const int* list_s; const float* gatev_s; const LAS int* rt_info;
    __device__ __forceinline__ void operator()(const AccT& acc, const pg8::Unit& u, int wr, int wc, int fr, int fq) const {
        const int e = rt_info[3 * u.pm], i0 = rt_info[3 * u.pm + 1], nv = rt_info[3 * u.pm + 2];
        const int col0 = u.pn * 256 + wc * 32 + 4 * fq;
        const int* lst = list_s + (size_t)e * M + i0;
#pragma unroll
        for (int ai = 0; ai < 2; ++ai)
#pragma unroll
            for (int m = 0; m < 4; ++m) { const int r = ai * 128 + wr * 64 + m * 16 + fr;
                if (r < nv) { const int tok = lst[r]; const float g = gatev_s[tok]; const size_t ro = (size_t)tok * D + col0;
#pragma unroll
                    for (int bj = 0; bj < 2; ++bj)
#pragma unroll
                        for (int n = 0; n < 2; ++n) { const size_t o = ro + bj * 128 + n * 16; *(f32x4*)(out + o) = *(const f32x4*)(out + o) + acc[ai][bj][m][n] * g; } } }
    }
};
struct EpiPe {
    bf16_t* O;
    __device__ __forceinline__ void operator()(const AccT& acc, const pg8::Unit& u, int wr, int wc, int fr, int fq) const {
        const int row0 = u.pm * 256 + wr * 64 + fr, col0 = u.pn * 256 + wc * 32 + 4 * fq;
#pragma unroll
        for (int ai = 0; ai < 2; ++ai)
#pragma unroll
            for (int m = 0; m < 4; ++m) { const size_t ro = (size_t)(row0 + ai * 128 + m * 16) * D + col0;
#pragma unroll
                for (int bj = 0; bj < 2; ++bj)
#pragma unroll
                    for (int n = 0; n < 2; ++n) { const f32x4 x = acc[ai][bj][m][n]; u32x2 w; w.x = cvt_pk_bf16(x[0], x[1]); w.y = cvt_pk_bf16(x[2], x[3]); *(u32x2*)(O + ro + bj * 128 + n * 16) = w; } }
    }
};
struct EpiPle {
    float* out; const bf16_t* PE;
    __device__ __forceinline__ void operator()(const AccT& acc, const pg8::Unit& u, int wr, int wc, int fr, int fq) const {
        const int row0 = u.pm * 256 + wr * 64 + fr, col0 = u.pn * 256 + wc * 32 + 4 * fq;
#pragma unroll
        for (int ai = 0; ai < 2; ++ai)
#pragma unroll
            for (int m = 0; m < 4; ++m) { const size_t ro = (size_t)(row0 + ai * 128 + m * 16) * D + col0;
#pragma unroll
                for (int bj = 0; bj < 2; ++bj)
#pragma unroll
                    for (int n = 0; n < 2; ++n) { const size_t o = ro + bj * 128 + n * 16; const u32x2 w = *(const u32x2*)(PE + o); const f32x4 x = acc[ai][bj][m][n]; f32x4 h = *(const f32x4*)(out + o);
                        h[0] += fast_sigmoid(x[0]) * bflo(w.x); h[1] += fast_sigmoid(x[1]) * bfhi(w.x); h[2] += fast_sigmoid(x[2]) * bflo(w.y); h[3] += fast_sigmoid(x[3]) * bfhi(w.y);
                        *(f32x4*)(out + o) = h; } }
    }
};

struct MoeSched {
    pg8::StaticOrder so; const LAS int* rt_info; int ntn;
    __device__ __forceinline__ bool next(int i, pg8::Unit& u) const { if (!so.tile(i, u.pm, u.pn)) return false; u.pb = rt_info[3 * u.pm] * ntn + u.pn; return true; }
};
__device__ __forceinline__ int moe_build_tiles(Frame& F, int s, LAS int* rt_info) {
    int RT = 0;
    int cnt[8];
#pragma unroll
    for (int e = 0; e < 8; ++e) cnt[e] = (int)__hip_atomic_load((unsigned*)(F.ctl + CW_CNT + s * 8 + e), RLX_AGENT);
    if (F.tid == 0) { int rt = 0; for (int e = 0; e < 8; ++e) for (int i0 = 0; i0 < cnt[e]; i0 += 256) { rt_info[3 * rt] = e; rt_info[3 * rt + 1] = i0; rt_info[3 * rt + 2] = (cnt[e] - i0) < 256 ? (cnt[e] - i0) : 256; ++rt; } }
#pragma unroll
    for (int e = 0; e < 8; ++e) RT += (cnt[e] + 255) >> 8;
    __syncthreads();
    return RT;
}
namespace nvb {
using nv::sigmoidf_; using nv::siluf_; using nv::wsum; using nv::wmax;
__global__ void mprep(const bf16_t* U, const float* GATE, const float* cw, const float* bi, const float* bf, float* QK, float* IG, float* LF) {
    const int t = blockIdx.x, c = threadIdx.x;
    float acc = 0.f;
    for (int j = 0; j < 4; ++j) { const int tt = t - 3 + j; if (tt >= 0) acc += cw[j * 512 + c] * bf2f(U[(size_t)tt * UW + c]); }
    QK[(size_t)t * 512 + c] = siluf_(acc);
    if (c < 4) {
        IG[t * 4 + c] = GATE[(size_t)t * 8 + c] + bi[c];
        const float f = GATE[(size_t)t * 8 + 4 + c] + bf[c];
        LF[t * 4 + c] = fminf(f, 0.f) - log1pf(expf(-fabsf(f)));
    }
}
__global__ void mlstm_rec(const float* QK, const bf16_t* U, const float* IG, const float* LF, float* HM) {
    __shared__ float sq[64][64], sk[64][64], sv[64][64];
    __shared__ float sig[64], slf[64];
    __shared__ float red[2][4][64], redd[2][4][64];
    const int h = blockIdx.x, tid = threadIdx.x, e = tid & 63, dq = tid >> 6;
    float C[16], n[16]; float m = 0.f;
    for (int i = 0; i < 16; ++i) { C[i] = 0.f; n[i] = 0.f; }
    for (int t0 = 0; t0 < SEQ; t0 += 64) {
        __syncthreads();
        for (int i = tid; i < 64 * 64; i += 256) {
            const int tt = i >> 6, d = i & 63;
            sq[tt][d] = QK[(size_t)(t0 + tt) * 512 + h * 64 + d] * 0.125f;
            sk[tt][d] = QK[(size_t)(t0 + tt) * 512 + 256 + h * 64 + d];
            sv[tt][d] = bf2f(U[(size_t)(t0 + tt) * UW + UC_MV + h * 64 + d]);
        }
        if (tid < 64) { sig[tid] = IG[(t0 + tid) * 4 + h]; slf[tid] = LF[(t0 + tid) * 4 + h]; }
        __syncthreads();
        for (int tt = 0; tt < 64; ++tt) {
            const float ig = sig[tt], lf = slf[tt];
            const float mn = fmaxf(lf + m, ig), a = expf(lf + m - mn), bb = expf(ig - mn);
            m = mn;
            const float v = sv[tt][e];
            float num = 0.f, den = 0.f;
#pragma unroll
            for (int i = 0; i < 16; ++i) {
                const int d = dq * 16 + i; const float k = sk[tt][d], q = sq[tt][d];
                C[i] = a * C[i] + bb * k * v; n[i] = a * n[i] + bb * k;
                num += q * C[i]; den += q * n[i];
            }
            red[tt & 1][dq][e] = num; redd[tt & 1][dq][e] = den;
            __syncthreads();
            if (dq == 0) {
                const float nu = red[tt & 1][0][e] + red[tt & 1][1][e] + red[tt & 1][2][e] + red[tt & 1][3][e];
                const float de = redd[tt & 1][0][e] + redd[tt & 1][1][e] + redd[tt & 1][2][e] + redd[tt & 1][3][e];
                HM[(size_t)(t0 + tt) * 256 + h * 64 + e] = nu / fmaxf(fabsf(de), expf(-m));
            }
        }
    }
}
__global__ void mgate(const float* HMN, const bf16_t* U, bf16_t* Y) {
    const int t = blockIdx.x, c = threadIdx.x;
    Y[(size_t)t * D + c] = (bf16_t)f2bf(HMN[(size_t)t * 256 + c] * sigmoidf_(bf2f(U[(size_t)t * UW + UC_MO + c])));
}
__global__ void cconv(const bf16_t* U, const float* w, const float* b, const float* lg, const float* lb, bf16_t* Y) {
    __shared__ float sm[4], sv2[4];
    const int t = blockIdx.x, c = threadIdx.x;
    float acc = b[c];
    for (int j = 0; j < 31; ++j) { const int tt = t - 30 + j; if (tt >= 0) acc += w[j * 256 + c] * bf2f(U[(size_t)tt * UW + UC_Z + c]); }
    float s = wsum(acc);
    if ((c & 63) == 0) sm[c >> 6] = s;
    __syncthreads();
    const float mu = (sm[0] + sm[1] + sm[2] + sm[3]) * (1.f / 256.f);
    const float dv = acc - mu;
    float s2 = wsum(dv * dv);
    if ((c & 63) == 0) sv2[c >> 6] = s2;
    __syncthreads();
    const float var = (sv2[0] + sv2[1] + sv2[2] + sv2[3]) * (1.f / 256.f);
    const float yv = dv * rsqrtf(var + 1e-6f) * lg[c] + lb[c];
    Y[(size_t)t * D + 256 + c] = (bf16_t)f2bf(siluf_(yv));
}
__global__ void attn(const bf16_t* U, float* O) {
    __shared__ float sK[64][65];
    __shared__ float sV[64][128];
    __shared__ float sQ[16][64];
    __shared__ float sP[16][64];
    const int j = blockIdx.y, hd = j >> 1, q0 = blockIdx.x * 16, tid = threadIdx.x, w = tid >> 6, lane = tid & 63;
    const int qpos = q0 + w;
    const float slope2 = exp2f(-8.f * (float)(hd + 1) / 4.f) * 1.4426950408889634f;
    sQ[w][lane] = bf2f(U[(size_t)qpos * UW + UC_Q + j * 64 + lane]);
    float m = -INFINITY, l = 0.f, o0 = 0.f, o1 = 0.f;
    const int ntile = (q0 + 15) / 64 + 1;
    for (int kt = 0; kt < ntile; ++kt) {
        __syncthreads();
        for (int i = tid; i < 64 * 64; i += 1024) { const int r = i >> 6, d = i & 63; sK[r][d] = bf2f(U[(size_t)(kt * 64 + r) * UW + UC_K + j * 64 + d]); }
        for (int i = tid; i < 64 * 128; i += 1024) { const int r = i >> 7, d = i & 127; sV[r][d] = bf2f(U[(size_t)(kt * 64 + r) * UW + UC_V + hd * 128 + d]); }
        __syncthreads();
        const int kpos = kt * 64 + lane;
        float s = 0.f;
        for (int d = 0; d < 64; ++d) s += sQ[w][d] * sK[lane][d];
        s = s - slope2 * (float)(qpos - kpos);
        if (kpos > qpos) s = -INFINITY;
        const float tm = wmax(s), mn = fmaxf(m, tm), corr = exp2f(m - mn), p = exp2f(s - mn);
        l = l * corr + wsum(p); o0 *= corr; o1 *= corr; m = mn;
        sP[w][lane] = p;
        __syncthreads();
        for (int k = 0; k < 64; ++k) { const float pk = sP[w][k]; o0 += pk * sV[k][lane]; o1 += pk * sV[k][64 + lane]; }
    }
    O[((size_t)qpos * 8 + j) * 128 + lane] = o0 / l;
    O[((size_t)qpos * 8 + j) * 128 + 64 + lane] = o1 / l;
}
__global__ void subln(const float* YA, const float* gain, float scale, bf16_t* Y) {
    const int rg = blockIdx.x, row = rg >> 2, g = rg & 3, lane = threadIdx.x;
    const float* x = YA + (size_t)row * 512 + g * 128;
    const float a = x[lane], b = x[64 + lane];
    const float r = rsqrtf(wsum(a * a + b * b) / 128.f + 1e-6f);
    Y[(size_t)row * D + 512 + g * 128 + lane] = (bf16_t)f2bf(a * r * gain[lane] * scale);
    Y[(size_t)row * D + 512 + g * 128 + 64 + lane] = (bf16_t)f2bf(b * r * gain[64 + lane] * scale);
}
static void mixers(void* const* d_in, unsigned char* ws, int L, hipStream_t st, int mask) {
    const float* const* in = (const float* const*)d_in;
    unsigned char* tail = ws + WS_BIG + 176 * MiB;
    float* QK = (float*)tail; float* HM = (float*)(tail + 16 * MiB); float* HMN = (float*)(tail + 24 * MiB); float* AO = (float*)tail;
    float* YA = (float*)(tail + 32 * MiB); float* IG = (float*)(tail + 48 * MiB); float* LF = (float*)(tail + 49 * MiB);
    const float lam_init = 0.8f - 0.6f * expf(-0.3f * (float)L);
    for (int b = 0; b < NB; ++b) {
        const bf16_t* U = (const bf16_t*)(ws + WS_BIG) + (size_t)b * SEQ * UW;
        const float* GATE = (const float*)(ws + WS_GATE) + (size_t)b * SEQ * 8;
        bf16_t* Y = (bf16_t*)(ws + WS_AY) + (size_t)b * SEQ * D;
        if (mask & 1) {
        hipLaunchKernelGGL(mprep, dim3(SEQ), dim3(512), 0, st, U, GATE, in[6] + L * 2048, in[4] + L * 4, in[5] + L * 4, QK, IG, LF);
        hipLaunchKernelGGL(mlstm_rec, dim3(4), dim3(256), 0, st, (const float*)QK, U, (const float*)IG, (const float*)LF, HM);
        hipLaunchKernelGGL(nv::groupnorm, dim3(SEQ * 4), dim3(64), 0, st, (const float*)HM, 256, HMN, 256, 4, 64, in[7] + L * 256, 64, 1.f);
        hipLaunchKernelGGL(mgate, dim3(SEQ), dim3(256), 0, st, (const float*)HMN, U, Y);
        }
        if (mask & 2)
        hipLaunchKernelGGL(cconv, dim3(SEQ), dim3(256), 0, st, U, in[8] + L * 31 * 256, in[9] + L * 256, in[10] + L * 256, in[11] + L * 256, Y);
        if (mask & 4) {
        hipLaunchKernelGGL(attn, dim3(SEQ / 16, 8), dim3(1024), 0, st, U, AO);
        hipLaunchKernelGGL(nv::acomb, dim3(SEQ), dim3(512), 0, st, (const float*)AO, in[14] + L * 64, in[15] + L * 64, in[16] + L * 64, in[17] + L * 64, lam_init, YA);
        hipLaunchKernelGGL(subln, dim3(SEQ * 4), dim3(64), 0, st, (const float*)YA, in[18] + L * 128, 1.f - lam_init, Y);
        }
    }
}
}
typedef float f32x16 __attribute__((ext_vector_type(16)));
typedef short s16x4 __attribute__((ext_vector_type(4)));
typedef short v4i16_t __attribute__((ext_vector_type(4)));
#define MFMA32(a, b, c) __builtin_amdgcn_mfma_f32_32x32x16_bf16((a), (b), (c), 0, 0, 0)
__device__ __forceinline__ int crow(int r, int hi) { return (r & 3) + 8 * (r >> 2) + 4 * hi; }
__device__ __forceinline__ float fast_silu(float x) { return x * fast_sigmoid(x); }
__device__ __forceinline__ s16x4 tr_read(const LAS unsigned char* p) { return __builtin_bit_cast(s16x4, __builtin_amdgcn_ds_read_tr16_b64_v4i16((LAS v4i16_t*)p)); }
__device__ __forceinline__ bf16x8 tr_frag(const LAS unsigned char* T, int row0, int step2, int c0, int lane) {
    const int q = (lane & 15) >> 2, p = lane & 3, cg = (lane >> 4) & 1;
    const LAS unsigned char* a = T + (row0 + q) * 128 + (c0 + 16 * cg + 4 * p) * 2;
    const s16x4 lo = tr_read(a), hi = tr_read(a + step2 * 128);
    return (bf16x8){lo[0], lo[1], lo[2], lo[3], hi[0], hi[1], hi[2], hi[3]};
}

__device__ __forceinline__ void conformer_phase(Frame& F, int L) {
    const bf16_t* U = (const bf16_t*)(F.ws + WS_BIG); bf16_t* Y = (bf16_t*)(F.ws + WS_AY);
    const float* cw = F.in[8] + L * 31 * 256; const float* cb = F.in[9] + L * 256; const float* lg = F.in[10] + L * 256; const float* lb = F.in[11] + L * 256;
    LAS unsigned char* zt = F.lds;
    LAS float* ot = (LAS float*)(F.lds + 49152);
    const int tid = F.tid, c = tid & 255, hf = tid >> 8;
    float w[31];
#pragma unroll
    for (int j = 0; j < 31; ++j) w[j] = cw[j * 256 + c];
    const float bias = cb[c];
    for (int unit = F.vcu; unit < M / 64; unit += F.G) {
        const int row0 = unit * 64, t0 = row0 & (SEQ - 1);
        __syncthreads();
        for (int i = tid; i < 94 * 32; i += NWAVES * 64) { const int r = i >> 5, ch = i & 31; u32x4 v = (u32x4){0u, 0u, 0u, 0u};
            if (t0 - 30 + r >= 0) v = *(const GAS u32x4*)(U + (size_t)(row0 - 30 + r) * UW + UC_Z + ch * 8);
            *(LAS u32x4*)(zt + r * 512 + ch * 16) = v; }
        __syncthreads();
        float acc[32];
#pragma unroll
        for (int o = 0; o < 32; ++o) acc[o] = bias;
#pragma unroll
        for (int i = 0; i < 62; ++i) { const float x = bf2f(*(const LAS unsigned short*)(zt + (32 * hf + i) * 512 + c * 2));
#pragma unroll
            for (int o = 0; o < 32; ++o) { const int j = i - o; if (j >= 0 && j < 31) acc[o] += w[j] * x; } }
#pragma unroll
        for (int o = 0; o < 32; ++o) ot[(32 * hf + o) * 260 + c] = acc[o];
        __syncthreads();
        const f32x4 g4 = *(const f32x4*)(lg + 4 * F.lane), b4 = *(const f32x4*)(lb + 4 * F.lane);
#pragma unroll 2
        for (int tt = 0; tt < 8; ++tt) { const int t = F.wave * 8 + tt;
            const f32x4 x = *(const LAS f32x4*)(ot + t * 260 + 4 * F.lane);
            const float mu = wave_sum((x[0] + x[1]) + (x[2] + x[3])) * (1.f / 256.f);
            const f32x4 dv = x - mu;
            const float var = wave_sum((dv[0] * dv[0] + dv[1] * dv[1]) + (dv[2] * dv[2] + dv[3] * dv[3])) * (1.f / 256.f);
            const float rstd = 1.0f / sqrtf(var + EPS);
            f32x4 y = dv * rstd * g4 + b4;
#pragma unroll
            for (int i = 0; i < 4; ++i) y[i] = fast_silu(y[i]);
            u32x2 o; o.x = cvt_pk_bf16(y[0], y[1]); o.y = cvt_pk_bf16(y[2], y[3]);
            *(GAS u32x2*)(Y + (size_t)(row0 + t) * D + 256 + 4 * F.lane) = o; }
    }
    __syncthreads();
}

constexpr size_t MST_N = (size_t)2048 * 4096 * 4, MST_MG = MST_N + (size_t)2048 * 64 * 4, MST_MP = MST_MG + (size_t)2048 * 2 * 4;
template <bool NEEDQ>
__device__ __forceinline__ void mlstm_load(const bf16_t* U, const float* cw, int row0, int t0, int h, int lane, float kscale, float qscale, LAS unsigned char* qt, LAS unsigned char* kt, LAS unsigned char* vt) {
    { const GAS u32x4* vp = (const GAS u32x4*)(U + (size_t)(row0 + lane) * UW + UC_MV + h * 64);
#pragma unroll
      for (int i = 0; i < 8; ++i) *(LAS u32x4*)(vt + lane * 128 + i * 16) = vp[i]; }
#pragma unroll
    for (int which = NEEDQ ? 0 : 1; which < 2; ++which) {
        const int col = (which ? UC_MK : UC_MQ) + h * 64; const float* wv = cw + (which ? 256 : 0) + h * 64; LAS unsigned char* dst = which ? kt : qt; const float sc = which ? kscale : qscale;
#pragma unroll
        for (int i = 0; i < 8; ++i) {
            float acc[8];
#pragma unroll
            for (int d = 0; d < 8; ++d) acc[d] = 0.f;
#pragma unroll
            for (int j = 0; j < 4; ++j) { u32x4 x = (u32x4){0u, 0u, 0u, 0u};
                if (t0 + lane - 3 + j >= 0) x = *(const GAS u32x4*)(U + (size_t)(row0 + lane - 3 + j) * UW + col + i * 8);
                const float* wj = wv + j * 512 + i * 8;
                acc[0] += wj[0] * bflo(x.x); acc[1] += wj[1] * bfhi(x.x); acc[2] += wj[2] * bflo(x.y); acc[3] += wj[3] * bfhi(x.y);
                acc[4] += wj[4] * bflo(x.z); acc[5] += wj[5] * bfhi(x.z); acc[6] += wj[6] * bflo(x.w); acc[7] += wj[7] * bfhi(x.w); }
#pragma unroll
            for (int d = 0; d < 8; ++d) acc[d] = fast_silu(acc[d]) * sc;
            u32x4 o; o.x = cvt_pk_bf16(acc[0], acc[1]); o.y = cvt_pk_bf16(acc[2], acc[3]); o.z = cvt_pk_bf16(acc[4], acc[5]); o.w = cvt_pk_bf16(acc[6], acc[7]);
            *(LAS u32x4*)(dst + lane * 128 + i * 16) = o; }
    }
}
__device__ __forceinline__ void mlstm_gates(const float* GATE, const float* bi, const float* bfg, int row0, int h, int lane, float& ig, float& bcum, float& g) {
    ig = GATE[(size_t)(row0 + lane) * 8 + h] + bi[h];
    const float f = GATE[(size_t)(row0 + lane) * 8 + 4 + h] + bfg[h];
    float lf = fminf(f, 0.f) - log1pf(__expf(-fabsf(f)));
#pragma unroll
    for (int o = 1; o < 64; o <<= 1) { const float t = __shfl_up(lf, o); if (lane >= o) lf += t; }
    bcum = lf; g = __shfl(lf, 63);
}

__device__ __forceinline__ void mlstm_local_phase(Frame& F, int L) {
    const bf16_t* U = (const bf16_t*)(F.ws + WS_BIG); const float* GATE = (const float*)(F.ws + WS_GATE);
    float* Cst = (float*)(F.ws + WS_MST); float* Nst = (float*)(F.ws + WS_MST + MST_N); float* MG = (float*)(F.ws + WS_MST + MST_MG);
    const float* cw = F.in[6] + L * 2048; const float* bi = F.in[4] + L * 4; const float* bfg = F.in[5] + L * 4;
    LAS unsigned char* kt = F.lds + F.wave * 16384; LAS unsigned char* vt = kt + 8192;
    const int lane = F.lane, r32 = lane & 31, half = lane >> 5;
    for (int unit = F.vcu * NWAVES + F.wave; unit < 2048; unit += F.G * NWAVES) {
        const int h = unit & 3, bc = unit >> 2, row0 = bc * 64, t0 = row0 & (SEQ - 1);
        float ig, bcum, g; mlstm_gates(GATE, bi, bfg, row0, h, lane, ig, bcum, g);
        const float wl = g - bcum + ig, ml = wave_max(wl), el = __expf(wl - ml);
        mlstm_load<false>(U, cw, row0, t0, h, lane, el, 1.f, nullptr, kt, vt);
        LDS_WAIT(); asm volatile("" ::: "memory");
        f32x16 acc[2][2], nacc[2];
#pragma unroll
        for (int db = 0; db < 2; ++db) { nacc[db] = f32x16{};
#pragma unroll
            for (int eb = 0; eb < 2; ++eb) acc[db][eb] = f32x16{}; }
        const bf16x8 ones = (bf16x8){0x3F80, 0x3F80, 0x3F80, 0x3F80, 0x3F80, 0x3F80, 0x3F80, 0x3F80};
#pragma unroll
        for (int ks = 0; ks < 4; ++ks) {
            bf16x8 a[2], b[2];
#pragma unroll
            for (int db = 0; db < 2; ++db) a[db] = tr_frag(kt, 16 * ks + 8 * half, 4, 32 * db, lane);
#pragma unroll
            for (int eb = 0; eb < 2; ++eb) b[eb] = tr_frag(vt, 16 * ks + 8 * half, 4, 32 * eb, lane);
#pragma unroll
            for (int db = 0; db < 2; ++db) { nacc[db] = MFMA32(a[db], ones, nacc[db]);
#pragma unroll
                for (int eb = 0; eb < 2; ++eb) acc[db][eb] = MFMA32(a[db], b[eb], acc[db][eb]); }
        }
        float* Cu = Cst + (size_t)unit * 4096;
#pragma unroll
        for (int db = 0; db < 2; ++db)
#pragma unroll
            for (int eb = 0; eb < 2; ++eb)
#pragma unroll
                for (int r = 0; r < 16; ++r) Cu[(32 * db + crow(r, half)) * 64 + 32 * eb + r32] = acc[db][eb][r];
        if (r32 == 0) {
#pragma unroll
            for (int db = 0; db < 2; ++db)
#pragma unroll
                for (int r = 0; r < 16; ++r) Nst[(size_t)unit * 64 + 32 * db + crow(r, half)] = nacc[db][r];
        }
        if (lane == 0) { MG[unit * 2] = ml; MG[unit * 2 + 1] = g; }
        LDS_WAIT(); asm volatile("" ::: "memory");
    }
}

__device__ __forceinline__ void mlstm_scan_phase(Frame& F) {
    float* Cst = (float*)(F.ws + WS_MST); float* Nst = (float*)(F.ws + WS_MST + MST_N); float* MG = (float*)(F.ws + WS_MST + MST_MG);
    float* MP = (float*)(F.ws + WS_MST + MST_MP);
    const int gw = F.vcu * NWAVES + F.wave; if (gw >= 1024 + 16) return;
    const bool isn = gw >= 1024;
    const int bh = isn ? gw - 1024 : gw >> 6, b = bh >> 2, h = bh & 3, el = isn ? F.lane : (gw & 63) * 64 + F.lane;
    float st = 0.f, m = 0.f;
    for (int c0 = 0; c0 < 128; c0 += 8) {
        float x[8], ml[8], gg[8];
#pragma unroll
        for (int i = 0; i < 8; ++i) { const int unit = (b * 128 + c0 + i) * 4 + h;
            x[i] = isn ? Nst[(size_t)unit * 64 + el] : Cst[(size_t)unit * 4096 + el]; ml[i] = MG[unit * 2]; gg[i] = MG[unit * 2 + 1]; }
#pragma unroll
        for (int i = 0; i < 8; ++i) { const int unit = (b * 128 + c0 + i) * 4 + h;
            const float mn = fmaxf(gg[i] + m, ml[i]), a = __expf(gg[i] + m - mn), bb = __expf(ml[i] - mn);
            if (isn) { Nst[(size_t)unit * 64 + el] = st; } else Cst[(size_t)unit * 4096 + el] = st;
            st = a * st + bb * x[i];
            if (isn && F.lane == 0) MP[unit] = m;
            m = mn; }
    }
}

__device__ __forceinline__ void mlstm_out_phase(Frame& F, int L) {
    const bf16_t* U = (const bf16_t*)(F.ws + WS_BIG); const float* GATE = (const float*)(F.ws + WS_GATE); bf16_t* Y = (bf16_t*)(F.ws + WS_AY);
    const float* Cst = (const float*)(F.ws + WS_MST); const float* Nst = (const float*)(F.ws + WS_MST + MST_N); const float* MP = (const float*)(F.ws + WS_MST + MST_MP);
    const float* cw = F.in[6] + L * 2048; const float* bi = F.in[4] + L * 4; const float* bfg = F.in[5] + L * 4; const float* gm = F.in[7] + L * 256;
    if (F.wave >= 4) return;
    LAS unsigned char* qt = F.lds + F.wave * 32768; LAS unsigned char* kt = qt + 8192; LAS unsigned char* vt = qt + 16384; LAS unsigned char* ct = qt + 24576;
    LAS float* sc = (LAS float*)(F.lds + TAB_OFF + F.wave * 1024);
    const int lane = F.lane, r32 = lane & 31, half = lane >> 5;
    for (int unit = F.vcu * 4 + F.wave; unit < 2048; unit += F.G * 4) {
        const int h = unit & 3, bc = unit >> 2, row0 = bc * 64, t0 = row0 & (SEQ - 1);
        float ig, bcum, g; mlstm_gates(GATE, bi, bfg, row0, h, lane, ig, bcum, g);
        const float mprev = MP[unit];
        const float wv = ig - bcum; float pm = wv;
#pragma unroll
        for (int o = 1; o < 64; o <<= 1) { const float t = __shfl_up(pm, o); if (lane >= o) pm = fmaxf(pm, t); }
        const float mml = fmaxf(mprev, pm);
        mlstm_load<true>(U, cw, row0, t0, h, lane, 1.f, 0.125f, qt, kt, vt);
        { const GAS f32x4* cp = (const GAS f32x4*)(Cst + (size_t)unit * 4096 + lane * 64);
#pragma unroll
          for (int i = 0; i < 8; ++i) { const f32x4 a = cp[2 * i], b = cp[2 * i + 1]; *(LAS u32x4*)(ct + lane * 128 + i * 16) = pack8(a, b); } }
        LDS_WAIT(); asm volatile("" ::: "memory");
        float d2 = 0.f;
#pragma unroll
        for (int i = 0; i < 8; ++i) { const u32x4 qv = *(const LAS u32x4*)(qt + lane * 128 + i * 16); const float* np = Nst + (size_t)unit * 64 + i * 8;
            d2 += bflo(qv.x) * np[0] + bfhi(qv.x) * np[1] + bflo(qv.y) * np[2] + bfhi(qv.y) * np[3] + bflo(qv.z) * np[4] + bfhi(qv.z) * np[5] + bflo(qv.w) * np[6] + bfhi(qv.w) * np[7]; }
        sc[lane] = mml; sc[64 + lane] = bcum; sc[128 + lane] = wv; sc[192 + lane] = d2;
        LDS_WAIT(); asm volatile("" ::: "memory");
        f32x16 S00 = f32x16{}, S01 = f32x16{}, S11 = f32x16{};
#pragma unroll
        for (int ks = 0; ks < 4; ++ks) {
            const int ko = (16 * ks + 8 * half) * 2;
            const bf16x8 k0 = *(const LAS bf16x8*)(kt + r32 * 128 + ko), k1 = *(const LAS bf16x8*)(kt + (32 + r32) * 128 + ko);
            const bf16x8 q0 = *(const LAS bf16x8*)(qt + r32 * 128 + ko), q1 = *(const LAS bf16x8*)(qt + (32 + r32) * 128 + ko);
            S00 = MFMA32(k0, q0, S00); S01 = MFMA32(k0, q1, S01); S11 = MFMA32(k1, q1, S11);
        }
        const float mm0 = sc[r32], mm1 = sc[32 + r32];
        float dn0 = 0.f, dn1 = 0.f;
#pragma unroll
        for (int r = 0; r < 16; ++r) { const int s0 = crow(r, half); const float w0 = sc[128 + s0], w1 = sc[128 + 32 + s0];
            const float a = (s0 <= r32) ? S00[r] * __expf(w0 - mm0) : 0.f; S00[r] = a; dn0 += a;
            const float b = S01[r] * __expf(w0 - mm1); S01[r] = b; dn1 += b;
            const float c = (s0 <= r32) ? S11[r] * __expf(w1 - mm1) : 0.f; S11[r] = c; dn1 += c; }
        dn0 += __shfl_xor(dn0, 32); dn1 += __shfl_xor(dn1, 32);
        f32x16 N[2][2], Mx[2][2];
#pragma unroll
        for (int eb = 0; eb < 2; ++eb)
#pragma unroll
            for (int lb = 0; lb < 2; ++lb) { N[eb][lb] = f32x16{}; Mx[eb][lb] = f32x16{}; }
#pragma unroll
        for (int kk = 0; kk < 2; ++kk) {
            bf16x8 p00, p01, p11;
            { u32x4 t; t.x = cvt_pk_bf16(S00[8 * kk], S00[8 * kk + 1]); t.y = cvt_pk_bf16(S00[8 * kk + 2], S00[8 * kk + 3]); t.z = cvt_pk_bf16(S00[8 * kk + 4], S00[8 * kk + 5]); t.w = cvt_pk_bf16(S00[8 * kk + 6], S00[8 * kk + 7]); p00 = __builtin_bit_cast(bf16x8, t); }
            { u32x4 t; t.x = cvt_pk_bf16(S01[8 * kk], S01[8 * kk + 1]); t.y = cvt_pk_bf16(S01[8 * kk + 2], S01[8 * kk + 3]); t.z = cvt_pk_bf16(S01[8 * kk + 4], S01[8 * kk + 5]); t.w = cvt_pk_bf16(S01[8 * kk + 6], S01[8 * kk + 7]); p01 = __builtin_bit_cast(bf16x8, t); }
            { u32x4 t; t.x = cvt_pk_bf16(S11[8 * kk], S11[8 * kk + 1]); t.y = cvt_pk_bf16(S11[8 * kk + 2], S11[8 * kk + 3]); t.z = cvt_pk_bf16(S11[8 * kk + 4], S11[8 * kk + 5]); t.w = cvt_pk_bf16(S11[8 * kk + 6], S11[8 * kk + 7]); p11 = __builtin_bit_cast(bf16x8, t); }
#pragma unroll
            for (int eb = 0; eb < 2; ++eb) {
                const bf16x8 v0 = tr_frag(vt, 16 * kk + 4 * half, 8, 32 * eb, lane), v1 = tr_frag(vt, 32 + 16 * kk + 4 * half, 8, 32 * eb, lane);
                N[eb][0] = MFMA32(v0, p00, N[eb][0]); N[eb][1] = MFMA32(v0, p01, N[eb][1]); N[eb][1] = MFMA32(v1, p11, N[eb][1]);
            }
        }
#pragma unroll
        for (int ks = 0; ks < 4; ++ks) {
            const int ko = (16 * ks + 8 * half) * 2;
            const bf16x8 q0 = *(const LAS bf16x8*)(qt + r32 * 128 + ko), q1 = *(const LAS bf16x8*)(qt + (32 + r32) * 128 + ko);
#pragma unroll
            for (int eb = 0; eb < 2; ++eb) { const bf16x8 cf = tr_frag(ct, 16 * ks + 8 * half, 4, 32 * eb, lane);
                Mx[eb][0] = MFMA32(cf, q0, Mx[eb][0]); Mx[eb][1] = MFMA32(cf, q1, Mx[eb][1]); }
        }
#pragma unroll
        for (int lb = 0; lb < 2; ++lb) {
            const int l = 32 * lb + r32; const float mm = lb ? mm1 : mm0, is = __expf(mprev - mm), den = (lb ? dn1 : dn0) + is * sc[192 + l];
            const float mout = sc[64 + l] + mm, rden = 1.0f / fmaxf(fabsf(den), __expf(-mout));
            float o[2][16]; float ss = 0.f;
#pragma unroll
            for (int eb = 0; eb < 2; ++eb)
#pragma unroll
                for (int r = 0; r < 16; ++r) { const float x = (N[eb][lb][r] + is * Mx[eb][lb][r]) * rden; o[eb][r] = x; ss += x * x; }
            ss += __shfl_xor(ss, 32);
            const float rs = 1.0f / sqrtf(ss * (1.f / 64.f) + EPS);
            const bf16_t* mo = U + (size_t)(row0 + l) * UW + UC_MO + h * 64; bf16_t* yo = Y + (size_t)(row0 + l) * D + h * 64;
#pragma unroll
            for (int eb = 0; eb < 2; ++eb)
#pragma unroll
                for (int gq = 0; gq < 4; ++gq) { const int e0 = 32 * eb + 8 * gq + 4 * half;
                    const f32x4 gv = *(const f32x4*)(gm + h * 64 + e0); const u32x2 mv = *(const GAS u32x2*)(mo + e0);
                    const float y0 = o[eb][4 * gq] * rs * gv[0] * fast_sigmoid(bflo(mv.x)), y1 = o[eb][4 * gq + 1] * rs * gv[1] * fast_sigmoid(bfhi(mv.x));
                    const float y2 = o[eb][4 * gq + 2] * rs * gv[2] * fast_sigmoid(bflo(mv.y)), y3 = o[eb][4 * gq + 3] * rs * gv[3] * fast_sigmoid(bfhi(mv.y));
                    u32x2 w; w.x = cvt_pk_bf16(y0, y1); w.y = cvt_pk_bf16(y2, y3); *(GAS u32x2*)(yo + e0) = w; }
        }
        LDS_WAIT(); asm volatile("" ::: "memory");
    }
}
constexpr int AT_SLOT = 32768, AT_K2 = 8192, AT_V = 16384;
__device__ __forceinline__ void attn_dma_tile(const bf16_t* Ub  , int hd, int k0, LAS unsigned char* slot, int wave, int lane) {
#pragma unroll
    for (int i = 0; i < 4; ++i) {
        const int id = 4 * wave + i;
        const bf16_t* src; LAS unsigned char* dst;
        if (id < 16) { const int m = id >> 3, c = id & 7; src = Ub + (size_t)(k0 + lane) * UW + UC_K + (2 * hd + m) * 64 + 8 * c; dst = slot + m * AT_K2 + c * 1024; }
        else { const int db = (id - 16) >> 2, rq = (id - 16) & 3; src = Ub + (size_t)(k0 + 16 * rq + (lane >> 2)) * UW + UC_V + hd * 128 + 32 * db + 8 * (lane & 3); dst = slot + AT_V + db * 4096 + rq * 1024; }
        __builtin_amdgcn_global_load_lds((const unsigned*)src, (LAS unsigned*)dst, 16, 0, 0);
    }
}
__device__ __forceinline__ void attn_phase(Frame& F, int L) {
    const bf16_t* U = (const bf16_t*)(F.ws + WS_BIG); bf16_t* Y = (bf16_t*)(F.ws + WS_AY);
    const int lane = F.lane, r32 = lane & 31, half = lane >> 5, wave = F.wave, mi = wave >> 2, sb = wave & 3;
    const float lam_init = 0.8f - 0.6f * __expf(-0.3f * (float)L);
    const float lam = __expf(wave_sum(F.in[14][L * 64 + lane] * F.in[15][L * 64 + lane])) - __expf(wave_sum(F.in[16][L * 64 + lane] * F.in[17][L * 64 + lane])) + lam_init;
    const float M2 = 64.f * C2 * 1.01f * wave_max(fabsf(F.in[12][L * 64 + lane])) * wave_max(fabsf(F.in[13][L * 64 + lane]));
    const float* gsub = F.in[18] + L * 128;
    LAS float* lsc = (LAS float*)(F.lds + TAB_OFF) + wave * 32;
    LAS float* xch = (LAS float*)F.lds;
    for (int it = 0; it < 4; ++it) {
        const int pi = F.vcu + (it >> 1) * F.G; if (pi >= 512) break;
        const int bh = pi >> 5, j = pi & 31, b = bh >> 2, hd = bh & 3, qb = (it & 1) ? 63 - j : j;
        const int q0 = qb * 128, qs = q0 + 32 * sb, nkt = 2 * qb + 2;
        const bf16_t* Ub = U + (size_t)b * SEQ * UW;
        const float slope2 = exp2f(-2.f * (float)(hd + 1)) * 1.4426950408889634f;
        bf16x8 qf[4];
#pragma unroll
        for (int ks = 0; ks < 4; ++ks) qf[ks] = *(const GAS bf16x8*)(Ub + (size_t)(qs + r32) * UW + UC_Q + (2 * hd + mi) * 64 + 16 * ks + 8 * half);
        attn_dma_tile(Ub, hd, 0, F.lds, wave, lane);
        attn_dma_tile(Ub, hd, 64, F.lds + AT_SLOT, wave, lane);
        f32x16 o[4];
#pragma unroll
        for (int db = 0; db < 4; ++db) o[db] = f32x16{};
        float lsum = 0.f;
        const float rowc = -slope2 * (float)(qs + r32) - M2;
        int slot = 0;
        for (int kt = 0; kt < nkt; ++kt) {
            if (kt + 1 < nkt) asm volatile("s_waitcnt vmcnt(4)" ::: "memory"); else asm volatile("s_waitcnt vmcnt(0)" ::: "memory");
            __builtin_amdgcn_s_barrier();
            asm volatile("" ::: "memory");
            if (kt + 2 < nkt) { const int s2 = slot >= 1 ? slot - 1 : 2; attn_dma_tile(Ub, hd, (kt + 2) * 64, F.lds + s2 * AT_SLOT, wave, lane); }
            const LAS unsigned char* sl = F.lds + slot * AT_SLOT;
            slot = (slot == 2) ? 0 : slot + 1;
            const int k0 = kt * 64;
            if (k0 > qs + 31) continue;
            f32x16 p0, p1;
            { const float base = rowc + slope2 * (float)(k0 + 4 * half);
#pragma unroll
              for (int r = 0; r < 16; ++r) { p0[r] = base + slope2 * (float)((r & 3) + 8 * (r >> 2)); p1[r] = p0[r] + 32.f * slope2; } }
            const LAS unsigned char* kim = sl + mi * AT_K2 + r32 * 16 + half * 1024;
#pragma unroll
            for (int ks = 0; ks < 4; ++ks) {
                const bf16x8 kf0 = *(const LAS bf16x8*)(kim + ks * 2048), kf1 = *(const LAS bf16x8*)(kim + ks * 2048 + 512);
                p0 = MFMA32(kf0, qf[ks], p0); p1 = MFMA32(kf1, qf[ks], p1);
            }
            if (k0 + 63 > qs) {
                const int qrel = qs + r32 - k0 - 4 * half;
#pragma unroll
                for (int r = 0; r < 16; ++r) { const int kr = (r & 3) + 8 * (r >> 2); if (kr > qrel) p0[r] = -INFINITY; if (kr + 32 > qrel) p1[r] = -INFINITY; }
            }
            float ls = 0.f;
#pragma unroll
            for (int r = 0; r < 16; ++r) { p0[r] = __builtin_amdgcn_exp2f(p0[r]); p1[r] = __builtin_amdgcn_exp2f(p1[r]); ls += p0[r] + p1[r]; }
            lsum += ls;
            const LAS unsigned char* vim = sl + AT_V + (4 * half + ((lane & 15) >> 2)) * 64 + (16 * ((lane >> 4) & 1) + 4 * (lane & 3)) * 2;
#pragma unroll
            for (int ks = 0; ks < 4; ++ks) {
                u32x4 t;
                if (ks < 2) { t.x = cvt_pk_bf16(p0[8 * ks], p0[8 * ks + 1]); t.y = cvt_pk_bf16(p0[8 * ks + 2], p0[8 * ks + 3]); t.z = cvt_pk_bf16(p0[8 * ks + 4], p0[8 * ks + 5]); t.w = cvt_pk_bf16(p0[8 * ks + 6], p0[8 * ks + 7]); }
                else { const int k2 = ks - 2; t.x = cvt_pk_bf16(p1[8 * k2], p1[8 * k2 + 1]); t.y = cvt_pk_bf16(p1[8 * k2 + 2], p1[8 * k2 + 3]); t.z = cvt_pk_bf16(p1[8 * k2 + 4], p1[8 * k2 + 5]); t.w = cvt_pk_bf16(p1[8 * k2 + 6], p1[8 * k2 + 7]); }
                const bf16x8 pf = __builtin_bit_cast(bf16x8, t);
#pragma unroll
                for (int db = 0; db < 4; ++db) {
                    const LAS unsigned char* a = vim + db * 4096 + ks * 1024;
                    const s16x4 lo = tr_read(a), hi = tr_read(a + 512);
                    const bf16x8 vf = (bf16x8){lo[0], lo[1], lo[2], lo[3], hi[0], hi[1], hi[2], hi[3]};
                    o[db] = MFMA32(pf, vf, o[db]);
                }
            }
        }
        lsum += __shfl_xor(lsum, 32);
        asm volatile("s_waitcnt vmcnt(0) lgkmcnt(0)" ::: "memory");
        __builtin_amdgcn_s_barrier();
        asm volatile("" ::: "memory");
        if (half == 0) lsc[r32] = lsum;
        LDS_WAIT(); asm volatile("" ::: "memory");
        float rl[16];
#pragma unroll
        for (int r = 0; r < 16; ++r) rl[r] = __builtin_amdgcn_rcpf(lsc[crow(r, half)]);
        if (mi == 1) {
#pragma unroll
            for (int db = 0; db < 4; ++db)
#pragma unroll
                for (int r = 0; r < 16; ++r) xch[((sb * 4 + db) * 16 + r) * 64 + lane] = o[db][r] * rl[r] * lam;
        }
        asm volatile("s_waitcnt lgkmcnt(0)" ::: "memory");
        __builtin_amdgcn_s_barrier();
        asm volatile("" ::: "memory");
        if (mi == 0) {
            float ss[16];
#pragma unroll
            for (int r = 0; r < 16; ++r) ss[r] = 0.f;
#pragma unroll
            for (int db = 0; db < 4; ++db)
#pragma unroll
                for (int r = 0; r < 16; ++r) { const float y = o[db][r] * rl[r] - xch[((sb * 4 + db) * 16 + r) * 64 + lane]; o[db][r] = y; ss[r] += y * y; }
#pragma unroll
            for (int r = 0; r < 16; ++r) {
#pragma unroll
                for (int m = 1; m < 32; m <<= 1) ss[r] += __shfl_xor(ss[r], m);
                ss[r] = (1.f - lam_init) / sqrtf(ss[r] * (1.f / 128.f) + EPS);
            }
            bf16_t* yo = Y + (size_t)(b * SEQ + qs) * D + 512 + hd * 128;
#pragma unroll
            for (int db = 0; db < 4; ++db) { const float gsv = gsub[32 * db + r32];
#pragma unroll
                for (int r = 0; r < 16; ++r) yo[(size_t)crow(r, half) * D + 32 * db + r32] = (bf16_t)f2bf(o[db][r] * ss[r] * gsv); }
        }
        asm volatile("s_waitcnt lgkmcnt(0)" ::: "memory");
        __builtin_amdgcn_s_barrier();
        asm volatile("" ::: "memory");
    }
}
#define ONE_LAUNCH 0
#ifndef NAIVE_MASK
#define NAIVE_MASK 0
#endif
#define MIX_PHASE_A do { if (!(NAIVE_MASK & 1)) mlstm_local_phase(F, L); if (!(NAIVE_MASK & 2)) conformer_phase(F, L); } while (0)
#define MIX_PHASE_B do { if (!(NAIVE_MASK & 1)) mlstm_scan_phase(F); if (!(NAIVE_MASK & 4)) attn_phase(F, L); } while (0)
#define MIX_PHASE_C do { if (!(NAIVE_MASK & 1)) mlstm_out_phase(F, L); } while (0)
__device__ __forceinline__ int bxl() { int b = blockIdx.x; asm volatile("" : "+s"(b)); return b; }
constexpr int PH_PER_LAYER = 13, NPHASE = 1 + 2 * PH_PER_LAYER;
struct Args { const float* in[31]; float* out; unsigned char* ws; int ph_lo, ph_hi; };

#define PH(k) (lo <= (k) && (k) < hi && (F.lane = lane_id_v(), F.tid = F.wave * 64 + F.lane, true))
#define SEAM(k) do { if ((k) + 1 < hi) xcd_barrier(bar); } while (0)
template <int L>
__device__ __forceinline__ void layer_phases(Frame& F, const XcdBarrier& bar, int lo, int hi) {
    bf16_t* const AY = (bf16_t*)(F.ws + WS_AY);
    bf16_t* const BIGB = (bf16_t*)(F.ws + WS_BIG);
    float* const wsm = (float*)(F.ws + WS_WSM);
        const int pb = 1 + PH_PER_LAYER * L;
        if (pb + PH_PER_LAYER <= lo || pb >= hi) return;
        const float* hsrc = (L == 0) ? F.in[0] : F.out;
        if (PH(pb + 0)) { norm_phase<1>(F, hsrc, wsm + L * 8 * D, nullptr, nullptr); SEAM(pb + 0); }
        if (PH(pb + 1)) {
            pg8::StaticOrder S; S.init(M / 256, NIN / 256, F.G, bxl());
            EpiIn E{BIGB, F.in[12] + L * 64, F.in[13] + L * 64};
            pg8::gemm_phase<EpiIn, pg8::StaticOrder, pg8::AOffDense, true>(F.lds, F.wave, AY, (const bf16_t*)(F.ws + WS_WIN) + (size_t)L * NIN * D, D, S, E, pg8::AOffDense{D});
            SEAM(pb + 1);
        }
        if (PH(pb + 2)) { MIX_PHASE_A; SEAM(pb + 2); }
        if (PH(pb + 3)) { MIX_PHASE_B; SEAM(pb + 3); }
        if (PH(pb + 4)) { MIX_PHASE_C; SEAM(pb + 4); }
        if (PH(pb + 5)) {
            pg8::StaticOrder S; S.init(M / 256, D / 256, F.G, bxl());
            EpiRes E{hsrc, F.out};
            pg8::gemm_phase<EpiRes, pg8::StaticOrder, pg8::AOffDense, true>(F.lds, F.wave, AY, (const bf16_t*)(F.ws + WS_WOUT) + (size_t)L * D * D, D, S, E, pg8::AOffDense{D});
            SEAM(pb + 5);
        }
        if (L == 0) {
            if (PH(pb + 6)) { norm_phase<0>(F, F.out, nullptr, nullptr, nullptr); SEAM(pb + 6); }
            if (PH(pb + 7)) {
                pg8::StaticOrder S; S.init(M / 256, 2 * FFD / 256, F.G, bxl());
                EpiGlu E{BIGB, FFD};
                pg8::gemm_phase<EpiGlu, pg8::StaticOrder, pg8::AOffDense, true>(F.lds, F.wave, AY, (const bf16_t*)(F.ws + WS_WDGU), D, S, E, pg8::AOffDense{D});
                SEAM(pb + 7);
            }
            if (PH(pb + 8)) {
                pg8::StaticOrder S; S.init(M / 256, D / 256, F.G, bxl());
                EpiRes E{F.out, F.out};
                pg8::gemm_phase<EpiRes, pg8::StaticOrder, pg8::AOffDense, true>(F.lds, F.wave, BIGB, (const bf16_t*)(F.ws + WS_WDD), FFD, S, E, pg8::AOffDense{FFD});
                SEAM(pb + 8);
            }
        } else {
            if (PH(pb + 6)) { norm_phase<2>(F, F.out, wsm + 2 * 8 * D, nullptr, nullptr); SEAM(pb + 6); }
            for (int s = 0; s < 2; ++s) {
                LAS int* rt_info = (LAS int*)(F.lds + TAB_OFF); LAS int* rowtab = (LAS int*)(F.lds + TAB_OFF + 2048);
                const int* list_s = (const int*)(F.ws + WS_MOE + MOE_LIST) + (size_t)s * 8 * M;
                const float* gatev_s = (const float*)(F.ws + WS_MOE + MOE_GATEV) + (size_t)s * M;
                if (PH(pb + 7 + 2 * s)) {
                    const int RT = moe_build_tiles(F, s, rt_info);
                    MoeSched S; S.so.init(RT, 2 * FFE / 256, F.G, bxl()); S.rt_info = rt_info; S.ntn = 2 * FFE / 256;
                    { pg8::Unit u; for (int i = 0; S.next(i, u); ++i) { if (F.tid < 256) { const int e = rt_info[3 * u.pm], i0 = rt_info[3 * u.pm + 1], nv = rt_info[3 * u.pm + 2];
                        rowtab[i * 256 + F.tid] = F.tid < nv ? list_s[(size_t)e * M + i0 + F.tid] : 0; } } }
                    __syncthreads();
                    EpiGlu E{BIGB, FFE};
                    pg8::gemm_phase<EpiGlu, MoeSched, pg8::AOffGather, true>(F.lds, F.wave, AY, (const bf16_t*)(F.ws + WS_WMGU), D, S, E, pg8::AOffGather{D, rowtab});
                    SEAM(pb + 7 + 2 * s);
                }
                if (PH(pb + 8 + 2 * s)) {
                    const int RT = moe_build_tiles(F, s, rt_info);
                    MoeSched S; S.so.init(RT, D / 256, F.G, bxl()); S.rt_info = rt_info; S.ntn = D / 256;
                    EpiScatter E{F.out, list_s, gatev_s, rt_info};
                    pg8::gemm_phase<EpiScatter, MoeSched, pg8::AOffDense, true>(F.lds, F.wave, BIGB, (const bf16_t*)(F.ws + WS_WMD), FFE, S, E, pg8::AOffDense{FFE});
                    SEAM(pb + 8 + 2 * s);
                }
            }
        }
        bf16_t* const PB = BIGB;
        bf16_t* const PEB = BIGB + (size_t)16 * MiB;
        if (PH(pb + 11)) { norm_phase<0>(F, F.out, nullptr, F.in[1] + (size_t)L * M * PLE, PB); SEAM(pb + 11); }
        if (PH(pb + 12)) {
            pg8::StaticOrder S; S.init(M / 256, D / 256, F.G, bxl());
            EpiPe E1{PEB};
            pg8::gemm_phase<EpiPe, pg8::StaticOrder, pg8::AOffDense, true>(F.lds, F.wave, PB, (const bf16_t*)(F.ws + WS_WPP) + (size_t)L * D * PLE, PLE, S, E1, pg8::AOffDense{PLE});
            EpiPle E2{F.out, PEB};
            pg8::gemm_phase<EpiPle, pg8::StaticOrder, pg8::AOffDense, true>(F.lds, F.wave, AY, (const bf16_t*)(F.ws + WS_WPG) + (size_t)L * D * D, D, S, E2, pg8::AOffDense{D});
            SEAM(pb + 12);
        }
    }
__global__ void __launch_bounds__(NWAVES * 64, 2) fwd(Args args) {
    extern __shared__ __attribute__((aligned(16))) unsigned char lds[];
    Frame F;
    F.lds = (LAS unsigned char*)lds;
    F.MISC = (volatile LAS unsigned*)(F.lds + MISC_OFF);
    F.wave = __builtin_amdgcn_readfirstlane(threadIdx.x >> 6); F.lane = lane_id_v(); F.tid = F.wave * 64 + F.lane;
    F.G = gridDim.x; { const int bx = blockIdx.x; F.vcu = (F.G % 8 == 0) ? (bx % 8) * (F.G / 8) + bx / 8 : bx; }
    F.ws = args.ws; F.ctl = (gu32*)(args.ws + WS_CTL); F.out = args.out;
#pragma unroll
    for (int i = 0; i < 31; ++i) F.in[i] = args.in[i];
    for (int u = F.tid; u < 256; u += NWAVES * 64) ((LAS unsigned*)(F.lds + LDSCTL_OFF))[u] = 0u;
    __syncthreads();
    const int lo = args.ph_lo, hi = args.ph_hi;
    XcdBarrier bar; bar.bar = (unsigned*)(F.ctl + CW_BAR); bar.x = 0; bar.st = nullptr;
    if (hi - lo > 1) bar = xcd_barrier_post((unsigned*)(F.ctl + CW_BAR), F.MISC + 8);

    bf16_t* const AY = (bf16_t*)(F.ws + WS_AY);
    bf16_t* const BIGB = (bf16_t*)(F.ws + WS_BIG);
    float* const wsm = (float*)(F.ws + WS_WSM);

    if (PH(0)) { p0_prologue(F); SEAM(0); }

    layer_phases<0>(F, bar, lo, hi);
    layer_phases<1>(F, bar, lo, hi);
#undef PH
#undef SEAM
}

extern "C" void kernel_launch(void* const* d_in, const int* in_sizes, int n_in, void* d_out, int out_size, void* d_ws, size_t ws_size, hipStream_t stream) {
    static int grid = 0;
    if (grid == 0) {
        int dev = 0, cus = 0;
        grid = -1;
        if (hipGetDevice(&dev) == hipSuccess && hipDeviceGetAttribute(&cus, hipDeviceAttributeMultiprocessorCount, dev) == hipSuccess && cus == 256 && ws_size >= WS_END && n_in == 31 &&
            hipFuncSetAttribute((const void*)fwd, hipFuncAttributeMaxDynamicSharedMemorySize, LDS_BYTES) == hipSuccess) grid = cus;
        (void)hipGetLastError();
    }
    if (grid < 0) { nv::forward(d_in, (float*)d_out, (unsigned char*)d_ws, stream); return; }
    (void)hipMemsetAsync((char*)d_ws + WS_CTL, 0, CTL_ZERO_BYTES, stream);
    Args a{};
    for (int i = 0; i < 31; ++i) a.in[i] = (const float*)d_in[i];
    a.out = (float*)d_out; a.ws = (unsigned char*)d_ws;
#if ONE_LAUNCH
    a.ph_lo = 0; a.ph_hi = NPHASE;
    hipLaunchKernelGGL(fwd, dim3(grid), dim3(NWAVES * 64), LDS_BYTES, stream, a);
#else
    for (int p = 0; p < NPHASE; ++p) {
        const int L = (p - 1) / PH_PER_LAYER, k = (p - 1) % PH_PER_LAYER;
        if (p > 0 && L == 0 && (k == 9 || k == 10)) continue;
        if (p > 0 && k == 2 && NAIVE_MASK) nvb::mixers(d_in, (unsigned char*)d_ws, L, stream, NAIVE_MASK);
        a.ph_lo = p; a.ph_hi = p + 1;
        hipLaunchKernelGGL(fwd, dim3(grid), dim3(NWAVES * 64), LDS_BYTES, stream, a);
    }
#endif
}
```

```cpp
#include <hip/hip_runtime.h>
#include <cstdio>
#include <cstdint>
#include <cmath>
namespace nv {
constexpr int S = 8192, D = 1024, DIN = 3080, NB = 4;
constexpr int FFD = 2816, FFE = 3584, NE = 8, PLE = 256;
constexpr int OFF_MQ = 0, OFF_MK = 256, OFF_MV = 512, OFF_MO = 768, OFF_MI = 1024, OFF_MF = 1028, OFF_CA = 1032, OFF_CG = 1288, OFF_AQ = 1544, OFF_AK = 2056, OFF_AV = 2568;

__device__ __forceinline__ float sigmoidf_(float x) { return 1.f / (1.f + expf(-x)); }
__device__ __forceinline__ float siluf_(float x) { return x / (1.f + expf(-x)); }
__device__ __forceinline__ float wsum(float v) { for (int o = 32; o > 0; o >>= 1) v += __shfl_xor(v, o); return v; }
__device__ __forceinline__ float wmax(float v) { for (int o = 32; o > 0; o >>= 1) v = fmaxf(v, __shfl_xor(v, o)); return v; }

__global__ void groupnorm(const float* in, int ldi, float* out, int ldo, int ngroups, int gdim, const float* gain, int gain_stride, float scale) {
    const int rg = blockIdx.x, row = rg / ngroups, g = rg % ngroups, lane = threadIdx.x;
    const float* x = in + (size_t)row * ldi + g * gdim;
    float s = 0.f;
    for (int i = lane; i < gdim; i += 64) s += x[i] * x[i];
    s = wsum(s);
    const float r = rsqrtf(s / (float)gdim + 1e-6f);
    float* o = out + (size_t)row * ldo + g * gdim;
    for (int i = lane; i < gdim; i += 64) o[i] = x[i] * r * gain[g * gain_stride + i] * scale;
}

template <bool ACC>
__global__ void gemm(const float* A, int lda, const float* B, int ldb, float* C, int ldc, int M, int N, int K, const int* rowlist, const int* nrows_dev) {
    __shared__ float As[16][65];
    __shared__ float Bs[16][64];
    const int Meff = nrows_dev ? *nrows_dev : M;
    const int m0 = blockIdx.y * 64, n0 = blockIdx.x * 64;
    if (m0 >= Meff) return;
    const int tid = threadIdx.x, ty = tid >> 4, tx = tid & 15;
    float acc[4][4];
    for (int i = 0; i < 4; ++i) for (int j = 0; j < 4; ++j) acc[i][j] = 0.f;
    for (int k0 = 0; k0 < K; k0 += 16) {
        for (int i = 0; i < 4; ++i) {
            const int idx = tid + i * 256, r = idx >> 4, kk = idx & 15;
            float v = 0.f;
            if (m0 + r < Meff) { const int ar = rowlist ? rowlist[m0 + r] : (m0 + r); v = A[(size_t)ar * lda + k0 + kk]; }
            As[kk][r] = v;
        }
        for (int i = 0; i < 4; ++i) {
            const int idx = tid + i * 256, kk = idx >> 6, c = idx & 63;
            Bs[kk][c] = (n0 + c < N) ? B[(size_t)(k0 + kk) * ldb + n0 + c] : 0.f;
        }
        __syncthreads();
#pragma unroll
        for (int kk = 0; kk < 16; ++kk) {
            float a[4], b[4];
            for (int i = 0; i < 4; ++i) a[i] = As[kk][ty * 4 + i];
            for (int j = 0; j < 4; ++j) b[j] = Bs[kk][tx * 4 + j];
            for (int i = 0; i < 4; ++i) for (int j = 0; j < 4; ++j) acc[i][j] += a[i] * b[j];
        }
        __syncthreads();
    }
    for (int i = 0; i < 4; ++i) {
        const int r = m0 + ty * 4 + i;
        if (r >= Meff) continue;
        for (int j = 0; j < 4; ++j) {
            const int c = n0 + tx * 4 + j;
            if (c < N) { float* p = C + (size_t)r * ldc + c; *p = ACC ? (*p + acc[i][j]) : acc[i][j]; }
        }
    }
}

__global__ void mprep(const float* U, const float* cw  , const float* bi, const float* bf, float* QK, float* IG, float* LF) {
    const int t = blockIdx.x, c = threadIdx.x;
    float acc = 0.f;
    for (int j = 0; j < 4; ++j) { const int tt = t - 3 + j; if (tt >= 0) acc += cw[j * 512 + c] * U[(size_t)tt * DIN + c]; }
    QK[(size_t)t * 512 + c] = siluf_(acc);
    if (c < 4) {
        IG[t * 4 + c] = U[(size_t)t * DIN + OFF_MI + c] + bi[c];
        const float f = U[(size_t)t * DIN + OFF_MF + c] + bf[c];
        LF[t * 4 + c] = fminf(f, 0.f) - log1pf(expf(-fabsf(f)));
    }
}

__global__ void mlstm_rec(const float* QK, const float* U, const float* IG, const float* LF, float* HM) {
    __shared__ float sq[64][64], sk[64][64], sv[64][64];
    __shared__ float sig[64], slf[64];
    __shared__ float red[2][4][64], redd[2][4][64];
    const int h = blockIdx.x, tid = threadIdx.x, e = tid & 63, dq = tid >> 6;
    float C[16], n[16]; float m = 0.f;
    for (int i = 0; i < 16; ++i) { C[i] = 0.f; n[i] = 0.f; }
    for (int t0 = 0; t0 < S; t0 += 64) {
        __syncthreads();
        for (int i = tid; i < 64 * 64; i += 256) {
            const int tt = i >> 6, d = i & 63;
            sq[tt][d] = QK[(size_t)(t0 + tt) * 512 + h * 64 + d] * 0.125f;
            sk[tt][d] = QK[(size_t)(t0 + tt) * 512 + 256 + h * 64 + d];
            sv[tt][d] = U[(size_t)(t0 + tt) * DIN + OFF_MV + h * 64 + d];
        }
        if (tid < 64) { sig[tid] = IG[(t0 + tid) * 4 + h]; slf[tid] = LF[(t0 + tid) * 4 + h]; }
        __syncthreads();
        for (int tt = 0; tt < 64; ++tt) {
            const float ig = sig[tt], lf = slf[tt];
            const float mn = fmaxf(lf + m, ig), a = expf(lf + m - mn), bb = expf(ig - mn);
            m = mn;
            const float v = sv[tt][e];
            float num = 0.f, den = 0.f;
#pragma unroll
            for (int i = 0; i < 16; ++i) {
                const int d = dq * 16 + i; const float k = sk[tt][d], q = sq[tt][d];
                C[i] = a * C[i] + bb * k * v; n[i] = a * n[i] + bb * k;
                num += q * C[i]; den += q * n[i];
            }
            red[tt & 1][dq][e] = num; redd[tt & 1][dq][e] = den;
            __syncthreads();
            if (dq == 0) {
                const float nu = red[tt & 1][0][e] + red[tt & 1][1][e] + red[tt & 1][2][e] + red[tt & 1][3][e];
                const float de = redd[tt & 1][0][e] + redd[tt & 1][1][e] + redd[tt & 1][2][e] + redd[tt & 1][3][e];
                HM[(size_t)(t0 + tt) * 256 + h * 64 + e] = nu / fmaxf(fabsf(de), expf(-m));
            }
        }
    }
}

__global__ void mgate(const float* HMN, const float* U, float* Y) {
    const int t = blockIdx.x, c = threadIdx.x;
    Y[(size_t)t * D + c] = HMN[(size_t)t * 256 + c] * sigmoidf_(U[(size_t)t * DIN + OFF_MO + c]);
}

__global__ void cglu(const float* U, float* Z) {
    const int t = blockIdx.x, c = threadIdx.x;
    Z[(size_t)t * 256 + c] = U[(size_t)t * DIN + OFF_CA + c] * sigmoidf_(U[(size_t)t * DIN + OFF_CG + c]);
}
__global__ void cconv(const float* Z, const float* w  , const float* b, const float* lg, const float* lb, float* Y) {
    __shared__ float sm[4], sv2[4];
    const int t = blockIdx.x, c = threadIdx.x;
    float acc = b[c];
    for (int j = 0; j < 31; ++j) { const int tt = t - 30 + j; if (tt >= 0) acc += w[j * 256 + c] * Z[(size_t)tt * 256 + c]; }
    float s = wsum(acc);
    if ((c & 63) == 0) sm[c >> 6] = s;
    __syncthreads();
    const float mu = (sm[0] + sm[1] + sm[2] + sm[3]) * (1.f / 256.f);
    const float dv = acc - mu;
    float s2 = wsum(dv * dv);
    if ((c & 63) == 0) sv2[c >> 6] = s2;
    __syncthreads();
    const float var = (sv2[0] + sv2[1] + sv2[2] + sv2[3]) * (1.f / 256.f);
    const float yv = dv * rsqrtf(var + 1e-6f) * lg[c] + lb[c];
    Y[(size_t)t * D + 256 + c] = siluf_(yv);
}

__global__ void attn(const float* QN  , const float* KN  , const float* U, float* O  ) {
    __shared__ float sK[64][65];
    __shared__ float sV[64][128];
    __shared__ float sQ[16][64];
    __shared__ float sP[16][64];
    const int j = blockIdx.y, hd = j >> 1, q0 = blockIdx.x * 16, tid = threadIdx.x, w = tid >> 6, lane = tid & 63;
    const int qpos = q0 + w;
    const float slope = exp2f(-8.f * (float)(hd + 1) / 4.f);
    sQ[w][lane] = QN[(size_t)qpos * 512 + j * 64 + lane];
    float m = -INFINITY, l = 0.f, o0 = 0.f, o1 = 0.f;
    const int ntile = (q0 + 15) / 64 + 1;
    for (int kt = 0; kt < ntile; ++kt) {
        __syncthreads();
        for (int i = tid; i < 64 * 64; i += 1024) { const int r = i >> 6, d = i & 63; sK[r][d] = KN[(size_t)(kt * 64 + r) * 512 + j * 64 + d]; }
        for (int i = tid; i < 64 * 128; i += 1024) { const int r = i >> 7, d = i & 127; sV[r][d] = U[(size_t)(kt * 64 + r) * DIN + OFF_AV + hd * 128 + d]; }
        __syncthreads();
        const int kpos = kt * 64 + lane;
        float s = 0.f;
        for (int d = 0; d < 64; ++d) s += sQ[w][d] * sK[lane][d];
        s = s * 0.125f - slope * (float)(qpos - kpos);
        if (kpos > qpos) s = -INFINITY;
        const float tm = wmax(s), mn = fmaxf(m, tm), corr = expf(m - mn), p = expf(s - mn);
        l = l * corr + wsum(p); o0 *= corr; o1 *= corr; m = mn;
        sP[w][lane] = p;
        __syncthreads();
        for (int k = 0; k < 64; ++k) { const float pk = sP[w][k]; o0 += pk * sV[k][lane]; o1 += pk * sV[k][64 + lane]; }
    }
    O[((size_t)qpos * 8 + j) * 128 + lane] = o0 / l;
    O[((size_t)qpos * 8 + j) * 128 + 64 + lane] = o1 / l;
}
__device__ __forceinline__ float lam_of(const float* q1, const float* k1, const float* q2, const float* k2, float lam_init) {
    float a = 0.f, b = 0.f;
    for (int i = 0; i < 64; ++i) { a += q1[i] * k1[i]; b += q2[i] * k2[i]; }
    return expf(a) - expf(b) + lam_init;
}
__global__ void acomb(const float* O, const float* q1, const float* k1, const float* q2, const float* k2, float lam_init, float* YA  ) {
    const int t = blockIdx.x, c = threadIdx.x;
    const float lam = lam_of(q1, k1, q2, k2, lam_init);
    const int hd = c >> 7, e = c & 127;
    YA[(size_t)t * 512 + c] = O[((size_t)t * 8 + 2 * hd) * 128 + e] - lam * O[((size_t)t * 8 + 2 * hd + 1) * 128 + e];
}
__global__ void swiglu_act(float* G, const float* Uu, int ld, const int* nrows_dev) {
    const int r = blockIdx.x; if (nrows_dev && r >= *nrows_dev) return;
    for (int c = threadIdx.x; c < ld; c += blockDim.x) { const size_t i = (size_t)r * ld + c; G[i] = siluf_(G[i]) * Uu[i]; }
}
__global__ void route(const float* LG  , int* cnt  , int* list  , float* gl  ) {
    const int t = blockIdx.x * blockDim.x + threadIdx.x; if (t >= S) return;
    float v[8]; for (int e = 0; e < 8; ++e) v[e] = LG[t * 8 + e];
    int i0 = 0; for (int e = 1; e < 8; ++e) if (v[e] > v[i0]) i0 = e;
    int i1 = (i0 == 0) ? 1 : 0; for (int e = 0; e < 8; ++e) if (e != i0 && v[e] > v[i1]) i1 = e;
    const float e1 = expf(v[i1] - v[i0]), g0 = 1.f / (1.f + e1), g1 = e1 / (1.f + e1);
    int p0 = atomicAdd(&cnt[i0], 1); list[i0 * S + p0] = t; gl[i0 * S + p0] = g0;
    int p1 = atomicAdd(&cnt[i1], 1); list[i1 * S + p1] = t; gl[i1 * S + p1] = g1;
}
__global__ void scatter_add(const float* Dn  , const int* list, const float* gl, const int* nrows_dev, float* H) {
    const int r = blockIdx.x; if (r >= *nrows_dev) return;
    const int t = list[r]; const float g = gl[r];
    for (int c = threadIdx.x; c < D; c += blockDim.x) H[(size_t)t * D + c] += g * Dn[(size_t)r * D + c];
}
__global__ void ple_apply(const float* GT, const float* PE, float* H) {
    const int t = blockIdx.x;
    for (int c = threadIdx.x; c < D; c += blockDim.x) H[(size_t)t * D + c] += sigmoidf_(GT[(size_t)t * D + c]) * PE[(size_t)t * D + c];
}

static void gemm_l(hipStream_t st, bool acc, const float* A, int lda, const float* B, int ldb, float* C, int ldc, int M, int N, int K, const int* rowlist = nullptr, const int* nrows = nullptr) {
    dim3 g((N + 63) / 64, M / 64);
    if (acc) hipLaunchKernelGGL(gemm<true>, g, dim3(256), 0, st, A, lda, B, ldb, C, ldc, M, N, K, rowlist, nrows);
    else hipLaunchKernelGGL(gemm<false>, g, dim3(256), 0, st, A, lda, B, ldb, C, ldc, M, N, K, rowlist, nrows);
}

static void forward(void* const* d_in, float* out, unsigned char* ws, hipStream_t st) {
    const float* const* in = (const float* const*)d_in;
    size_t off = 0;
    auto take = [&](size_t bytes) { unsigned char* p = ws + off; off += (bytes + 255) & ~(size_t)255; return p; };
    float* A = (float*)take((size_t)S * D * 4);
    float* U = (float*)take((size_t)S * DIN * 4);
    float* QK = (float*)take((size_t)S * 512 * 4);
    float* Y = (float*)take((size_t)S * D * 4);
    float* G = (float*)take((size_t)S * FFE * 4);
    float* U2 = (float*)take((size_t)S * FFE * 4);
    float* IG = (float*)take((size_t)S * 4 * 4);
    float* LF = (float*)take((size_t)S * 4 * 4);
    int* cnt = (int*)take(256);
    int* list = (int*)take((size_t)NE * S * 4);
    float* gl = (float*)take((size_t)NE * S * 4);
    float* HM = G;
    float* HMN = G + (size_t)S * 256;
    float* Z = G + (size_t)S * 512;
    float* QN = G + (size_t)S * 768;
    float* KN = G + (size_t)S * 1280;
    float* YA = G + (size_t)S * 1792;
    float* AO = U2;
    hipMemcpyAsync(out, in[0], (size_t)NB * S * D * 4, hipMemcpyDeviceToDevice, st);
    for (int b = 0; b < NB; ++b) {
        float* H = out + (size_t)b * S * D;
        for (int L = 0; L < 2; ++L) {
            const float lam_init = 0.8f - 0.6f * expf(-0.3f * (float)L);
            hipLaunchKernelGGL(groupnorm, dim3(S), dim3(64), 0, st, H, D, A, D, 1, D, in[2] + L * D, 0, 1.f);
            gemm_l(st, false, A, D, in[3] + (size_t)L * D * DIN, DIN, U, DIN, S, DIN, D);
            hipLaunchKernelGGL(mprep, dim3(S), dim3(512), 0, st, U, in[6] + L * 2048, in[4] + L * 4, in[5] + L * 4, QK, IG, LF);
            hipLaunchKernelGGL(mlstm_rec, dim3(4), dim3(256), 0, st, QK, U, IG, LF, HM);
            hipLaunchKernelGGL(groupnorm, dim3(S * 4), dim3(64), 0, st, HM, 256, HMN, 256, 4, 64, in[7] + L * 256, 64, 1.f);
            hipLaunchKernelGGL(mgate, dim3(S), dim3(256), 0, st, HMN, U, Y);
            hipLaunchKernelGGL(cglu, dim3(S), dim3(256), 0, st, U, Z);
            hipLaunchKernelGGL(cconv, dim3(S), dim3(256), 0, st, Z, in[8] + L * 31 * 256, in[9] + L * 256, in[10] + L * 256, in[11] + L * 256, Y);
            hipLaunchKernelGGL(groupnorm, dim3(S * 8), dim3(64), 0, st, U + OFF_AQ, DIN, QN, 512, 8, 64, in[12] + L * 64, 0, 1.f);
            hipLaunchKernelGGL(groupnorm, dim3(S * 8), dim3(64), 0, st, U + OFF_AK, DIN, KN, 512, 8, 64, in[13] + L * 64, 0, 1.f);
            hipLaunchKernelGGL(attn, dim3(S / 16, 8), dim3(1024), 0, st, QN, KN, U, AO);
            hipLaunchKernelGGL(acomb, dim3(S), dim3(512), 0, st, AO, in[14] + L * 64, in[15] + L * 64, in[16] + L * 64, in[17] + L * 64, lam_init, YA);
            hipLaunchKernelGGL(groupnorm, dim3(S * 4), dim3(64), 0, st, YA, 512, Y + 512, D, 4, 128, in[18] + L * 128, 0, 1.f - lam_init);
            gemm_l(st, true, Y, D, in[19] + (size_t)L * D * D, D, H, D, S, D, D);
            hipLaunchKernelGGL(groupnorm, dim3(S), dim3(64), 0, st, H, D, A, D, 1, D, in[20] + L * D, 0, 1.f);
            if (L == 0) {
                gemm_l(st, false, A, D, in[21], FFD, G, FFD, S, FFD, D);
                gemm_l(st, false, A, D, in[22], FFD, U2, FFD, S, FFD, D);
                hipLaunchKernelGGL(swiglu_act, dim3(S), dim3(256), 0, st, G, U2, FFD, (const int*)nullptr);
                gemm_l(st, true, G, FFD, in[23], D, H, D, S, D, FFD);
            } else {
                float* LG = Y;
                gemm_l(st, false, A, D, in[24], NE, LG, NE, S, NE, D);
                hipMemsetAsync(cnt, 0, 256, st);
                hipLaunchKernelGGL(route, dim3(S / 256), dim3(256), 0, st, LG, cnt, list, gl);
                float* Dn = Y;
                for (int e = 0; e < NE; ++e) {
                    gemm_l(st, false, A, D, in[25] + (size_t)e * D * FFE, FFE, G, FFE, S, FFE, D, list + e * S, cnt + e);
                    gemm_l(st, false, A, D, in[26] + (size_t)e * D * FFE, FFE, U2, FFE, S, FFE, D, list + e * S, cnt + e);
                    hipLaunchKernelGGL(swiglu_act, dim3(S), dim3(256), 0, st, G, U2, FFE, (const int*)(cnt + e));
                    gemm_l(st, false, G, FFE, in[27] + (size_t)e * FFE * D, D, Dn, D, S, D, FFE, nullptr, cnt + e);
                    hipLaunchKernelGGL(scatter_add, dim3(S), dim3(256), 0, st, Dn, list + e * S, gl + e * S, (const int*)(cnt + e), H);
                }
            }
            hipLaunchKernelGGL(groupnorm, dim3(S), dim3(64), 0, st, H, D, A, D, 1, D, in[28] + L * D, 0, 1.f);
            gemm_l(st, false, A, D, in[29] + (size_t)L * D * D, D, G, D, S, D, D);
            gemm_l(st, false, in[1] + ((size_t)L * NB + b) * S * PLE, PLE, in[30] + (size_t)L * PLE * D, D, U2, D, S, D, PLE);
            hipLaunchKernelGGL(ple_apply, dim3(S), dim3(256), 0, st, G, U2, H);
        }
    }
}
}
#define GAS __attribute__((address_space(1)))
#define LAS __attribute__((address_space(3)))
typedef unsigned short bf16_t;
typedef unsigned u32x4 __attribute__((ext_vector_type(4)));
typedef unsigned u32x2 __attribute__((ext_vector_type(2)));
typedef float f32x4 __attribute__((ext_vector_type(4)));
typedef float f32x2 __attribute__((ext_vector_type(2)));
typedef short bf16x8 __attribute__((ext_vector_type(8)));
typedef GAS unsigned gu32;
#define RLX_AGENT __ATOMIC_RELAXED, __HIP_MEMORY_SCOPE_AGENT

constexpr int NB = 4, SEQ = 8192, M = NB * SEQ, D = 1024, DIN = 3080;
constexpr int FFD = 2816, FFE = 3584, NE = 8, PLE = 256;
constexpr int UW = 2816;
constexpr int UC_MQ = 0, UC_MK = 256, UC_MV = 512, UC_MO = 768, UC_Z = 1024, UC_Q = 1280, UC_K = 1792, UC_V = 2304;
constexpr int NIN = 3072;
constexpr float EPS = 1e-6f;
constexpr float C2 = 0.125f * 1.4426950408889634f;
constexpr int MOE_MAXROWS = M + NE * 256;

constexpr size_t MiB = 1u << 20;
constexpr size_t WS_CTL = 0, CTL_ZERO_BYTES = 1 * MiB;
constexpr size_t WS_WIN = 1 * MiB;
constexpr size_t WS_WOUT = WS_WIN + 12 * MiB;
constexpr size_t WS_WDGU = WS_WOUT + 4 * MiB;
constexpr size_t WS_WDD = WS_WDGU + 11 * MiB;
constexpr size_t WS_WMGU = WS_WDD + 6 * MiB;
constexpr size_t WS_WMD = WS_WMGU + 112 * MiB;
constexpr size_t WS_WPG = WS_WMD + 56 * MiB;
constexpr size_t WS_WPP = WS_WPG + 4 * MiB;
constexpr size_t WS_WSM = WS_WPP + 1 * MiB;
constexpr size_t WS_GATE = WS_WSM + 1 * MiB;
constexpr size_t WS_MOE = WS_GATE + 1 * MiB;
constexpr size_t WS_MST = WS_MOE + 3 * MiB;
constexpr size_t WS_AY = WS_MST + 34 * MiB;
constexpr size_t WS_BIG = WS_AY + 64 * MiB;
constexpr size_t WS_END = WS_BIG + 238 * MiB;
static_assert((size_t)MOE_MAXROWS * FFE * 2 <= 238 * MiB, "act fits");
static_assert((size_t)M * UW * 2 <= 176 * MiB, "u fits");

constexpr int CW_TMO = 0, CW_CODE = 1;
constexpr int CW_BAR = 4096;
constexpr int CW_CNT = 16384;
constexpr size_t MOE_GATEV = 0;
constexpr size_t MOE_EIDX = 2 * (size_t)M * 4;
constexpr size_t MOE_LIST = 4 * (size_t)M * 4;
static_assert(MOE_LIST + 16 * (size_t)M * 4 <= 3 * MiB, "moe region");

constexpr int RING_BYTES = 131072;
constexpr int LDSCTL_OFF = RING_BYTES, MISC_OFF = LDSCTL_OFF + 320;
constexpr int TAB_OFF = RING_BYTES + 1024;
constexpr int LDS_BYTES = 163840;
constexpr int NWAVES = 8;

__device__ __forceinline__ unsigned f2bf(float f) { unsigned u = __builtin_bit_cast(unsigned, f); return (u + 0x7fffu + ((u >> 16) & 1u)) >> 16; }
__device__ __forceinline__ unsigned pk2(float lo, float hi) { return f2bf(lo) | (f2bf(hi) << 16); }
__device__ __forceinline__ float bf2f(unsigned short b) { return __builtin_bit_cast(float, (unsigned)b << 16); }
__device__ __forceinline__ float bflo(unsigned w) { return __builtin_bit_cast(float, w << 16); }
__device__ __forceinline__ float bfhi(unsigned w) { return __builtin_bit_cast(float, w & 0xffff0000u); }
__device__ __forceinline__ unsigned cvt_pk_bf16(float lo, float hi) { unsigned r; asm volatile("v_cvt_pk_bf16_f32 %0, %1, %2" : "=v"(r) : "v"(lo), "v"(hi)); return r; }
__device__ __forceinline__ float fast_sigmoid(float x) { return __builtin_amdgcn_rcpf(1.f + __builtin_amdgcn_exp2f(-1.4426950408889634f * x)); }
__device__ __forceinline__ int lane_id_v() { int l; asm volatile("v_mbcnt_lo_u32_b32 %0, -1, 0\n\tv_mbcnt_hi_u32_b32 %0, -1, %0" : "=v"(l)); return l; }
__device__ __forceinline__ float wave_sum(float v) {
#pragma unroll
    for (int o = 1; o < 64; o <<= 1) v += __shfl_xor(v, o);
    return v;
}
__device__ __forceinline__ float wave_max(float v) {
#pragma unroll
    for (int o = 1; o < 64; o <<= 1) v = fmaxf(v, __shfl_xor(v, o));
    return v;
}

#define XB_TMO      128
#define XB_XCNT(j)  (256  + 64 * (j))
#define XB_XSUB(j)  (1280 + 64 * (j))
#define XB_XGEN(j)  (2304 + 64 * (j))
#define XB_TOP      3328
#define XB_TOPGEN   3392
#define XCD_BAR_WORDS 3456
#define XB_SPIN_CAP (1u << 22)
__device__ __forceinline__ unsigned xb_ld(unsigned* p)              { return __hip_atomic_load(p, __ATOMIC_RELAXED, __HIP_MEMORY_SCOPE_AGENT); }
__device__ __forceinline__ unsigned xb_add(unsigned* p, unsigned v) { return __hip_atomic_fetch_add(p, v, __ATOMIC_RELAXED, __HIP_MEMORY_SCOPE_AGENT); }
__device__ __forceinline__ unsigned xb_xcc_id() { return (unsigned)__builtin_amdgcn_s_getreg((3 << 11) | 20) & 0xFu; }
#define XB_SPIN(cond, bar) do { unsigned _sp = 0; while (cond) { __builtin_amdgcn_s_sleep(1); \
    if ((++_sp & 255u) == 0u) { if (xb_ld(&(bar)[XB_TMO])) break; if (_sp > XB_SPIN_CAP) { atomicAdd(&(bar)[XB_TMO], 1u); break; } } } } while (0)
struct XcdBarrier { unsigned* bar; unsigned x; volatile LAS unsigned* st; };
__device__ __forceinline__ XcdBarrier xcd_barrier_post(unsigned* bar, volatile LAS unsigned* st) {
    XcdBarrier b; b.bar = bar; b.x = xb_xcc_id(); b.st = st;
    if (threadIdx.x == 0) (void)xb_add(&bar[XB_XCNT(b.x)], 1u);
    return b;
}
__device__ __forceinline__ void xcd_barrier_complete(unsigned* bar, unsigned x, unsigned& nloc, unsigned& nx) {
    const unsigned G = gridDim.x * gridDim.y * gridDim.z;
    unsigned sum, cnt, mine, sp = 0u;
    for (;;) {
        sum = 0u; cnt = 0u; mine = 0u;
#pragma unroll
        for (unsigned j = 0; j < 16; ++j) { const unsigned c = xb_ld(&bar[XB_XCNT(j)]); sum += c; cnt += (c > 0u) ? 1u : 0u; mine = (j == x) ? c : mine; }
        if (sum == G) break;
        __builtin_amdgcn_s_sleep(1);
        if ((++sp & 255u) == 0u) { if (xb_ld(&bar[XB_TMO])) break; if (sp > XB_SPIN_CAP) { atomicAdd(&bar[XB_TMO], 1u); break; } }
    }
    nloc = mine > 0u ? mine : 1u; nx = cnt > 0u ? cnt : 1u;
}
__device__ __forceinline__ void xcd_barrier(const XcdBarrier& b) {
    asm volatile("s_waitcnt vmcnt(0)" ::: "memory");
    __syncthreads();
    if (threadIdx.x == 0) {
        unsigned* bar = b.bar;
        __builtin_amdgcn_s_waitcnt(0);
        unsigned nloc = b.st[0], nx = b.st[1];
        if (nloc == 0u) { xcd_barrier_complete(bar, b.x, nloc, nx); b.st[0] = nloc; b.st[1] = nx; }
        const unsigned old = xb_add(&bar[XB_XSUB(b.x)], 1u);
        const unsigned gen = old / nloc;
        if (old + 1u == (gen + 1u) * nloc) {
            __builtin_amdgcn_fence(__ATOMIC_RELEASE, "agent");
            asm volatile("s_waitcnt vmcnt(0)" ::: "memory");
            const unsigned og = xb_add(&bar[XB_TOP], 1u);
            const unsigned tg = og / nx;
            if (og + 1u == (tg + 1u) * nx) xb_add(&bar[XB_TOPGEN], 1u);
            else XB_SPIN(xb_ld(&bar[XB_TOPGEN]) == tg, bar);
            __builtin_amdgcn_fence(__ATOMIC_ACQUIRE, "agent");
            xb_add(&bar[XB_XGEN(b.x)], 1u);
            asm volatile("s_waitcnt vmcnt(0)" ::: "memory");
        } else {
            XB_SPIN(xb_ld(&bar[XB_XGEN(b.x)]) == gen, bar);
            __builtin_amdgcn_fence(__ATOMIC_ACQUIRE, "agent");
            asm volatile("s_waitcnt vmcnt(0)" ::: "memory");
        }
    }
    __syncthreads();
}

namespace pg8 {
constexpr int BM = 256, BK = 64, HALF = 128, HTB = HALF * BK * 2, STAGE_BYTES = 8 * HTB, NXCD = 8, WGM = 8;
__host__ __device__ __forceinline__ int lds_byte(int r, int c) { const int st = (r >> 4) * 2 + (c >> 5), rr = r & 15, cc = c & 31, ob = rr * 64 + cc * 2; return st * 1024 + (ob ^ (((ob >> 9) & 1) << 5)); }
__host__ __device__ __forceinline__ void stage_rc(int b, int& R, int& C) { const int st = b / 1024, sb = b % 1024, swz = sb ^ (((sb >> 9) & 1) << 5); R = (st >> 1) * 16 + swz / 64; C = (st & 1) * 32 + (swz % 64) / 2; }
__host__ __device__ __forceinline__ int perm32(int rho) { const int n = rho >> 4, i = rho & 15; return 8 * (i >> 2) + 4 * n + (i & 3); }

struct Unit { int pm, pn, pb; };

struct StaticOrder {
    int nM, nN, nwg, G, c;
    __device__ void init(int nM_, int nN_, int G_, int c_) { nM = nM_; nN = nN_; nwg = nM * nN; G = G_; c = c_; }
    __device__ __forceinline__ bool tile(int i, int& pm, int& pn) const {
        const long L = (long)i * G + c; if (L >= nwg) return false;
        int wgid = (int)L; { const int q = nwg / NXCD, r = nwg % NXCD, xcd = wgid % NXCD, off = wgid / NXCD; wgid = (xcd < r ? xcd * (q + 1) : r * (q + 1) + (xcd - r) * q) + off; }
        const int nig = WGM * nN, gid = wgid / nig, fm = gid * WGM, gsz = (nM - fm) < WGM ? (nM - fm) : WGM;
        pm = fm + ((wgid % nig) % gsz); pn = (wgid % nig) / gsz; return true;
    }
    __device__ __forceinline__ bool next(int i, Unit& u) const { if (!tile(i, u.pm, u.pn)) return false; u.pb = u.pn; return true; }
};

template <class Epi, class Sched, class AOff, bool ALIGN_EPI>
__device__ __forceinline__ void gemm_phase(LAS unsigned char* lds, int wave, const bf16_t* A, const bf16_t* Bt, int K, const Sched& S, const Epi& E, const AOff& AO) {
    asm volatile("" : "+s"(A), "+s"(Bt), "+s"(K), "+s"(wave));
    const int lane = lane_id_v(), wid = wave, tid = wid * 64 + lane, wr = wid >> 2, wc = wid & 3, fr = lane & 15, fq = lane >> 4;
    const int nt = K / BK;
    int R0, C0, R1, C1; stage_rc(tid * 16, R0, C0); stage_rc(tid * 16 + 8192, R1, C1);
    unsigned voffB[2]; voffB[0] = (unsigned)(R0 * K + C0) * 2u; voffB[1] = (unsigned)(R1 * K + C1) * 2u;
    const size_t kstep = (size_t)(BK * 2);
    const size_t hstep = (size_t)HALF * K * 2;
    const size_t tstep = 2 * hstep;
    const unsigned ldsw = (unsigned)wid * 1024u;
    const int aoff = lds_byte(wr * 64 + fr, fq * 8), boff = lds_byte(wc * 32 + fr, fq * 8);
    const char* Ab = (const char*)A;
#define PG8_SA(b, h) (((b) * 2 + (h)) * HTB)
#define PG8_SB(b, h) ((4 + (b) * 2 + (h)) * HTB)
#define PG8_STAGE(bufoff, gbase, voff) do { _Pragma("unroll") for (int _i = 0; _i < 2; ++_i) \
        __builtin_amdgcn_global_load_lds((const unsigned*)((const char*)(gbase) + (voff)[_i]), (LAS unsigned*)(lds + (bufoff) + ldsw + _i * 8192), 16, 0, 0); } while (0)
#define PG8_LDA(dst, b, h) do { _Pragma("unroll") for (int m = 0; m < 4; ++m) _Pragma("unroll") for (int k = 0; k < 2; ++k) dst[m][k] = *(const LAS bf16x8*)(lds + PG8_SA(b, h) + aoff + m * 2048 + k * 1024); } while (0)
#define PG8_LDB(dst, b, h) do { _Pragma("unroll") for (int n = 0; n < 2; ++n) _Pragma("unroll") for (int k = 0; k < 2; ++k) dst[n][k] = *(const LAS bf16x8*)(lds + PG8_SB(b, h) + boff + n * 2048 + k * 1024); } while (0)
#define PG8_MMA(ai, bj, At, Bt_) do { __builtin_amdgcn_s_setprio(1); _Pragma("unroll") for (int m = 0; m < 4; ++m) _Pragma("unroll") for (int n = 0; n < 2; ++n) _Pragma("unroll") for (int k = 0; k < 2; ++k) \
        acc[ai][bj][m][n] = __builtin_amdgcn_mfma_f32_16x16x32_bf16(Bt_[n][k], At[m][k], acc[ai][bj][m][n], 0, 0, 0); __builtin_amdgcn_s_setprio(0); } while (0)
#define PG8_WAIT_V(n) asm volatile("s_waitcnt vmcnt(" #n ")" ::: "memory")
#define PG8_WAIT_L(n) asm volatile("s_waitcnt lgkmcnt(" #n ")" ::: "memory")
#define PG8_BAR __builtin_amdgcn_s_barrier()
#define PG8_SCHED __builtin_amdgcn_sched_barrier(0)
    Unit cur, nxt; int ui = 0;
    if (!S.next(0, cur)) return;
    f32x4 acc[2][2][4][2];
#pragma unroll
    for (int a = 0; a < 2; ++a)
#pragma unroll
        for (int b = 0; b < 2; ++b)
#pragma unroll
            for (int m = 0; m < 4; ++m)
#pragma unroll
                for (int n = 0; n < 2; ++n) acc[a][b][m][n] = (f32x4){0.f, 0.f, 0.f, 0.f};
    bf16x8 At[4][2], B0[2][2], B1[2][2];
    unsigned va[2][2], vn[2][2];
    AO(cur, 0, R0, C0, R1, C1, va);
    const char* cB = (const char*)Bt + (size_t)cur.pb * tstep;
    PG8_STAGE(PG8_SB(0, 0), cB, voffB); PG8_STAGE(PG8_SB(0, 1), cB + hstep, voffB); PG8_STAGE(PG8_SA(0, 0), Ab, va[0]); PG8_STAGE(PG8_SA(0, 1), Ab, va[1]);
    if (wr == 1) PG8_BAR;
    PG8_WAIT_V(2); PG8_BAR;
    PG8_STAGE(PG8_SB(1, 0), cB + kstep, voffB); PG8_STAGE(PG8_SA(1, 0), Ab + kstep, va[0]); PG8_STAGE(PG8_SB(1, 1), cB + hstep + kstep, voffB);
    PG8_WAIT_V(6); PG8_BAR;
    for (;;) {
        const bool has_next = S.next(ui + 1, nxt);
        if (has_next) AO(nxt, ui + 1, R0, C0, R1, C1, vn);
        else { vn[0][0] = va[0][0]; vn[0][1] = va[0][1]; vn[1][0] = va[1][0]; vn[1][1] = va[1][1]; }
        const char* nB = has_next ? (const char*)Bt + (size_t)nxt.pb * tstep : cB;
        for (int t = 0; t < nt; t += 2) {
            const bool last = (t == nt - 2);
            const size_t ka1 = (size_t)(t + 1) * kstep;
            const size_t ka2 = last ? 0 : (size_t)(t + 2) * kstep, ka3 = ka2 + kstep;
            const char* b2 = last ? nB : cB + (size_t)(t + 2) * kstep; const char* b3 = b2 + kstep;
            unsigned w0[2], w1[2];
            w0[0] = last ? vn[0][0] : va[0][0]; w0[1] = last ? vn[0][1] : va[0][1]; w1[0] = last ? vn[1][0] : va[1][0]; w1[1] = last ? vn[1][1] : va[1][1];
            PG8_LDB(B0, 0, 0); PG8_LDB(B1, 0, 1); PG8_SCHED; PG8_LDA(At, 0, 0); PG8_STAGE(PG8_SA(1, 1), Ab + ka1, va[1]);
            PG8_WAIT_V(8); PG8_WAIT_L(0); PG8_BAR; PG8_MMA(0, 0, At, B0); PG8_MMA(0, 1, At, B1); PG8_BAR; PG8_SCHED;
            PG8_LDA(At, 0, 1); PG8_STAGE(PG8_SB(0, 0), b2, voffB); PG8_STAGE(PG8_SB(0, 1), b2 + hstep, voffB); PG8_STAGE(PG8_SA(0, 0), Ab + ka2, w0);
            PG8_WAIT_V(8); PG8_WAIT_L(0); PG8_BAR; PG8_MMA(1, 0, At, B0); PG8_MMA(1, 1, At, B1); PG8_BAR; PG8_SCHED;
            PG8_LDB(B0, 1, 0); PG8_LDB(B1, 1, 1); PG8_SCHED; PG8_LDA(At, 1, 0); PG8_STAGE(PG8_SA(0, 1), Ab + ka2, w1);
            PG8_WAIT_V(8); PG8_WAIT_L(0); PG8_BAR; PG8_MMA(0, 0, At, B0); PG8_MMA(0, 1, At, B1); PG8_BAR; PG8_SCHED;
            PG8_LDA(At, 1, 1); PG8_STAGE(PG8_SB(1, 0), b3, voffB); PG8_STAGE(PG8_SB(1, 1), b3 + hstep, voffB); PG8_STAGE(PG8_SA(1, 0), Ab + ka3, w0);
            PG8_WAIT_V(8); PG8_WAIT_L(0); PG8_BAR; PG8_MMA(1, 0, At, B0); PG8_MMA(1, 1, At, B1); PG8_BAR; PG8_SCHED;
        }
        if constexpr (ALIGN_EPI) { if (wr == 0) PG8_BAR; }
        E(acc, cur, wr, wc, fr, fq);
        if (!has_next) break;
#pragma unroll
        for (int a = 0; a < 2; ++a)
#pragma unroll
            for (int b = 0; b < 2; ++b)
#pragma unroll
                for (int m = 0; m < 4; ++m)
#pragma unroll
                    for (int n = 0; n < 2; ++n) acc[a][b][m][n] = (f32x4){0.f, 0.f, 0.f, 0.f};
        cur = nxt; cB = nB; ++ui;
        va[0][0] = vn[0][0]; va[0][1] = vn[0][1]; va[1][0] = vn[1][0]; va[1][1] = vn[1][1];
        if constexpr (ALIGN_EPI) { if (wr == 1) PG8_BAR; }
    }
    PG8_WAIT_V(0);
    if constexpr (!ALIGN_EPI) { if (wr == 0) PG8_BAR; }
    PG8_BAR;
#undef PG8_SA
#undef PG8_SB
#undef PG8_STAGE
#undef PG8_LDA
#undef PG8_LDB
#undef PG8_MMA
#undef PG8_WAIT_V
#undef PG8_WAIT_L
#undef PG8_BAR
#undef PG8_SCHED
}

struct AOffDense { int K; __device__ __forceinline__ void operator()(const Unit& u, int, int R0, int C0, int R1, int C1, unsigned (&vo)[2][2]) const {
#pragma unroll
    for (int h = 0; h < 2; ++h) { vo[h][0] = (unsigned)((u.pm * 256 + h * 128 + R0) * K + C0) * 2u; vo[h][1] = (unsigned)((u.pm * 256 + h * 128 + R1) * K + C1) * 2u; } } };
struct AOffGather { int K; const LAS int* tab; __device__ __forceinline__ void operator()(const Unit&, int ui, int R0, int C0, int R1, int C1, unsigned (&vo)[2][2]) const {
#pragma unroll
    for (int h = 0; h < 2; ++h) { vo[h][0] = (unsigned)(tab[ui * 256 + h * 128 + R0] * K + C0) * 2u; vo[h][1] = (unsigned)(tab[ui * 256 + h * 128 + R1] * K + C1) * 2u; } } };
}
struct Frame {
    LAS unsigned char* lds;
    volatile LAS unsigned* MISC;
    gu32* ctl;
    int tid, lane, wave, vcu, G;
    const float* in[31];
    float* out;
    unsigned char* ws;
};
#define LDS_WAIT() asm volatile("s_waitcnt lgkmcnt(0)" ::: "memory")
#define VM_WAIT() asm volatile("s_waitcnt vmcnt(0)" ::: "memory")

__device__ __forceinline__ void prep_item(const float* W, int ldw, int c0s, const float* gain, bf16_t* WT, int K, int n0d, int k0, bool perm, LAS float* scr, int lane) {
#pragma unroll 8
    for (int i = 0; i < 32; ++i) { const int kk = 2 * i + (lane >> 5); float v = W[(size_t)(k0 + kk) * ldw + c0s + (lane & 31)]; if (gain) v *= gain[k0 + kk]; scr[kk * 33 + (lane & 31)] = v; }
    LDS_WAIT(); asm volatile("" ::: "memory");
    const int c = lane & 7;
#pragma unroll
    for (int j = 0; j < 4; ++j) { const int n = (lane >> 3) + 8 * j; const int ns = perm ? pg8::perm32(n) : n; const LAS float* s = scr + (8 * c) * 33 + ns;
        u32x4 o; o.x = pk2(s[0 * 33], s[1 * 33]); o.y = pk2(s[2 * 33], s[3 * 33]); o.z = pk2(s[4 * 33], s[5 * 33]); o.w = pk2(s[6 * 33], s[7 * 33]);
        *(GAS u32x4*)(WT + (size_t)(n0d + n) * K + k0 + 8 * c) = o; }
    LDS_WAIT(); asm volatile("" ::: "memory");
}
__device__ __forceinline__ int win_src_col(int gd) {
    const int tile = gd >> 3, bj = (gd >> 2) & 1, wc = gd & 3;
    if (tile < 4) return 256 * tile + 128 * bj + 32 * wc;
    if (tile < 6) return (bj ? 1288 : 1032) + 128 * (tile - 4) + 32 * wc;
    if (tile < 8) return 1544 + 256 * (tile - 6) + 64 * wc + 32 * bj;
    if (tile < 10) return 2056 + 256 * (tile - 8) + 64 * wc + 32 * bj;
    return 2568 + 256 * (tile - 10) + 128 * bj + 32 * wc;
}
__device__ __forceinline__ void p0_prologue(Frame& F) {
    LAS float* scr = (LAS float*)(F.lds + F.wave * 16384);
    const int gw = F.vcu * NWAVES + F.wave, NGW = F.G * NWAVES, lane = F.lane;
    bf16_t* ws16 = (bf16_t*)F.ws;
    constexpr int I_IN = 16 * 96, I_OUT = 16 * 32, I_DGU = 16 * 176, I_DD = 44 * 32, I_MGU = 16 * 224, I_MD = 56 * 32, I_PG = 16 * 32, I_PP = 4 * 32;
    constexpr int NITEMS = 2 * I_IN + 2 * I_OUT + I_DGU + I_DD + 8 * I_MGU + 8 * I_MD + 2 * I_PG + 2 * I_PP;
    for (int it = gw; it < NITEMS; it += NGW) {
        int r = it;
        const float* W; const float* gain = nullptr; bf16_t* WT; int ldw, c0s, K, gd, kb; bool perm = false;
        if (r < 2 * I_IN) { const int L = r / I_IN; r %= I_IN; gd = r % 96; kb = r / 96;
            W = F.in[3] + (size_t)L * D * DIN; ldw = DIN; c0s = win_src_col(gd); gain = F.in[2] + L * D; WT = (bf16_t*)(F.ws + WS_WIN) + (size_t)L * NIN * D; K = D; perm = true; }
        else if ((r -= 2 * I_IN) < 2 * I_OUT) { const int L = r / I_OUT; r %= I_OUT; gd = r % 32; kb = r / 32;
            W = F.in[19] + (size_t)L * D * D; ldw = D; c0s = 32 * gd; WT = (bf16_t*)(F.ws + WS_WOUT) + (size_t)L * D * D; K = D; }
        else if ((r -= 2 * I_OUT) < I_DGU) { gd = r % 176; kb = r / 176; const int tile = gd >> 3, bj = (gd >> 2) & 1, wc = gd & 3;
            W = bj ? F.in[22] : F.in[21]; ldw = FFD; c0s = 128 * tile + 32 * wc; gain = F.in[20]; WT = (bf16_t*)(F.ws + WS_WDGU); K = D; perm = true; }
        else if ((r -= I_DGU) < I_DD) { gd = r % 32; kb = r / 32;
            W = F.in[23]; ldw = D; c0s = 32 * gd; WT = (bf16_t*)(F.ws + WS_WDD); K = FFD; }
        else if ((r -= I_DD) < 8 * I_MGU) { const int e = r / I_MGU; r %= I_MGU; gd = r % 224; kb = r / 224; const int tile = gd >> 3, bj = (gd >> 2) & 1, wc = gd & 3;
            W = (bj ? F.in[26] : F.in[25]) + (size_t)e * D * FFE; ldw = FFE; c0s = 128 * tile + 32 * wc; gain = F.in[20] + D; WT = (bf16_t*)(F.ws + WS_WMGU) + (size_t)e * 2 * FFE * D; K = D; perm = true; }
        else if ((r -= 8 * I_MGU) < 8 * I_MD) { const int e = r / I_MD; r %= I_MD; gd = r % 32; kb = r / 32;
            W = F.in[27] + (size_t)e * FFE * D; ldw = D; c0s = 32 * gd; WT = (bf16_t*)(F.ws + WS_WMD) + (size_t)e * D * FFE; K = FFE; }
        else if ((r -= 8 * I_MD) < 2 * I_PG) { const int L = r / I_PG; r %= I_PG; gd = r % 32; kb = r / 32;
            W = F.in[29] + (size_t)L * D * D; ldw = D; c0s = 32 * gd; gain = F.in[28] + L * D; WT = (bf16_t*)(F.ws + WS_WPG) + (size_t)L * D * D; K = D; }
        else { r -= 2 * I_PG; const int L = r / I_PP; r %= I_PP; gd = r % 32; kb = r / 32;
            W = F.in[30] + (size_t)L * PLE * D; ldw = D; c0s = 32 * gd; WT = (bf16_t*)(F.ws + WS_WPP) + (size_t)L * D * PLE; K = PLE; }
        prep_item(W, ldw, c0s, gain, WT, K, 32 * gd, 64 * kb, perm, scr, lane);
    }
    (void)ws16;
    float* wsm = (float*)(F.ws + WS_WSM);
    const int gt = F.vcu * (NWAVES * 64) + F.tid, NGT = F.G * NWAVES * 64;
    for (int i = gt; i < 3 * 8 * D; i += NGT) {
        const int which = i / (8 * D), j = (i / D) % 8, k = i % D;
        float v;
        if (which < 2) v = F.in[2][which * D + k] * F.in[3][(size_t)which * D * DIN + (size_t)k * DIN + 1024 + j];
        else v = F.in[20][D + k] * F.in[24][k * NE + j];
        wsm[i] = v;
    }
}

template <int MODE>
__device__ __forceinline__ void norm_phase(Frame& F, const float* src, const float* wx, const float* pconv, bf16_t* pconv_out) {
    bf16_t* AY = (bf16_t*)(F.ws + WS_AY);
    LAS float* wl = (LAS float*)F.lds;
    LAS int* rinfo = (LAS int*)(F.lds + 32768);
    if (MODE != 0) { for (int i = F.tid; i < 8 * D; i += NWAVES * 64) wl[i] = wx[i]; __syncthreads(); }
    const int gw = F.vcu * NWAVES + F.wave, NGW = F.G * NWAVES, lane = F.lane;
    int nrow = 0;
    for (int m = gw; m < M; m += NGW, ++nrow) {
        const GAS f32x4* xr = (const GAS f32x4*)(src + (size_t)m * D) + lane;
        f32x4 v[4]; float s = 0.f;
#pragma unroll
        for (int j = 0; j < 4; ++j) { v[j] = xr[64 * j]; s += (v[j].x * v[j].x + v[j].y * v[j].y) + (v[j].z * v[j].z + v[j].w * v[j].w); }
        const float rs = 1.0f / sqrtf(wave_sum(s) * (1.f / D) + EPS);
#pragma unroll
        for (int j = 0; j < 4; ++j) v[j] = v[j] * rs;
        GAS unsigned long long* o8 = (GAS unsigned long long*)(AY + (size_t)m * D) + lane;
#pragma unroll
        for (int j = 0; j < 4; ++j) o8[64 * j] = (unsigned long long)pk2(v[j].x, v[j].y) | ((unsigned long long)pk2(v[j].z, v[j].w) << 32);
        if (MODE != 0) {
            float dt[8];
#pragma unroll
            for (int c = 0; c < 8; ++c) { float a = 0.f;
#pragma unroll
                for (int j = 0; j < 4; ++j) { const f32x4 w = *(const LAS f32x4*)(wl + c * D + 256 * j + 4 * lane); a += (v[j].x * w.x + v[j].y * w.y) + (v[j].z * w.z + v[j].w * w.w); }
                dt[c] = wave_sum(a); }
            if (MODE == 1) { if (lane == 0) { GAS f32x4* g = (GAS f32x4*)((float*)(F.ws + WS_GATE) + (size_t)m * 8); g[0] = (f32x4){dt[0], dt[1], dt[2], dt[3]}; g[1] = (f32x4){dt[4], dt[5], dt[6], dt[7]}; } }
            if (MODE == 2) {
                int i0 = 0;
#pragma unroll
                for (int e = 1; e < 8; ++e) if (dt[e] > dt[i0]) i0 = e;
                int i1 = (i0 == 0) ? 1 : 0;
#pragma unroll
                for (int e = 0; e < 8; ++e) if (e != i0 && dt[e] > dt[i1]) i1 = e;
                float v0 = dt[0], v1 = dt[0];
#pragma unroll
                for (int e = 0; e < 8; ++e) { v0 = (e == i0) ? dt[e] : v0; v1 = (e == i1) ? dt[e] : v1; }
                const float e1 = __expf(v1 - v0), g0 = 1.f / (1.f + e1), g1 = e1 / (1.f + e1);
                if (lane == 0) {
                    float* gv = (float*)(F.ws + WS_MOE + MOE_GATEV); gv[m] = g0; gv[M + m] = g1;
                    rinfo[(F.wave * 16 + nrow) * 2] = i0; rinfo[(F.wave * 16 + nrow) * 2 + 1] = i1;
                }
            }
        }
    }
    if (MODE == 2) {
        __syncthreads();
        if (F.tid < 16) {
            const int s = F.tid >> 3, e = F.tid & 7; int n = 0;
#pragma unroll 1
            for (int wr_ = 0; wr_ < 128; ++wr_) n += (rinfo[wr_ * 2 + s] == e) ? 1 : 0;
            unsigned base = 0; if (n) base = __hip_atomic_fetch_add((unsigned*)(F.ctl + CW_CNT + s * 8 + e), (unsigned)n, RLX_AGENT);
            int* list = (int*)(F.ws + WS_MOE + MOE_LIST) + ((size_t)(s * 8 + e)) * M;
            int k = 0;
#pragma unroll 1
            for (int wr_ = 0; wr_ < 128; ++wr_) if (rinfo[wr_ * 2 + s] == e) { list[base + k] = (F.vcu * NWAVES + (wr_ >> 4)) + (wr_ & 15) * NGW; ++k; }
        }
        __syncthreads();
    }
    if (pconv) {
        const size_t n4 = (size_t)M * PLE / 4, gt = (size_t)F.vcu * (NWAVES * 64) + F.tid, NGT = (size_t)F.G * NWAVES * 64;
        for (size_t i = gt; i < n4; i += NGT) { const f32x4 x = ((const GAS f32x4*)pconv)[i]; ((GAS unsigned long long*)pconv_out)[i] = (unsigned long long)pk2(x.x, x.y) | ((unsigned long long)pk2(x.z, x.w) << 32); }
    }
}

typedef f32x4 AccT[2][2][4][2];
__device__ __forceinline__ u32x4 pack8(const f32x4& a, const f32x4& b) { u32x4 w; w.x = cvt_pk_bf16(a[0], a[1]); w.y = cvt_pk_bf16(a[2], a[3]); w.z = cvt_pk_bf16(b[0], b[1]); w.w = cvt_pk_bf16(b[2], b[3]); return w; }

struct EpiIn {
    bf16_t* U; const float* gq; const float* gk;
    __device__ __forceinline__ void operator()(const AccT& acc, const pg8::Unit& u, int wr, int wc, int fr, int fq) const {
        const int row0 = u.pm * 256 + wr * 64 + fr, pn = u.pn;
        if (pn < 4 || pn >= 10) {
            const int cb = (pn < 4 ? 256 * pn : UC_V + 256 * (pn - 10)) + wc * 32 + 8 * fq;
#pragma unroll
            for (int ai = 0; ai < 2; ++ai)
#pragma unroll
                for (int m = 0; m < 4; ++m) { bf16_t* rp = U + (size_t)(row0 + ai * 128 + m * 16) * UW + cb;
#pragma unroll
                    for (int bj = 0; bj < 2; ++bj) *(u32x4*)(rp + bj * 128) = pack8(acc[ai][bj][m][0], acc[ai][bj][m][1]); }
        } else if (pn < 6) {
            const int cb = UC_Z + 128 * (pn - 4) + wc * 32 + 8 * fq;
#pragma unroll
            for (int ai = 0; ai < 2; ++ai)
#pragma unroll
                for (int m = 0; m < 4; ++m) { f32x4 z0, z1;
#pragma unroll
                    for (int i = 0; i < 4; ++i) { z0[i] = acc[ai][0][m][0][i] * fast_sigmoid(acc[ai][1][m][0][i]); z1[i] = acc[ai][0][m][1][i] * fast_sigmoid(acc[ai][1][m][1][i]); }
                    *(u32x4*)(U + (size_t)(row0 + ai * 128 + m * 16) * UW + cb) = pack8(z0, z1); }
        } else {
            const bool isq = pn < 8; const int j = 4 * (pn - (isq ? 6 : 8)) + wc;
            const float* g = isq ? gq : gk; const float sc = isq ? C2 : 1.f;
            f32x4 gv[2][2];
#pragma unroll
            for (int bj = 0; bj < 2; ++bj)
#pragma unroll
                for (int n = 0; n < 2; ++n) gv[bj][n] = *(const f32x4*)(g + 32 * bj + 8 * fq + 4 * n) * sc;
            const int cb = (isq ? UC_Q : UC_K) + 64 * j + 8 * fq;
#pragma unroll
            for (int ai = 0; ai < 2; ++ai)
#pragma unroll
                for (int m = 0; m < 4; ++m) { float ss = 0.f;
#pragma unroll
                    for (int bj = 0; bj < 2; ++bj)
#pragma unroll
                        for (int n = 0; n < 2; ++n) { const f32x4 x = acc[ai][bj][m][n]; ss += (x[0] * x[0] + x[1] * x[1]) + (x[2] * x[2] + x[3] * x[3]); }
                    ss += __shfl_xor(ss, 16); ss += __shfl_xor(ss, 32);
                    const float rs = 1.0f / sqrtf(ss * (1.f / 64.f) + EPS);
                    bf16_t* rp = U + (size_t)(row0 + ai * 128 + m * 16) * UW + cb;
#pragma unroll
                    for (int bj = 0; bj < 2; ++bj) *(u32x4*)(rp + 32 * bj) = pack8(acc[ai][bj][m][0] * gv[bj][0] * rs, acc[ai][bj][m][1] * gv[bj][1] * rs); }
        }
    }
};
struct EpiRes {
    const float* res; float* out;
    __device__ __forceinline__ void operator()(const AccT& acc, const pg8::Unit& u, int wr, int wc, int fr, int fq) const {
        const int row0 = u.pm * 256 + wr * 64 + fr, col0 = u.pn * 256 + wc * 32 + 4 * fq;
#pragma unroll
        for (int ai = 0; ai < 2; ++ai)
#pragma unroll
            for (int m = 0; m < 4; ++m) { const size_t ro = (size_t)(row0 + ai * 128 + m * 16) * D + col0;
#pragma unroll
                for (int bj = 0; bj < 2; ++bj)
#pragma unroll
                    for (int n = 0; n < 2; ++n) { const size_t o = ro + bj * 128 + n * 16; *(f32x4*)(out + o) = *(const f32x4*)(res + o) + acc[ai][bj][m][n]; } }
    }
};
struct EpiGlu {
    bf16_t* O; int ldc;
    __device__ __forceinline__ void operator()(const AccT& acc, const pg8::Unit& u, int wr, int wc, int fr, int fq) const {
        const int row0 = u.pm * 256 + wr * 64 + fr, cb = 128 * u.pn + wc * 32 + 8 * fq;
#pragma unroll
        for (int ai = 0; ai < 2; ++ai)
#pragma unroll
            for (int m = 0; m < 4; ++m) { f32x4 z0, z1;
#pragma unroll
                for (int i = 0; i < 4; ++i) { const float g0 = acc[ai][0][m][0][i], g1 = acc[ai][0][m][1][i]; z0[i] = g0 * fast_sigmoid(g0) * acc[ai][1][m][0][i]; z1[i] = g1 * fast_sigmoid(g1) * acc[ai][1][m][1][i]; }
                *(u32x4*)(O + (size_t)(row0 + ai * 128 + m * 16) * ldc + cb) = pack8(z0, z1); }
    }
};
struct EpiScatter {
    float* out; const int* list_s; const float* gatev_s; const LAS int* rt_info;
    __device__ __forceinline__ void operator()(const AccT& acc, const pg8::Unit& u, int wr, int wc, int fr, int fq) const {
        const int e = rt_info[3 * u.pm], i0 = rt_info[3 * u.pm + 1], nv = rt_info[3 * u.pm + 2];
        const int col0 = u.pn * 256 + wc * 32 + 4 * fq;
        const int* lst = list_s + (size_t)e * M + i0;
#pragma unroll
        for (int ai = 0; ai < 2; ++ai)
#pragma unroll
            for (int m = 0; m < 4; ++m) { const int r = ai * 128 + wr * 64 + m * 16 + fr;
                if (r < nv) { const int tok = lst[r]; const float g = gatev_s[tok]; const size_t ro = (size_t)tok * D + col0;
#pragma unroll
                    for (int bj = 0; bj < 2; ++bj)
#pragma unroll
                        for (int n = 0; n < 2; ++n) { const size_t o = ro + bj * 128 + n * 16; *(f32x4*)(out + o) = *(const f32x4*)(out + o) + acc[ai][bj][m][n] * g; } } }
    }
};
struct EpiPe {
    bf16_t* O;
    __device__ __forceinline__ void operator()(const AccT& acc, const pg8::Unit& u, int wr, int wc, int fr, int fq) const {
        const int row0 = u.pm * 256 + wr * 64 + fr, col0 = u.pn * 256 + wc * 32 + 4 * fq;
#pragma unroll
        for (int ai = 0; ai < 2; ++ai)
#pragma unroll
            for (int m = 0; m < 4; ++m) { const size_t ro = (size_t)(row0 + ai * 128 + m * 16) * D + col0;
#pragma unroll
                for (int bj = 0; bj < 2; ++bj)
#pragma unroll
                    for (int n = 0; n < 2; ++n) { const f32x4 x = acc[ai][bj][m][n]; u32x2 w; w.x = cvt_pk_bf16(x[0], x[1]); w.y = cvt_pk_bf16(x[2], x[3]); *(u32x2*)(O + ro + bj * 128 + n * 16) = w; } }
    }
};
struct EpiPle {
    float* out; const bf16_t* PE;
    __device__ __forceinline__ void operator()(const AccT& acc, const pg8::Unit& u, int wr, int wc, int fr, int fq) const {
        const int row0 = u.pm * 256 + wr * 64 + fr, col0 = u.pn * 256 + wc * 32 + 4 * fq;
#pragma unroll
        for (int ai = 0; ai < 2; ++ai)
#pragma unroll
            for (int m = 0; m < 4; ++m) { const size_t ro = (size_t)(row0 + ai * 128 + m * 16) * D + col0;
#pragma unroll
                for (int bj = 0; bj < 2; ++bj)
#pragma unroll
                    for (int n = 0; n < 2; ++n) { const size_t o = ro + bj * 128 + n * 16; const u32x2 w = *(const u32x2*)(PE + o); const f32x4 x = acc[ai][bj][m][n]; f32x4 h = *(const f32x4*)(out + o);
                        h[0] += fast_sigmoid(x[0]) * bflo(w.x); h[1] += fast_sigmoid(x[1]) * bfhi(w.x); h[2] += fast_sigmoid(x[2]) * bflo(w.y); h[3] += fast_sigmoid(x[3]) * bfhi(w.y);
                        *(f32x4*)(out + o) = h; } }
    }
};

struct MoeSched {
    pg8::StaticOrder so; const LAS int* rt_info; int ntn;
    __device__ __forceinline__ bool next(int i, pg8::Unit& u) const { if (!so.tile(i, u.pm, u.pn)) return false; u.pb = rt_info[3 * u.pm] * ntn + u.pn; return true; }
};
__device__ __forceinline__ int moe_build_tiles(Frame& F, int s, LAS int* rt_info) {
    int RT = 0;
    int cnt[8];
#pragma unroll
    for (int e = 0; e < 8; ++e) cnt[e] = (int)__hip_atomic_load((unsigned*)(F.ctl + CW_CNT + s * 8 + e), RLX_AGENT);
    if (F.tid == 0) { int rt = 0; for (int e = 0; e < 8; ++e) for (int i0 = 0; i0 < cnt[e]; i0 += 256) { rt_info[3 * rt] = e; rt_info[3 * rt + 1] = i0; rt_info[3 * rt + 2] = (cnt[e] - i0) < 256 ? (cnt[e] - i0) : 256; ++rt; } }
#pragma unroll
    for (int e = 0; e < 8; ++e) RT += (cnt[e] + 255) >> 8;
    __syncthreads();
    return RT;
}
namespace nvb {
using nv::sigmoidf_; using nv::siluf_; using nv::wsum; using nv::wmax;
__global__ void mprep(const bf16_t* U, const float* GATE, const float* cw, const float* bi, const float* bf, float* QK, float* IG, float* LF) {
    const int t = blockIdx.x, c = threadIdx.x;
    float acc = 0.f;
    for (int j = 0; j < 4; ++j) { const int tt = t - 3 + j; if (tt >= 0) acc += cw[j * 512 + c] * bf2f(U[(size_t)tt * UW + c]); }
    QK[(size_t)t * 512 + c] = siluf_(acc);
    if (c < 4) {
        IG[t * 4 + c] = GATE[(size_t)t * 8 + c] + bi[c];
        const float f = GATE[(size_t)t * 8 + 4 + c] + bf[c];
        LF[t * 4 + c] = fminf(f, 0.f) - log1pf(expf(-fabsf(f)));
    }
}
__global__ void mlstm_rec(const float* QK, const bf16_t* U, const float* IG, const float* LF, float* HM) {
    __shared__ float sq[64][64], sk[64][64], sv[64][64];
    __shared__ float sig[64], slf[64];
    __shared__ float red[2][4][64], redd[2][4][64];
    const int h = blockIdx.x, tid = threadIdx.x, e = tid & 63, dq = tid >> 6;
    float C[16], n[16]; float m = 0.f;
    for (int i = 0; i < 16; ++i) { C[i] = 0.f; n[i] = 0.f; }
    for (int t0 = 0; t0 < SEQ; t0 += 64) {
        __syncthreads();
        for (int i = tid; i < 64 * 64; i += 256) {
            const int tt = i >> 6, d = i & 63;
            sq[tt][d] = QK[(size_t)(t0 + tt) * 512 + h * 64 + d] * 0.125f;
            sk[tt][d] = QK[(size_t)(t0 + tt) * 512 + 256 + h * 64 + d];
            sv[tt][d] = bf2f(U[(size_t)(t0 + tt) * UW + UC_MV + h * 64 + d]);
        }
        if (tid < 64) { sig[tid] = IG[(t0 + tid) * 4 + h]; slf[tid] = LF[(t0 + tid) * 4 + h]; }
        __syncthreads();
        for (int tt = 0; tt < 64; ++tt) {
            const float ig = sig[tt], lf = slf[tt];
            const float mn = fmaxf(lf + m, ig), a = expf(lf + m - mn), bb = expf(ig - mn);
            m = mn;
            const float v = sv[tt][e];
            float num = 0.f, den = 0.f;
#pragma unroll
            for (int i = 0; i < 16; ++i) {
                const int d = dq * 16 + i; const float k = sk[tt][d], q = sq[tt][d];
                C[i] = a * C[i] + bb * k * v; n[i] = a * n[i] + bb * k;
                num += q * C[i]; den += q * n[i];
            }
            red[tt & 1][dq][e] = num; redd[tt & 1][dq][e] = den;
            __syncthreads();
            if (dq == 0) {
                const float nu = red[tt & 1][0][e] + red[tt & 1][1][e] + red[tt & 1][2][e] + red[tt & 1][3][e];
                const float de = redd[tt & 1][0][e] + redd[tt & 1][1][e] + redd[tt & 1][2][e] + redd[tt & 1][3][e];
                HM[(size_t)(t0 + tt) * 256 + h * 64 + e] = nu / fmaxf(fabsf(de), expf(-m));
            }
        }
    }
}
__global__ void mgate(const float* HMN, const bf16_t* U, bf16_t* Y) {
    const int t = blockIdx.x, c = threadIdx.x;
    Y[(size_t)t * D + c] = (bf16_t)f2bf(HMN[(size_t)t * 256 + c] * sigmoidf_(bf2f(U[(size_t)t * UW + UC_MO + c])));
}
__global__ void cconv(const bf16_t* U, const float* w, const float* b, const float* lg, const float* lb, bf16_t* Y) {
    __shared__ float sm[4], sv2[4];
    const int t = blockIdx.x, c = threadIdx.x;
    float acc = b[c];
    for (int j = 0; j < 31; ++j) { const int tt = t - 30 + j; if (tt >= 0) acc += w[j * 256 + c] * bf2f(U[(size_t)tt * UW + UC_Z + c]); }
    float s = wsum(acc);
    if ((c & 63) == 0) sm[c >> 6] = s;
    __syncthreads();
    const float mu = (sm[0] + sm[1] + sm[2] + sm[3]) * (1.f / 256.f);
    const float dv = acc - mu;
    float s2 = wsum(dv * dv);
    if ((c & 63) == 0) sv2[c >> 6] = s2;
    __syncthreads();
    const float var = (sv2[0] + sv2[1] + sv2[2] + sv2[3]) * (1.f / 256.f);
    const float yv = dv * rsqrtf(var + 1e-6f) * lg[c] + lb[c];
    Y[(size_t)t * D + 256 + c] = (bf16_t)f2bf(siluf_(yv));
}
__global__ void attn(const bf16_t* U, float* O) {
    __shared__ float sK[64][65];
    __shared__ float sV[64][128];
    __shared__ float sQ[16][64];
    __shared__ float sP[16][64];
    const int j = blockIdx.y, hd = j >> 1, q0 = blockIdx.x * 16, tid = threadIdx.x, w = tid >> 6, lane = tid & 63;
    const int qpos = q0 + w;
    const float slope2 = exp2f(-8.f * (float)(hd + 1) / 4.f) * 1.4426950408889634f;
    sQ[w][lane] = bf2f(U[(size_t)qpos * UW + UC_Q + j * 64 + lane]);
    float m = -INFINITY, l = 0.f, o0 = 0.f, o1 = 0.f;
    const int ntile = (q0 + 15) / 64 + 1;
    for (int kt = 0; kt < ntile; ++kt) {
        __syncthreads();
        for (int i = tid; i < 64 * 64; i += 1024) { const int r = i >> 6, d = i & 63; sK[r][d] = bf2f(U[(size_t)(kt * 64 + r) * UW + UC_K + j * 64 + d]); }
        for (int i = tid; i < 64 * 128; i += 1024) { const int r = i >> 7, d = i & 127; sV[r][d] = bf2f(U[(size_t)(kt * 64 + r) * UW + UC_V + hd * 128 + d]); }
        __syncthreads();
        const int kpos = kt * 64 + lane;
        float s = 0.f;
        for (int d = 0; d < 64; ++d) s += sQ[w][d] * sK[lane][d];
        s = s - slope2 * (float)(qpos - kpos);
        if (kpos > qpos) s = -INFINITY;
        const float tm = wmax(s), mn = fmaxf(m, tm), corr = exp2f(m - mn), p = exp2f(s - mn);
        l = l * corr + wsum(p); o0 *= corr; o1 *= corr; m = mn;
        sP[w][lane] = p;
        __syncthreads();
        for (int k = 0; k < 64; ++k) { const float pk = sP[w][k]; o0 += pk * sV[k][lane]; o1 += pk * sV[k][64 + lane]; }
    }
    O[((size_t)qpos * 8 + j) * 128 + lane] = o0 / l;
    O[((size_t)qpos * 8 + j) * 128 + 64 + lane] = o1 / l;
}
__global__ void subln(const float* YA, const float* gain, float scale, bf16_t* Y) {
    const int rg = blockIdx.x, row = rg >> 2, g = rg & 3, lane = threadIdx.x;
    const float* x = YA + (size_t)row * 512 + g * 128;
    const float a = x[lane], b = x[64 + lane];
    const float r = rsqrtf(wsum(a * a + b * b) / 128.f + 1e-6f);
    Y[(size_t)row * D + 512 + g * 128 + lane] = (bf16_t)f2bf(a * r * gain[lane] * scale);
    Y[(size_t)row * D + 512 + g * 128 + 64 + lane] = (bf16_t)f2bf(b * r * gain[64 + lane] * scale);
}
static void mixers(void* const* d_in, unsigned char* ws, int L, hipStream_t st, int mask) {
    const float* const* in = (const float* const*)d_in;
    unsigned char* tail = ws + WS_BIG + 176 * MiB;
    float* QK = (float*)tail; float* HM = (float*)(tail + 16 * MiB); float* HMN = (float*)(tail + 24 * MiB); float* AO = (float*)tail;
    float* YA = (float*)(tail + 32 * MiB); float* IG = (float*)(tail + 48 * MiB); float* LF = (float*)(tail + 49 * MiB);
    const float lam_init = 0.8f - 0.6f * expf(-0.3f * (float)L);
    for (int b = 0; b < NB; ++b) {
        const bf16_t* U = (const bf16_t*)(ws + WS_BIG) + (size_t)b * SEQ * UW;
        const float* GATE = (const float*)(ws + WS_GATE) + (size_t)b * SEQ * 8;
        bf16_t* Y = (bf16_t*)(ws + WS_AY) + (size_t)b * SEQ * D;
        if (mask & 1) {
        hipLaunchKernelGGL(mprep, dim3(SEQ), dim3(512), 0, st, U, GATE, in[6] + L * 2048, in[4] + L * 4, in[5] + L * 4, QK, IG, LF);
        hipLaunchKernelGGL(mlstm_rec, dim3(4), dim3(256), 0, st, (const float*)QK, U, (const float*)IG, (const float*)LF, HM);
        hipLaunchKernelGGL(nv::groupnorm, dim3(SEQ * 4), dim3(64), 0, st, (const float*)HM, 256, HMN, 256, 4, 64, in[7] + L * 256, 64, 1.f);
        hipLaunchKernelGGL(mgate, dim3(SEQ), dim3(256), 0, st, (const float*)HMN, U, Y);
        }
        if (mask & 2)
        hipLaunchKernelGGL(cconv, dim3(SEQ), dim3(256), 0, st, U, in[8] + L * 31 * 256, in[9] + L * 256, in[10] + L * 256, in[11] + L * 256, Y);
        if (mask & 4) {
        hipLaunchKernelGGL(attn, dim3(SEQ / 16, 8), dim3(1024), 0, st, U, AO);
        hipLaunchKernelGGL(nv::acomb, dim3(SEQ), dim3(512), 0, st, (const float*)AO, in[14] + L * 64, in[15] + L * 64, in[16] + L * 64, in[17] + L * 64, lam_init, YA);
        hipLaunchKernelGGL(subln, dim3(SEQ * 4), dim3(64), 0, st, (const float*)YA, in[18] + L * 128, 1.f - lam_init, Y);
        }
    }
}
}
typedef float f32x16 __attribute__((ext_vector_type(16)));
typedef short s16x4 __attribute__((ext_vector_type(4)));
typedef short v4i16_t __attribute__((ext_vector_type(4)));
#define MFMA32(a, b, c) __builtin_amdgcn_mfma_f32_32x32x16_bf16((a), (b), (c), 0, 0, 0)
__device__ __forceinline__ int crow(int r, int hi) { return (r & 3) + 8 * (r >> 2) + 4 * hi; }
__device__ __forceinline__ float fast_silu(float x) { return x * fast_sigmoid(x); }
__device__ __forceinline__ s16x4 tr_read(const LAS unsigned char* p) { return __builtin_bit_cast(s16x4, __builtin_amdgcn_ds_read_tr16_b64_v4i16((LAS v4i16_t*)p)); }
__device__ __forceinline__ bf16x8 tr_frag(const LAS unsigned char* T, int row0, int step2, int c0, int lane) {
    const int q = (lane & 15) >> 2, p = lane & 3, cg = (lane >> 4) & 1;
    const LAS unsigned char* a = T + (row0 + q) * 128 + (c0 + 16 * cg + 4 * p) * 2;
    const s16x4 lo = tr_read(a), hi = tr_read(a + step2 * 128);
    return (bf16x8){lo[0], lo[1], lo[2], lo[3], hi[0], hi[1], hi[2], hi[3]};
}

__device__ __forceinline__ void conformer_phase(Frame& F, int L) {
    const bf16_t* U = (const bf16_t*)(F.ws + WS_BIG); bf16_t* Y = (bf16_t*)(F.ws + WS_AY);
    const float* cw = F.in[8] + L * 31 * 256; const float* cb = F.in[9] + L * 256; const float* lg = F.in[10] + L * 256; const float* lb = F.in[11] + L * 256;
    LAS unsigned char* zt = F.lds;
    LAS float* ot = (LAS float*)(F.lds + 49152);
    const int tid = F.tid, c = tid & 255, hf = tid >> 8;
    float w[31];
#pragma unroll
    for (int j = 0; j < 31; ++j) w[j] = cw[j * 256 + c];
    const float bias = cb[c];
    for (int unit = F.vcu; unit < M / 64; unit += F.G) {
        const int row0 = unit * 64, t0 = row0 & (SEQ - 1);
        __syncthreads();
        for (int i = tid; i < 94 * 32; i += NWAVES * 64) { const int r = i >> 5, ch = i & 31; u32x4 v = (u32x4){0u, 0u, 0u, 0u};
            if (t0 - 30 + r >= 0) v = *(const GAS u32x4*)(U + (size_t)(row0 - 30 + r) * UW + UC_Z + ch * 8);
            *(LAS u32x4*)(zt + r * 512 + ch * 16) = v; }
        __syncthreads();
        float acc[32];
#pragma unroll
        for (int o = 0; o < 32; ++o) acc[o] = bias;
#pragma unroll
        for (int i = 0; i < 62; ++i) { const float x = bf2f(*(const LAS unsigned short*)(zt + (32 * hf + i) * 512 + c * 2));
#pragma unroll
            for (int o = 0; o < 32; ++o) { const int j = i - o; if (j >= 0 && j < 31) acc[o] += w[j] * x; } }
#pragma unroll
        for (int o = 0; o < 32; ++o) ot[(32 * hf + o) * 260 + c] = acc[o];
        __syncthreads();
        const f32x4 g4 = *(const f32x4*)(lg + 4 * F.lane), b4 = *(const f32x4*)(lb + 4 * F.lane);
#pragma unroll 2
        for (int tt = 0; tt < 8; ++tt) { const int t = F.wave * 8 + tt;
            const f32x4 x = *(const LAS f32x4*)(ot + t * 260 + 4 * F.lane);
            const float mu = wave_sum((x[0] + x[1]) + (x[2] + x[3])) * (1.f / 256.f);
            const f32x4 dv = x - mu;
            const float var = wave_sum((dv[0] * dv[0] + dv[1] * dv[1]) + (dv[2] * dv[2] + dv[3] * dv[3])) * (1.f / 256.f);
            const float rstd = 1.0f / sqrtf(var + EPS);
            f32x4 y = dv * rstd * g4 + b4;
#pragma unroll
            for (int i = 0; i < 4; ++i) y[i] = fast_silu(y[i]);
            u32x2 o; o.x = cvt_pk_bf16(y[0], y[1]); o.y = cvt_pk_bf16(y[2], y[3]);
            *(GAS u32x2*)(Y + (size_t)(row0 + t) * D + 256 + 4 * F.lane) = o; }
    }
    __syncthreads();
}

constexpr size_t MST_N = (size_t)2048 * 4096 * 4, MST_MG = MST_N + (size_t)2048 * 64 * 4, MST_MP = MST_MG + (size_t)2048 * 2 * 4;
template <bool NEEDQ>
__device__ __forceinline__ void mlstm_load(const bf16_t* U, const float* cw, int row0, int t0, int h, int lane, float kscale, float qscale, LAS unsigned char* qt, LAS unsigned char* kt, LAS unsigned char* vt) {
    { const GAS u32x4* vp = (const GAS u32x4*)(U + (size_t)(row0 + lane) * UW + UC_MV + h * 64);
#pragma unroll
      for (int i = 0; i < 8; ++i) *(LAS u32x4*)(vt + lane * 128 + i * 16) = vp[i]; }
#pragma unroll
    for (int which = NEEDQ ? 0 : 1; which < 2; ++which) {
        const int col = (which ? UC_MK : UC_MQ) + h * 64; const float* wv = cw + (which ? 256 : 0) + h * 64; LAS unsigned char* dst = which ? kt : qt; const float sc = which ? kscale : qscale;
#pragma unroll
        for (int i = 0; i < 8; ++i) {
            float acc[8];
#pragma unroll
            for (int d = 0; d < 8; ++d) acc[d] = 0.f;
#pragma unroll
            for (int j = 0; j < 4; ++j) { u32x4 x = (u32x4){0u, 0u, 0u, 0u};
                if (t0 + lane - 3 + j >= 0) x = *(const GAS u32x4*)(U + (size_t)(row0 + lane - 3 + j) * UW + col + i * 8);
                const float* wj = wv + j * 512 + i * 8;
                acc[0] += wj[0] * bflo(x.x); acc[1] += wj[1] * bfhi(x.x); acc[2] += wj[2] * bflo(x.y); acc[3] += wj[3] * bfhi(x.y);
                acc[4] += wj[4] * bflo(x.z); acc[5] += wj[5] * bfhi(x.z); acc[6] += wj[6] * bflo(x.w); acc[7] += wj[7] * bfhi(x.w); }
#pragma unroll
            for (int d = 0; d < 8; ++d) acc[d] = fast_silu(acc[d]) * sc;
            u32x4 o; o.x = cvt_pk_bf16(acc[0], acc[1]); o.y = cvt_pk_bf16(acc[2], acc[3]); o.z = cvt_pk_bf16(acc[4], acc[5]); o.w = cvt_pk_bf16(acc[6], acc[7]);
            *(LAS u32x4*)(dst + lane * 128 + i * 16) = o; }
    }
}
__device__ __forceinline__ void mlstm_gates(const float* GATE, const float* bi, const float* bfg, int row0, int h, int lane, float& ig, float& bcum, float& g) {
    ig = GATE[(size_t)(row0 + lane) * 8 + h] + bi[h];
    const float f = GATE[(size_t)(row0 + lane) * 8 + 4 + h] + bfg[h];
    float lf = fminf(f, 0.f) - log1pf(__expf(-fabsf(f)));
#pragma unroll
    for (int o = 1; o < 64; o <<= 1) { const float t = __shfl_up(lf, o); if (lane >= o) lf += t; }
    bcum = lf; g = __shfl(lf, 63);
}

__device__ __forceinline__ void mlstm_local_phase(Frame& F, int L) {
    const bf16_t* U = (const bf16_t*)(F.ws + WS_BIG); const float* GATE = (const float*)(F.ws + WS_GATE);
    float* Cst = (float*)(F.ws + WS_MST); float* Nst = (float*)(F.ws + WS_MST + MST_N); float* MG = (float*)(F.ws + WS_MST + MST_MG);
    const float* cw = F.in[6] + L * 2048; const float* bi = F.in[4] + L * 4; const float* bfg = F.in[5] + L * 4;
    LAS unsigned char* kt = F.lds + F.wave * 16384; LAS unsigned char* vt = kt + 8192;
    const int lane = F.lane, r32 = lane & 31, half = lane >> 5;
    for (int unit = F.vcu * NWAVES + F.wave; unit < 2048; unit += F.G * NWAVES) {
        const int h = unit & 3, bc = unit >> 2, row0 = bc * 64, t0 = row0 & (SEQ - 1);
        float ig, bcum, g; mlstm_gates(GATE, bi, bfg, row0, h, lane, ig, bcum, g);
        const float wl = g - bcum + ig, ml = wave_max(wl), el = __expf(wl - ml);
        mlstm_load<false>(U, cw, row0, t0, h, lane, el, 1.f, nullptr, kt, vt);
        LDS_WAIT(); asm volatile("" ::: "memory");
        f32x16 acc[2][2], nacc[2];
#pragma unroll
        for (int db = 0; db < 2; ++db) { nacc[db] = f32x16{};
#pragma unroll
            for (int eb = 0; eb < 2; ++eb) acc[db][eb] = f32x16{}; }
        const bf16x8 ones = (bf16x8){0x3F80, 0x3F80, 0x3F80, 0x3F80, 0x3F80, 0x3F80, 0x3F80, 0x3F80};
#pragma unroll
        for (int ks = 0; ks < 4; ++ks) {
            bf16x8 a[2], b[2];
#pragma unroll
            for (int db = 0; db < 2; ++db) a[db] = tr_frag(kt, 16 * ks + 8 * half, 4, 32 * db, lane);
#pragma unroll
            for (int eb = 0; eb < 2; ++eb) b[eb] = tr_frag(vt, 16 * ks + 8 * half, 4, 32 * eb, lane);
#pragma unroll
            for (int db = 0; db < 2; ++db) { nacc[db] = MFMA32(a[db], ones, nacc[db]);
#pragma unroll
                for (int eb = 0; eb < 2; ++eb) acc[db][eb] = MFMA32(a[db], b[eb], acc[db][eb]); }
        }
        float* Cu = Cst + (size_t)unit * 4096;
#pragma unroll
        for (int db = 0; db < 2; ++db)
#pragma unroll
            for (int eb = 0; eb < 2; ++eb)
#pragma unroll
                for (int r = 0; r < 16; ++r) Cu[(32 * db + crow(r, half)) * 64 + 32 * eb + r32] = acc[db][eb][r];
        if (r32 == 0) {
#pragma unroll
            for (int db = 0; db < 2; ++db)
#pragma unroll
                for (int r = 0; r < 16; ++r) Nst[(size_t)unit * 64 + 32 * db + crow(r, half)] = nacc[db][r];
        }
        if (lane == 0) { MG[unit * 2] = ml; MG[unit * 2 + 1] = g; }
        LDS_WAIT(); asm volatile("" ::: "memory");
    }
}

__device__ __forceinline__ void mlstm_scan_phase(Frame& F) {
    float* Cst = (float*)(F.ws + WS_MST); float* Nst = (float*)(F.ws + WS_MST + MST_N); float* MG = (float*)(F.ws + WS_MST + MST_MG);
    float* MP = (float*)(F.ws + WS_MST + MST_MP);
    const int gw = F.vcu * NWAVES + F.wave; if (gw >= 1024 + 16) return;
    const bool isn = gw >= 1024;
    const int bh = isn ? gw - 1024 : gw >> 6, b = bh >> 2, h = bh & 3, el = isn ? F.lane : (gw & 63) * 64 + F.lane;
    float st = 0.f, m = 0.f;
    for (int c0 = 0; c0 < 128; c0 += 8) {
        float x[8], ml[8], gg[8];
#pragma unroll
        for (int i = 0; i < 8; ++i) { const int unit = (b * 128 + c0 + i) * 4 + h;
            x[i] = isn ? Nst[(size_t)unit * 64 + el] : Cst[(size_t)unit * 4096 + el]; ml[i] = MG[unit * 2]; gg[i] = MG[unit * 2 + 1]; }
#pragma unroll
        for (int i = 0; i < 8; ++i) { const int unit = (b * 128 + c0 + i) * 4 + h;
            const float mn = fmaxf(gg[i] + m, ml[i]), a = __expf(gg[i] + m - mn), bb = __expf(ml[i] - mn);
            if (isn) { Nst[(size_t)unit * 64 + el] = st; } else Cst[(size_t)unit * 4096 + el] = st;
            st = a * st + bb * x[i];
            if (isn && F.lane == 0) MP[unit] = m;
            m = mn; }
    }
}

__device__ __forceinline__ void mlstm_out_phase(Frame& F, int L) {
    const bf16_t* U = (const bf16_t*)(F.ws + WS_BIG); const float* GATE = (const float*)(F.ws + WS_GATE); bf16_t* Y = (bf16_t*)(F.ws + WS_AY);
    const float* Cst = (const float*)(F.ws + WS_MST); const float* Nst = (const float*)(F.ws + WS_MST + MST_N); const float* MP = (const float*)(F.ws + WS_MST + MST_MP);
    const float* cw = F.in[6] + L * 2048; const float* bi = F.in[4] + L * 4; const float* bfg = F.in[5] + L * 4; const float* gm = F.in[7] + L * 256;
    if (F.wave >= 4) return;
    LAS unsigned char* qt = F.lds + F.wave * 32768; LAS unsigned char* kt = qt + 8192; LAS unsigned char* vt = qt + 16384; LAS unsigned char* ct = qt + 24576;
    LAS float* sc = (LAS float*)(F.lds + TAB_OFF + F.wave * 1024);
    const int lane = F.lane, r32 = lane & 31, half = lane >> 5;
    for (int unit = F.vcu * 4 + F.wave; unit < 2048; unit += F.G * 4) {
        const int h = unit & 3, bc = unit >> 2, row0 = bc * 64, t0 = row0 & (SEQ - 1);
        float ig, bcum, g; mlstm_gates(GATE, bi, bfg, row0, h, lane, ig, bcum, g);
        const float mprev = MP[unit];
        const float wv = ig - bcum; float pm = wv;
#pragma unroll
        for (int o = 1; o < 64; o <<= 1) { const float t = __shfl_up(pm, o); if (lane >= o) pm = fmaxf(pm, t); }
        const float mml = fmaxf(mprev, pm);
        mlstm_load<true>(U, cw, row0, t0, h, lane, 1.f, 0.125f, qt, kt, vt);
        { const GAS f32x4* cp = (const GAS f32x4*)(Cst + (size_t)unit * 4096 + lane * 64);
#pragma unroll
          for (int i = 0; i < 8; ++i) { const f32x4 a = cp[2 * i], b = cp[2 * i + 1]; *(LAS u32x4*)(ct + lane * 128 + i * 16) = pack8(a, b); } }
        LDS_WAIT(); asm volatile("" ::: "memory");
        float d2 = 0.f;
#pragma unroll
        for (int i = 0; i < 8; ++i) { const u32x4 qv = *(const LAS u32x4*)(qt + lane * 128 + i * 16); const float* np = Nst + (size_t)unit * 64 + i * 8;
            d2 += bflo(qv.x) * np[0] + bfhi(qv.x) * np[1] + bflo(qv.y) * np[2] + bfhi(qv.y) * np[3] + bflo(qv.z) * np[4] + bfhi(qv.z) * np[5] + bflo(qv.w) * np[6] + bfhi(qv.w) * np[7]; }
        sc[lane] = mml; sc[64 + lane] = bcum; sc[128 + lane] = wv; sc[192 + lane] = d2;
        LDS_WAIT(); asm volatile("" ::: "memory");
        f32x16 S00 = f32x16{}, S01 = f32x16{}, S11 = f32x16{};
#pragma unroll
        for (int ks = 0; ks < 4; ++ks) {
            const int ko = (16 * ks + 8 * half) * 2;
            const bf16x8 k0 = *(const LAS bf16x8*)(kt + r32 * 128 + ko), k1 = *(const LAS bf16x8*)(kt + (32 + r32) * 128 + ko);
            const bf16x8 q0 = *(const LAS bf16x8*)(qt + r32 * 128 + ko), q1 = *(const LAS bf16x8*)(qt + (32 + r32) * 128 + ko);
            S00 = MFMA32(k0, q0, S00); S01 = MFMA32(k0, q1, S01); S11 = MFMA32(k1, q1, S11);
        }
        const float mm0 = sc[r32], mm1 = sc[32 + r32];
        float dn0 = 0.f, dn1 = 0.f;
#pragma unroll
        for (int r = 0; r < 16; ++r) { const int s0 = crow(r, half); const float w0 = sc[128 + s0], w1 = sc[128 + 32 + s0];
            const float a = (s0 <= r32) ? S00[r] * __expf(w0 - mm0) : 0.f; S00[r] = a; dn0 += a;
            const float b = S01[r] * __expf(w0 - mm1); S01[r] = b; dn1 += b;
            const float c = (s0 <= r32) ? S11[r] * __expf(w1 - mm1) : 0.f; S11[r] = c; dn1 += c; }
        dn0 += __shfl_xor(dn0, 32); dn1 += __shfl_xor(dn1, 32);
        f32x16 N[2][2], Mx[2][2];
#pragma unroll
        for (int eb = 0; eb < 2; ++eb)
#pragma unroll
            for (int lb = 0; lb < 2; ++lb) { N[eb][lb] = f32x16{}; Mx[eb][lb] = f32x16{}; }
#pragma unroll
        for (int kk = 0; kk < 2; ++kk) {
            bf16x8 p00, p01, p11;
            { u32x4 t; t.x = cvt_pk_bf16(S00[8 * kk], S00[8 * kk + 1]); t.y = cvt_pk_bf16(S00[8 * kk + 2], S00[8 * kk + 3]); t.z = cvt_pk_bf16(S00[8 * kk + 4], S00[8 * kk + 5]); t.w = cvt_pk_bf16(S00[8 * kk + 6], S00[8 * kk + 7]); p00 = __builtin_bit_cast(bf16x8, t); }
            { u32x4 t; t.x = cvt_pk_bf16(S01[8 * kk], S01[8 * kk + 1]); t.y = cvt_pk_bf16(S01[8 * kk + 2], S01[8 * kk + 3]); t.z = cvt_pk_bf16(S01[8 * kk + 4], S01[8 * kk + 5]); t.w = cvt_pk_bf16(S01[8 * kk + 6], S01[8 * kk + 7]); p01 = __builtin_bit_cast(bf16x8, t); }
            { u32x4 t; t.x = cvt_pk_bf16(S11[8 * kk], S11[8 * kk + 1]); t.y = cvt_pk_bf16(S11[8 * kk + 2], S11[8 * kk + 3]); t.z = cvt_pk_bf16(S11[8 * kk + 4], S11[8 * kk + 5]); t.w = cvt_pk_bf16(S11[8 * kk + 6], S11[8 * kk + 7]); p11 = __builtin_bit_cast(bf16x8, t); }
#pragma unroll
            for (int eb = 0; eb < 2; ++eb) {
                const bf16x8 v0 = tr_frag(vt, 16 * kk + 4 * half, 8, 32 * eb, lane), v1 = tr_frag(vt, 32 + 16 * kk + 4 * half, 8, 32 * eb, lane);
                N[eb][0] = MFMA32(v0, p00, N[eb][0]); N[eb][1] = MFMA32(v0, p01, N[eb][1]); N[eb][1] = MFMA32(v1, p11, N[eb][1]);
            }
        }
#pragma unroll
        for (int ks = 0; ks < 4; ++ks) {
            const int ko = (16 * ks + 8 * half) * 2;
            const bf16x8 q0 = *(const LAS bf16x8*)(qt + r32 * 128 + ko), q1 = *(const LAS bf16x8*)(qt + (32 + r32) * 128 + ko);
#pragma unroll
            for (int eb = 0; eb < 2; ++eb) { const bf16x8 cf = tr_frag(ct, 16 * ks + 8 * half, 4, 32 * eb, lane);
                Mx[eb][0] = MFMA32(cf, q0, Mx[eb][0]); Mx[eb][1] = MFMA32(cf, q1, Mx[eb][1]); }
        }
#pragma unroll
        for (int lb = 0; lb < 2; ++lb) {
            const int l = 32 * lb + r32; const float mm = lb ? mm1 : mm0, is = __expf(mprev - mm), den = (lb ? dn1 : dn0) + is * sc[192 + l];
            const float mout = sc[64 + l] + mm, rden = 1.0f / fmaxf(fabsf(den), __expf(-mout));
            float o[2][16]; float ss = 0.f;
#pragma unroll
            for (int eb = 0; eb < 2; ++eb)
#pragma unroll
                for (int r = 0; r < 16; ++r) { const float x = (N[eb][lb][r] + is * Mx[eb][lb][r]) * rden; o[eb][r] = x; ss += x * x; }
            ss += __shfl_xor(ss, 32);
            const float rs = 1.0f / sqrtf(ss * (1.f / 64.f) + EPS);
            const bf16_t* mo = U + (size_t)(row0 + l) * UW + UC_MO + h * 64; bf16_t* yo = Y + (size_t)(row0 + l) * D + h * 64;
#pragma unroll
            for (int eb = 0; eb < 2; ++eb)
#pragma unroll
                for (int gq = 0; gq < 4; ++gq) { const int e0 = 32 * eb + 8 * gq + 4 * half;
                    const f32x4 gv = *(const f32x4*)(gm + h * 64 + e0); const u32x2 mv = *(const GAS u32x2*)(mo + e0);
                    const float y0 = o[eb][4 * gq] * rs * gv[0] * fast_sigmoid(bflo(mv.x)), y1 = o[eb][4 * gq + 1] * rs * gv[1] * fast_sigmoid(bfhi(mv.x));
                    const float y2 = o[eb][4 * gq + 2] * rs * gv[2] * fast_sigmoid(bflo(mv.y)), y3 = o[eb][4 * gq + 3] * rs * gv[3] * fast_sigmoid(bfhi(mv.y));
                    u32x2 w; w.x = cvt_pk_bf16(y0, y1); w.y = cvt_pk_bf16(y2, y3); *(GAS u32x2*)(yo + e0) = w; }
        }
        LDS_WAIT(); asm volatile("" ::: "memory");
    }
}
constexpr int AT_SLOT = 32768, AT_K2 = 8192, AT_V = 16384;
__device__ __forceinline__ void attn_dma_tile(const bf16_t* Ub  , int hd, int k0, LAS unsigned char* slot, int wave, int lane) {
#pragma unroll
    for (int i = 0; i < 4; ++i) {
        const int id = 4 * wave + i;
        const bf16_t* src; LAS unsigned char* dst;
        if (id < 16) { const int m = id >> 3, c = id & 7; src = Ub + (size_t)(k0 + lane) * UW + UC_K + (2 * hd + m) * 64 + 8 * c; dst = slot + m * AT_K2 + c * 1024; }
        else { const int db = (id - 16) >> 2, rq = (id - 16) & 3; src = Ub + (size_t)(k0 + 16 * rq + (lane >> 2)) * UW + UC_V + hd * 128 + 32 * db + 8 * (lane & 3); dst = slot + AT_V + db * 4096 + rq * 1024; }
        __builtin_amdgcn_global_load_lds((const unsigned*)src, (LAS unsigned*)dst, 16, 0, 0);
    }
}
__device__ __forceinline__ void attn_phase(Frame& F, int L) {
    const bf16_t* U = (const bf16_t*)(F.ws + WS_BIG); bf16_t* Y = (bf16_t*)(F.ws + WS_AY);
    const int lane = F.lane, r32 = lane & 31, half = lane >> 5, wave = F.wave, mi = wave >> 2, sb = wave & 3;
    const float lam_init = 0.8f - 0.6f * __expf(-0.3f * (float)L);
    const float lam = __expf(wave_sum(F.in[14][L * 64 + lane] * F.in[15][L * 64 + lane])) - __expf(wave_sum(F.in[16][L * 64 + lane] * F.in[17][L * 64 + lane])) + lam_init;
    const float M2 = 64.f * C2 * 1.01f * wave_max(fabsf(F.in[12][L * 64 + lane])) * wave_max(fabsf(F.in[13][L * 64 + lane]));
    const float* gsub = F.in[18] + L * 128;
    LAS float* lsc = (LAS float*)(F.lds + TAB_OFF) + wave * 32;
    LAS float* xch = (LAS float*)F.lds;
    for (int it = 0; it < 4; ++it) {
        const int pi = F.vcu + (it >> 1) * F.G; if (pi >= 512) break;
        const int bh = pi >> 5, j = pi & 31, b = bh >> 2, hd = bh & 3, qb = (it & 1) ? 63 - j : j;
        const int q0 = qb * 128, qs = q0 + 32 * sb, nkt = 2 * qb + 2;
        const bf16_t* Ub = U + (size_t)b * SEQ * UW;
        const float slope2 = exp2f(-2.f * (float)(hd + 1)) * 1.4426950408889634f;
        bf16x8 qf[4];
#pragma unroll
        for (int ks = 0; ks < 4; ++ks) qf[ks] = *(const GAS bf16x8*)(Ub + (size_t)(qs + r32) * UW + UC_Q + (2 * hd + mi) * 64 + 16 * ks + 8 * half);
        attn_dma_tile(Ub, hd, 0, F.lds, wave, lane);
        attn_dma_tile(Ub, hd, 64, F.lds + AT_SLOT, wave, lane);
        f32x16 o[4];
#pragma unroll
        for (int db = 0; db < 4; ++db) o[db] = f32x16{};
        float lsum = 0.f;
        const float rowc = -slope2 * (float)(qs + r32) - M2;
        int slot = 0;
        for (int kt = 0; kt < nkt; ++kt) {
            if (kt + 1 < nkt) asm volatile("s_waitcnt vmcnt(4)" ::: "memory"); else asm volatile("s_waitcnt vmcnt(0)" ::: "memory");
            __builtin_amdgcn_s_barrier();
            asm volatile("" ::: "memory");
            if (kt + 2 < nkt) { const int s2 = slot >= 1 ? slot - 1 : 2; attn_dma_tile(Ub, hd, (kt + 2) * 64, F.lds + s2 * AT_SLOT, wave, lane); }
            const LAS unsigned char* sl = F.lds + slot * AT_SLOT;
            slot = (slot == 2) ? 0 : slot + 1;
            const int k0 = kt * 64;
            if (k0 > qs + 31) continue;
            f32x16 p0, p1;
            { const float base = rowc + slope2 * (float)(k0 + 4 * half);
#pragma unroll
              for (int r = 0; r < 16; ++r) { p0[r] = base + slope2 * (float)((r & 3) + 8 * (r >> 2)); p1[r] = p0[r] + 32.f * slope2; } }
            const LAS unsigned char* kim = sl + mi * AT_K2 + r32 * 16 + half * 1024;
#pragma unroll
            for (int ks = 0; ks < 4; ++ks) {
                const bf16x8 kf0 = *(const LAS bf16x8*)(kim + ks * 2048), kf1 = *(const LAS bf16x8*)(kim + ks * 2048 + 512);
                p0 = MFMA32(kf0, qf[ks], p0); p1 = MFMA32(kf1, qf[ks], p1);
            }
            if (k0 + 63 > qs) {
                const int qrel = qs + r32 - k0 - 4 * half;
#pragma unroll
                for (int r = 0; r < 16; ++r) { const int kr = (r & 3) + 8 * (r >> 2); if (kr > qrel) p0[r] = -INFINITY; if (kr + 32 > qrel) p1[r] = -INFINITY; }
            }
            float ls = 0.f;
#pragma unroll
            for (int r = 0; r < 16; ++r) { p0[r] = __builtin_amdgcn_exp2f(p0[r]); p1[r] = __builtin_amdgcn_exp2f(p1[r]); ls += p0[r] + p1[r]; }
            lsum += ls;
            const LAS unsigned char* vim = sl + AT_V + (4 * half + ((lane & 15) >> 2)) * 64 + (16 * ((lane >> 4) & 1) + 4 * (lane & 3)) * 2;
#pragma unroll
            for (int ks = 0; ks < 4; ++ks) {
                u32x4 t;
                if (ks < 2) { t.x = cvt_pk_bf16(p0[8 * ks], p0[8 * ks + 1]); t.y = cvt_pk_bf16(p0[8 * ks + 2], p0[8 * ks + 3]); t.z = cvt_pk_bf16(p0[8 * ks + 4], p0[8 * ks + 5]); t.w = cvt_pk_bf16(p0[8 * ks + 6], p0[8 * ks + 7]); }
                else { const int k2 = ks - 2; t.x = cvt_pk_bf16(p1[8 * k2], p1[8 * k2 + 1]); t.y = cvt_pk_bf16(p1[8 * k2 + 2], p1[8 * k2 + 3]); t.z = cvt_pk_bf16(p1[8 * k2 + 4], p1[8 * k2 + 5]); t.w = cvt_pk_bf16(p1[8 * k2 + 6], p1[8 * k2 + 7]); }
                const bf16x8 pf = __builtin_bit_cast(bf16x8, t);
#pragma unroll
                for (int db = 0; db < 4; ++db) {
                    const LAS unsigned char* a = vim + db * 4096 + ks * 1024;
                    const s16x4 lo = tr_read(a), hi = tr_read(a + 512);
                    const bf16x8 vf = (bf16x8){lo[0], lo[1], lo[2], lo[3], hi[0], hi[1], hi[2], hi[3]};
                    o[db] = MFMA32(pf, vf, o[db]);
                }
            }
        }
        lsum += __shfl_xor(lsum, 32);
        asm volatile("s_waitcnt vmcnt(0) lgkmcnt(0)" ::: "memory");
        __builtin_amdgcn_s_barrier();
        asm volatile("" ::: "memory");
        if (half == 0) lsc[r32] = lsum;
        LDS_WAIT(); asm volatile("" ::: "memory");
        float rl[16];
#pragma unroll
        for (int r = 0; r < 16; ++r) rl[r] = __builtin_amdgcn_rcpf(lsc[crow(r, half)]);
        if (mi == 1) {
#pragma unroll
            for (int db = 0; db < 4; ++db)
#pragma unroll
                for (int r = 0; r < 16; ++r) xch[((sb * 4 + db) * 16 + r) * 64 + lane] = o[db][r] * rl[r] * lam;
        }
        asm volatile("s_waitcnt lgkmcnt(0)" ::: "memory");
        __builtin_amdgcn_s_barrier();
        asm volatile("" ::: "memory");
        if (mi == 0) {
            float ss[16];
#pragma unroll
            for (int r = 0; r < 16; ++r) ss[r] = 0.f;
#pragma unroll
            for (int db = 0; db < 4; ++db)
#pragma unroll
                for (int r = 0; r < 16; ++r) { const float y = o[db][r] * rl[r] - xch[((sb * 4 + db) * 16 + r) * 64 + lane]; o[db][r] = y; ss[r] += y * y; }
#pragma unroll
            for (int r = 0; r < 16; ++r) {
#pragma unroll
                for (int m = 1; m < 32; m <<= 1) ss[r] += __shfl_xor(ss[r], m);
                ss[r] = (1.f - lam_init) / sqrtf(ss[r] * (1.f / 128.f) + EPS);
            }
            bf16_t* yo = Y + (size_t)(b * SEQ + qs) * D + 512 + hd * 128;
#pragma unroll
            for (int db = 0; db < 4; ++db) { const float gsv = gsub[32 * db + r32];
#pragma unroll
                for (int r = 0; r < 16; ++r) yo[(size_t)crow(r, half) * D + 32 * db + r32] = (bf16_t)f2bf(o[db][r] * ss[r] * gsv); }
        }
        asm volatile("s_waitcnt lgkmcnt(0)" ::: "memory");
        __builtin_amdgcn_s_barrier();
        asm volatile("" ::: "memory");
    }
}
#define ONE_LAUNCH 1
#define NAIVE_MASK 0
#define MIX_PHASE_A do { mlstm_local_phase(F, L); conformer_phase(F, L); } while (0)
#define MIX_PHASE_B do { mlstm_scan_phase(F); attn_phase(F, L); } while (0)
#define MIX_PHASE_C do { mlstm_out_phase(F, L); } while (0)
__device__ __forceinline__ int bxl() { int b = blockIdx.x; asm volatile("" : "+s"(b)); return b; }
constexpr int PH_PER_LAYER = 13, NPHASE = 1 + 2 * PH_PER_LAYER;
struct Args { const float* in[31]; float* out; unsigned char* ws; int ph_lo, ph_hi; };

#define PH(k) (lo <= (k) && (k) < hi && (F.lane = lane_id_v(), F.tid = F.wave * 64 + F.lane, true))
#define SEAM(k) do { if ((k) + 1 < hi) xcd_barrier(bar); } while (0)
template <int L>
__device__ __forceinline__ void layer_phases(Frame& F, const XcdBarrier& bar, int lo, int hi) {
    bf16_t* const AY = (bf16_t*)(F.ws + WS_AY);
    bf16_t* const BIGB = (bf16_t*)(F.ws + WS_BIG);
    float* const wsm = (float*)(F.ws + WS_WSM);
        const int pb = 1 + PH_PER_LAYER * L;
        if (pb + PH_PER_LAYER <= lo || pb >= hi) return;
        const float* hsrc = (L == 0) ? F.in[0] : F.out;
        if (PH(pb + 0)) { norm_phase<1>(F, hsrc, wsm + L * 8 * D, nullptr, nullptr); SEAM(pb + 0); }
        if (PH(pb + 1)) {
            pg8::StaticOrder S; S.init(M / 256, NIN / 256, F.G, bxl());
            EpiIn E{BIGB, F.in[12] + L * 64, F.in[13] + L * 64};
            pg8::gemm_phase<EpiIn, pg8::StaticOrder, pg8::AOffDense, true>(F.lds, F.wave, AY, (const bf16_t*)(F.ws + WS_WIN) + (size_t)L * NIN * D, D, S, E, pg8::AOffDense{D});
            SEAM(pb + 1);
        }
        if (PH(pb + 2)) { MIX_PHASE_A; SEAM(pb + 2); }
        if (PH(pb + 3)) { MIX_PHASE_B; SEAM(pb + 3); }
        if (PH(pb + 4)) { MIX_PHASE_C; SEAM(pb + 4); }
        if (PH(pb + 5)) {
            pg8::StaticOrder S; S.init(M / 256, D / 256, F.G, bxl());
            EpiRes E{hsrc, F.out};
            pg8::gemm_phase<EpiRes, pg8::StaticOrder, pg8::AOffDense, true>(F.lds, F.wave, AY, (const bf16_t*)(F.ws + WS_WOUT) + (size_t)L * D * D, D, S, E, pg8::AOffDense{D});
            SEAM(pb + 5);
        }
        if (L == 0) {
            if (PH(pb + 6)) { norm_phase<0>(F, F.out, nullptr, nullptr, nullptr); SEAM(pb + 6); }
            if (PH(pb + 7)) {
                pg8::StaticOrder S; S.init(M / 256, 2 * FFD / 256, F.G, bxl());
                EpiGlu E{BIGB, FFD};
                pg8::gemm_phase<EpiGlu, pg8::StaticOrder, pg8::AOffDense, true>(F.lds, F.wave, AY, (const bf16_t*)(F.ws + WS_WDGU), D, S, E, pg8::AOffDense{D});
                SEAM(pb + 7);
            }
            if (PH(pb + 8)) {
                pg8::StaticOrder S; S.init(M / 256, D / 256, F.G, bxl());
                EpiRes E{F.out, F.out};
                pg8::gemm_phase<EpiRes, pg8::StaticOrder, pg8::AOffDense, true>(F.lds, F.wave, BIGB, (const bf16_t*)(F.ws + WS_WDD), FFD, S, E, pg8::AOffDense{FFD});
                SEAM(pb + 8);
            }
        } else {
            if (PH(pb + 6)) { norm_phase<2>(F, F.out, wsm + 2 * 8 * D, nullptr, nullptr); SEAM(pb + 6); }
            for (int s = 0; s < 2; ++s) {
                LAS int* rt_info = (LAS int*)(F.lds + TAB_OFF); LAS int* rowtab = (LAS int*)(F.lds + TAB_OFF + 2048);
                const int* list_s = (const int*)(F.ws + WS_MOE + MOE_LIST) + (size_t)s * 8 * M;
                const float* gatev_s = (const float*)(F.ws + WS_MOE + MOE_GATEV) + (size_t)s * M;
                if (PH(pb + 7 + 2 * s)) {
                    const int RT = moe_build_tiles(F, s, rt_info);
                    MoeSched S; S.so.init(RT, 2 * FFE / 256, F.G, bxl()); S.rt_info = rt_info; S.ntn = 2 * FFE / 256;
                    { pg8::Unit u; for (int i = 0; S.next(i, u); ++i) { if (F.tid < 256) { const int e = rt_info[3 * u.pm], i0 = rt_info[3 * u.pm + 1], nv = rt_info[3 * u.pm + 2];
                        rowtab[i * 256 + F.tid] = F.tid < nv ? list_s[(size_t)e * M + i0 + F.tid] : 0; } } }
                    __syncthreads();
                    EpiGlu E{BIGB, FFE};
                    pg8::gemm_phase<EpiGlu, MoeSched, pg8::AOffGather, true>(F.lds, F.wave, AY, (const bf16_t*)(F.ws + WS_WMGU), D, S, E, pg8::AOffGather{D, rowtab});
                    SEAM(pb + 7 + 2 * s);
                }
                if (PH(pb + 8 + 2 * s)) {
                    const int RT = moe_build_tiles(F, s, rt_info);
                    MoeSched S; S.so.init(RT, D / 256, F.G, bxl()); S.rt_info = rt_info; S.ntn = D / 256;
                    EpiScatter E{F.out, list_s, gatev_s, rt_info};
                    pg8::gemm_phase<EpiScatter, MoeSched, pg8::AOffDense, true>(F.lds, F.wave, BIGB, (const bf16_t*)(F.ws + WS_WMD), FFE, S, E, pg8::AOffDense{FFE});
                    SEAM(pb + 8 + 2 * s);
                }
            }
        }
        bf16_t* const PB = BIGB;
        bf16_t* const PEB = BIGB + (size_t)16 * MiB;
        if (PH(pb + 11)) { norm_phase<0>(F, F.out, nullptr, F.in[1] + (size_t)L * M * PLE, PB); SEAM(pb + 11); }
        if (PH(pb + 12)) {
            pg8::StaticOrder S; S.init(M / 256, D / 256, F.G, bxl());
            EpiPe E1{PEB};
            pg8::gemm_phase<EpiPe, pg8::StaticOrder, pg8::AOffDense, true>(F.lds, F.wave, PB, (const bf16_t*)(F.ws + WS_WPP) + (size_t)L * D * PLE, PLE, S, E1, pg8::AOffDense{PLE});
            EpiPle E2{F.out, PEB};
            pg8::gemm_phase<EpiPle, pg8::StaticOrder, pg8::AOffDense, true>(F.lds, F.wave, AY, (const bf16_t*)(F.ws + WS_WPG) + (size_t)L * D * D, D, S, E2, pg8::AOffDense{D});
            SEAM(pb + 12);
        }
    }
__global__ void __launch_bounds__(NWAVES * 64, 2) fwd(Args args) {
    extern __shared__ __attribute__((aligned(16))) unsigned char lds[];
    Frame F;
    F.lds = (LAS unsigned char*)lds;
    F.MISC = (volatile LAS unsigned*)(F.lds + MISC_OFF);
    F.wave = __builtin_amdgcn_readfirstlane(threadIdx.x >> 6); F.lane = lane_id_v(); F.tid = F.wave * 64 + F.lane;
    F.G = gridDim.x; { const int bx = blockIdx.x; F.vcu = (F.G % 8 == 0) ? (bx % 8) * (F.G / 8) + bx / 8 : bx; }
    F.ws = args.ws; F.ctl = (gu32*)(args.ws + WS_CTL); F.out = args.out;
#pragma unroll
    for (int i = 0; i < 31; ++i) F.in[i] = args.in[i];
    for (int u = F.tid; u < 256; u += NWAVES * 64) ((LAS unsigned*)(F.lds + LDSCTL_OFF))[u] = 0u;
    __syncthreads();
    const int lo = args.ph_lo, hi = args.ph_hi;
    XcdBarrier bar; bar.bar = (unsigned*)(F.ctl + CW_BAR); bar.x = 0; bar.st = nullptr;
    if (hi - lo > 1) bar = xcd_barrier_post((unsigned*)(F.ctl + CW_BAR), F.MISC + 8);

    bf16_t* const AY = (bf16_t*)(F.ws + WS_AY);
    bf16_t* const BIGB = (bf16_t*)(F.ws + WS_BIG);
    float* const wsm = (float*)(F.ws + WS_WSM);

    if (PH(0)) { p0_prologue(F); SEAM(0); }

    layer_phases<0>(F, bar, lo, hi);
    layer_phases<1>(F, bar, lo, hi);
#undef PH
#undef SEAM
}

extern "C" void kernel_launch(void* const* d_in, const int* in_sizes, int n_in, void* d_out, int out_size, void* d_ws, size_t ws_size, hipStream_t stream) {
    static int grid = 0;
    if (grid == 0) {
        int dev = 0, cus = 0;
        grid = -1;
        if (hipGetDevice(&dev) == hipSuccess && hipDeviceGetAttribute(&cus, hipDeviceAttributeMultiprocessorCount, dev) == hipSuccess && cus == 256 && ws_size >= WS_END && n_in == 31 &&
            hipFuncSetAttribute((const void*)fwd, hipFuncAttributeMaxDynamicSharedMemorySize, LDS_BYTES) == hipSuccess) grid = cus;
        (void)hipGetLastError();
    }
    if (grid < 0) { nv::forward(d_in, (float*)d_out, (unsigned char*)d_ws, stream); return; }
    (void)hipMemsetAsync((char*)d_ws + WS_CTL, 0, CTL_ZERO_BYTES, stream);
    Args a{};
    for (int i = 0; i < 31; ++i) a.in[i] = (const float*)d_in[i];
    a.out = (float*)d_out; a.ws = (unsigned char*)d_ws;
#if ONE_LAUNCH
    a.ph_lo = 0; a.ph_hi = NPHASE;
    hipLaunchKernelGGL(fwd, dim3(grid), dim3(NWAVES * 64), LDS_BYTES, stream, a);
#else
    for (int p = 0; p < NPHASE; ++p) {
        const int L = (p - 1) / PH_PER_LAYER, k = (p - 1) % PH_PER_LAYER;
        if (p > 0 && L == 0 && (k == 9 || k == 10)) continue;
        if (p > 0 && k == 2 && NAIVE_MASK) nvb::mixers(d_in, (unsigned char*)d_ws, L, stream, NAIVE_MASK);
        a.ph_lo = p; a.ph_hi = p + 1;
        hipLaunchKernelGGL(fwd, dim3(grid), dim3(NWAVES * 64), LDS_BYTES, stream, a);
    }
#endif
}
```

```cpp
#include <hip/hip_runtime.h>
#include <cstdio>
#include <cstdint>
#include <cmath>
namespace nv {
constexpr int S = 8192, D = 1024, DIN = 3080, NB = 4;
constexpr int FFD = 2816, FFE = 3584, NE = 8, PLE = 256;
constexpr int OFF_MQ = 0, OFF_MK = 256, OFF_MV = 512, OFF_MO = 768, OFF_MI = 1024, OFF_MF = 1028, OFF_CA = 1032, OFF_CG = 1288, OFF_AQ = 1544, OFF_AK = 2056, OFF_AV = 2568;

__device__ __forceinline__ float sigmoidf_(float x) { return 1.f / (1.f + expf(-x)); }
__device__ __forceinline__ float siluf_(float x) { return x / (1.f + expf(-x)); }
__device__ __forceinline__ float wsum(float v) { for (int o = 32; o > 0; o >>= 1) v += __shfl_xor(v, o); return v; }
__device__ __forceinline__ float wmax(float v) { for (int o = 32; o > 0; o >>= 1) v = fmaxf(v, __shfl_xor(v, o)); return v; }

__global__ void groupnorm(const float* in, int ldi, float* out, int ldo, int ngroups, int gdim, const float* gain, int gain_stride, float scale) {
    const int rg = blockIdx.x, row = rg / ngroups, g = rg % ngroups, lane = threadIdx.x;
    const float* x = in + (size_t)row * ldi + g * gdim;
    float s = 0.f;
    for (int i = lane; i < gdim; i += 64) s += x[i] * x[i];
    s = wsum(s);
    const float r = rsqrtf(s / (float)gdim + 1e-6f);
    float* o = out + (size_t)row * ldo + g * gdim;
    for (int i = lane; i < gdim; i += 64) o[i] = x[i] * r * gain[g * gain_stride + i] * scale;
}

template <bool ACC>
__global__ void gemm(const float* A, int lda, const float* B, int ldb, float* C, int ldc, int M, int N, int K, const int* rowlist, const int* nrows_dev) {
    __shared__ float As[16][65];
    __shared__ float Bs[16][64];
    const int Meff = nrows_dev ? *nrows_dev : M;
    const int m0 = blockIdx.y * 64, n0 = blockIdx.x * 64;
    if (m0 >= Meff) return;
    const int tid = threadIdx.x, ty = tid >> 4, tx = tid & 15;
    float acc[4][4];
    for (int i = 0; i < 4; ++i) for (int j = 0; j < 4; ++j) acc[i][j] = 0.f;
    for (int k0 = 0; k0 < K; k0 += 16) {
        for (int i = 0; i < 4; ++i) {
            const int idx = tid + i * 256, r = idx >> 4, kk = idx & 15;
            float v = 0.f;
            if (m0 + r < Meff) { const int ar = rowlist ? rowlist[m0 + r] : (m0 + r); v = A[(size_t)ar * lda + k0 + kk]; }
            As[kk][r] = v;
        }
        for (int i = 0; i < 4; ++i) {
            const int idx = tid + i * 256, kk = idx >> 6, c = idx & 63;
            Bs[kk][c] = (n0 + c < N) ? B[(size_t)(k0 + kk) * ldb + n0 + c] : 0.f;
        }
        __syncthreads();
#pragma unroll
        for (int kk = 0; kk < 16; ++kk) {
            float a[4], b[4];
            for (int i = 0; i < 4; ++i) a[i] = As[kk][ty * 4 + i];
            for (int j = 0; j < 4; ++j) b[j] = Bs[kk][tx * 4 + j];
            for (int i = 0; i < 4; ++i) for (int j = 0; j < 4; ++j) acc[i][j] += a[i] * b[j];
        }
        __syncthreads();
    }
    for (int i = 0; i < 4; ++i) {
        const int r = m0 + ty * 4 + i;
        if (r >= Meff) continue;
        for (int j = 0; j < 4; ++j) {
            const int c = n0 + tx * 4 + j;
            if (c < N) { float* p = C + (size_t)r * ldc + c; *p = ACC ? (*p + acc[i][j]) : acc[i][j]; }
        }
    }
}

__global__ void mprep(const float* U, const float* cw  , const float* bi, const float* bf, float* QK, float* IG, float* LF) {
    const int t = blockIdx.x, c = threadIdx.x;
    float acc = 0.f;
    for (int j = 0; j < 4; ++j) { const int tt = t - 3 + j; if (tt >= 0) acc += cw[j * 512 + c] * U[(size_t)tt * DIN + c]; }
    QK[(size_t)t * 512 + c] = siluf_(acc);
    if (c < 4) {
        IG[t * 4 + c] = U[(size_t)t * DIN + OFF_MI + c] + bi[c];
        const float f = U[(size_t)t * DIN + OFF_MF + c] + bf[c];
        LF[t * 4 + c] = fminf(f, 0.f) - log1pf(expf(-fabsf(f)));
    }
}

__global__ void mlstm_rec(const float* QK, const float* U, const float* IG, const float* LF, float* HM) {
    __shared__ float sq[64][64], sk[64][64], sv[64][64];
    __shared__ float sig[64], slf[64];
    __shared__ float red[2][4][64], redd[2][4][64];
    const int h = blockIdx.x, tid = threadIdx.x, e = tid & 63, dq = tid >> 6;
    float C[16], n[16]; float m = 0.f;
    for (int i = 0; i < 16; ++i) { C[i] = 0.f; n[i] = 0.f; }
    for (int t0 = 0; t0 < S; t0 += 64) {
        __syncthreads();
        for (int i = tid; i < 64 * 64; i += 256) {
            const int tt = i >> 6, d = i & 63;
            sq[tt][d] = QK[(size_t)(t0 + tt) * 512 + h * 64 + d] * 0.125f;
            sk[tt][d] = QK[(size_t)(t0 + tt) * 512 + 256 + h * 64 + d];
            sv[tt][d] = U[(size_t)(t0 + tt) * DIN + OFF_MV + h * 64 + d];
        }
        if (tid < 64) { sig[tid] = IG[(t0 + tid) * 4 + h]; slf[tid] = LF[(t0 + tid) * 4 + h]; }
        __syncthreads();
        for (int tt = 0; tt < 64; ++tt) {
            const float ig = sig[tt], lf = slf[tt];
            const float mn = fmaxf(lf + m, ig), a = expf(lf + m - mn), bb = expf(ig - mn);
            m = mn;
            const float v = sv[tt][e];
            float num = 0.f, den = 0.f;
#pragma unroll
            for (int i = 0; i < 16; ++i) {
                const int d = dq * 16 + i; const float k = sk[tt][d], q = sq[tt][d];
                C[i] = a * C[i] + bb * k * v; n[i] = a * n[i] + bb * k;
                num += q * C[i]; den += q * n[i];
            }
            red[tt & 1][dq][e] = num; redd[tt & 1][dq][e] = den;
            __syncthreads();
            if (dq == 0) {
                const float nu = red[tt & 1][0][e] + red[tt & 1][1][e] + red[tt & 1][2][e] + red[tt & 1][3][e];
                const float de = redd[tt & 1][0][e] + redd[tt & 1][1][e] + redd[tt & 1][2][e] + redd[tt & 1][3][e];
                HM[(size_t)(t0 + tt) * 256 + h * 64 + e] = nu / fmaxf(fabsf(de), expf(-m));
            }
        }
    }
}

__global__ void mgate(const float* HMN, const float* U, float* Y) {
    const int t = blockIdx.x, c = threadIdx.x;
    Y[(size_t)t * D + c] = HMN[(size_t)t * 256 + c] * sigmoidf_(U[(size_t)t * DIN + OFF_MO + c]);
}

__global__ void cglu(const float* U, float* Z) {
    const int t = blockIdx.x, c = threadIdx.x;
    Z[(size_t)t * 256 + c] = U[(size_t)t * DIN + OFF_CA + c] * sigmoidf_(U[(size_t)t * DIN + OFF_CG + c]);
}
__global__ void cconv(const float* Z, const float* w  , const float* b, const float* lg, const float* lb, float* Y) {
    __shared__ float sm[4], sv2[4];
    const int t = blockIdx.x, c = threadIdx.x;
    float acc = b[c];
    for (int j = 0; j < 31; ++j) { const int tt = t - 30 + j; if (tt >= 0) acc += w[j * 256 + c] * Z[(size_t)tt * 256 + c]; }
    float s = wsum(acc);
    if ((c & 63) == 0) sm[c >> 6] = s;
    __syncthreads();
    const float mu = (sm[0] + sm[1] + sm[2] + sm[3]) * (1.f / 256.f);
    const float dv = acc - mu;
    float s2 = wsum(dv * dv);
    if ((c & 63) == 0) sv2[c >> 6] = s2;
    __syncthreads();
    const float var = (sv2[0] + sv2[1] + sv2[2] + sv2[3]) * (1.f / 256.f);
    const float yv = dv * rsqrtf(var + 1e-6f) * lg[c] + lb[c];
    Y[(size_t)t * D + 256 + c] = siluf_(yv);
}

__global__ void attn(const float* QN  , const float* KN  , const float* U, float* O  ) {
    __shared__ float sK[64][65];
    __shared__ float sV[64][128];
    __shared__ float sQ[16][64];
    __shared__ float sP[16][64];
    const int j = blockIdx.y, hd = j >> 1, q0 = blockIdx.x * 16, tid = threadIdx.x, w = tid >> 6, lane = tid & 63;
    const int qpos = q0 + w;
    const float slope = exp2f(-8.f * (float)(hd + 1) / 4.f);
    sQ[w][lane] = QN[(size_t)qpos * 512 + j * 64 + lane];
    float m = -INFINITY, l = 0.f, o0 = 0.f, o1 = 0.f;
    const int ntile = (q0 + 15) / 64 + 1;
    for (int kt = 0; kt < ntile; ++kt) {
        __syncthreads();
        for (int i = tid; i < 64 * 64; i += 1024) { const int r = i >> 6, d = i & 63; sK[r][d] = KN[(size_t)(kt * 64 + r) * 512 + j * 64 + d]; }
        for (int i = tid; i < 64 * 128; i += 1024) { const int r = i >> 7, d = i & 127; sV[r][d] = U[(size_t)(kt * 64 + r) * DIN + OFF_AV + hd * 128 + d]; }
        __syncthreads();
        const int kpos = kt * 64 + lane;
        float s = 0.f;
        for (int d = 0; d < 64; ++d) s += sQ[w][d] * sK[lane][d];
        s = s * 0.125f - slope * (float)(qpos - kpos);
        if (kpos > qpos) s = -INFINITY;
        const float tm = wmax(s), mn = fmaxf(m, tm), corr = expf(m - mn), p = expf(s - mn);
        l = l * corr + wsum(p); o0 *= corr; o1 *= corr; m = mn;
        sP[w][lane] = p;
        __syncthreads();
        for (int k = 0; k < 64; ++k) { const float pk = sP[w][k]; o0 += pk * sV[k][lane]; o1 += pk * sV[k][64 + lane]; }
    }
    O[((size_t)qpos * 8 + j) * 128 + lane] = o0 / l;
    O[((size_t)qpos * 8 + j) * 128 + 64 + lane] = o1 / l;
}
__device__ __forceinline__ float lam_of(const float* q1, const float* k1, const float* q2, const float* k2, float lam_init) {
    float a = 0.f, b = 0.f;
    for (int i = 0; i < 64; ++i) { a += q1[i] * k1[i]; b += q2[i] * k2[i]; }
    return expf(a) - expf(b) + lam_init;
}
__global__ void acomb(const float* O, const float* q1, const float* k1, const float* q2, const float* k2, float lam_init, float* YA  ) {
    const int t = blockIdx.x, c = threadIdx.x;
    const float lam = lam_of(q1, k1, q2, k2, lam_init);
    const int hd = c >> 7, e = c & 127;
    YA[(size_t)t * 512 + c] = O[((size_t)t * 8 + 2 * hd) * 128 + e] - lam * O[((size_t)t * 8 + 2 * hd + 1) * 128 + e];
}
__global__ void swiglu_act(float* G, const float* Uu, int ld, const int* nrows_dev) {
    const int r = blockIdx.x; if (nrows_dev && r >= *nrows_dev) return;
    for (int c = threadIdx.x; c < ld; c += blockDim.x) { const size_t i = (size_t)r * ld + c; G[i] = siluf_(G[i]) * Uu[i]; }
}
__global__ void route(const float* LG  , int* cnt  , int* list  , float* gl  ) {
    const int t = blockIdx.x * blockDim.x + threadIdx.x; if (t >= S) return;
    float v[8]; for (int e = 0; e < 8; ++e) v[e] = LG[t * 8 + e];
    int i0 = 0; for (int e = 1; e < 8; ++e) if (v[e] > v[i0]) i0 = e;
    int i1 = (i0 == 0) ? 1 : 0; for (int e = 0; e < 8; ++e) if (e != i0 && v[e] > v[i1]) i1 = e;
    const float e1 = expf(v[i1] - v[i0]), g0 = 1.f / (1.f + e1), g1 = e1 / (1.f + e1);
    int p0 = atomicAdd(&cnt[i0], 1); list[i0 * S + p0] = t; gl[i0 * S + p0] = g0;
    int p1 = atomicAdd(&cnt[i1], 1); list[i1 * S + p1] = t; gl[i1 * S + p1] = g1;
}
__global__ void scatter_add(const float* Dn  , const int* list, const float* gl, const int* nrows_dev, float* H) {
    const int r = blockIdx.x; if (r >= *nrows_dev) return;
    const int t = list[r]; const float g = gl[r];
    for (int c = threadIdx.x; c < D; c += blockDim.x) H[(size_t)t * D + c] += g * Dn[(size_t)r * D + c];
}
__global__ void ple_apply(const float* GT, const float* PE, float* H) {
    const int t = blockIdx.x;
    for (int c = threadIdx.x; c < D; c += blockDim.x) H[(size_t)t * D + c] += sigmoidf_(GT[(size_t)t * D + c]) * PE[(size_t)t * D + c];
}

static void gemm_l(hipStream_t st, bool acc, const float* A, int lda, const float* B, int ldb, float* C, int ldc, int M, int N, int K, const int* rowlist = nullptr, const int* nrows = nullptr) {
    dim3 g((N + 63) / 64, M / 64);
    if (acc) hipLaunchKernelGGL(gemm<true>, g, dim3(256), 0, st, A, lda, B, ldb, C, ldc, M, N, K, rowlist, nrows);
    else hipLaunchKernelGGL(gemm<false>, g, dim3(256), 0, st, A, lda, B, ldb, C, ldc, M, N, K, rowlist, nrows);
}

static void forward(void* const* d_in, float* out, unsigned char* ws, hipStream_t st) {
    const float* const* in = (const float* const*)d_in;
    size_t off = 0;
    auto take = [&](size_t bytes) { unsigned char* p = ws + off; off += (bytes + 255) & ~(size_t)255; return p; };
    float* A = (float*)take((size_t)S * D * 4);
    float* U = (float*)take((size_t)S * DIN * 4);
    float* QK = (float*)take((size_t)S * 512 * 4);
    float* Y = (float*)take((size_t)S * D * 4);
    float* G = (float*)take((size_t)S * FFE * 4);
    float* U2 = (float*)take((size_t)S * FFE * 4);
    float* IG = (float*)take((size_t)S * 4 * 4);
    float* LF = (float*)take((size_t)S * 4 * 4);
    int* cnt = (int*)take(256);
    int* list = (int*)take((size_t)NE * S * 4);
    float* gl = (float*)take((size_t)NE * S * 4);
    float* HM = G;
    float* HMN = G + (size_t)S * 256;
    float* Z = G + (size_t)S * 512;
    float* QN = G + (size_t)S * 768;
    float* KN = G + (size_t)S * 1280;
    float* YA = G + (size_t)S * 1792;
    float* AO = U2;
    hipMemcpyAsync(out, in[0], (size_t)NB * S * D * 4, hipMemcpyDeviceToDevice, st);
    for (int b = 0; b < NB; ++b) {
        float* H = out + (size_t)b * S * D;
        for (int L = 0; L < 2; ++L) {
            const float lam_init = 0.8f - 0.6f * expf(-0.3f * (float)L);
            hipLaunchKernelGGL(groupnorm, dim3(S), dim3(64), 0, st, H, D, A, D, 1, D, in[2] + L * D, 0, 1.f);
            gemm_l(st, false, A, D, in[3] + (size_t)L * D * DIN, DIN, U, DIN, S, DIN, D);
            hipLaunchKernelGGL(mprep, dim3(S), dim3(512), 0, st, U, in[6] + L * 2048, in[4] + L * 4, in[5] + L * 4, QK, IG, LF);
            hipLaunchKernelGGL(mlstm_rec, dim3(4), dim3(256), 0, st, QK, U, IG, LF, HM);
            hipLaunchKernelGGL(groupnorm, dim3(S * 4), dim3(64), 0, st, HM, 256, HMN, 256, 4, 64, in[7] + L * 256, 64, 1.f);
            hipLaunchKernelGGL(mgate, dim3(S), dim3(256), 0, st, HMN, U, Y);
            hipLaunchKernelGGL(cglu, dim3(S), dim3(256), 0, st, U, Z);
            hipLaunchKernelGGL(cconv, dim3(S), dim3(256), 0, st, Z, in[8] + L * 31 * 256, in[9] + L * 256, in[10] + L * 256, in[11] + L * 256, Y);
            hipLaunchKernelGGL(groupnorm, dim3(S * 8), dim3(64), 0, st, U + OFF_AQ, DIN, QN, 512, 8, 64, in[12] + L * 64, 0, 1.f);
            hipLaunchKernelGGL(groupnorm, dim3(S * 8), dim3(64), 0, st, U + OFF_AK, DIN, KN, 512, 8, 64, in[13] + L * 64, 0, 1.f);
            hipLaunchKernelGGL(attn, dim3(S / 16, 8), dim3(1024), 0, st, QN, KN, U, AO);
            hipLaunchKernelGGL(acomb, dim3(S), dim3(512), 0, st, AO, in[14] + L * 64, in[15] + L * 64, in[16] + L * 64, in[17] + L * 64, lam_init, YA);
            hipLaunchKernelGGL(groupnorm, dim3(S * 4), dim3(64), 0, st, YA, 512, Y + 512, D, 4, 128, in[18] + L * 128, 0, 1.f - lam_init);
            gemm_l(st, true, Y, D, in[19] + (size_t)L * D * D, D, H, D, S, D, D);
            hipLaunchKernelGGL(groupnorm, dim3(S), dim3(64), 0, st, H, D, A, D, 1, D, in[20] + L * D, 0, 1.f);
            if (L == 0) {
                gemm_l(st, false, A, D, in[21], FFD, G, FFD, S, FFD, D);
                gemm_l(st, false, A, D, in[22], FFD, U2, FFD, S, FFD, D);
                hipLaunchKernelGGL(swiglu_act, dim3(S), dim3(256), 0, st, G, U2, FFD, (const int*)nullptr);
                gemm_l(st, true, G, FFD, in[23], D, H, D, S, D, FFD);
            } else {
                float* LG = Y;
                gemm_l(st, false, A, D, in[24], NE, LG, NE, S, NE, D);
                hipMemsetAsync(cnt, 0, 256, st);
                hipLaunchKernelGGL(route, dim3(S / 256), dim3(256), 0, st, LG, cnt, list, gl);
                float* Dn = Y;
                for (int e = 0; e < NE; ++e) {
                    gemm_l(st, false, A, D, in[25] + (size_t)e * D * FFE, FFE, G, FFE, S, FFE, D, list + e * S, cnt + e);
                    gemm_l(st, false, A, D, in[26] + (size_t)e * D * FFE, FFE, U2, FFE, S, FFE, D, list + e * S, cnt + e);
                    hipLaunchKernelGGL(swiglu_act, dim3(S), dim3(256), 0, st, G, U2, FFE, (const int*)(cnt + e));
                    gemm_l(st, false, G, FFE, in[27] + (size_t)e * FFE * D, D, Dn, D, S, D, FFE, nullptr, cnt + e);
                    hipLaunchKernelGGL(scatter_add, dim3(S), dim3(256), 0, st, Dn, list + e * S, gl + e * S, (const int*)(cnt + e), H);
                }
            }
            hipLaunchKernelGGL(groupnorm, dim3(S), dim3(64), 0, st, H, D, A, D, 1, D, in[28] + L * D, 0, 1.f);
            gemm_l(st, false, A, D, in[29] + (size_t)L * D * D, D, G, D, S, D, D);
            gemm_l(st, false, in[1] + ((size_t)L * NB + b) * S * PLE, PLE, in[30] + (size_t)L * PLE * D, D, U2, D, S, D, PLE);
            hipLaunchKernelGGL(ple_apply, dim3(S), dim3(256), 0, st, G, U2, H);
        }
    }
}
}
#define GAS __attribute__((address_space(1)))
#define LAS __attribute__((address_space(3)))
typedef unsigned short bf16_t;
typedef unsigned u32x4 __attribute__((ext_vector_type(4)));
typedef unsigned u32x2 __attribute__((ext_vector_type(2)));
typedef float f32x4 __attribute__((ext_vector_type(4)));
typedef float f32x2 __attribute__((ext_vector_type(2)));
typedef short bf16x8 __attribute__((ext_vector_type(8)));
typedef GAS unsigned gu32;
#define RLX_AGENT __ATOMIC_RELAXED, __HIP_MEMORY_SCOPE_AGENT

constexpr int NB = 4, SEQ = 8192, M = NB * SEQ, D = 1024, DIN = 3080;
constexpr int FFD = 2816, FFE = 3584, NE = 8, PLE = 256;
constexpr int UW = 2816;
constexpr int UC_MQ = 0, UC_MK = 256, UC_MV = 512, UC_MO = 768, UC_Z = 1024, UC_Q = 1280, UC_K = 1792, UC_V = 2304;
constexpr int NIN = 3072;
constexpr float EPS = 1e-6f;
constexpr float C2 = 0.125f * 1.4426950408889634f;
constexpr int MOE_MAXROWS = M + NE * 256;

constexpr size_t MiB = 1u << 20;
constexpr size_t WS_CTL = 0, CTL_ZERO_BYTES = 1 * MiB;
constexpr size_t WS_WIN = 1 * MiB;
constexpr size_t WS_WOUT = WS_WIN + 12 * MiB;
constexpr size_t WS_WDGU = WS_WOUT + 4 * MiB;
constexpr size_t WS_WDD = WS_WDGU + 11 * MiB;
constexpr size_t WS_WMGU = WS_WDD + 6 * MiB;
constexpr size_t WS_WMD = WS_WMGU + 112 * MiB;
constexpr size_t WS_WPG = WS_WMD + 56 * MiB;
constexpr size_t WS_WPP = WS_WPG + 4 * MiB;
constexpr size_t WS_WSM = WS_WPP + 1 * MiB;
constexpr size_t WS_GATE = WS_WSM + 1 * MiB;
constexpr size_t WS_MOE = WS_GATE + 1 * MiB;
constexpr size_t WS_MST = WS_MOE + 3 * MiB;
constexpr size_t WS_AY = WS_MST + 34 * MiB;
constexpr size_t WS_BIG = WS_AY + 64 * MiB;
constexpr size_t WS_END = WS_BIG + 238 * MiB;
static_assert((size_t)MOE_MAXROWS * FFE * 2 <= 238 * MiB, "act fits");
static_assert((size_t)M * UW * 2 <= 176 * MiB, "u fits");

constexpr int CW_TMO = 0, CW_CODE = 1;
constexpr int CW_BAR = 4096;
constexpr int CW_CNT = 16384;
constexpr int CW_QATT = 16448;
constexpr size_t MOE_GATEV = 0;
constexpr size_t MOE_EIDX = 2 * (size_t)M * 4;
constexpr size_t MOE_LIST = 4 * (size_t)M * 4;
static_assert(MOE_LIST + 16 * (size_t)M * 4 <= 3 * MiB, "moe region");

constexpr int RING_BYTES = 131072;
constexpr int LDSCTL_OFF = RING_BYTES, MISC_OFF = LDSCTL_OFF + 320;
constexpr int TAB_OFF = RING_BYTES + 1024;
constexpr int LDS_BYTES = 163840;
constexpr int NWAVES = 8;

__device__ __forceinline__ unsigned f2bf(float f) { unsigned u = __builtin_bit_cast(unsigned, f); return (u + 0x7fffu + ((u >> 16) & 1u)) >> 16; }
__device__ __forceinline__ unsigned pk2(float lo, float hi) { return f2bf(lo) | (f2bf(hi) << 16); }
__device__ __forceinline__ float bf2f(unsigned short b) { return __builtin_bit_cast(float, (unsigned)b << 16); }
__device__ __forceinline__ float bflo(unsigned w) { return __builtin_bit_cast(float, w << 16); }
__device__ __forceinline__ float bfhi(unsigned w) { return __builtin_bit_cast(float, w & 0xffff0000u); }
__device__ __forceinline__ unsigned cvt_pk_bf16(float lo, float hi) { unsigned r; asm volatile("v_cvt_pk_bf16_f32 %0, %1, %2" : "=v"(r) : "v"(lo), "v"(hi)); return r; }
__device__ __forceinline__ float fast_sigmoid(float x) { return __builtin_amdgcn_rcpf(1.f + __builtin_amdgcn_exp2f(-1.4426950408889634f * x)); }
__device__ __forceinline__ int lane_id_v() { int l; asm volatile("v_mbcnt_lo_u32_b32 %0, -1, 0\n\tv_mbcnt_hi_u32_b32 %0, -1, %0" : "=v"(l)); return l; }
__device__ __forceinline__ float wave_sum(float v) {
#pragma unroll
    for (int o = 1; o < 64; o <<= 1) v += __shfl_xor(v, o);
    return v;
}
__device__ __forceinline__ float wave_max(float v) {
#pragma unroll
    for (int o = 1; o < 64; o <<= 1) v = fmaxf(v, __shfl_xor(v, o));
    return v;
}

#define XB_TMO      128
#define XB_XCNT(j)  (256  + 64 * (j))
#define XB_XSUB(j)  (1280 + 64 * (j))
#define XB_XGEN(j)  (2304 + 64 * (j))
#define XB_TOP      3328
#define XB_TOPGEN   3392
#define XCD_BAR_WORDS 3456
#define XB_SPIN_CAP (1u << 22)
__device__ __forceinline__ unsigned xb_ld(unsigned* p)              { return __hip_atomic_load(p, __ATOMIC_RELAXED, __HIP_MEMORY_SCOPE_AGENT); }
__device__ __forceinline__ unsigned xb_add(unsigned* p, unsigned v) { return __hip_atomic_fetch_add(p, v, __ATOMIC_RELAXED, __HIP_MEMORY_SCOPE_AGENT); }
__device__ __forceinline__ unsigned xb_xcc_id() { return (unsigned)__builtin_amdgcn_s_getreg((3 << 11) | 20) & 0xFu; }
#define XB_SPIN(cond, bar) do { unsigned _sp = 0; while (cond) { __builtin_amdgcn_s_sleep(1); \
    if ((++_sp & 255u) == 0u) { if (xb_ld(&(bar)[XB_TMO])) break; if (_sp > XB_SPIN_CAP) { atomicAdd(&(bar)[XB_TMO], 1u); break; } } } } while (0)
struct XcdBarrier { unsigned* bar; unsigned x; volatile LAS unsigned* st; };
__device__ __forceinline__ XcdBarrier xcd_barrier_post(unsigned* bar, volatile LAS unsigned* st) {
    XcdBarrier b; b.bar = bar; b.x = xb_xcc_id(); b.st = st;
    if (threadIdx.x == 0) (void)xb_add(&bar[XB_XCNT(b.x)], 1u);
    return b;
}
__device__ __forceinline__ void xcd_barrier_complete(unsigned* bar, unsigned x, unsigned& nloc, unsigned& nx) {
    const unsigned G = gridDim.x * gridDim.y * gridDim.z;
    unsigned sum, cnt, mine, sp = 0u;
    for (;;) {
        sum = 0u; cnt = 0u; mine = 0u;
#pragma unroll
        for (unsigned j = 0; j < 16; ++j) { const unsigned c = xb_ld(&bar[XB_XCNT(j)]); sum += c; cnt += (c > 0u) ? 1u : 0u; mine = (j == x) ? c : mine; }
        if (sum == G) break;
        __builtin_amdgcn_s_sleep(1);
        if ((++sp & 255u) == 0u) { if (xb_ld(&bar[XB_TMO])) break; if (sp > XB_SPIN_CAP) { atomicAdd(&bar[XB_TMO], 1u); break; } }
    }
    nloc = mine > 0u ? mine : 1u; nx = cnt > 0u ? cnt : 1u;
}
__device__ __forceinline__ void xcd_barrier(const XcdBarrier& b) {
    asm volatile("s_waitcnt vmcnt(0)" ::: "memory");
    __syncthreads();
    if (threadIdx.x == 0) {
        unsigned* bar = b.bar;
        __builtin_amdgcn_s_waitcnt(0);
        unsigned nloc = b.st[0], nx = b.st[1];
        if (nloc == 0u) { xcd_barrier_complete(bar, b.x, nloc, nx); b.st[0] = nloc; b.st[1] = nx; }
        const unsigned old = xb_add(&bar[XB_XSUB(b.x)], 1u);
        const unsigned gen = old / nloc;
        if (old + 1u == (gen + 1u) * nloc) {
            __builtin_amdgcn_fence(__ATOMIC_RELEASE, "agent");
            asm volatile("s_waitcnt vmcnt(0)" ::: "memory");
            const unsigned og = xb_add(&bar[XB_TOP], 1u);
            const unsigned tg = og / nx;
            if (og + 1u == (tg + 1u) * nx) xb_add(&bar[XB_TOPGEN], 1u);
            else XB_SPIN(xb_ld(&bar[XB_TOPGEN]) == tg, bar);
            __builtin_amdgcn_fence(__ATOMIC_ACQUIRE, "agent");
            xb_add(&bar[XB_XGEN(b.x)], 1u);
            asm volatile("s_waitcnt vmcnt(0)" ::: "memory");
        } else {
            XB_SPIN(xb_ld(&bar[XB_XGEN(b.x)]) == gen, bar);
            __builtin_amdgcn_fence(__ATOMIC_ACQUIRE, "agent");
            asm volatile("s_waitcnt vmcnt(0)" ::: "memory");
        }
    }
    __syncthreads();
}

namespace pg8 {
constexpr int BM = 256, BK = 64, HALF = 128, HTB = HALF * BK * 2, STAGE_BYTES = 8 * HTB, NXCD = 8, WGM = 8;
__host__ __device__ __forceinline__ int lds_byte(int r, int c) { const int st = (r >> 4) * 2 + (c >> 5), rr = r & 15, cc = c & 31, ob = rr * 64 + cc * 2; return st * 1024 + (ob ^ (((ob >> 9) & 1) << 5)); }
__host__ __device__ __forceinline__ void stage_rc(int b, int& R, int& C) { const int st = b / 1024, sb = b % 1024, swz = sb ^ (((sb >> 9) & 1) << 5); R = (st >> 1) * 16 + swz / 64; C = (st & 1) * 32 + (swz % 64) / 2; }
__host__ __device__ __forceinline__ int perm32(int rho) { const int n = rho >> 4, i = rho & 15; return 8 * (i >> 2) + 4 * n + (i & 3); }

struct Unit { int pm, pn, pb; };

struct StaticOrder {
    int nM, nN, nwg, G, c;
    __device__ void init(int nM_, int nN_, int G_, int c_) { nM = nM_; nN = nN_; nwg = nM * nN; G = G_; c = c_; }
    __device__ __forceinline__ bool tile(int i, int& pm, int& pn) const {
        const long L = (long)i * G + c; if (L >= nwg) return false;
        int wgid = (int)L; { const int q = nwg / NXCD, r = nwg % NXCD, xcd = wgid % NXCD, off = wgid / NXCD; wgid = (xcd < r ? xcd * (q + 1) : r * (q + 1) + (xcd - r) * q) + off; }
        const int nig = WGM * nN, gid = wgid / nig, fm = gid * WGM, gsz = (nM - fm) < WGM ? (nM - fm) : WGM;
        pm = fm + ((wgid % nig) % gsz); pn = (wgid % nig) / gsz; return true;
    }
    __device__ __forceinline__ bool next(int i, Unit& u) const { if (!tile(i, u.pm, u.pn)) return false; u.pb = u.pn; return true; }
};

template <class Epi, class Sched, class AOff, bool ALIGN_EPI>
__device__ __forceinline__ void gemm_phase(LAS unsigned char* lds, int wave, const bf16_t* A, const bf16_t* Bt, int K, const Sched& S, const Epi& E, const AOff& AO) {
    asm volatile("" : "+s"(A), "+s"(Bt), "+s"(K), "+s"(wave));
    const int lane = lane_id_v(), wid = wave, tid = wid * 64 + lane, wr = wid >> 2, wc = wid & 3, fr = lane & 15, fq = lane >> 4;
    const int nt = K / BK;
    int R0, C0, R1, C1; stage_rc(tid * 16, R0, C0); stage_rc(tid * 16 + 8192, R1, C1);
    unsigned voffB[2]; voffB[0] = (unsigned)(R0 * K + C0) * 2u; voffB[1] = (unsigned)(R1 * K + C1) * 2u;
    const size_t kstep = (size_t)(BK * 2);
    const size_t hstep = (size_t)HALF * K * 2;
    const size_t tstep = 2 * hstep;
    const unsigned ldsw = (unsigned)wid * 1024u;
    const int aoff = lds_byte(wr * 64 + fr, fq * 8), boff = lds_byte(wc * 32 + fr, fq * 8);
    const char* Ab = (const char*)A;
#define PG8_SA(b, h) (((b) * 2 + (h)) * HTB)
#define PG8_SB(b, h) ((4 + (b) * 2 + (h)) * HTB)
#define PG8_STAGE(bufoff, gbase, voff) do { _Pragma("unroll") for (int _i = 0; _i < 2; ++_i) \
        __builtin_amdgcn_global_load_lds((const unsigned*)((const char*)(gbase) + (voff)[_i]), (LAS unsigned*)(lds + (bufoff) + ldsw + _i * 8192), 16, 0, 0); } while (0)
#define PG8_LDA(dst, b, h) do { _Pragma("unroll") for (int m = 0; m < 4; ++m) _Pragma("unroll") for (int k = 0; k < 2; ++k) dst[m][k] = *(const LAS bf16x8*)(lds + PG8_SA(b, h) + aoff + m * 2048 + k * 1024); } while (0)
#define PG8_LDB(dst, b, h) do { _Pragma("unroll") for (int n = 0; n < 2; ++n) _Pragma("unroll") for (int k = 0; k < 2; ++k) dst[n][k] = *(const LAS bf16x8*)(lds + PG8_SB(b, h) + boff + n * 2048 + k * 1024); } while (0)
#define PG8_MMA(ai, bj, At, Bt_) do { __builtin_amdgcn_s_setprio(1); _Pragma("unroll") for (int m = 0; m < 4; ++m) _Pragma("unroll") for (int n = 0; n < 2; ++n) _Pragma("unroll") for (int k = 0; k < 2; ++k) \
        acc[ai][bj][m][n] = __builtin_amdgcn_mfma_f32_16x16x32_bf16(Bt_[n][k], At[m][k], acc[ai][bj][m][n], 0, 0, 0); __builtin_amdgcn_s_setprio(0); } while (0)
#define PG8_WAIT_V(n) asm volatile("s_waitcnt vmcnt(" #n ")" ::: "memory")
#define PG8_WAIT_L(n) asm volatile("s_waitcnt lgkmcnt(" #n ")" ::: "memory")
#define PG8_BAR __builtin_amdgcn_s_barrier()
#define PG8_SCHED __builtin_amdgcn_sched_barrier(0)
    Unit cur, nxt; int ui = 0;
    if (!S.next(0, cur)) return;
    f32x4 acc[2][2][4][2];
#pragma unroll
    for (int a = 0; a < 2; ++a)
#pragma unroll
        for (int b = 0; b < 2; ++b)
#pragma unroll
            for (int m = 0; m < 4; ++m)
#pragma unroll
                for (int n = 0; n < 2; ++n) acc[a][b][m][n] = (f32x4){0.f, 0.f, 0.f, 0.f};
    bf16x8 At[4][2], B0[2][2], B1[2][2];
    unsigned va[2][2], vn[2][2];
    AO(cur, 0, R0, C0, R1, C1, va);
    const char* cB = (const char*)Bt + (size_t)cur.pb * tstep;
    PG8_STAGE(PG8_SB(0, 0), cB, voffB); PG8_STAGE(PG8_SB(0, 1), cB + hstep, voffB); PG8_STAGE(PG8_SA(0, 0), Ab, va[0]); PG8_STAGE(PG8_SA(0, 1), Ab, va[1]);
    if (wr == 1) PG8_BAR;
    PG8_WAIT_V(2); PG8_BAR;
    PG8_STAGE(PG8_SB(1, 0), cB + kstep, voffB); PG8_STAGE(PG8_SA(1, 0), Ab + kstep, va[0]); PG8_STAGE(PG8_SB(1, 1), cB + hstep + kstep, voffB);
    PG8_WAIT_V(6); PG8_BAR;
    for (;;) {
        const bool has_next = S.next(ui + 1, nxt);
        if (has_next) AO(nxt, ui + 1, R0, C0, R1, C1, vn);
        else { vn[0][0] = va[0][0]; vn[0][1] = va[0][1]; vn[1][0] = va[1][0]; vn[1][1] = va[1][1]; }
        const char* nB = has_next ? (const char*)Bt + (size_t)nxt.pb * tstep : cB;
        for (int t = 0; t < nt; t += 2) {
            const bool last = (t == nt - 2);
            const size_t ka1 = (size_t)(t + 1) * kstep;
            const size_t ka2 = last ? 0 : (size_t)(t + 2) * kstep, ka3 = ka2 + kstep;
            const char* b2 = last ? nB : cB + (size_t)(t + 2) * kstep; const char* b3 = b2 + kstep;
            unsigned w0[2], w1[2];
            w0[0] = last ? vn[0][0] : va[0][0]; w0[1] = last ? vn[0][1] : va[0][1]; w1[0] = last ? vn[1][0] : va[1][0]; w1[1] = last ? vn[1][1] : va[1][1];
            PG8_LDB(B0, 0, 0); PG8_LDB(B1, 0, 1); PG8_SCHED; PG8_LDA(At, 0, 0); PG8_STAGE(PG8_SA(1, 1), Ab + ka1, va[1]);
            PG8_WAIT_V(8); PG8_WAIT_L(0); PG8_BAR; PG8_MMA(0, 0, At, B0); PG8_MMA(0, 1, At, B1); PG8_BAR; PG8_SCHED;
            PG8_LDA(At, 0, 1); PG8_STAGE(PG8_SB(0, 0), b2, voffB); PG8_STAGE(PG8_SB(0, 1), b2 + hstep, voffB); PG8_STAGE(PG8_SA(0, 0), Ab + ka2, w0);
            PG8_WAIT_V(8); PG8_WAIT_L(0); PG8_BAR; PG8_MMA(1, 0, At, B0); PG8_MMA(1, 1, At, B1); PG8_BAR; PG8_SCHED;
            PG8_LDB(B0, 1, 0); PG8_LDB(B1, 1, 1); PG8_SCHED; PG8_LDA(At, 1, 0); PG8_STAGE(PG8_SA(0, 1), Ab + ka2, w1);
            PG8_WAIT_V(8); PG8_WAIT_L(0); PG8_BAR; PG8_MMA(0, 0, At, B0); PG8_MMA(0, 1, At, B1); PG8_BAR; PG8_SCHED;
            PG8_LDA(At, 1, 1); PG8_STAGE(PG8_SB(1, 0), b3, voffB); PG8_STAGE(PG8_SB(1, 1), b3 + hstep, voffB); PG8_STAGE(PG8_SA(1, 0), Ab + ka3, w0);
            PG8_WAIT_V(8); PG8_WAIT_L(0); PG8_BAR; PG8_MMA(1, 0, At, B0); PG8_MMA(1, 1, At, B1); PG8_BAR; PG8_SCHED;
        }
        if constexpr (ALIGN_EPI) { if (wr == 0) PG8_BAR; }
        E(acc, cur, wr, wc, fr, fq);
        if (!has_next) break;
#pragma unroll
        for (int a = 0; a < 2; ++a)
#pragma unroll
            for (int b = 0; b < 2; ++b)
#pragma unroll
                for (int m = 0; m < 4; ++m)
#pragma unroll
                    for (int n = 0; n < 2; ++n) acc[a][b][m][n] = (f32x4){0.f, 0.f, 0.f, 0.f};
        cur = nxt; cB = nB; ++ui;
        va[0][0] = vn[0][0]; va[0][1] = vn[0][1]; va[1][0] = vn[1][0]; va[1][1] = vn[1][1];
        if constexpr (ALIGN_EPI) { if (wr == 1) PG8_BAR; }
    }
    PG8_WAIT_V(0);
    if constexpr (!ALIGN_EPI) { if (wr == 0) PG8_BAR; }
    PG8_BAR;
#undef PG8_SA
#undef PG8_SB
#undef PG8_STAGE
#undef PG8_LDA
#undef PG8_LDB
#undef PG8_MMA
#undef PG8_WAIT_V
#undef PG8_WAIT_L
#undef PG8_BAR
#undef PG8_SCHED
}

struct AOffDense { int K; __device__ __forceinline__ void operator()(const Unit& u, int, int R0, int C0, int R1, int C1, unsigned (&vo)[2][2]) const {
#pragma unroll
    for (int h = 0; h < 2; ++h) { vo[h][0] = (unsigned)((u.pm * 256 + h * 128 + R0) * K + C0) * 2u; vo[h][1] = (unsigned)((u.pm * 256 + h * 128 + R1) * K + C1) * 2u; } } };
struct AOffGather { int K; const LAS int* tab; __device__ __forceinline__ void operator()(const Unit&, int ui, int R0, int C0, int R1, int C1, unsigned (&vo)[2][2]) const {
#pragma unroll
    for (int h = 0; h < 2; ++h) { vo[h][0] = (unsigned)(tab[ui * 256 + h * 128 + R0] * K + C0) * 2u; vo[h][1] = (unsigned)(tab[ui * 256 + h * 128 + R1] * K + C1) * 2u; } } };
}
struct Frame {
    LAS unsigned char* lds;
    volatile LAS unsigned* MISC;
    gu32* ctl;
    int tid, lane, wave, vcu, G;
    const float* in[31];
    float* out;
    unsigned char* ws;
};
#define LDS_WAIT() asm volatile("s_waitcnt lgkmcnt(0)" ::: "memory")
#define VM_WAIT() asm volatile("s_waitcnt vmcnt(0)" ::: "memory")

__device__ __forceinline__ void prep_item(const float* W, int ldw, int c0s, const float* gain, bf16_t* WT, int K, int n0d, int k0, bool perm, LAS float* scr, int lane) {
    f32x4 v[8];
#pragma unroll
    for (int i = 0; i < 8; ++i) v[i] = *(const GAS f32x4*)(W + (size_t)(k0 + 8 * i + (lane >> 3)) * ldw + c0s + 4 * (lane & 7));
#pragma unroll
    for (int i = 0; i < 8; ++i) { const int kk = 8 * i + (lane >> 3); const float g = gain ? gain[k0 + kk] : 1.f; LAS float* d = scr + kk * 33 + 4 * (lane & 7);
        d[0] = v[i][0] * g; d[1] = v[i][1] * g; d[2] = v[i][2] * g; d[3] = v[i][3] * g; }
    LDS_WAIT(); asm volatile("" ::: "memory");
    const int c = lane & 7;
#pragma unroll
    for (int j = 0; j < 4; ++j) { const int n = (lane >> 3) + 8 * j; const int ns = perm ? pg8::perm32(n) : n; const LAS float* s = scr + (8 * c) * 33 + ns;
        u32x4 o; o.x = pk2(s[0 * 33], s[1 * 33]); o.y = pk2(s[2 * 33], s[3 * 33]); o.z = pk2(s[4 * 33], s[5 * 33]); o.w = pk2(s[6 * 33], s[7 * 33]);
        *(GAS u32x4*)(WT + (size_t)(n0d + n) * K + k0 + 8 * c) = o; }
    LDS_WAIT(); asm volatile("" ::: "memory");
}
__device__ __forceinline__ int win_src_col(int gd) {
    const int tile = gd >> 3, bj = (gd >> 2) & 1, wc = gd & 3;
    if (tile < 4) return 256 * tile + 128 * bj + 32 * wc;
    if (tile < 6) return (bj ? 1288 : 1032) + 128 * (tile - 4) + 32 * wc;
    if (tile < 8) return 1544 + 256 * (tile - 6) + 64 * wc + 32 * bj;
    if (tile < 10) return 2056 + 256 * (tile - 8) + 64 * wc + 32 * bj;
    return 2568 + 256 * (tile - 10) + 128 * bj + 32 * wc;
}
__device__ __forceinline__ void p0_prologue(Frame& F) {
    LAS float* scr = (LAS float*)(F.lds + F.wave * 16384);
    const int gw = F.vcu * NWAVES + F.wave, NGW = F.G * NWAVES, lane = F.lane;
    bf16_t* ws16 = (bf16_t*)F.ws;
    constexpr int I_IN = 16 * 96, I_OUT = 16 * 32, I_DGU = 16 * 176, I_DD = 44 * 32, I_MGU = 16 * 224, I_MD = 56 * 32, I_PG = 16 * 32, I_PP = 4 * 32;
    constexpr int NITEMS = 2 * I_IN + 2 * I_OUT + I_DGU + I_DD + 8 * I_MGU + 8 * I_MD + 2 * I_PG + 2 * I_PP;
    for (int it = gw; it < NITEMS; it += NGW) {
        int r = it;
        const float* W; const float* gain = nullptr; bf16_t* WT; int ldw, c0s, K, gd, kb; bool perm = false;
        if (r < 2 * I_IN) { const int L = r / I_IN; r %= I_IN; gd = r % 96; kb = r / 96;
            W = F.in[3] + (size_t)L * D * DIN; ldw = DIN; c0s = win_src_col(gd); gain = F.in[2] + L * D; WT = (bf16_t*)(F.ws + WS_WIN) + (size_t)L * NIN * D; K = D; perm = true; }
        else if ((r -= 2 * I_IN) < 2 * I_OUT) { const int L = r / I_OUT; r %= I_OUT; gd = r % 32; kb = r / 32;
            W = F.in[19] + (size_t)L * D * D; ldw = D; c0s = 32 * gd; WT = (bf16_t*)(F.ws + WS_WOUT) + (size_t)L * D * D; K = D; }
        else if ((r -= 2 * I_OUT) < I_DGU) { gd = r % 176; kb = r / 176; const int tile = gd >> 3, bj = (gd >> 2) & 1, wc = gd & 3;
            W = bj ? F.in[22] : F.in[21]; ldw = FFD; c0s = 128 * tile + 32 * wc; gain = F.in[20]; WT = (bf16_t*)(F.ws + WS_WDGU); K = D; perm = true; }
        else if ((r -= I_DGU) < I_DD) { gd = r % 32; kb = r / 32;
            W = F.in[23]; ldw = D; c0s = 32 * gd; WT = (bf16_t*)(F.ws + WS_WDD); K = FFD; }
        else if ((r -= I_DD) < 8 * I_MGU) { const int e = r / I_MGU; r %= I_MGU; gd = r % 224; kb = r / 224; const int tile = gd >> 3, bj = (gd >> 2) & 1, wc = gd & 3;
            W = (bj ? F.in[26] : F.in[25]) + (size_t)e * D * FFE; ldw = FFE; c0s = 128 * tile + 32 * wc; gain = F.in[20] + D; WT = (bf16_t*)(F.ws + WS_WMGU) + (size_t)e * 2 * FFE * D; K = D; perm = true; }
        else if ((r -= 8 * I_MGU) < 8 * I_MD) { const int e = r / I_MD; r %= I_MD; gd = r % 32; kb = r / 32;
            W = F.in[27] + (size_t)e * FFE * D; ldw = D; c0s = 32 * gd; WT = (bf16_t*)(F.ws + WS_WMD) + (size_t)e * D * FFE; K = FFE; }
        else if ((r -= 8 * I_MD) < 2 * I_PG) { const int L = r / I_PG; r %= I_PG; gd = r % 32; kb = r / 32;
            W = F.in[29] + (size_t)L * D * D; ldw = D; c0s = 32 * gd; gain = F.in[28] + L * D; WT = (bf16_t*)(F.ws + WS_WPG) + (size_t)L * D * D; K = D; }
        else { r -= 2 * I_PG; const int L = r / I_PP; r %= I_PP; gd = r % 32; kb = r / 32;
            W = F.in[30] + (size_t)L * PLE * D; ldw = D; c0s = 32 * gd; WT = (bf16_t*)(F.ws + WS_WPP) + (size_t)L * D * PLE; K = PLE; }
        prep_item(W, ldw, c0s, gain, WT, K, 32 * gd, 64 * kb, perm, scr, lane);
    }
    (void)ws16;
    float* wsm = (float*)(F.ws + WS_WSM);
    const int gt = F.vcu * (NWAVES * 64) + F.tid, NGT = F.G * NWAVES * 64;
    for (int i = gt; i < 3 * 8 * D; i += NGT) {
        const int which = i / (8 * D), j = (i / D) % 8, k = i % D;
        float v;
        if (which < 2) v = F.in[2][which * D + k] * F.in[3][(size_t)which * D * DIN + (size_t)k * DIN + 1024 + j];
        else v = F.in[20][D + k] * F.in[24][k * NE + j];
        wsm[i] = v;
    }
}

template <int MODE>
__device__ __forceinline__ void norm_phase(Frame& F, const float* src, const float* wx, const float* pconv, bf16_t* pconv_out) {
    bf16_t* AY = (bf16_t*)(F.ws + WS_AY);
    LAS float* wl = (LAS float*)F.lds;
    LAS int* rinfo = (LAS int*)(F.lds + 32768);
    if (MODE != 0) { for (int i = F.tid; i < 8 * D; i += NWAVES * 64) wl[i] = wx[i]; __syncthreads(); }
    const int gw = F.vcu * NWAVES + F.wave, NGW = F.G * NWAVES, lane = F.lane;
    int nrow = 0;
    for (int m = gw; m < M; m += NGW, ++nrow) {
        const GAS f32x4* xr = (const GAS f32x4*)(src + (size_t)m * D) + lane;
        f32x4 v[4]; float s = 0.f;
#pragma unroll
        for (int j = 0; j < 4; ++j) { v[j] = xr[64 * j]; s += (v[j].x * v[j].x + v[j].y * v[j].y) + (v[j].z * v[j].z + v[j].w * v[j].w); }
        const float rs = 1.0f / sqrtf(wave_sum(s) * (1.f / D) + EPS);
#pragma unroll
        for (int j = 0; j < 4; ++j) v[j] = v[j] * rs;
        GAS unsigned long long* o8 = (GAS unsigned long long*)(AY + (size_t)m * D) + lane;
#pragma unroll
        for (int j = 0; j < 4; ++j) o8[64 * j] = (unsigned long long)pk2(v[j].x, v[j].y) | ((unsigned long long)pk2(v[j].z, v[j].w) << 32);
        if (MODE != 0) {
            float dt[8];
#pragma unroll
            for (int c = 0; c < 8; ++c) { float a = 0.f;
#pragma unroll
                for (int j = 0; j < 4; ++j) { const f32x4 w = *(const LAS f32x4*)(wl + c * D + 256 * j + 4 * lane); a += (v[j].x * w.x + v[j].y * w.y) + (v[j].z * w.z + v[j].w * w.w); }
                dt[c] = wave_sum(a); }
            if (MODE == 1) { if (lane == 0) { GAS f32x4* g = (GAS f32x4*)((float*)(F.ws + WS_GATE) + (size_t)m * 8); g[0] = (f32x4){dt[0], dt[1], dt[2], dt[3]}; g[1] = (f32x4){dt[4], dt[5], dt[6], dt[7]}; } }
            if (MODE == 2) {
                int i0 = 0;
#pragma unroll
                for (int e = 1; e < 8; ++e) if (dt[e] > dt[i0]) i0 = e;
                int i1 = (i0 == 0) ? 1 : 0;
#pragma unroll
                for (int e = 0; e < 8; ++e) if (e != i0 && dt[e] > dt[i1]) i1 = e;
                float v0 = dt[0], v1 = dt[0];
#pragma unroll
                for (int e = 0; e < 8; ++e) { v0 = (e == i0) ? dt[e] : v0; v1 = (e == i1) ? dt[e] : v1; }
                const float e1 = __expf(v1 - v0), g0 = 1.f / (1.f + e1), g1 = e1 / (1.f + e1);
                if (lane == 0) {
                    float* gv = (float*)(F.ws + WS_MOE + MOE_GATEV); gv[m] = g0; gv[M + m] = g1;
                    rinfo[(F.wave * 16 + nrow) * 2] = i0; rinfo[(F.wave * 16 + nrow) * 2 + 1] = i1;
                }
            }
        }
    }
    if (MODE == 2) {
        __syncthreads();
        if (F.tid < 16) {
            const int s = F.tid >> 3, e = F.tid & 7; int n = 0;
#pragma unroll 1
            for (int wr_ = 0; wr_ < 128; ++wr_) n += (rinfo[wr_ * 2 + s] == e) ? 1 : 0;
            unsigned base = 0; if (n) base = __hip_atomic_fetch_add((unsigned*)(F.ctl + CW_CNT + s * 8 + e), (unsigned)n, RLX_AGENT);
            int* list = (int*)(F.ws + WS_MOE + MOE_LIST) + ((size_t)(s * 8 + e)) * M;
            int k = 0;
#pragma unroll 1
            for (int wr_ = 0; wr_ < 128; ++wr_) if (rinfo[wr_ * 2 + s] == e) { list[base + k] = (F.vcu * NWAVES + (wr_ >> 4)) + (wr_ & 15) * NGW; ++k; }
        }
        __syncthreads();
    }
    if (pconv) {
        const size_t n4 = (size_t)M * PLE / 4, gt = (size_t)F.vcu * (NWAVES * 64) + F.tid, NGT = (size_t)F.G * NWAVES * 64;
        for (size_t i = gt; i < n4; i += NGT) { const f32x4 x = ((const GAS f32x4*)pconv)[i]; ((GAS unsigned long long*)pconv_out)[i] = (unsigned long long)pk2(x.x, x.y) | ((unsigned long long)pk2(x.z, x.w) << 32); }
    }
}

typedef f32x4 AccT[2][2][4][2];
__device__ __forceinline__ u32x4 pack8(const f32x4& a, const f32x4& b) { u32x4 w; w.x = cvt_pk_bf16(a[0], a[1]); w.y = cvt_pk_bf16(a[2], a[3]); w.z = cvt_pk_bf16(b[0], b[1]); w.w = cvt_pk_bf16(b[2], b[3]); return w; }

struct EpiIn {
    bf16_t* U; const float* gq; const float* gk;
    __device__ __forceinline__ void operator()(const AccT& acc, const pg8::Unit& u, int wr, int wc, int fr, int fq) const {
        const int row0 = u.pm * 256 + wr * 64 + fr, pn = u.pn;
        if (pn < 4 || pn >= 10) {
            const int cb = (pn < 4 ? 256 * pn : UC_V + 256 * (pn - 10)) + wc * 32 + 8 * fq;
#pragma unroll
            for (int ai = 0; ai < 2; ++ai)
#pragma unroll
                for (int m = 0; m < 4; ++m) { bf16_t* rp = U + (size_t)(row0 + ai * 128 + m * 16) * UW + cb;
#pragma unroll
                    for (int bj = 0; bj < 2; ++bj) *(u32x4*)(rp + bj * 128) = pack8(acc[ai][bj][m][0], acc[ai][bj][m][1]); }
        } else if (pn < 6) {
            const int cb = UC_Z + 128 * (pn - 4) + wc * 32 + 8 * fq;
#pragma unroll
            for (int ai = 0; ai < 2; ++ai)
#pragma unroll
                for (int m = 0; m < 4; ++m) { f32x4 z0, z1;
#pragma unroll
                    for (int i = 0; i < 4; ++i) { z0[i] = acc[ai][0][m][0][i] * fast_sigmoid(acc[ai][1][m][0][i]); z1[i] = acc[ai][0][m][1][i] * fast_sigmoid(acc[ai][1][m][1][i]); }
                    *(u32x4*)(U + (size_t)(row0 + ai * 128 + m * 16) * UW + cb) = pack8(z0, z1); }
        } else {
            const bool isq = pn < 8; const int j = 4 * (pn - (isq ? 6 : 8)) + wc;
            const float* g = isq ? gq : gk; const float sc = isq ? C2 : 1.f;
            f32x4 gv[2][2];
#pragma unroll
            for (int bj = 0; bj < 2; ++bj)
#pragma unroll
                for (int n = 0; n < 2; ++n) gv[bj][n] = *(const f32x4*)(g + 32 * bj + 8 * fq + 4 * n) * sc;
            const int cb = (isq ? UC_Q : UC_K) + 64 * j + 8 * fq;
#pragma unroll
            for (int ai = 0; ai < 2; ++ai)
#pragma unroll
                for (int m = 0; m < 4; ++m) { float ss = 0.f;
#pragma unroll
                    for (int bj = 0; bj < 2; ++bj)
#pragma unroll
                        for (int n = 0; n < 2; ++n) { const f32x4 x = acc[ai][bj][m][n]; ss += (x[0] * x[0] + x[1] * x[1]) + (x[2] * x[2] + x[3] * x[3]); }
                    ss += __shfl_xor(ss, 16); ss += __shfl_xor(ss, 32);
                    const float rs = 1.0f / sqrtf(ss * (1.f / 64.f) + EPS);
                    bf16_t* rp = U + (size_t)(row0 + ai * 128 + m * 16) * UW + cb;
#pragma unroll
                    for (int bj = 0; bj < 2; ++bj) *(u32x4*)(rp + 32 * bj) = pack8(acc[ai][bj][m][0] * gv[bj][0] * rs, acc[ai][bj][m][1] * gv[bj][1] * rs); }
        }
    }
};
struct EpiRes {
    const float* res; float* out;
    __device__ __forceinline__ void operator()(const AccT& acc, const pg8::Unit& u, int wr, int wc, int fr, int fq) const {
        const int row0 = u.pm * 256 + wr * 64 + fr, col0 = u.pn * 256 + wc * 32 + 4 * fq;
#pragma unroll
        for (int ai = 0; ai < 2; ++ai)
#pragma unroll
            for (int m = 0; m < 4; ++m) { const size_t ro = (size_t)(row0 + ai * 128 + m * 16) * D + col0;
#pragma unroll
                for (int bj = 0; bj < 2; ++bj)
#pragma unroll
                    for (int n = 0; n < 2; ++n) { const size_t o = ro + bj * 128 + n * 16; *(f32x4*)(out + o) = *(const f32x4*)(res + o) + acc[ai][bj][m][n]; } }
    }
};
struct EpiGlu {
    bf16_t* O; int ldc;
    __device__ __forceinline__ void operator()(const AccT& acc, const pg8::Unit& u, int wr, int wc, int fr, int fq) const {
        const int row0 = u.pm * 256 + wr * 64 + fr, cb = 128 * u.pn + wc * 32 + 8 * fq;
#pragma unroll
        for (int ai = 0; ai < 2; ++ai)
#pragma unroll
            for (int m = 0; m < 4; ++m) { f32x4 z0, z1;
#pragma unroll
                for (int i = 0; i < 4; ++i) { const float g0 = acc[ai][0][m][0][i], g1 = acc[ai][0][m][1][i]; z0[i] = g0 * fast_sigmoid(g0) * acc[ai][1][m][0][i]; z1[i] = g1 * fast_sigmoid(g1) * acc[ai][1][m][1][i]; }
                *(u32x4*)(O + (size_t)(row0 + ai * 128 + m * 16) * ldc + cb) = pack8(z0, z1); }
    }
};
struct EpiScatter {
    float* out; const int* list_s; const float* gatev_s; const LAS int* rt_info;
    __device__ __forceinline__ void operator()(const AccT& acc, const pg8::Unit& u, int wr, int wc, int fr, int fq) const {
        const int e = rt_info[3 * u.pm], i0 = rt_info[3 * u.pm + 1], nv = rt_info[3 * u.pm + 2];
        const int col0 = u.pn * 256 + wc * 32 + 4 * fq;
        const int* lst = list_s + (size_t)e * M + i0;
#pragma unroll
        for (int ai = 0; ai < 2; ++ai)
#pragma unroll
            for (int m = 0; m < 4; ++m) { const int r = ai * 128 + wr * 64 + m * 16 + fr;
                if (r < nv) { const int tok = lst[r]; const float g = gatev_s[tok]; const size_t ro = (size_t)tok * D + col0;
#pragma unroll
                    for (int bj = 0; bj < 2; ++bj)
#pragma unroll
                        for (int n = 0; n < 2; ++n) { const size_t o = ro + bj * 128 + n * 16; *(f32x4*)(out + o) = *(const f32x4*)(out + o) + acc[ai][bj][m][n] * g; } } }
    }
};
struct EpiPe {
    bf16_t* O;
    __device__ __forceinline__ void operator()(const AccT& acc, const pg8::Unit& u, int wr, int wc, int fr, int fq) const {
        const int row0 = u.pm * 256 + wr * 64 + fr, col0 = u.pn * 256 + wc * 32 + 4 * fq;
#pragma unroll
        for (int ai = 0; ai < 2; ++ai)
#pragma unroll
            for (int m = 0; m < 4; ++m) { const size_t ro = (size_t)(row0 + ai * 128 + m * 16) * D + col0;
#pragma unroll
                for (int bj = 0; bj < 2; ++bj)
#pragma unroll
                    for (int n = 0; n < 2; ++n) { const f32x4 x = acc[ai][bj][m][n]; u32x2 w; w.x = cvt_pk_bf16(x[0], x[1]); w.y = cvt_pk_bf16(x[2], x[3]); *(u32x2*)(O + ro + bj * 128 + n * 16) = w; } }
    }
};
struct EpiPle {
    float* out; const bf16_t* PE;
    __device__ __forceinline__ void operator()(const AccT& acc, const pg8::Unit& u, int wr, int wc, int fr, int fq) const {
        const int row0 = u.pm * 256 + wr * 64 + fr, col0 = u.pn * 256 + wc * 32 + 4 * fq;
#pragma unroll
        for (int ai = 0; ai < 2; ++ai)
#pragma unroll
            for (int m = 0; m < 4; ++m) { const size_t ro = (size_t)(row0 + ai * 128 + m * 16) * D + col0;
#pragma unroll
                for (int bj = 0; bj < 2; ++bj)
#pragma unroll
                    for (int n = 0; n < 2; ++n) { const size_t o = ro + bj * 128 + n * 16; const u32x2 w = *(const u32x2*)(PE + o); const f32x4 x = acc[ai][bj][m][n]; f32x4 h = *(const f32x4*)(out + o);
                        h[0] += fast_sigmoid(x[0]) * bflo(w.x); h[1] += fast_sigmoid(x[1]) * bfhi(w.x); h[2] += fast_sigmoid(x[2]) * bflo(w.y); h[3] += fast_sigmoid(x[3]) * bfhi(w.y);
                        *(f32x4*)(out + o) = h; } }
    }
};

struct MoeSched {
    pg8::StaticOrder so; const LAS int* rt_info; int ntn;
    __device__ __forceinline__ bool next(int i, pg8::Unit& u) const { if (!so.tile(i, u.pm, u.pn)) return false; u.pb = rt_info[3 * u.pm] * ntn + u.pn; return true; }
};
__device__ __forceinline__ int moe_build_tiles(Frame& F, int s, LAS int* rt_info) {
    int RT = 0;
    int cnt[8];
#pragma unroll
    for (int e = 0; e < 8; ++e) cnt[e] = (int)__hip_atomic_load((unsigned*)(F.ctl + CW_CNT + s * 8 + e), RLX_AGENT);
    if (F.tid == 0) { int rt = 0; for (int e = 0; e < 8; ++e) for (int i0 = 0; i0 < cnt[e]; i0 += 256) { rt_info[3 * rt] = e; rt_info[3 * rt + 1] = i0; rt_info[3 * rt + 2] = (cnt[e] - i0) < 256 ? (cnt[e] - i0) : 256; ++rt; } }
#pragma unroll
    for (int e = 0; e < 8; ++e) RT += (cnt[e] + 255) >> 8;
    __syncthreads();
    return RT;
}
namespace nvb {
using nv::sigmoidf_; using nv::siluf_; using nv::wsum; using nv::wmax;
__global__ void mprep(const bf16_t* U, const float* GATE, const float* cw, const float* bi, const float* bf, float* QK, float* IG, float* LF) {
    const int t = blockIdx.x, c = threadIdx.x;
    float acc = 0.f;
    for (int j = 0; j < 4; ++j) { const int tt = t - 3 + j; if (tt >= 0) acc += cw[j * 512 + c] * bf2f(U[(size_t)tt * UW + c]); }
    QK[(size_t)t * 512 + c] = siluf_(acc);
    if (c < 4) {
        IG[t * 4 + c] = GATE[(size_t)t * 8 + c] + bi[c];
        const float f = GATE[(size_t)t * 8 + 4 + c] + bf[c];
        LF[t * 4 + c] = fminf(f, 0.f) - log1pf(expf(-fabsf(f)));
    }
}
__global__ void mlstm_rec(const float* QK, const bf16_t* U, const float* IG, const float* LF, float* HM) {
    __shared__ float sq[64][64], sk[64][64], sv[64][64];
    __shared__ float sig[64], slf[64];
    __shared__ float red[2][4][64], redd[2][4][64];
    const int h = blockIdx.x, tid = threadIdx.x, e = tid & 63, dq = tid >> 6;
    float C[16], n[16]; float m = 0.f;
    for (int i = 0; i < 16; ++i) { C[i] = 0.f; n[i] = 0.f; }
    for (int t0 = 0; t0 < SEQ; t0 += 64) {
        __syncthreads();
        for (int i = tid; i < 64 * 64; i += 256) {
            const int tt = i >> 6, d = i & 63;
            sq[tt][d] = QK[(size_t)(t0 + tt) * 512 + h * 64 + d] * 0.125f;
            sk[tt][d] = QK[(size_t)(t0 + tt) * 512 + 256 + h * 64 + d];
            sv[tt][d] = bf2f(U[(size_t)(t0 + tt) * UW + UC_MV + h * 64 + d]);
        }
        if (tid < 64) { sig[tid] = IG[(t0 + tid) * 4 + h]; slf[tid] = LF[(t0 + tid) * 4 + h]; }
        __syncthreads();
        for (int tt = 0; tt < 64; ++tt) {
            const float ig = sig[tt], lf = slf[tt];
            const float mn = fmaxf(lf + m, ig), a = expf(lf + m - mn), bb = expf(ig - mn);
            m = mn;
            const float v = sv[tt][e];
            float num = 0.f, den = 0.f;
#pragma unroll
            for (int i = 0; i < 16; ++i) {
                const int d = dq * 16 + i; const float k = sk[tt][d], q = sq[tt][d];
                C[i] = a * C[i] + bb * k * v; n[i] = a * n[i] + bb * k;
                num += q * C[i]; den += q * n[i];
            }
            red[tt & 1][dq][e] = num; redd[tt & 1][dq][e] = den;
            __syncthreads();
            if (dq == 0) {
                const float nu = red[tt & 1][0][e] + red[tt & 1][1][e] + red[tt & 1][2][e] + red[tt & 1][3][e];
                const float de = redd[tt & 1][0][e] + redd[tt & 1][1][e] + redd[tt & 1][2][e] + redd[tt & 1][3][e];
                HM[(size_t)(t0 + tt) * 256 + h * 64 + e] = nu / fmaxf(fabsf(de), expf(-m));
            }
        }
    }
}
__global__ void mgate(const float* HMN, const bf16_t* U, bf16_t* Y) {
    const int t = blockIdx.x, c = threadIdx.x;
    Y[(size_t)t * D + c] = (bf16_t)f2bf(HMN[(size_t)t * 256 + c] * sigmoidf_(bf2f(U[(size_t)t * UW + UC_MO + c])));
}
__global__ void cconv(const bf16_t* U, const float* w, const float* b, const float* lg, const float* lb, bf16_t* Y) {
    __shared__ float sm[4], sv2[4];
    const int t = blockIdx.x, c = threadIdx.x;
    float acc = b[c];
    for (int j = 0; j < 31; ++j) { const int tt = t - 30 + j; if (tt >= 0) acc += w[j * 256 + c] * bf2f(U[(size_t)tt * UW + UC_Z + c]); }
    float s = wsum(acc);
    if ((c & 63) == 0) sm[c >> 6] = s;
    __syncthreads();
    const float mu = (sm[0] + sm[1] + sm[2] + sm[3]) * (1.f / 256.f);
    const float dv = acc - mu;
    float s2 = wsum(dv * dv);
    if ((c & 63) == 0) sv2[c >> 6] = s2;
    __syncthreads();
    const float var = (sv2[0] + sv2[1] + sv2[2] + sv2[3]) * (1.f / 256.f);
    const float yv = dv * rsqrtf(var + 1e-6f) * lg[c] + lb[c];
    Y[(size_t)t * D + 256 + c] = (bf16_t)f2bf(siluf_(yv));
}
__global__ void attn(const bf16_t* U, float* O) {
    __shared__ float sK[64][65];
    __shared__ float sV[64][128];
    __shared__ float sQ[16][64];
    __shared__ float sP[16][64];
    const int j = blockIdx.y, hd = j >> 1, q0 = blockIdx.x * 16, tid = threadIdx.x, w = tid >> 6, lane = tid & 63;
    const int qpos = q0 + w;
    const float slope2 = exp2f(-8.f * (float)(hd + 1) / 4.f) * 1.4426950408889634f;
    sQ[w][lane] = bf2f(U[(size_t)qpos * UW + UC_Q + j * 64 + lane]);
    float m = -INFINITY, l = 0.f, o0 = 0.f, o1 = 0.f;
    const int ntile = (q0 + 15) / 64 + 1;
    for (int kt = 0; kt < ntile; ++kt) {
        __syncthreads();
        for (int i = tid; i < 64 * 64; i += 1024) { const int r = i >> 6, d = i & 63; sK[r][d] = bf2f(U[(size_t)(kt * 64 + r) * UW + UC_K + j * 64 + d]); }
        for (int i = tid; i < 64 * 128; i += 1024) { const int r = i >> 7, d = i & 127; sV[r][d] = bf2f(U[(size_t)(kt * 64 + r) * UW + UC_V + hd * 128 + d]); }
        __syncthreads();
        const int kpos = kt * 64 + lane;
        float s = 0.f;
        for (int d = 0; d < 64; ++d) s += sQ[w][d] * sK[lane][d];
        s = s - slope2 * (float)(qpos - kpos);
        if (kpos > qpos) s = -INFINITY;
        const float tm = wmax(s), mn = fmaxf(m, tm), corr = exp2f(m - mn), p = exp2f(s - mn);
        l = l * corr + wsum(p); o0 *= corr; o1 *= corr; m = mn;
        sP[w][lane] = p;
        __syncthreads();
        for (int k = 0; k < 64; ++k) { const float pk = sP[w][k]; o0 += pk * sV[k][lane]; o1 += pk * sV[k][64 + lane]; }
    }
    O[((size_t)qpos * 8 + j) * 128 + lane] = o0 / l;
    O[((size_t)qpos * 8 + j) * 128 + 64 + lane] = o1 / l;
}
__global__ void subln(const float* YA, const float* gain, float scale, bf16_t* Y) {
    const int rg = blockIdx.x, row = rg >> 2, g = rg & 3, lane = threadIdx.x;
    const float* x = YA + (size_t)row * 512 + g * 128;
    const float a = x[lane], b = x[64 + lane];
    const float r = rsqrtf(wsum(a * a + b * b) / 128.f + 1e-6f);
    Y[(size_t)row * D + 512 + g * 128 + lane] = (bf16_t)f2bf(a * r * gain[lane] * scale);
    Y[(size_t)row * D + 512 + g * 128 + 64 + lane] = (bf16_t)f2bf(b * r * gain[64 + lane] * scale);
}
static void mixers(void* const* d_in, unsigned char* ws, int L, hipStream_t st, int mask) {
    const float* const* in = (const float* const*)d_in;
    unsigned char* tail = ws + WS_BIG + 176 * MiB;
    float* QK = (float*)tail; float* HM = (float*)(tail + 16 * MiB); float* HMN = (float*)(tail + 24 * MiB); float* AO = (float*)tail;
    float* YA = (float*)(tail + 32 * MiB); float* IG = (float*)(tail + 48 * MiB); float* LF = (float*)(tail + 49 * MiB);
    const float lam_init = 0.8f - 0.6f * expf(-0.3f * (float)L);
    for (int b = 0; b < NB; ++b) {
        const bf16_t* U = (const bf16_t*)(ws + WS_BIG) + (size_t)b * SEQ * UW;
        const float* GATE = (const float*)(ws + WS_GATE) + (size_t)b * SEQ * 8;
        bf16_t* Y = (bf16_t*)(ws + WS_AY) + (size_t)b * SEQ * D;
        if (mask & 1) {
        hipLaunchKernelGGL(mprep, dim3(SEQ), dim3(512), 0, st, U, GATE, in[6] + L * 2048, in[4] + L * 4, in[5] + L * 4, QK, IG, LF);
        hipLaunchKernelGGL(mlstm_rec, dim3(4), dim3(256), 0, st, (const float*)QK, U, (const float*)IG, (const float*)LF, HM);
        hipLaunchKernelGGL(nv::groupnorm, dim3(SEQ * 4), dim3(64), 0, st, (const float*)HM, 256, HMN, 256, 4, 64, in[7] + L * 256, 64, 1.f);
        hipLaunchKernelGGL(mgate, dim3(SEQ), dim3(256), 0, st, (const float*)HMN, U, Y);
        }
        if (mask & 2)
        hipLaunchKernelGGL(cconv, dim3(SEQ), dim3(256), 0, st, U, in[8] + L * 31 * 256, in[9] + L * 256, in[10] + L * 256, in[11] + L * 256, Y);
        if (mask & 4) {
        hipLaunchKernelGGL(attn, dim3(SEQ / 16, 8), dim3(1024), 0, st, U, AO);
        hipLaunchKernelGGL(nv::acomb, dim3(SEQ), dim3(512), 0, st, (const float*)AO, in[14] + L * 64, in[15] + L * 64, in[16] + L * 64, in[17] + L * 64, lam_init, YA);
        hipLaunchKernelGGL(subln, dim3(SEQ * 4), dim3(64), 0, st, (const float*)YA, in[18] + L * 128, 1.f - lam_init, Y);
        }
    }
}
}
typedef float f32x16 __attribute__((ext_vector_type(16)));
typedef short s16x4 __attribute__((ext_vector_type(4)));
typedef short v4i16_t __attribute__((ext_vector_type(4)));
#define MFMA32(a, b, c) __builtin_amdgcn_mfma_f32_32x32x16_bf16((a), (b), (c), 0, 0, 0)
__device__ __forceinline__ int crow(int r, int hi) { return (r & 3) + 8 * (r >> 2) + 4 * hi; }
__device__ __forceinline__ float fast_silu(float x) { return x * fast_sigmoid(x); }
__device__ __forceinline__ s16x4 tr_read(const LAS unsigned char* p) { return __builtin_bit_cast(s16x4, __builtin_amdgcn_ds_read_tr16_b64_v4i16((LAS v4i16_t*)p)); }
__device__ __forceinline__ bf16x8 tr_frag(const LAS unsigned char* T, int row0, int step2, int c0, int lane) {
    const int q = (lane & 15) >> 2, p = lane & 3, cg = (lane >> 4) & 1;
    const LAS unsigned char* a = T + (row0 + q) * 128 + (c0 + 16 * cg + 4 * p) * 2;
    const s16x4 lo = tr_read(a), hi = tr_read(a + step2 * 128);
    return (bf16x8){lo[0], lo[1], lo[2], lo[3], hi[0], hi[1], hi[2], hi[3]};
}

__device__ __forceinline__ void conformer_phase(Frame& F, int L) {
    const bf16_t* U = (const bf16_t*)(F.ws + WS_BIG); bf16_t* Y = (bf16_t*)(F.ws + WS_AY);
    const float* cw = F.in[8] + L * 31 * 256; const float* cb = F.in[9] + L * 256; const float* lg = F.in[10] + L * 256; const float* lb = F.in[11] + L * 256;
    LAS unsigned char* zt = F.lds;
    LAS float* ot = (LAS float*)(F.lds + 49152);
    const int tid = F.tid, c = tid & 255, hf = tid >> 8;
    float w[31];
#pragma unroll
    for (int j = 0; j < 31; ++j) w[j] = cw[j * 256 + c];
    const float bias = cb[c];
    for (int unit = F.vcu; unit < M / 64; unit += F.G) {
        const int row0 = unit * 64, t0 = row0 & (SEQ - 1);
        __syncthreads();
        for (int i = tid; i < 94 * 32; i += NWAVES * 64) { const int r = i >> 5, ch = i & 31; u32x4 v = (u32x4){0u, 0u, 0u, 0u};
            if (t0 - 30 + r >= 0) v = *(const GAS u32x4*)(U + (size_t)(row0 - 30 + r) * UW + UC_Z + ch * 8);
            *(LAS u32x4*)(zt + r * 512 + ch * 16) = v; }
        __syncthreads();
        float acc[32];
#pragma unroll
        for (int o = 0; o < 32; ++o) acc[o] = bias;
#pragma unroll
        for (int i = 0; i < 62; ++i) { const float x = bf2f(*(const LAS unsigned short*)(zt + (32 * hf + i) * 512 + c * 2));
#pragma unroll
            for (int o = 0; o < 32; ++o) { const int j = i - o; if (j >= 0 && j < 31) acc[o] += w[j] * x; } }
#pragma unroll
        for (int o = 0; o < 32; ++o) ot[(32 * hf + o) * 260 + c] = acc[o];
        __syncthreads();
        const f32x4 g4 = *(const f32x4*)(lg + 4 * F.lane), b4 = *(const f32x4*)(lb + 4 * F.lane);
#pragma unroll 2
        for (int tt = 0; tt < 8; ++tt) { const int t = F.wave * 8 + tt;
            const f32x4 x = *(const LAS f32x4*)(ot + t * 260 + 4 * F.lane);
            const float mu = wave_sum((x[0] + x[1]) + (x[2] + x[3])) * (1.f / 256.f);
            const f32x4 dv = x - mu;
            const float var = wave_sum((dv[0] * dv[0] + dv[1] * dv[1]) + (dv[2] * dv[2] + dv[3] * dv[3])) * (1.f / 256.f);
            const float rstd = 1.0f / sqrtf(var + EPS);
            f32x4 y = dv * rstd * g4 + b4;
#pragma unroll
            for (int i = 0; i < 4; ++i) y[i] = fast_silu(y[i]);
            u32x2 o; o.x = cvt_pk_bf16(y[0], y[1]); o.y = cvt_pk_bf16(y[2], y[3]);
            *(GAS u32x2*)(Y + (size_t)(row0 + t) * D + 256 + 4 * F.lane) = o; }
    }
    __syncthreads();
}

constexpr size_t MST_N = (size_t)2048 * 4096 * 4, MST_MG = MST_N + (size_t)2048 * 64 * 4, MST_MP = MST_MG + (size_t)2048 * 2 * 4;
template <bool NEEDQ>
__device__ __forceinline__ void mlstm_load(const bf16_t* U, const float* cw, int row0, int t0, int h, int lane, float kscale, float qscale, LAS unsigned char* qt, LAS unsigned char* kt, LAS unsigned char* vt) {
    { const GAS u32x4* vp = (const GAS u32x4*)(U + (size_t)(row0 + lane) * UW + UC_MV + h * 64);
#pragma unroll
      for (int i = 0; i < 8; ++i) *(LAS u32x4*)(vt + lane * 128 + i * 16) = vp[i]; }
#pragma unroll
    for (int which = NEEDQ ? 0 : 1; which < 2; ++which) {
        const int col = (which ? UC_MK : UC_MQ) + h * 64; const float* wv = cw + (which ? 256 : 0) + h * 64; LAS unsigned char* dst = which ? kt : qt; const float sc = which ? kscale : qscale;
#pragma unroll
        for (int i = 0; i < 8; ++i) {
            float acc[8];
#pragma unroll
            for (int d = 0; d < 8; ++d) acc[d] = 0.f;
#pragma unroll
            for (int j = 0; j < 4; ++j) { u32x4 x = (u32x4){0u, 0u, 0u, 0u};
                if (t0 + lane - 3 + j >= 0) x = *(const GAS u32x4*)(U + (size_t)(row0 + lane - 3 + j) * UW + col + i * 8);
                const float* wj = wv + j * 512 + i * 8;
                acc[0] += wj[0] * bflo(x.x); acc[1] += wj[1] * bfhi(x.x); acc[2] += wj[2] * bflo(x.y); acc[3] += wj[3] * bfhi(x.y);
                acc[4] += wj[4] * bflo(x.z); acc[5] += wj[5] * bfhi(x.z); acc[6] += wj[6] * bflo(x.w); acc[7] += wj[7] * bfhi(x.w); }
#pragma unroll
            for (int d = 0; d < 8; ++d) acc[d] = fast_silu(acc[d]) * sc;
            u32x4 o; o.x = cvt_pk_bf16(acc[0], acc[1]); o.y = cvt_pk_bf16(acc[2], acc[3]); o.z = cvt_pk_bf16(acc[4], acc[5]); o.w = cvt_pk_bf16(acc[6], acc[7]);
            *(LAS u32x4*)(dst + lane * 128 + i * 16) = o; }
    }
}
__device__ __forceinline__ void mlstm_gates(const float* GATE, const float* bi, const float* bfg, int row0, int h, int lane, float& ig, float& bcum, float& g) {
    ig = GATE[(size_t)(row0 + lane) * 8 + h] + bi[h];
    const float f = GATE[(size_t)(row0 + lane) * 8 + 4 + h] + bfg[h];
    float lf = fminf(f, 0.f) - log1pf(__expf(-fabsf(f)));
#pragma unroll
    for (int o = 1; o < 64; o <<= 1) { const float t = __shfl_up(lf, o); if (lane >= o) lf += t; }
    bcum = lf; g = __shfl(lf, 63);
}

__device__ __forceinline__ void mlstm_local_phase(Frame& F, int L) {
    const bf16_t* U = (const bf16_t*)(F.ws + WS_BIG); const float* GATE = (const float*)(F.ws + WS_GATE);
    float* Cst = (float*)(F.ws + WS_MST); float* Nst = (float*)(F.ws + WS_MST + MST_N); float* MG = (float*)(F.ws + WS_MST + MST_MG);
    const float* cw = F.in[6] + L * 2048; const float* bi = F.in[4] + L * 4; const float* bfg = F.in[5] + L * 4;
    LAS unsigned char* kt = F.lds + F.wave * 16384; LAS unsigned char* vt = kt + 8192;
    const int lane = F.lane, r32 = lane & 31, half = lane >> 5;
    for (int unit = F.vcu * NWAVES + F.wave; unit < 2048; unit += F.G * NWAVES) {
        const int h = unit & 3, bc = unit >> 2, row0 = bc * 64, t0 = row0 & (SEQ - 1);
        float ig, bcum, g; mlstm_gates(GATE, bi, bfg, row0, h, lane, ig, bcum, g);
        const float wl = g - bcum + ig, ml = wave_max(wl), el = __expf(wl - ml);
        mlstm_load<false>(U, cw, row0, t0, h, lane, el, 1.f, nullptr, kt, vt);
        LDS_WAIT(); asm volatile("" ::: "memory");
        f32x16 acc[2][2], nacc[2];
#pragma unroll
        for (int db = 0; db < 2; ++db) { nacc[db] = f32x16{};
#pragma unroll
            for (int eb = 0; eb < 2; ++eb) acc[db][eb] = f32x16{}; }
        const bf16x8 ones = (bf16x8){0x3F80, 0x3F80, 0x3F80, 0x3F80, 0x3F80, 0x3F80, 0x3F80, 0x3F80};
#pragma unroll
        for (int ks = 0; ks < 4; ++ks) {
            bf16x8 a[2], b[2];
#pragma unroll
            for (int db = 0; db < 2; ++db) a[db] = tr_frag(kt, 16 * ks + 8 * half, 4, 32 * db, lane);
#pragma unroll
            for (int eb = 0; eb < 2; ++eb) b[eb] = tr_frag(vt, 16 * ks + 8 * half, 4, 32 * eb, lane);
#pragma unroll
            for (int db = 0; db < 2; ++db) { nacc[db] = MFMA32(a[db], ones, nacc[db]);
#pragma unroll
                for (int eb = 0; eb < 2; ++eb) acc[db][eb] = MFMA32(a[db], b[eb], acc[db][eb]); }
        }
        float* Cu = Cst + (size_t)unit * 4096;
#pragma unroll
        for (int db = 0; db < 2; ++db)
#pragma unroll
            for (int eb = 0; eb < 2; ++eb)
#pragma unroll
                for (int r = 0; r < 16; ++r) Cu[(32 * db + crow(r, half)) * 64 + 32 * eb + r32] = acc[db][eb][r];
        if (r32 == 0) {
#pragma unroll
            for (int db = 0; db < 2; ++db)
#pragma unroll
                for (int r = 0; r < 16; ++r) Nst[(size_t)unit * 64 + 32 * db + crow(r, half)] = nacc[db][r];
        }
        if (lane == 0) { MG[unit * 2] = ml; MG[unit * 2 + 1] = g; }
        LDS_WAIT(); asm volatile("" ::: "memory");
    }
}

__device__ __forceinline__ void mlstm_scan_phase(Frame& F) {
    float* Cst = (float*)(F.ws + WS_MST); float* Nst = (float*)(F.ws + WS_MST + MST_N); float* MG = (float*)(F.ws + WS_MST + MST_MG);
    float* MP = (float*)(F.ws + WS_MST + MST_MP);
    const int gw = F.vcu * NWAVES + F.wave; if (gw >= 1024 + 16) return;
    const bool isn = gw >= 1024;
    const int bh = isn ? gw - 1024 : gw >> 6, b = bh >> 2, h = bh & 3, el = isn ? F.lane : (gw & 63) * 64 + F.lane;
    float st = 0.f, m = 0.f;
    for (int c0 = 0; c0 < 128; c0 += 8) {
        float x[8], ml[8], gg[8];
#pragma unroll
        for (int i = 0; i < 8; ++i) { const int unit = (b * 128 + c0 + i) * 4 + h;
            x[i] = isn ? Nst[(size_t)unit * 64 + el] : Cst[(size_t)unit * 4096 + el]; ml[i] = MG[unit * 2]; gg[i] = MG[unit * 2 + 1]; }
#pragma unroll
        for (int i = 0; i < 8; ++i) { const int unit = (b * 128 + c0 + i) * 4 + h;
            const float mn = fmaxf(gg[i] + m, ml[i]), a = __expf(gg[i] + m - mn), bb = __expf(ml[i] - mn);
            if (isn) { Nst[(size_t)unit * 64 + el] = st; } else Cst[(size_t)unit * 4096 + el] = st;
            st = a * st + bb * x[i];
            if (isn && F.lane == 0) MP[unit] = m;
            m = mn; }
    }
}

__device__ __forceinline__ void mlstm_out_phase(Frame& F, int L) {
    const bf16_t* U = (const bf16_t*)(F.ws + WS_BIG); const float* GATE = (const float*)(F.ws + WS_GATE); bf16_t* Y = (bf16_t*)(F.ws + WS_AY);
    const float* Cst = (const float*)(F.ws + WS_MST); const float* Nst = (const float*)(F.ws + WS_MST + MST_N); const float* MP = (const float*)(F.ws + WS_MST + MST_MP);
    const float* cw = F.in[6] + L * 2048; const float* bi = F.in[4] + L * 4; const float* bfg = F.in[5] + L * 4; const float* gm = F.in[7] + L * 256;
    if (F.wave >= 4) return;
    LAS unsigned char* qt = F.lds + F.wave * 32768; LAS unsigned char* kt = qt + 8192; LAS unsigned char* vt = qt + 16384; LAS unsigned char* ct = qt + 24576;
    LAS float* sc = (LAS float*)(F.lds + TAB_OFF + F.wave * 1024);
    const int lane = F.lane, r32 = lane & 31, half = lane >> 5;
    for (int unit = F.vcu * 4 + F.wave; unit < 2048; unit += F.G * 4) {
        const int h = unit & 3, bc = unit >> 2, row0 = bc * 64, t0 = row0 & (SEQ - 1);
        float ig, bcum, g; mlstm_gates(GATE, bi, bfg, row0, h, lane, ig, bcum, g);
        const float mprev = MP[unit];
        const float wv = ig - bcum; float pm = wv;
#pragma unroll
        for (int o = 1; o < 64; o <<= 1) { const float t = __shfl_up(pm, o); if (lane >= o) pm = fmaxf(pm, t); }
        const float mml = fmaxf(mprev, pm);
        mlstm_load<true>(U, cw, row0, t0, h, lane, 1.f, 0.125f, qt, kt, vt);
        { const GAS f32x4* cp = (const GAS f32x4*)(Cst + (size_t)unit * 4096 + lane * 64);
#pragma unroll
          for (int i = 0; i < 8; ++i) { const f32x4 a = cp[2 * i], b = cp[2 * i + 1]; *(LAS u32x4*)(ct + lane * 128 + i * 16) = pack8(a, b); } }
        LDS_WAIT(); asm volatile("" ::: "memory");
        float d2 = 0.f;
#pragma unroll
        for (int i = 0; i < 8; ++i) { const u32x4 qv = *(const LAS u32x4*)(qt + lane * 128 + i * 16); const float* np = Nst + (size_t)unit * 64 + i * 8;
            d2 += bflo(qv.x) * np[0] + bfhi(qv.x) * np[1] + bflo(qv.y) * np[2] + bfhi(qv.y) * np[3] + bflo(qv.z) * np[4] + bfhi(qv.z) * np[5] + bflo(qv.w) * np[6] + bfhi(qv.w) * np[7]; }
        sc[lane] = mml; sc[64 + lane] = bcum; sc[128 + lane] = wv; sc[192 + lane] = d2;
        LDS_WAIT(); asm volatile("" ::: "memory");
        f32x16 S00 = f32x16{}, S01 = f32x16{}, S11 = f32x16{};
#pragma unroll
        for (int ks = 0; ks < 4; ++ks) {
            const int ko = (16 * ks + 8 * half) * 2;
            const bf16x8 k0 = *(const LAS bf16x8*)(kt + r32 * 128 + ko), k1 = *(const LAS bf16x8*)(kt + (32 + r32) * 128 + ko);
            const bf16x8 q0 = *(const LAS bf16x8*)(qt + r32 * 128 + ko), q1 = *(const LAS bf16x8*)(qt + (32 + r32) * 128 + ko);
            S00 = MFMA32(k0, q0, S00); S01 = MFMA32(k0, q1, S01); S11 = MFMA32(k1, q1, S11);
        }
        const float mm0 = sc[r32], mm1 = sc[32 + r32];
        float dn0 = 0.f, dn1 = 0.f;
#pragma unroll
        for (int r = 0; r < 16; ++r) { const int s0 = crow(r, half); const float w0 = sc[128 + s0], w1 = sc[128 + 32 + s0];
            const float a = (s0 <= r32) ? S00[r] * __expf(w0 - mm0) : 0.f; S00[r] = a; dn0 += a;
            const float b = S01[r] * __expf(w0 - mm1); S01[r] = b; dn1 += b;
            const float c = (s0 <= r32) ? S11[r] * __expf(w1 - mm1) : 0.f; S11[r] = c; dn1 += c; }
        dn0 += __shfl_xor(dn0, 32); dn1 += __shfl_xor(dn1, 32);
        f32x16 N[2][2], Mx[2][2];
#pragma unroll
        for (int eb = 0; eb < 2; ++eb)
#pragma unroll
            for (int lb = 0; lb < 2; ++lb) { N[eb][lb] = f32x16{}; Mx[eb][lb] = f32x16{}; }
#pragma unroll
        for (int kk = 0; kk < 2; ++kk) {
            bf16x8 p00, p01, p11;
            { u32x4 t; t.x = cvt_pk_bf16(S00[8 * kk], S00[8 * kk + 1]); t.y = cvt_pk_bf16(S00[8 * kk + 2], S00[8 * kk + 3]); t.z = cvt_pk_bf16(S00[8 * kk + 4], S00[8 * kk + 5]); t.w = cvt_pk_bf16(S00[8 * kk + 6], S00[8 * kk + 7]); p00 = __builtin_bit_cast(bf16x8, t); }
            { u32x4 t; t.x = cvt_pk_bf16(S01[8 * kk], S01[8 * kk + 1]); t.y = cvt_pk_bf16(S01[8 * kk + 2], S01[8 * kk + 3]); t.z = cvt_pk_bf16(S01[8 * kk + 4], S01[8 * kk + 5]); t.w = cvt_pk_bf16(S01[8 * kk + 6], S01[8 * kk + 7]); p01 = __builtin_bit_cast(bf16x8, t); }
            { u32x4 t; t.x = cvt_pk_bf16(S11[8 * kk], S11[8 * kk + 1]); t.y = cvt_pk_bf16(S11[8 * kk + 2], S11[8 * kk + 3]); t.z = cvt_pk_bf16(S11[8 * kk + 4], S11[8 * kk + 5]); t.w = cvt_pk_bf16(S11[8 * kk + 6], S11[8 * kk + 7]); p11 = __builtin_bit_cast(bf16x8, t); }
#pragma unroll
            for (int eb = 0; eb < 2; ++eb) {
                const bf16x8 v0 = tr_frag(vt, 16 * kk + 4 * half, 8, 32 * eb, lane), v1 = tr_frag(vt, 32 + 16 * kk + 4 * half, 8, 32 * eb, lane);
                N[eb][0] = MFMA32(v0, p00, N[eb][0]); N[eb][1] = MFMA32(v0, p01, N[eb][1]); N[eb][1] = MFMA32(v1, p11, N[eb][1]);
            }
        }
#pragma unroll
        for (int ks = 0; ks < 4; ++ks) {
            const int ko = (16 * ks + 8 * half) * 2;
            const bf16x8 q0 = *(const LAS bf16x8*)(qt + r32 * 128 + ko), q1 = *(const LAS bf16x8*)(qt + (32 + r32) * 128 + ko);
#pragma unroll
            for (int eb = 0; eb < 2; ++eb) { const bf16x8 cf = tr_frag(ct, 16 * ks + 8 * half, 4, 32 * eb, lane);
                Mx[eb][0] = MFMA32(cf, q0, Mx[eb][0]); Mx[eb][1] = MFMA32(cf, q1, Mx[eb][1]); }
        }
#pragma unroll
        for (int lb = 0; lb < 2; ++lb) {
            const int l = 32 * lb + r32; const float mm = lb ? mm1 : mm0, is = __expf(mprev - mm), den = (lb ? dn1 : dn0) + is * sc[192 + l];
            const float mout = sc[64 + l] + mm, rden = 1.0f / fmaxf(fabsf(den), __expf(-mout));
            float o[2][16]; float ss = 0.f;
#pragma unroll
            for (int eb = 0; eb < 2; ++eb)
#pragma unroll
                for (int r = 0; r < 16; ++r) { const float x = (N[eb][lb][r] + is * Mx[eb][lb][r]) * rden; o[eb][r] = x; ss += x * x; }
            ss += __shfl_xor(ss, 32);
            const float rs = 1.0f / sqrtf(ss * (1.f / 64.f) + EPS);
            const bf16_t* mo = U + (size_t)(row0 + l) * UW + UC_MO + h * 64; bf16_t* yo = Y + (size_t)(row0 + l) * D + h * 64;
#pragma unroll
            for (int eb = 0; eb < 2; ++eb)
#pragma unroll
                for (int gq = 0; gq < 4; ++gq) { const int e0 = 32 * eb + 8 * gq + 4 * half;
                    const f32x4 gv = *(const f32x4*)(gm + h * 64 + e0); const u32x2 mv = *(const GAS u32x2*)(mo + e0);
                    const float y0 = o[eb][4 * gq] * rs * gv[0] * fast_sigmoid(bflo(mv.x)), y1 = o[eb][4 * gq + 1] * rs * gv[1] * fast_sigmoid(bfhi(mv.x));
                    const float y2 = o[eb][4 * gq + 2] * rs * gv[2] * fast_sigmoid(bflo(mv.y)), y3 = o[eb][4 * gq + 3] * rs * gv[3] * fast_sigmoid(bfhi(mv.y));
                    u32x2 w; w.x = cvt_pk_bf16(y0, y1); w.y = cvt_pk_bf16(y2, y3); *(GAS u32x2*)(yo + e0) = w; }
        }
        LDS_WAIT(); asm volatile("" ::: "memory");
    }
}
constexpr int AT_SLOT = 32768, AT_K2 = 8192, AT_V = 16384;
__device__ __forceinline__ void attn_dma_tile(const bf16_t* Ub  , int hd, int k0, LAS unsigned char* slot, int wave, int lane) {
#pragma unroll
    for (int i = 0; i < 4; ++i) {
        const int id = 4 * wave + i;
        const bf16_t* src; LAS unsigned char* dst;
        if (id < 16) { const int m = id >> 3, c = id & 7; src = Ub + (size_t)(k0 + lane) * UW + UC_K + (2 * hd + m) * 64 + 8 * c; dst = slot + m * AT_K2 + c * 1024; }
        else { const int db = (id - 16) >> 2, rq = (id - 16) & 3; src = Ub + (size_t)(k0 + 16 * rq + (lane >> 2)) * UW + UC_V + hd * 128 + 32 * db + 8 * (lane & 3); dst = slot + AT_V + db * 4096 + rq * 1024; }
        __builtin_amdgcn_global_load_lds((const unsigned*)src, (LAS unsigned*)dst, 16, 0, 0);
    }
}
__device__ __forceinline__ void attn_phase(Frame& F, int L) {
    const bf16_t* U = (const bf16_t*)(F.ws + WS_BIG); bf16_t* Y = (bf16_t*)(F.ws + WS_AY);
    const int lane = F.lane, r32 = lane & 31, half = lane >> 5, wave = F.wave, mi = wave >> 2, sb = wave & 3;
    const float lam_init = 0.8f - 0.6f * __expf(-0.3f * (float)L);
    const float lam = __expf(wave_sum(F.in[14][L * 64 + lane] * F.in[15][L * 64 + lane])) - __expf(wave_sum(F.in[16][L * 64 + lane] * F.in[17][L * 64 + lane])) + lam_init;
    const float M2 = 64.f * C2 * 1.01f * wave_max(fabsf(F.in[12][L * 64 + lane])) * wave_max(fabsf(F.in[13][L * 64 + lane]));
    const float* gsub = F.in[18] + L * 128;
    LAS float* lsc = (LAS float*)(F.lds + TAB_OFF) + wave * 32;
    LAS float* xch = (LAS float*)F.lds;
    const float Sb = M2;
    unsigned* queue = (unsigned*)(F.ctl + CW_QATT + L);
    LAS int* qslot = (LAS int*)(F.lds + TAB_OFF + 2048);
    if (F.tid == 0) qslot[0] = (int)__hip_atomic_fetch_add(queue, 1u, RLX_AGENT);
    __syncthreads();
    int u = __builtin_amdgcn_readfirstlane(qslot[0]);
    while (u < 1024) {
        const int hd = 3 - (u >> 8), qb = 63 - ((u & 255) >> 2), b = u & 3;
        const int q0 = qb * 128, qs = q0 + 32 * sb, nkt = 2 * qb + 2;
        const float slope2 = exp2f(-2.f * (float)(hd + 1)) * 1.4426950408889634f;
        const float Wf = ceilf((2.f * Sb + 24.f - log2f(1.f - exp2f(-slope2))) / slope2);
        int kt_lo = 0; if ((float)q0 > Wf) kt_lo = (q0 - (int)Wf) >> 6;
        const bf16_t* Ub = U + (size_t)b * SEQ * UW;
        bf16x8 qf[4];
#pragma unroll
        for (int ks = 0; ks < 4; ++ks) qf[ks] = *(const GAS bf16x8*)(Ub + (size_t)(qs + r32) * UW + UC_Q + (2 * hd + mi) * 64 + 16 * ks + 8 * half);
        attn_dma_tile(Ub, hd, kt_lo * 64, F.lds, wave, lane);
        attn_dma_tile(Ub, hd, kt_lo * 64 + 64, F.lds + AT_SLOT, wave, lane);
        f32x16 o[4];
#pragma unroll
        for (int db = 0; db < 4; ++db) o[db] = f32x16{};
        float lsum = 0.f;
        const float rowc = -slope2 * (float)(qs + r32) - M2;
        int slot = 0;
        for (int kt = kt_lo; kt < nkt; ++kt) {
            if (kt + 1 < nkt) asm volatile("s_waitcnt vmcnt(4)" ::: "memory"); else asm volatile("s_waitcnt vmcnt(0)" ::: "memory");
            __builtin_amdgcn_s_barrier();
            asm volatile("" ::: "memory");
            if (kt + 2 < nkt) { const int s2 = slot >= 1 ? slot - 1 : 2; attn_dma_tile(Ub, hd, (kt + 2) * 64, F.lds + s2 * AT_SLOT, wave, lane); }
            const LAS unsigned char* sl = F.lds + slot * AT_SLOT;
            slot = (slot == 2) ? 0 : slot + 1;
            const int k0 = kt * 64;
            if (k0 > qs + 31) continue;
            f32x16 p0, p1;
            { const float base = rowc + slope2 * (float)(k0 + 4 * half);
#pragma unroll
              for (int r = 0; r < 16; ++r) { p0[r] = base + slope2 * (float)((r & 3) + 8 * (r >> 2)); p1[r] = p0[r] + 32.f * slope2; } }
            const LAS unsigned char* kim = sl + mi * AT_K2 + r32 * 16 + half * 1024;
#pragma unroll
            for (int ks = 0; ks < 4; ++ks) {
                const bf16x8 kf0 = *(const LAS bf16x8*)(kim + ks * 2048), kf1 = *(const LAS bf16x8*)(kim + ks * 2048 + 512);
                p0 = MFMA32(kf0, qf[ks], p0); p1 = MFMA32(kf1, qf[ks], p1);
            }
            if (k0 + 63 > qs) {
                const int qrel = qs + r32 - k0 - 4 * half;
#pragma unroll
                for (int r = 0; r < 16; ++r) { const int kr = (r & 3) + 8 * (r >> 2); if (kr > qrel) p0[r] = -INFINITY; if (kr + 32 > qrel) p1[r] = -INFINITY; }
            }
            float ls = 0.f;
#pragma unroll
            for (int r = 0; r < 16; ++r) { p0[r] = __builtin_amdgcn_exp2f(p0[r]); p1[r] = __builtin_amdgcn_exp2f(p1[r]); ls += p0[r] + p1[r]; }
            lsum += ls;
            const LAS unsigned char* vim = sl + AT_V + (4 * half + ((lane & 15) >> 2)) * 64 + (16 * ((lane >> 4) & 1) + 4 * (lane & 3)) * 2;
#pragma unroll
            for (int ks = 0; ks < 4; ++ks) {
                u32x4 t;
                if (ks < 2) { t.x = cvt_pk_bf16(p0[8 * ks], p0[8 * ks + 1]); t.y = cvt_pk_bf16(p0[8 * ks + 2], p0[8 * ks + 3]); t.z = cvt_pk_bf16(p0[8 * ks + 4], p0[8 * ks + 5]); t.w = cvt_pk_bf16(p0[8 * ks + 6], p0[8 * ks + 7]); }
                else { const int k2 = ks - 2; t.x = cvt_pk_bf16(p1[8 * k2], p1[8 * k2 + 1]); t.y = cvt_pk_bf16(p1[8 * k2 + 2], p1[8 * k2 + 3]); t.z = cvt_pk_bf16(p1[8 * k2 + 4], p1[8 * k2 + 5]); t.w = cvt_pk_bf16(p1[8 * k2 + 6], p1[8 * k2 + 7]); }
                const bf16x8 pf = __builtin_bit_cast(bf16x8, t);
#pragma unroll
                for (int db = 0; db < 4; ++db) {
                    const LAS unsigned char* a = vim + db * 4096 + ks * 1024;
                    const s16x4 lo = tr_read(a), hi = tr_read(a + 512);
                    const bf16x8 vf = (bf16x8){lo[0], lo[1], lo[2], lo[3], hi[0], hi[1], hi[2], hi[3]};
                    o[db] = MFMA32(pf, vf, o[db]);
                }
            }
        }
        lsum += __shfl_xor(lsum, 32);
        asm volatile("s_waitcnt vmcnt(0) lgkmcnt(0)" ::: "memory");
        __builtin_amdgcn_s_barrier();
        asm volatile("" ::: "memory");
        if (half == 0) lsc[r32] = lsum;
        LDS_WAIT(); asm volatile("" ::: "memory");
        float rl[16];
#pragma unroll
        for (int r = 0; r < 16; ++r) rl[r] = __builtin_amdgcn_rcpf(lsc[crow(r, half)]);
        if (mi == 1) {
#pragma unroll
            for (int db = 0; db < 4; ++db)
#pragma unroll
                for (int r = 0; r < 16; ++r) xch[((sb * 4 + db) * 16 + r) * 64 + lane] = o[db][r] * rl[r] * lam;
        }
        asm volatile("s_waitcnt lgkmcnt(0)" ::: "memory");
        __builtin_amdgcn_s_barrier();
        asm volatile("" ::: "memory");
        if (mi == 0) {
            float ss[16];
#pragma unroll
            for (int r = 0; r < 16; ++r) ss[r] = 0.f;
#pragma unroll
            for (int db = 0; db < 4; ++db)
#pragma unroll
                for (int r = 0; r < 16; ++r) { const float y = o[db][r] * rl[r] - xch[((sb * 4 + db) * 16 + r) * 64 + lane]; o[db][r] = y; ss[r] += y * y; }
#pragma unroll
            for (int r = 0; r < 16; ++r) {
#pragma unroll
                for (int m = 1; m < 32; m <<= 1) ss[r] += __shfl_xor(ss[r], m);
                ss[r] = (1.f - lam_init) / sqrtf(ss[r] * (1.f / 128.f) + EPS);
            }
            bf16_t* yo = Y + (size_t)(b * SEQ + qs) * D + 512 + hd * 128;
#pragma unroll
            for (int db = 0; db < 4; ++db) { const float gsv = gsub[32 * db + r32];
#pragma unroll
                for (int r = 0; r < 16; ++r) yo[(size_t)crow(r, half) * D + 32 * db + r32] = (bf16_t)f2bf(o[db][r] * ss[r] * gsv); }
        }
        if (F.tid == 0) qslot[0] = (int)__hip_atomic_fetch_add(queue, 1u, RLX_AGENT);
        asm volatile("s_waitcnt vmcnt(0) lgkmcnt(0)" ::: "memory");
        __builtin_amdgcn_s_barrier();
        asm volatile("" ::: "memory");
        u = __builtin_amdgcn_readfirstlane(qslot[0]);
    }
}
#define ONE_LAUNCH 1
#define NAIVE_MASK 0
#define MIX_PHASE_A do { mlstm_local_phase(F, L); conformer_phase(F, L); } while (0)
#define MIX_PHASE_B do { mlstm_scan_phase(F); attn_phase(F, L); } while (0)
#define MIX_PHASE_C do { mlstm_out_phase(F, L); } while (0)
#ifndef REP_PRO
#define REP_PRO 1
#endif
#ifndef REP_FFN1D
#define REP_FFN1D 1
#endif
__device__ __forceinline__ int bxl() { int b = blockIdx.x; asm volatile("" : "+s"(b)); return b; }
constexpr int PH_PER_LAYER = 13, NPHASE = 1 + 2 * PH_PER_LAYER;
struct Args { const float* in[31]; float* out; unsigned char* ws; int ph_lo, ph_hi; };

#define PH(k) (lo <= (k) && (k) < hi && (F.lane = lane_id_v(), F.tid = F.wave * 64 + F.lane, true))
#define SEAM(k) do { if ((k) + 1 < hi) xcd_barrier(bar); } while (0)
template <int L>
__device__ __forceinline__ void layer_phases(Frame& F, const XcdBarrier& bar, int lo, int hi) {
    bf16_t* const AY = (bf16_t*)(F.ws + WS_AY);
    bf16_t* const BIGB = (bf16_t*)(F.ws + WS_BIG);
    float* const wsm = (float*)(F.ws + WS_WSM);
        const int pb = 1 + PH_PER_LAYER * L;
        if (pb + PH_PER_LAYER <= lo || pb >= hi) return;
        const float* hsrc = (L == 0) ? F.in[0] : F.out;
        if (PH(pb + 0)) { norm_phase<1>(F, hsrc, wsm + L * 8 * D, nullptr, nullptr); SEAM(pb + 0); }
        if (PH(pb + 1)) {
            pg8::StaticOrder S; S.init(M / 256, NIN / 256, F.G, bxl());
            EpiIn E{BIGB, F.in[12] + L * 64, F.in[13] + L * 64};
            pg8::gemm_phase<EpiIn, pg8::StaticOrder, pg8::AOffDense, true>(F.lds, F.wave, AY, (const bf16_t*)(F.ws + WS_WIN) + (size_t)L * NIN * D, D, S, E, pg8::AOffDense{D});
            SEAM(pb + 1);
        }
        if (PH(pb + 2)) { MIX_PHASE_A; SEAM(pb + 2); }
        if (PH(pb + 3)) { MIX_PHASE_B; SEAM(pb + 3); }
        if (PH(pb + 4)) { MIX_PHASE_C; SEAM(pb + 4); }
        if (PH(pb + 5)) {
            pg8::StaticOrder S; S.init(M / 256, D / 256, F.G, bxl());
            EpiRes E{hsrc, F.out};
            pg8::gemm_phase<EpiRes, pg8::StaticOrder, pg8::AOffDense, true>(F.lds, F.wave, AY, (const bf16_t*)(F.ws + WS_WOUT) + (size_t)L * D * D, D, S, E, pg8::AOffDense{D});
            SEAM(pb + 5);
        }
        if (L == 0) {
            if (PH(pb + 6)) { norm_phase<0>(F, F.out, nullptr, nullptr, nullptr); SEAM(pb + 6); }
            if (PH(pb + 7)) {
                pg8::StaticOrder S; S.init(M / 256, 2 * FFD / 256, F.G, bxl());
                EpiGlu E{BIGB, FFD};
                pg8::gemm_phase<EpiGlu, pg8::StaticOrder, pg8::AOffDense, true>(F.lds, F.wave, AY, (const bf16_t*)(F.ws + WS_WDGU), D, S, E, pg8::AOffDense{D});
#if REP_FFN1D == 2
                pg8::gemm_phase<EpiGlu, pg8::StaticOrder, pg8::AOffDense, true>(F.lds, F.wave, AY, (const bf16_t*)(F.ws + WS_WDGU), D, S, E, pg8::AOffDense{D});
#endif
                SEAM(pb + 7);
            }
            if (PH(pb + 8)) {
                pg8::StaticOrder S; S.init(M / 256, D / 256, F.G, bxl());
                EpiRes E{F.out, F.out};
                pg8::gemm_phase<EpiRes, pg8::StaticOrder, pg8::AOffDense, true>(F.lds, F.wave, BIGB, (const bf16_t*)(F.ws + WS_WDD), FFD, S, E, pg8::AOffDense{FFD});
                SEAM(pb + 8);
            }
        } else {
            if (PH(pb + 6)) { norm_phase<2>(F, F.out, wsm + 2 * 8 * D, nullptr, nullptr); SEAM(pb + 6); }
            for (int s = 0; s < 2; ++s) {
                LAS int* rt_info = (LAS int*)(F.lds + TAB_OFF); LAS int* rowtab = (LAS int*)(F.lds + TAB_OFF + 2048);
                const int* list_s = (const int*)(F.ws + WS_MOE + MOE_LIST) + (size_t)s * 8 * M;
                const float* gatev_s = (const float*)(F.ws + WS_MOE + MOE_GATEV) + (size_t)s * M;
                if (PH(pb + 7 + 2 * s)) {
                    const int RT = moe_build_tiles(F, s, rt_info);
                    MoeSched S; S.so.init(RT, 2 * FFE / 256, F.G, bxl()); S.rt_info = rt_info; S.ntn = 2 * FFE / 256;
                    { pg8::Unit u; for (int i = 0; S.next(i, u); ++i) { if (F.tid < 256) { const int e = rt_info[3 * u.pm], i0 = rt_info[3 * u.pm + 1], nv = rt_info[3 * u.pm + 2];
                        rowtab[i * 256 + F.tid] = F.tid < nv ? list_s[(size_t)e * M + i0 + F.tid] : 0; } } }
                    __syncthreads();
                    EpiGlu E{BIGB, FFE};
                    pg8::gemm_phase<EpiGlu, MoeSched, pg8::AOffGather, true>(F.lds, F.wave, AY, (const bf16_t*)(F.ws + WS_WMGU), D, S, E, pg8::AOffGather{D, rowtab});
                    SEAM(pb + 7 + 2 * s);
                }
                if (PH(pb + 8 + 2 * s)) {
                    const int RT = moe_build_tiles(F, s, rt_info);
                    MoeSched S; S.so.init(RT, D / 256, F.G, bxl()); S.rt_info = rt_info; S.ntn = D / 256;
                    EpiScatter E{F.out, list_s, gatev_s, rt_info};
                    pg8::gemm_phase<EpiScatter, MoeSched, pg8::AOffDense, true>(F.lds, F.wave, BIGB, (const bf16_t*)(F.ws + WS_WMD), FFE, S, E, pg8::AOffDense{FFE});
                    SEAM(pb + 8 + 2 * s);
                }
            }
        }
        bf16_t* const PB = BIGB;
        bf16_t* const PEB = BIGB + (size_t)16 * MiB;
        if (PH(pb + 11)) { norm_phase<0>(F, F.out, nullptr, F.in[1] + (size_t)L * M * PLE, PB); SEAM(pb + 11); }
        if (PH(pb + 12)) {
            pg8::StaticOrder S; S.init(M / 256, D / 256, F.G, bxl());
            EpiPe E1{PEB};
            pg8::gemm_phase<EpiPe, pg8::StaticOrder, pg8::AOffDense, true>(F.lds, F.wave, PB, (const bf16_t*)(F.ws + WS_WPP) + (size_t)L * D * PLE, PLE, S, E1, pg8::AOffDense{PLE});
            EpiPle E2{F.out, PEB};
            pg8::gemm_phase<EpiPle, pg8::StaticOrder, pg8::AOffDense, true>(F.lds, F.wave, AY, (const bf16_t*)(F.ws + WS_WPG) + (size_t)L * D * D, D, S, E2, pg8::AOffDense{D});
            SEAM(pb + 12);
        }
    }
__global__ void __launch_bounds__(NWAVES * 64, 2) fwd(Args args) {
    extern __shared__ __attribute__((aligned(16))) unsigned char lds[];
    Frame F;
    F.lds = (LAS unsigned char*)lds;
    F.MISC = (volatile LAS unsigned*)(F.lds + MISC_OFF);
    F.wave = __builtin_amdgcn_readfirstlane(threadIdx.x >> 6); F.lane = lane_id_v(); F.tid = F.wave * 64 + F.lane;
    F.G = gridDim.x; { const int bx = blockIdx.x; F.vcu = (F.G % 8 == 0) ? (bx % 8) * (F.G / 8) + bx / 8 : bx; }
    F.ws = args.ws; F.ctl = (gu32*)(args.ws + WS_CTL); F.out = args.out;
#pragma unroll
    for (int i = 0; i < 31; ++i) F.in[i] = args.in[i];
    for (int u = F.tid; u < 256; u += NWAVES * 64) ((LAS unsigned*)(F.lds + LDSCTL_OFF))[u] = 0u;
    __syncthreads();
    const int lo = args.ph_lo, hi = args.ph_hi;
    XcdBarrier bar; bar.bar = (unsigned*)(F.ctl + CW_BAR); bar.x = 0; bar.st = nullptr;
    if (hi - lo > 1) bar = xcd_barrier_post((unsigned*)(F.ctl + CW_BAR), F.MISC + 8);

    bf16_t* const AY = (bf16_t*)(F.ws + WS_AY);
    bf16_t* const BIGB = (bf16_t*)(F.ws + WS_BIG);
    float* const wsm = (float*)(F.ws + WS_WSM);

    if (PH(0)) { for (int rep_ = 0; rep_ < REP_PRO; ++rep_) { p0_prologue(F); __syncthreads(); } SEAM(0); }

    layer_phases<0>(F, bar, lo, hi);
    layer_phases<1>(F, bar, lo, hi);
#undef PH
#undef SEAM
}

extern "C" void kernel_launch(void* const* d_in, const int* in_sizes, int n_in, void* d_out, int out_size, void* d_ws, size_t ws_size, hipStream_t stream) {
    static int grid = 0;
    if (grid == 0) {
        int dev = 0, cus = 0;
        grid = -1;
        if (hipGetDevice(&dev) == hipSuccess && hipDeviceGetAttribute(&cus, hipDeviceAttributeMultiprocessorCount, dev) == hipSuccess && cus == 256 && ws_size >= WS_END && n_in == 31 &&
            hipFuncSetAttribute((const void*)fwd, hipFuncAttributeMaxDynamicSharedMemorySize, LDS_BYTES) == hipSuccess) grid = cus;
        (void)hipGetLastError();
    }
    if (grid < 0) { nv::forward(d_in, (float*)d_out, (unsigned char*)d_ws, stream); return; }
    (void)hipMemsetAsync((char*)d_ws + WS_CTL, 0, CTL_ZERO_BYTES, stream);
    Args a{};
    for (int i = 0; i < 31; ++i) a.in[i] = (const float*)d_in[i];
    a.out = (float*)d_out; a.ws = (unsigned char*)d_ws;
#if ONE_LAUNCH
    a.ph_lo = 0; a.ph_hi = NPHASE;
    hipLaunchKernelGGL(fwd, dim3(grid), dim3(NWAVES * 64), LDS_BYTES, stream, a);
#else
    for (int p = 0; p < NPHASE; ++p) {
        const int L = (p - 1) / PH_PER_LAYER, k = (p - 1) % PH_PER_LAYER;
        if (p > 0 && L == 0 && (k == 9 || k == 10)) continue;
        if (p > 0 && k == 2 && NAIVE_MASK) nvb::mixers(d_in, (unsigned char*)d_ws, L, stream, NAIVE_MASK);
        a.ph_lo = p; a.ph_hi = p + 1;
        hipLaunchKernelGGL(fwd, dim3(grid), dim3(NWAVES * 64), LDS_BYTES, stream, a);
    }
#endif
}
```

```cpp
#include <hip/hip_runtime.h>
#include <cstdio>
#include <cstdint>
#include <cmath>
namespace nv {
constexpr int S = 8192, D = 1024, DIN = 3080, NB = 4;
constexpr int FFD = 2816, FFE = 3584, NE = 8, PLE = 256;
constexpr int OFF_MQ = 0, OFF_MK = 256, OFF_MV = 512, OFF_MO = 768, OFF_MI = 1024, OFF_MF = 1028, OFF_CA = 1032, OFF_CG = 1288, OFF_AQ = 1544, OFF_AK = 2056, OFF_AV = 2568;

__device__ __forceinline__ float sigmoidf_(float x) { return 1.f / (1.f + expf(-x)); }
__device__ __forceinline__ float siluf_(float x) { return x / (1.f + expf(-x)); }
__device__ __forceinline__ float wsum(float v) { for (int o = 32; o > 0; o >>= 1) v += __shfl_xor(v, o); return v; }
__device__ __forceinline__ float wmax(float v) { for (int o = 32; o > 0; o >>= 1) v = fmaxf(v, __shfl_xor(v, o)); return v; }

__global__ void groupnorm(const float* in, int ldi, float* out, int ldo, int ngroups, int gdim, const float* gain, int gain_stride, float scale) {
    const int rg = blockIdx.x, row = rg / ngroups, g = rg % ngroups, lane = threadIdx.x;
    const float* x = in + (size_t)row * ldi + g * gdim;
    float s = 0.f;
    for (int i = lane; i < gdim; i += 64) s += x[i] * x[i];
    s = wsum(s);
    const float r = rsqrtf(s / (float)gdim + 1e-6f);
    float* o = out + (size_t)row * ldo + g * gdim;
    for (int i = lane; i < gdim; i += 64) o[i] = x[i] * r * gain[g * gain_stride + i] * scale;
}

template <bool ACC>
__global__ void gemm(const float* A, int lda, const float* B, int ldb, float* C, int ldc, int M, int N, int K, const int* rowlist, const int* nrows_dev) {
    __shared__ float As[16][65];
    __shared__ float Bs[16][64];
    const int Meff = nrows_dev ? *nrows_dev : M;
    const int m0 = blockIdx.y * 64, n0 = blockIdx.x * 64;
    if (m0 >= Meff) return;
    const int tid = threadIdx.x, ty = tid >> 4, tx = tid & 15;
    float acc[4][4];
    for (int i = 0; i < 4; ++i) for (int j = 0; j < 4; ++j) acc[i][j] = 0.f;
    for (int k0 = 0; k0 < K; k0 += 16) {
        for (int i = 0; i < 4; ++i) {
            const int idx = tid + i * 256, r = idx >> 4, kk = idx & 15;
            float v = 0.f;
            if (m0 + r < Meff) { const int ar = rowlist ? rowlist[m0 + r] : (m0 + r); v = A[(size_t)ar * lda + k0 + kk]; }
            As[kk][r] = v;
        }
        for (int i = 0; i < 4; ++i) {
            const int idx = tid + i * 256, kk = idx >> 6, c = idx & 63;
            Bs[kk][c] = (n0 + c < N) ? B[(size_t)(k0 + kk) * ldb + n0 + c] : 0.f;
        }
        __syncthreads();
#pragma unroll
        for (int kk = 0; kk < 16; ++kk) {
            float a[4], b[4];
            for (int i = 0; i < 4; ++i) a[i] = As[kk][ty * 4 + i];
            for (int j = 0; j < 4; ++j) b[j] = Bs[kk][tx * 4 + j];
            for (int i = 0; i < 4; ++i) for (int j = 0; j < 4; ++j) acc[i][j] += a[i] * b[j];
        }
        __syncthreads();
    }
    for (int i = 0; i < 4; ++i) {
        const int r = m0 + ty * 4 + i;
        if (r >= Meff) continue;
        for (int j = 0; j < 4; ++j) {
            const int c = n0 + tx * 4 + j;
            if (c < N) { float* p = C + (size_t)r * ldc + c; *p = ACC ? (*p + acc[i][j]) : acc[i][j]; }
        }
    }
}

__global__ void mprep(const float* U, const float* cw  , const float* bi, const float* bf, float* QK, float* IG, float* LF) {
    const int t = blockIdx.x, c = threadIdx.x;
    float acc = 0.f;
    for (int j = 0; j < 4; ++j) { const int tt = t - 3 + j; if (tt >= 0) acc += cw[j * 512 + c] * U[(size_t)tt * DIN + c]; }
    QK[(size_t)t * 512 + c] = siluf_(acc);
    if (c < 4) {
        IG[t * 4 + c] = U[(size_t)t * DIN + OFF_MI + c] + bi[c];
        const float f = U[(size_t)t * DIN + OFF_MF + c] + bf[c];
        LF[t * 4 + c] = fminf(f, 0.f) - log1pf(expf(-fabsf(f)));
    }
}

__global__ void mlstm_rec(const float* QK, const float* U, const float* IG, const float* LF, float* HM) {
    __shared__ float sq[64][64], sk[64][64], sv[64][64];
    __shared__ float sig[64], slf[64];
    __shared__ float red[2][4][64], redd[2][4][64];
    const int h = blockIdx.x, tid = threadIdx.x, e = tid & 63, dq = tid >> 6;
    float C[16], n[16]; float m = 0.f;
    for (int i = 0; i < 16; ++i) { C[i] = 0.f; n[i] = 0.f; }
    for (int t0 = 0; t0 < S; t0 += 64) {
        __syncthreads();
        for (int i = tid; i < 64 * 64; i += 256) {
            const int tt = i >> 6, d = i & 63;
            sq[tt][d] = QK[(size_t)(t0 + tt) * 512 + h * 64 + d] * 0.125f;
            sk[tt][d] = QK[(size_t)(t0 + tt) * 512 + 256 + h * 64 + d];
            sv[tt][d] = U[(size_t)(t0 + tt) * DIN + OFF_MV + h * 64 + d];
        }
        if (tid < 64) { sig[tid] = IG[(t0 + tid) * 4 + h]; slf[tid] = LF[(t0 + tid) * 4 + h]; }
        __syncthreads();
        for (int tt = 0; tt < 64; ++tt) {
            const float ig = sig[tt], lf = slf[tt];
            const float mn = fmaxf(lf + m, ig), a = expf(lf + m - mn), bb = expf(ig - mn);
            m = mn;
            const float v = sv[tt][e];
            float num = 0.f, den = 0.f;
#pragma unroll
            for (int i = 0; i < 16; ++i) {
                const int d = dq * 16 + i; const float k = sk[tt][d], q = sq[tt][d];
                C[i] = a * C[i] + bb * k * v; n[i] = a * n[i] + bb * k;
                num += q * C[i]; den += q * n[i];
            }
            red[tt & 1][dq][e] = num; redd[tt & 1][dq][e] = den;
            __syncthreads();
            if (dq == 0) {
                const float nu = red[tt & 1][0][e] + red[tt & 1][1][e] + red[tt & 1][2][e] + red[tt & 1][3][e];
                const float de = redd[tt & 1][0][e] + redd[tt & 1][1][e] + redd[tt & 1][2][e] + redd[tt & 1][3][e];
                HM[(size_t)(t0 + tt) * 256 + h * 64 + e] = nu / fmaxf(fabsf(de), expf(-m));
            }
        }
    }
}

__global__ void mgate(const float* HMN, const float* U, float* Y) {
    const int t = blockIdx.x, c = threadIdx.x;
    Y[(size_t)t * D + c] = HMN[(size_t)t * 256 + c] * sigmoidf_(U[(size_t)t * DIN + OFF_MO + c]);
}

__global__ void cglu(const float* U, float* Z) {
    const int t = blockIdx.x, c = threadIdx.x;
    Z[(size_t)t * 256 + c] = U[(size_t)t * DIN + OFF_CA + c] * sigmoidf_(U[(size_t)t * DIN + OFF_CG + c]);
}
__global__ void cconv(const float* Z, const float* w  , const float* b, const float* lg, const float* lb, float* Y) {
    __shared__ float sm[4], sv2[4];
    const int t = blockIdx.x, c = threadIdx.x;
    float acc = b[c];
    for (int j = 0; j < 31; ++j) { const int tt = t - 30 + j; if (tt >= 0) acc += w[j * 256 + c] * Z[(size_t)tt * 256 + c]; }
    float s = wsum(acc);
    if ((c & 63) == 0) sm[c >> 6] = s;
    __syncthreads();
    const float mu = (sm[0] + sm[1] + sm[2] + sm[3]) * (1.f / 256.f);
    const float dv = acc - mu;
    float s2 = wsum(dv * dv);
    if ((c & 63) == 0) sv2[c >> 6] = s2;
    __syncthreads();
    const float var = (sv2[0] + sv2[1] + sv2[2] + sv2[3]) * (1.f / 256.f);
    const float yv = dv * rsqrtf(var + 1e-6f) * lg[c] + lb[c];
    Y[(size_t)t * D + 256 + c] = siluf_(yv);
}

__global__ void attn(const float* QN  , const float* KN  , const float* U, float* O  ) {
    __shared__ float sK[64][65];
    __shared__ float sV[64][128];
    __shared__ float sQ[16][64];
    __shared__ float sP[16][64];
    const int j = blockIdx.y, hd = j >> 1, q0 = blockIdx.x * 16, tid = threadIdx.x, w = tid >> 6, lane = tid & 63;
    const int qpos = q0 + w;
    const float slope = exp2f(-8.f * (float)(hd + 1) / 4.f);
    sQ[w][lane] = QN[(size_t)qpos * 512 + j * 64 + lane];
    float m = -INFINITY, l = 0.f, o0 = 0.f, o1 = 0.f;
    const int ntile = (q0 + 15) / 64 + 1;
    for (int kt = 0; kt < ntile; ++kt) {
        __syncthreads();
        for (int i = tid; i < 64 * 64; i += 1024) { const int r = i >> 6, d = i & 63; sK[r][d] = KN[(size_t)(kt * 64 + r) * 512 + j * 64 + d]; }
        for (int i = tid; i < 64 * 128; i += 1024) { const int r = i >> 7, d = i & 127; sV[r][d] = U[(size_t)(kt * 64 + r) * DIN + OFF_AV + hd * 128 + d]; }
        __syncthreads();
        const int kpos = kt * 64 + lane;
        float s = 0.f;
        for (int d = 0; d < 64; ++d) s += sQ[w][d] * sK[lane][d];
        s = s * 0.125f - slope * (float)(qpos - kpos);
        if (kpos > qpos) s = -INFINITY;
        const float tm = wmax(s), mn = fmaxf(m, tm), corr = expf(m - mn), p = expf(s - mn);
        l = l * corr + wsum(p); o0 *= corr; o1 *= corr; m = mn;
        sP[w][lane] = p;
        __syncthreads();
        for (int k = 0; k < 64; ++k) { const float pk = sP[w][k]; o0 += pk * sV[k][lane]; o1 += pk * sV[k][64 + lane]; }
    }
    O[((size_t)qpos * 8 + j) * 128 + lane] = o0 / l;
    O[((size_t)qpos * 8 + j) * 128 + 64 + lane] = o1 / l;
}
__device__ __forceinline__ float lam_of(const float* q1, const float* k1, const float* q2, const float* k2, float lam_init) {
    float a = 0.f, b = 0.f;
    for (int i = 0; i < 64; ++i) { a += q1[i] * k1[i]; b += q2[i] * k2[i]; }
    return expf(a) - expf(b) + lam_init;
}
__global__ void acomb(const float* O, const float* q1, const float* k1, const float* q2, const float* k2, float lam_init, float* YA  ) {
    const int t = blockIdx.x, c = threadIdx.x;
    const float lam = lam_of(q1, k1, q2, k2, lam_init);
    const int hd = c >> 7, e = c & 127;
    YA[(size_t)t * 512 + c] = O[((size_t)t * 8 + 2 * hd) * 128 + e] - lam * O[((size_t)t * 8 + 2 * hd + 1) * 128 + e];
}
__global__ void swiglu_act(float* G, const float* Uu, int ld, const int* nrows_dev) {
    const int r = blockIdx.x; if (nrows_dev && r >= *nrows_dev) return;
    for (int c = threadIdx.x; c < ld; c += blockDim.x) { const size_t i = (size_t)r * ld + c; G[i] = siluf_(G[i]) * Uu[i]; }
}
__global__ void route(const float* LG  , int* cnt  , int* list  , float* gl  ) {
    const int t = blockIdx.x * blockDim.x + threadIdx.x; if (t >= S) return;
    float v[8]; for (int e = 0; e < 8; ++e) v[e] = LG[t * 8 + e];
    int i0 = 0; for (int e = 1; e < 8; ++e) if (v[e] > v[i0]) i0 = e;
    int i1 = (i0 == 0) ? 1 : 0; for (int e = 0; e < 8; ++e) if (e != i0 && v[e] > v[i1]) i1 = e;
    const float e1 = expf(v[i1] - v[i0]), g0 = 1.f / (1.f + e1), g1 = e1 / (1.f + e1);
    int p0 = atomicAdd(&cnt[i0], 1); list[i0 * S + p0] = t; gl[i0 * S + p0] = g0;
    int p1 = atomicAdd(&cnt[i1], 1); list[i1 * S + p1] = t; gl[i1 * S + p1] = g1;
}
__global__ void scatter_add(const float* Dn  , const int* list, const float* gl, const int* nrows_dev, float* H) {
    const int r = blockIdx.x; if (r >= *nrows_dev) return;
    const int t = list[r]; const float g = gl[r];
    for (int c = threadIdx.x; c < D; c += blockDim.x) H[(size_t)t * D + c] += g * Dn[(size_t)r * D + c];
}
__global__ void ple_apply(const float* GT, const float* PE, float* H) {
    const int t = blockIdx.x;
    for (int c = threadIdx.x; c < D; c += blockDim.x) H[(size_t)t * D + c] += sigmoidf_(GT[(size_t)t * D + c]) * PE[(size_t)t * D + c];
}

static void gemm_l(hipStream_t st, bool acc, const float* A, int lda, const float* B, int ldb, float* C, int ldc, int M, int N, int K, const int* rowlist = nullptr, const int* nrows = nullptr) {
    dim3 g((N + 63) / 64, M / 64);
    if (acc) hipLaunchKernelGGL(gemm<true>, g, dim3(256), 0, st, A, lda, B, ldb, C, ldc, M, N, K, rowlist, nrows);
    else hipLaunchKernelGGL(gemm<false>, g, dim3(256), 0, st, A, lda, B, ldb, C, ldc, M, N, K, rowlist, nrows);
}

static void forward(void* const* d_in, float* out, unsigned char* ws, hipStream_t st) {
    const float* const* in = (const float* const*)d_in;
    size_t off = 0;
    auto take = [&](size_t bytes) { unsigned char* p = ws + off; off += (bytes + 255) & ~(size_t)255; return p; };
    float* A = (float*)take((size_t)S * D * 4);
    float* U = (float*)take((size_t)S * DIN * 4);
    float* QK = (float*)take((size_t)S * 512 * 4);
    float* Y = (float*)take((size_t)S * D * 4);
    float* G = (float*)take((size_t)S * FFE * 4);
    float* U2 = (float*)take((size_t)S * FFE * 4);
    float* IG = (float*)take((size_t)S * 4 * 4);
    float* LF = (float*)take((size_t)S * 4 * 4);
    int* cnt = (int*)take(256);
    int* list = (int*)take((size_t)NE * S * 4);
    float* gl = (float*)take((size_t)NE * S * 4);
    float* HM = G;
    float* HMN = G + (size_t)S * 256;
    float* Z = G + (size_t)S * 512;
    float* QN = G + (size_t)S * 768;
    float* KN = G + (size_t)S * 1280;
    float* YA = G + (size_t)S * 1792;
    float* AO = U2;
    hipMemcpyAsync(out, in[0], (size_t)NB * S * D * 4, hipMemcpyDeviceToDevice, st);
    for (int b = 0; b < NB; ++b) {
        float* H = out + (size_t)b * S * D;
        for (int L = 0; L < 2; ++L) {
            const float lam_init = 0.8f - 0.6f * expf(-0.3f * (float)L);
            hipLaunchKernelGGL(groupnorm, dim3(S), dim3(64), 0, st, H, D, A, D, 1, D, in[2] + L * D, 0, 1.f);
            gemm_l(st, false, A, D, in[3] + (size_t)L * D * DIN, DIN, U, DIN, S, DIN, D);
            hipLaunchKernelGGL(mprep, dim3(S), dim3(512), 0, st, U, in[6] + L * 2048, in[4] + L * 4, in[5] + L * 4, QK, IG, LF);
            hipLaunchKernelGGL(mlstm_rec, dim3(4), dim3(256), 0, st, QK, U, IG, LF, HM);
            hipLaunchKernelGGL(groupnorm, dim3(S * 4), dim3(64), 0, st, HM, 256, HMN, 256, 4, 64, in[7] + L * 256, 64, 1.f);
            hipLaunchKernelGGL(mgate, dim3(S), dim3(256), 0, st, HMN, U, Y);
            hipLaunchKernelGGL(cglu, dim3(S), dim3(256), 0, st, U, Z);
            hipLaunchKernelGGL(cconv, dim3(S), dim3(256), 0, st, Z, in[8] + L * 31 * 256, in[9] + L * 256, in[10] + L * 256, in[11] + L * 256, Y);
            hipLaunchKernelGGL(groupnorm, dim3(S * 8), dim3(64), 0, st, U + OFF_AQ, DIN, QN, 512, 8, 64, in[12] + L * 64, 0, 1.f);
            hipLaunchKernelGGL(groupnorm, dim3(S * 8), dim3(64), 0, st, U + OFF_AK, DIN, KN, 512, 8, 64, in[13] + L * 64, 0, 1.f);
            hipLaunchKernelGGL(attn, dim3(S / 16, 8), dim3(1024), 0, st, QN, KN, U, AO);
            hipLaunchKernelGGL(acomb, dim3(S), dim3(512), 0, st, AO, in[14] + L * 64, in[15] + L * 64, in[16] + L * 64, in[17] + L * 64, lam_init, YA);
            hipLaunchKernelGGL(groupnorm, dim3(S * 4), dim3(64), 0, st, YA, 512, Y + 512, D, 4, 128, in[18] + L * 128, 0, 1.f - lam_init);
            gemm_l(st, true, Y, D, in[19] + (size_t)L * D * D, D, H, D, S, D, D);
            hipLaunchKernelGGL(groupnorm, dim3(S), dim3(64), 0, st, H, D, A, D, 1, D, in[20] + L * D, 0, 1.f);
            if (L == 0) {
                gemm_l(st, false, A, D, in[21], FFD, G, FFD, S, FFD, D);
                gemm_l(st, false, A, D, in[22], FFD, U2, FFD, S, FFD, D);
                hipLaunchKernelGGL(swiglu_act, dim3(S), dim3(256), 0, st, G, U2, FFD, (const int*)nullptr);
                gemm_l(st, true, G, FFD, in[23], D, H, D, S, D, FFD);
            } else {
                float* LG = Y;
                gemm_l(st, false, A, D, in[24], NE, LG, NE, S, NE, D);
                hipMemsetAsync(cnt, 0, 256, st);
                hipLaunchKernelGGL(route, dim3(S / 256), dim3(256), 0, st, LG, cnt, list, gl);
                float* Dn = Y;
                for (int e = 0; e < NE; ++e) {
                    gemm_l(st, false, A, D, in[25] + (size_t)e * D * FFE, FFE, G, FFE, S, FFE, D, list + e * S, cnt + e);
                    gemm_l(st, false, A, D, in[26] + (size_t)e * D * FFE, FFE, U2, FFE, S, FFE, D, list + e * S, cnt + e);
                    hipLaunchKernelGGL(swiglu_act, dim3(S), dim3(256), 0, st, G, U2, FFE, (const int*)(cnt + e));
                    gemm_l(st, false, G, FFE, in[27] + (size_t)e * FFE * D, D, Dn, D, S, D, FFE, nullptr, cnt + e);
                    hipLaunchKernelGGL(scatter_add, dim3(S), dim3(256), 0, st, Dn, list + e * S, gl + e * S, (const int*)(cnt + e), H);
                }
            }
            hipLaunchKernelGGL(groupnorm, dim3(S), dim3(64), 0, st, H, D, A, D, 1, D, in[28] + L * D, 0, 1.f);
            gemm_l(st, false, A, D, in[29] + (size_t)L * D * D, D, G, D, S, D, D);
            gemm_l(st, false, in[1] + ((size_t)L * NB + b) * S * PLE, PLE, in[30] + (size_t)L * PLE * D, D, U2, D, S, D, PLE);
            hipLaunchKernelGGL(ple_apply, dim3(S), dim3(256), 0, st, G, U2, H);
        }
    }
}
}
#define GAS __attribute__((address_space(1)))
#define LAS __attribute__((address_space(3)))
typedef unsigned short bf16_t;
typedef unsigned u32x4 __attribute__((ext_vector_type(4)));
typedef unsigned u32x2 __attribute__((ext_vector_type(2)));
typedef float f32x4 __attribute__((ext_vector_type(4)));
typedef float f32x2 __attribute__((ext_vector_type(2)));
typedef short bf16x8 __attribute__((ext_vector_type(8)));
typedef GAS unsigned gu32;
#define RLX_AGENT __ATOMIC_RELAXED, __HIP_MEMORY_SCOPE_AGENT

constexpr int NB = 4, SEQ = 8192, M = NB * SEQ, D = 1024, DIN = 3080;
constexpr int FFD = 2816, FFE = 3584, NE = 8, PLE = 256;
constexpr int UW = 2816;
constexpr int UC_MQ = 0, UC_MK = 256, UC_MV = 512, UC_MO = 768, UC_Z = 1024, UC_Q = 1280, UC_K = 1792, UC_V = 2304;
constexpr int NIN = 3072;
constexpr float EPS = 1e-6f;
constexpr float C2 = 0.125f * 1.4426950408889634f;
constexpr int MOE_MAXROWS = M + NE * 256;

constexpr size_t MiB = 1u << 20;
constexpr size_t WS_CTL = 0, CTL_ZERO_BYTES = 1 * MiB;
constexpr size_t WS_WIN = 1 * MiB;
constexpr size_t WS_WOUT = WS_WIN + 12 * MiB;
constexpr size_t WS_WDGU = WS_WOUT + 4 * MiB;
constexpr size_t WS_WDD = WS_WDGU + 11 * MiB;
constexpr size_t WS_WMGU = WS_WDD + 6 * MiB;
constexpr size_t WS_WMD = WS_WMGU + 112 * MiB;
constexpr size_t WS_WPG = WS_WMD + 56 * MiB;
constexpr size_t WS_WPP = WS_WPG + 4 * MiB;
constexpr size_t WS_WSM = WS_WPP + 1 * MiB;
constexpr size_t WS_GATE = WS_WSM + 1 * MiB;
constexpr size_t WS_MOE = WS_GATE + 1 * MiB;
constexpr size_t WS_MST = WS_MOE + 3 * MiB;
constexpr size_t WS_AY = WS_MST + 34 * MiB;
constexpr size_t WS_BIG = WS_AY + 64 * MiB;
constexpr size_t WS_PB = WS_BIG + 238 * MiB;
constexpr size_t WS_RS = WS_PB + 32 * MiB;
constexpr size_t WS_END = WS_RS + 3 * MiB;
constexpr size_t WS_H8 = WS_BIG + 160 * MiB;
constexpr float F8S_H = 16.f, F8S_WGU = 512.f, F8S_ACT = 16.f, F8S_WD = 1024.f;
static_assert((size_t)MOE_MAXROWS * FFE * 2 <= 238 * MiB, "act fits");
static_assert((size_t)M * UW * 2 <= 176 * MiB, "u fits");

constexpr int CW_TMO = 0, CW_CODE = 1;
constexpr int CW_BAR = 4096;
constexpr int CW_CNT = 16384;
constexpr int CW_RS = 32768;
constexpr int CW_QX = 16640;
constexpr int CW_QCONV = 16512;
constexpr int CW_QATT = 16448;
constexpr size_t MOE_GATEV = 0;
constexpr size_t MOE_EIDX = 2 * (size_t)M * 4;
constexpr size_t MOE_LIST = 4 * (size_t)M * 4;
constexpr size_t MOE_CNTW = MOE_LIST + 16 * (size_t)M * 4;
static_assert(MOE_CNTW + 256 * 64 * 4 <= 3 * MiB, "moe region");

constexpr int RING_BYTES = 131072;
constexpr int LDS_BYTES = 163840;
constexpr int LDSCTL_OFF = LDS_BYTES - 1024, MISC_OFF = LDSCTL_OFF + 320;
constexpr int TAB_OFF = RING_BYTES;
constexpr int NWAVES = 8;

__device__ __forceinline__ int lane_id_v() { int l; asm volatile("v_mbcnt_lo_u32_b32 %0, -1, 0\n\tv_mbcnt_hi_u32_b32 %0, -1, %0" : "=v"(l)); return l; }
__device__ __forceinline__ unsigned f2bf(float f) { unsigned u = __builtin_bit_cast(unsigned, f); return (u + 0x7fffu + ((u >> 16) & 1u)) >> 16; }
__device__ __forceinline__ unsigned pk2(float lo, float hi) { return f2bf(lo) | (f2bf(hi) << 16); }
__device__ __forceinline__ float bf2f(unsigned short b) { return __builtin_bit_cast(float, (unsigned)b << 16); }
__device__ __forceinline__ float bflo(unsigned w) { return __builtin_bit_cast(float, w << 16); }
__device__ __forceinline__ float bfhi(unsigned w) { return __builtin_bit_cast(float, w & 0xffff0000u); }
__device__ __forceinline__ unsigned pk4_fp8(float a, float b, float c, float d) {
    int w = 0;
    w = __builtin_amdgcn_cvt_pk_fp8_f32(__builtin_amdgcn_fmed3f(a, -448.f, 448.f), __builtin_amdgcn_fmed3f(b, -448.f, 448.f), w, false);
    w = __builtin_amdgcn_cvt_pk_fp8_f32(__builtin_amdgcn_fmed3f(c, -448.f, 448.f), __builtin_amdgcn_fmed3f(d, -448.f, 448.f), w, true);
    return (unsigned)w; }
__device__ __forceinline__ unsigned cvt_pk_bf16(float lo, float hi) { unsigned r; asm volatile("v_cvt_pk_bf16_f32 %0, %1, %2" : "=v"(r) : "v"(lo), "v"(hi)); return r; }
__device__ __forceinline__ float fast_sigmoid(float x) { return __builtin_amdgcn_rcpf(1.f + __builtin_amdgcn_exp2f(-1.4426950408889634f * x)); }
template <class T> __device__ __forceinline__ T shflx(T v, int m) { return __builtin_bit_cast(T, __builtin_amdgcn_ds_bpermute((lane_id_v() ^ m) << 2, __builtin_bit_cast(int, v))); }
#define __shfl_xor(v, m) shflx((v), (m))
__device__ __forceinline__ float wave_sum(float v) {
#pragma unroll
    for (int o = 1; o < 64; o <<= 1) v += __shfl_xor(v, o);
    return v;
}
__device__ __forceinline__ float wave_max(float v) {
#pragma unroll
    for (int o = 1; o < 64; o <<= 1) v = fmaxf(v, __shfl_xor(v, o));
    return v;
}

#define XB_TMO      128
#define XB_XCNT(j)  (256  + 64 * (j))
#define XB_XSUB(j)  (1280 + 64 * (j))
#define XB_XGEN(j)  (2304 + 64 * (j))
#define XB_TOP      3328
#define XB_TOPGEN   3392
#define XCD_BAR_WORDS 3456
#define XB_SPIN_CAP (1u << 22)
__device__ __forceinline__ unsigned xb_ld(unsigned* p)              { return __hip_atomic_load(p, __ATOMIC_RELAXED, __HIP_MEMORY_SCOPE_AGENT); }
__device__ __forceinline__ unsigned xb_add(unsigned* p, unsigned v) { return __hip_atomic_fetch_add(p, v, __ATOMIC_RELAXED, __HIP_MEMORY_SCOPE_AGENT); }
__device__ __forceinline__ unsigned xb_xcc_id() { return (unsigned)__builtin_amdgcn_s_getreg((3 << 11) | 20) & 0xFu; }
#define XB_SPIN(cond, bar) do { unsigned _sp = 0; while (cond) { __builtin_amdgcn_s_sleep(1); \
    if ((++_sp & 255u) == 0u) { if (xb_ld(&(bar)[XB_TMO])) break; if (_sp > XB_SPIN_CAP) { atomicAdd(&(bar)[XB_TMO], 1u); break; } } } } while (0)
struct XcdBarrier { unsigned* bar; unsigned x; volatile LAS unsigned* st; };
__device__ __forceinline__ XcdBarrier xcd_barrier_post(unsigned* bar, volatile LAS unsigned* st) {
    XcdBarrier b; b.bar = bar; b.x = xb_xcc_id(); b.st = st;
    if (threadIdx.x == 0) (void)xb_add(&bar[XB_XCNT(b.x)], 1u);
    return b;
}
__device__ __forceinline__ void xcd_barrier_complete(unsigned* bar, unsigned x, unsigned& nloc, unsigned& nx) {
    const unsigned G = gridDim.x * gridDim.y * gridDim.z;
    unsigned sum, cnt, mine, sp = 0u;
    for (;;) {
        sum = 0u; cnt = 0u; mine = 0u;
#pragma unroll
        for (unsigned j = 0; j < 16; ++j) { const unsigned c = xb_ld(&bar[XB_XCNT(j)]); sum += c; cnt += (c > 0u) ? 1u : 0u; mine = (j == x) ? c : mine; }
        if (sum == G) break;
        __builtin_amdgcn_s_sleep(1);
        if ((++sp & 255u) == 0u) { if (xb_ld(&bar[XB_TMO])) break; if (sp > XB_SPIN_CAP) { atomicAdd(&bar[XB_TMO], 1u); break; } }
    }
    nloc = mine > 0u ? mine : 1u; nx = cnt > 0u ? cnt : 1u;
}
__device__ __forceinline__ void xcd_barrier(const XcdBarrier& b, int wave) {
    asm volatile("s_waitcnt vmcnt(0)" ::: "memory");
    __syncthreads();
    if (wave == 0 && lane_id_v() == 0) {
        unsigned* bar = b.bar;
        __builtin_amdgcn_s_waitcnt(0);
        unsigned nloc = b.st[0], nx = b.st[1];
        if (nloc == 0u) { xcd_barrier_complete(bar, b.x, nloc, nx); b.st[0] = nloc; b.st[1] = nx; }
        const unsigned old = xb_add(&bar[XB_XSUB(b.x)], 1u);
        const unsigned gen = old / nloc;
        if (old + 1u == (gen + 1u) * nloc) {
            __builtin_amdgcn_fence(__ATOMIC_RELEASE, "agent");
            asm volatile("s_waitcnt vmcnt(0)" ::: "memory");
            const unsigned og = xb_add(&bar[XB_TOP], 1u);
            const unsigned tg = og / nx;
            if (og + 1u == (tg + 1u) * nx) xb_add(&bar[XB_TOPGEN], 1u);
            else XB_SPIN(xb_ld(&bar[XB_TOPGEN]) == tg, bar);
            __builtin_amdgcn_fence(__ATOMIC_ACQUIRE, "agent");
            xb_add(&bar[XB_XGEN(b.x)], 1u);
            asm volatile("s_waitcnt vmcnt(0)" ::: "memory");
        } else {
            XB_SPIN(xb_ld(&bar[XB_XGEN(b.x)]) == gen, bar);
            __builtin_amdgcn_fence(__ATOMIC_ACQUIRE, "agent");
            asm volatile("s_waitcnt vmcnt(0)" ::: "memory");
        }
    }
    __syncthreads();
}

namespace pg8 {
constexpr int BM = 256, BK = 64, HALF = 128, HTB = HALF * BK * 2, STAGE_BYTES = 8 * HTB, NXCD = 8, WGM = 8;
__host__ __device__ __forceinline__ int lds_byte(int r, int c) { const int st = (r >> 4) * 2 + (c >> 5), rr = r & 15, cc = c & 31, ob = rr * 64 + cc * 2; return st * 1024 + (ob ^ (((ob >> 9) & 1) << 5)); }
__host__ __device__ __forceinline__ void stage_rc(int b, int& R, int& C) { const int st = b / 1024, sb = b % 1024, swz = sb ^ (((sb >> 9) & 1) << 5); R = (st >> 1) * 16 + swz / 64; C = (st & 1) * 32 + (swz % 64) / 2; }
__host__ __device__ __forceinline__ int perm32(int rho) { const int n = rho >> 4, i = rho & 15; return 8 * (i >> 2) + 4 * n + (i & 3); }

struct Unit { int pm, pn, pb, ui, kb, aux; };

struct StaticOrder {
    int nM, nN, nwg, G, c;
    __device__ void init(int nM_, int nN_, int G_, int c_) { nM = nM_; nN = nN_; nwg = nM * nN; G = G_; c = c_; }
    __device__ __forceinline__ bool tile(int i, int& pm, int& pn) const {
        const long L = (long)i * G + c; if (L >= nwg) return false;
        int wgid = (int)L; { const int q = nwg / NXCD, r = nwg % NXCD, xcd = wgid % NXCD, off = wgid / NXCD; wgid = (xcd < r ? xcd * (q + 1) : r * (q + 1) + (xcd - r) * q) + off; }
        const int nig = WGM * nN, gid = wgid / nig, fm = gid * WGM, gsz = (nM - fm) < WGM ? (nM - fm) : WGM;
        pm = fm + ((wgid % nig) % gsz); pn = (wgid % nig) / gsz; return true;
    }
    __device__ __forceinline__ bool next(int i, Unit& u) const { if (!tile(i, u.pm, u.pn)) return false; u.pb = u.pn; u.kb = 0; u.aux = 0; return true; }
};

typedef int i32x8 __attribute__((ext_vector_type(8)));
typedef int i32x4 __attribute__((ext_vector_type(4)));
__device__ __forceinline__ i32x8 cat8(const bf16x8& lo, const bf16x8& hi) { return __builtin_shufflevector(__builtin_bit_cast(i32x4, lo), __builtin_bit_cast(i32x4, hi), 0, 1, 2, 3, 4, 5, 6, 7); }
template <class Epi, class Sched, class AOff, bool ALIGN_EPI, bool F8 = false>
__device__ __forceinline__ void gemm_phase(LAS unsigned char* lds, int wave, const bf16_t* A, const bf16_t* Bt, int K, const Sched& S, const Epi& E, const AOff& AO, int klen = 0) {
    asm volatile("" : "+s"(A), "+s"(Bt), "+s"(K), "+s"(wave));
    const int lane = lane_id_v(), wid = wave, tid = wid * 64 + lane, wr = wid >> 2, wc = wid & 3, fr = lane & 15, fq = lane >> 4;
    const int nt = (klen ? klen : K) / BK;
    int R0, C0, R1, C1; stage_rc(tid * 16, R0, C0); stage_rc(tid * 16 + 8192, R1, C1);
    unsigned voffB[2]; voffB[0] = (unsigned)(R0 * K + C0) * 2u; voffB[1] = (unsigned)(R1 * K + C1) * 2u;
    const size_t kstep = (size_t)(BK * 2);
    const size_t hstep = (size_t)HALF * K * 2;
    const size_t tstep = 2 * hstep;
    const unsigned ldsw = (unsigned)wid * 1024u;
    const int aoff = lds_byte(wr * 64 + fr, fq * 8), boff = lds_byte(wc * 32 + fr, fq * 8);
    const char* Ab = (const char*)A;
#define PG8_SA(b, h) (((b) * 2 + (h)) * HTB)
#define PG8_SB(b, h) ((4 + (b) * 2 + (h)) * HTB)
#define PG8_STAGE(bufoff, gbase, voff) do { _Pragma("unroll") for (int _i = 0; _i < 2; ++_i) { unsigned o_ = (voff)[_i]; if constexpr (F8) asm volatile("" : "+v"(o_));        \
        __builtin_amdgcn_global_load_lds((const unsigned*)((const char*)(gbase) + o_), (LAS unsigned*)(lds + (bufoff) + ldsw + _i * 8192), 16, 0, 0); } } while (0)
#define PG8_LDA(dst, b, h) do { _Pragma("unroll") for (int m = 0; m < 4; ++m) _Pragma("unroll") for (int k = 0; k < 2; ++k) dst[m][k] = *(const LAS bf16x8*)(lds + PG8_SA(b, h) + aoff + m * 2048 + k * 1024); } while (0)
#define PG8_LDB(dst, b, h) do { _Pragma("unroll") for (int n = 0; n < 2; ++n) _Pragma("unroll") for (int k = 0; k < 2; ++k) dst[n][k] = *(const LAS bf16x8*)(lds + PG8_SB(b, h) + boff + n * 2048 + k * 1024); } while (0)
#define PG8_MMA(ai, bj, At, Bt_) do { __builtin_amdgcn_s_setprio(1); _Pragma("unroll") for (int m = 0; m < 4; ++m) _Pragma("unroll") for (int n = 0; n < 2; ++n) { \
        if constexpr (F8) acc[ai][bj][m][n] = __builtin_amdgcn_mfma_scale_f32_16x16x128_f8f6f4(cat8(Bt_[n][0], Bt_[n][1]), cat8(At[m][0], At[m][1]), acc[ai][bj][m][n], 0, 0, 0, 0, 0, 0); \
        else { _Pragma("unroll") for (int k = 0; k < 2; ++k) acc[ai][bj][m][n] = __builtin_amdgcn_mfma_f32_16x16x32_bf16(Bt_[n][k], At[m][k], acc[ai][bj][m][n], 0, 0, 0); } } __builtin_amdgcn_s_setprio(0); } while (0)
#define PG8_WAIT_V(n) asm volatile("s_waitcnt vmcnt(" #n ")" ::: "memory")
#define PG8_WAIT_L(n) asm volatile("s_waitcnt lgkmcnt(" #n ")" ::: "memory")
#define PG8_BAR __builtin_amdgcn_s_barrier()
#define PG8_SCHED __builtin_amdgcn_sched_barrier(0)
    Unit cur, nxt; int ui = 0;
    if (!S.next(0, cur)) return;
    cur.ui = 0;
    f32x4 acc[2][2][4][2];
#pragma unroll
    for (int a = 0; a < 2; ++a)
#pragma unroll
        for (int b = 0; b < 2; ++b)
#pragma unroll
            for (int m = 0; m < 4; ++m)
#pragma unroll
                for (int n = 0; n < 2; ++n) acc[a][b][m][n] = (f32x4){0.f, 0.f, 0.f, 0.f};
    bf16x8 At[4][2], B0[2][2], B1[2][2];
    unsigned va[2][2], vn[2][2];
    AO(cur, 0, R0, C0, R1, C1, va);
    const char* cB = (const char*)Bt + (size_t)cur.pb * tstep + cur.kb;
    PG8_STAGE(PG8_SB(0, 0), cB, voffB); PG8_STAGE(PG8_SB(0, 1), cB + hstep, voffB); PG8_STAGE(PG8_SA(0, 0), Ab, va[0]); PG8_STAGE(PG8_SA(0, 1), Ab, va[1]);
    if (wr == 1) PG8_BAR;
    PG8_WAIT_V(2); PG8_BAR;
    PG8_STAGE(PG8_SB(1, 0), cB + kstep, voffB); PG8_STAGE(PG8_SA(1, 0), Ab + kstep, va[0]); PG8_STAGE(PG8_SB(1, 1), cB + hstep + kstep, voffB);
    PG8_WAIT_V(6); PG8_BAR;
    for (;;) {
        const bool has_next = S.next(ui + 1, nxt); nxt.ui = ui + 1;
        if constexpr (F8) { const int t_ = wid * 64 + lane_id_v(); stage_rc(t_ * 16, R0, C0); stage_rc(t_ * 16 + 8192, R1, C1); }
        if (has_next) AO(nxt, ui + 1, R0, C0, R1, C1, vn);
        else { vn[0][0] = va[0][0]; vn[0][1] = va[0][1]; vn[1][0] = va[1][0]; vn[1][1] = va[1][1]; }
        const char* nB = has_next ? (const char*)Bt + (size_t)nxt.pb * tstep + nxt.kb : cB;
        for (int t = 0; t < nt; t += 2) {
            const bool last = (t == nt - 2);
            const size_t ka1 = (size_t)(t + 1) * kstep;
            const size_t ka2 = last ? 0 : (size_t)(t + 2) * kstep, ka3 = ka2 + kstep;
            const char* b2 = last ? nB : cB + (size_t)(t + 2) * kstep; const char* b3 = b2 + kstep;
            unsigned w0[2], w1[2];
            w0[0] = last ? vn[0][0] : va[0][0]; w0[1] = last ? vn[0][1] : va[0][1]; w1[0] = last ? vn[1][0] : va[1][0]; w1[1] = last ? vn[1][1] : va[1][1];
            PG8_LDB(B0, 0, 0); PG8_LDB(B1, 0, 1); PG8_SCHED; PG8_LDA(At, 0, 0); PG8_STAGE(PG8_SA(1, 1), Ab + ka1, va[1]);
            PG8_WAIT_V(8); PG8_WAIT_L(0); PG8_BAR; PG8_MMA(0, 0, At, B0); PG8_MMA(0, 1, At, B1); PG8_BAR; PG8_SCHED;
            PG8_LDA(At, 0, 1); PG8_STAGE(PG8_SB(0, 0), b2, voffB); PG8_STAGE(PG8_SB(0, 1), b2 + hstep, voffB); PG8_STAGE(PG8_SA(0, 0), Ab + ka2, w0);
            PG8_WAIT_V(8); PG8_WAIT_L(0); PG8_BAR; PG8_MMA(1, 0, At, B0); PG8_MMA(1, 1, At, B1); PG8_BAR; PG8_SCHED;
            PG8_LDB(B0, 1, 0); PG8_LDB(B1, 1, 1); PG8_SCHED; PG8_LDA(At, 1, 0); PG8_STAGE(PG8_SA(0, 1), Ab + ka2, w1);
            PG8_WAIT_V(8); PG8_WAIT_L(0); PG8_BAR; PG8_MMA(0, 0, At, B0); PG8_MMA(0, 1, At, B1); PG8_BAR; PG8_SCHED;
            PG8_LDA(At, 1, 1); PG8_STAGE(PG8_SB(1, 0), b3, voffB); PG8_STAGE(PG8_SB(1, 1), b3 + hstep, voffB); PG8_STAGE(PG8_SA(1, 0), Ab + ka3, w0);
            PG8_WAIT_V(8); PG8_WAIT_L(0); PG8_BAR; PG8_MMA(1, 0, At, B0); PG8_MMA(1, 1, At, B1); PG8_BAR; PG8_SCHED;
        }
        if constexpr (ALIGN_EPI) { if (wr == 0) PG8_BAR; }
        { int fr_ = fr, fq_ = fq; if constexpr (F8) { const int l_ = lane_id_v(); fr_ = l_ & 15; fq_ = l_ >> 4; } asm volatile("" : "+v"(fr_), "+v"(fq_));
          E(acc, cur, wr, wc, fr_, fq_); }
        if (!has_next) break;
#pragma unroll
        for (int a = 0; a < 2; ++a)
#pragma unroll
            for (int b = 0; b < 2; ++b)
#pragma unroll
                for (int m = 0; m < 4; ++m)
#pragma unroll
                    for (int n = 0; n < 2; ++n) acc[a][b][m][n] = (f32x4){0.f, 0.f, 0.f, 0.f};
        cur = nxt; cB = nB; ++ui;
        va[0][0] = vn[0][0]; va[0][1] = vn[0][1]; va[1][0] = vn[1][0]; va[1][1] = vn[1][1];
        if constexpr (ALIGN_EPI) { if (wr == 1) PG8_BAR; }
    }
    PG8_WAIT_V(0);
    if constexpr (!ALIGN_EPI) { if (wr == 0) PG8_BAR; }
    PG8_BAR;
#undef PG8_SA
#undef PG8_SB
#undef PG8_STAGE
#undef PG8_LDA
#undef PG8_LDB
#undef PG8_MMA
#undef PG8_WAIT_V
#undef PG8_WAIT_L
#undef PG8_BAR
#undef PG8_SCHED
}

struct AOffDense { int K; __device__ __forceinline__ void operator()(const Unit& u, int, int R0, int C0, int R1, int C1, unsigned (&vo)[2][2]) const {
#pragma unroll
    for (int h = 0; h < 2; ++h) { vo[h][0] = (unsigned)((u.pm * 256 + h * 128 + R0) * K + C0) * 2u + (unsigned)u.kb; vo[h][1] = (unsigned)((u.pm * 256 + h * 128 + R1) * K + C1) * 2u + (unsigned)u.kb; } } };
struct AOffGather { int K; const LAS unsigned short* tab; __device__ __forceinline__ void operator()(const Unit&, int ui, int R0, int C0, int R1, int C1, unsigned (&vo)[2][2]) const {
#pragma unroll
    for (int h = 0; h < 2; ++h) { vo[h][0] = (unsigned)((int)tab[ui * 256 + h * 128 + R0] * K + C0) * 2u; vo[h][1] = (unsigned)((int)tab[ui * 256 + h * 128 + R1] * K + C1) * 2u; } } };
}
struct Frame {
    LAS unsigned char* lds;
    volatile LAS unsigned* MISC;
    gu32* ctl;
    int tid, lane, wave, vcu, G;
    const float* in[31];
    float* out;
    unsigned char* ws;
};
#define LDS_WAIT() asm volatile("s_waitcnt lgkmcnt(0)" ::: "memory")
#define VM_WAIT() asm volatile("s_waitcnt vmcnt(0)" ::: "memory")

struct PrepP { const float* W; const float* gain; bf16_t* WT; int ldw, c0s, K, n0d, k0; bool perm; float scl; };
__device__ __forceinline__ void prep_load(const PrepP& P, int lane, f32x4 (&v)[8], float (&g)[8]) {
#pragma unroll
    for (int i = 0; i < 8; ++i) { const int kk = 8 * i + (lane >> 3); v[i] = *(const GAS f32x4*)(P.W + (size_t)(P.k0 + kk) * P.ldw + P.c0s + 4 * (lane & 7)); g[i] = (P.gain ? P.gain[P.k0 + kk] : 1.f) * (P.scl != 0.f ? P.scl : 1.f); }
}
__device__ __forceinline__ void prep_finish(const PrepP& P, const f32x4 (&v)[8], const float (&g)[8], LAS float* scr, int lane) {
#pragma unroll
    for (int i = 0; i < 8; ++i) { const int kk = 8 * i + (lane >> 3); LAS float* d = scr + kk * 33 + 4 * (lane & 7);
        d[0] = v[i][0] * g[i]; d[1] = v[i][1] * g[i]; d[2] = v[i][2] * g[i]; d[3] = v[i][3] * g[i]; }
    LDS_WAIT(); asm volatile("" ::: "memory");
    const int c = lane & 7;
#pragma unroll
    for (int j = 0; j < 4; ++j) { const int n = (lane >> 3) + 8 * j; const int ns = P.perm ? pg8::perm32(n) : n; const LAS float* s = scr + (8 * c) * 33 + ns;
        if (P.scl != 0.f) { u32x2 o8; o8.x = pk4_fp8(s[0 * 33], s[1 * 33], s[2 * 33], s[3 * 33]); o8.y = pk4_fp8(s[4 * 33], s[5 * 33], s[6 * 33], s[7 * 33]);
            *(GAS u32x2*)((GAS unsigned char*)P.WT + (size_t)(P.n0d + n) * P.K + P.k0 + 8 * c) = o8; }
        else { u32x4 o; o.x = pk2(s[0 * 33], s[1 * 33]); o.y = pk2(s[2 * 33], s[3 * 33]); o.z = pk2(s[4 * 33], s[5 * 33]); o.w = pk2(s[6 * 33], s[7 * 33]);
            *(GAS u32x4*)(P.WT + (size_t)(P.n0d + n) * P.K + P.k0 + 8 * c) = o; } }
    LDS_WAIT(); asm volatile("" ::: "memory");
}

#ifndef DEFER_MOE_CONV
#define DEFER_MOE_CONV 0
#endif
__device__ __forceinline__ void prep_reg_load(const PrepP& P, int lane, f32x4 (&v)[8]) {
    const int kg = lane >> 3, n4 = lane & 7;
#pragma unroll
    for (int i = 0; i < 8; ++i) { const int k = P.k0 + 8 * kg + i; v[i] = *(const GAS f32x4*)(P.W + (size_t)k * P.ldw + P.c0s + 4 * n4) * (P.gain ? P.gain[k] : 1.f); }
}
__device__ __forceinline__ void prep_reg_store(const PrepP& P, int lane, const f32x4 (&v)[8]) {
    const int kg = lane >> 3, n4 = lane & 7;
#pragma unroll
    for (int j = 0; j < 4; ++j) { const int sc_ = 4 * n4 + j; const int rho = P.perm ? (16 * ((sc_ >> 2) & 1) + 4 * (sc_ >> 3) + (sc_ & 3)) : sc_;
        u32x4 o; o.x = pk2(v[0][j], v[1][j]); o.y = pk2(v[2][j], v[3][j]); o.z = pk2(v[4][j], v[5][j]); o.w = pk2(v[6][j], v[7][j]);
        *(GAS u32x4*)(P.WT + (size_t)(P.n0d + rho) * P.K + P.k0 + 8 * kg) = o; }
}
__device__ __forceinline__ PrepP moe_prep_decode(const float* q_wg, const float* q_wu, const float* q_wd, const float* q_gain, bf16_t* q_WMGU, bf16_t* q_WMD, int r) {
    constexpr int I_MGU = 16 * 224, I_MD = 56 * 32;
    PrepP P; P.gain = nullptr; P.perm = false; P.scl = 0.f;
    if (r < 8 * I_MGU) { const int e = r / I_MGU; r %= I_MGU; const int gd = r % 224, kb = r / 224, tile = gd >> 3, bj = (gd >> 2) & 1, wc = gd & 3;
        const unsigned long long a_ = (unsigned long long)q_wg, b_ = (unsigned long long)q_wu;
        P.W = (const float*)(bj ? b_ : a_) + (size_t)e * D * FFE; P.ldw = FFE; P.c0s = 128 * tile + 32 * wc; P.gain = q_gain; P.WT = q_WMGU + (size_t)e * 2 * FFE * D; P.K = D; P.perm = true; P.n0d = 32 * gd; P.k0 = 64 * kb; }
    else { r -= 8 * I_MGU; const int e = r / I_MD; r %= I_MD; const int gd = r % 32, kb = r / 32;
        P.W = q_wd + (size_t)e * FFE * D; P.ldw = D; P.c0s = 32 * gd; P.WT = q_WMD + (size_t)e * D * FFE; P.K = FFE; P.perm = true; P.n0d = 32 * gd; P.k0 = 64 * kb; }
    return P;
}
__device__ __forceinline__ int win_src_col(int gd) {
    const int tile = gd >> 3, bj = (gd >> 2) & 1, wc = gd & 3;
    if (tile < 4) return 256 * tile + 128 * bj + 32 * wc;
    if (tile < 6) return (bj ? 1288 : 1032) + 128 * (tile - 4) + 32 * wc;
    if (tile < 8) return 1544 + 256 * (tile - 6) + 64 * wc + 32 * bj;
    if (tile < 10) return 2056 + 256 * (tile - 8) + 64 * wc + 32 * bj;
    return 2568 + 256 * (tile - 10) + 128 * bj + 32 * wc;
}
__device__ __forceinline__ PrepP prep_decode(Frame& F, int it) {
    constexpr int I_IN = 16 * 96, I_OUT = 16 * 32, I_DGU = 16 * 176, I_DD = 44 * 32, I_MGU = 16 * 224, I_MD = 56 * 32, I_PG = 16 * 32, I_PP = 4 * 32;
        int r = it;
        const float* W; const float* gain = nullptr; bf16_t* WT; int ldw, c0s, K, gd, kb; bool perm = false; float scl = 0.f;
        if (r < 2 * I_IN) { const int L = r / I_IN; r %= I_IN; gd = r % 96; kb = r / 96;
            W = F.in[3] + (size_t)L * D * DIN; ldw = DIN; c0s = win_src_col(gd); gain = F.in[2] + L * D; WT = (bf16_t*)(F.ws + WS_WIN) + (size_t)L * NIN * D; K = D; perm = true; }
        else if ((r -= 2 * I_IN) < 2 * I_OUT) { const int L = r / I_OUT; r %= I_OUT; gd = r % 32; kb = r / 32;
            W = F.in[19] + (size_t)L * D * D; ldw = D; c0s = 32 * gd; WT = (bf16_t*)(F.ws + WS_WOUT) + (size_t)L * D * D; K = D; perm = true; }
        else if ((r -= 2 * I_OUT) < I_DGU) { gd = r % 176; kb = r / 176; const int tile = gd >> 3, bj = (gd >> 2) & 1, wc = gd & 3;
            W = bj ? F.in[22] : F.in[21]; ldw = FFD; c0s = 128 * tile + 32 * wc; gain = F.in[20]; WT = (bf16_t*)(F.ws + WS_WDGU); K = D; perm = true; }
        else if ((r -= I_DGU) < I_DD) { gd = r % 32; kb = r / 32;
            W = F.in[23]; ldw = D; c0s = 32 * gd; WT = (bf16_t*)(F.ws + WS_WDD); K = FFD; perm = true; }
        else if ((r -= I_DD) < 8 * I_MGU) { const int e = r / I_MGU; r %= I_MGU; gd = r % 224; kb = r / 224; const int tile = gd >> 3, bj = (gd >> 2) & 1, wc = gd & 3;
            W = (bj ? F.in[26] : F.in[25]) + (size_t)e * D * FFE; ldw = FFE; c0s = 128 * tile + 32 * wc; gain = F.in[20] + D; WT = (bf16_t*)(F.ws + WS_WMGU + (size_t)e * 2 * FFE * D); K = D; perm = true; scl = F8S_WGU; }
        else if ((r -= 8 * I_MGU) < 8 * I_MD) { const int e = r / I_MD; r %= I_MD; gd = r % 32; kb = r / 32;
            W = F.in[27] + (size_t)e * FFE * D; ldw = D; c0s = 32 * gd; WT = (bf16_t*)(F.ws + WS_WMD + (size_t)e * D * FFE); K = FFE; perm = true; scl = F8S_WD; }
        else if ((r -= 8 * I_MD) < 2 * I_PG) { const int L = r / I_PG; r %= I_PG; gd = r % 32; kb = r / 32;
            W = F.in[29] + (size_t)L * D * D; ldw = D; c0s = 32 * gd; gain = F.in[28] + L * D; WT = (bf16_t*)(F.ws + WS_WPG) + (size_t)L * D * D; K = D; perm = true; }
        else { r -= 2 * I_PG; const int L = r / I_PP; r %= I_PP; gd = r % 32; kb = r / 32;
            W = F.in[30] + (size_t)L * PLE * D; ldw = D; c0s = 32 * gd; WT = (bf16_t*)(F.ws + WS_WPP) + (size_t)L * D * PLE; K = PLE; perm = true; }
        PrepP P; P.W = W; P.gain = gain; P.WT = WT; P.ldw = ldw; P.c0s = c0s; P.K = K; P.n0d = 32 * gd; P.k0 = 64 * kb; P.perm = perm; P.scl = scl; return P;
}
constexpr int PREP_I_IN = 16 * 96, PREP_I_OUT = 16 * 32, PREP_I_DGU = 16 * 176, PREP_I_DD = 44 * 32, PREP_I_MGU = 16 * 224, PREP_I_MD = 56 * 32, PREP_I_PG = 16 * 32, PREP_I_PP = 4 * 32;
constexpr int PREP_MOE_LO = 2 * PREP_I_IN + 2 * PREP_I_OUT + PREP_I_DGU + PREP_I_DD, PREP_MOE_HI = PREP_MOE_LO + 8 * PREP_I_MGU + 8 * PREP_I_MD, PREP_NITEMS = PREP_MOE_HI + 2 * PREP_I_PG + 2 * PREP_I_PP;
__device__ __forceinline__ void p0_prologue(Frame& F) {
    LAS float* scr = (LAS float*)(F.lds + F.wave * 16384);
    const int gw = F.vcu * NWAVES + F.wave, NGW = F.G * NWAVES, lane = F.lane;
    bf16_t* ws16 = (bf16_t*)F.ws;
    {
        f32x4 va[8], vb[8]; float ga[8], gb[8]; PrepP Pa, Pb;
#if DEFER_MOE_CONV
        constexpr int NEARLY = PREP_NITEMS - (PREP_MOE_HI - PREP_MOE_LO);
#define PREP_MAP(i_) ((i_) < PREP_MOE_LO ? (i_) : (i_) + (PREP_MOE_HI - PREP_MOE_LO))
#else
        constexpr int NEARLY = PREP_NITEMS;
#define PREP_MAP(i_) (i_)
#endif
        int it = gw;
        if (it < NEARLY) { Pa = prep_decode(F, PREP_MAP(it)); prep_load(Pa, lane, va, ga); }
        while (it < NEARLY) {
            const int it1 = it + NGW; const bool h1 = it1 < NEARLY;
            if (h1) { Pb = prep_decode(F, PREP_MAP(it1)); prep_load(Pb, lane, vb, gb); }
            prep_finish(Pa, va, ga, scr, lane);
            if (!h1) break;
            const int it2 = it1 + NGW; const bool h2 = it2 < NEARLY;
            if (h2) { Pa = prep_decode(F, PREP_MAP(it2)); prep_load(Pa, lane, va, ga); }
            prep_finish(Pb, vb, gb, scr, lane);
            if (!h2) break;
            it = it2;
        }
    }
    (void)ws16;
    float* wsm = (float*)(F.ws + WS_WSM);
    const int gt = F.vcu * (NWAVES * 64) + F.tid, NGT = F.G * NWAVES * 64;
    for (int i = gt; i < 3 * 8 * D; i += NGT) {
        const int which = i / (8 * D), j = (i / D) % 8, k = i % D;
        float v;
        if (which < 2) v = F.in[2][which * D + k] * F.in[3][(size_t)which * D * DIN + (size_t)k * DIN + 1024 + j];
        else v = F.in[20][D + k] * F.in[24][k * NE + j];
        wsm[i] = v;
        bf16_t* wb = (bf16_t*)(F.ws + WS_WSM + 131072) + (size_t)which * 2 * 16 * D;
        const unsigned hi = f2bf(v); const float lo = v - __builtin_bit_cast(float, hi << 16);
        wb[(0 * 16 + j) * D + k] = (bf16_t)hi; wb[(1 * 16 + j) * D + k] = (bf16_t)f2bf(lo);
        wb[(0 * 16 + 8 + j) * D + k] = 0; wb[(1 * 16 + 8 + j) * D + k] = 0;
    }
    { bf16_t* XB = (bf16_t*)F.out + (size_t)M * D; float* RS0 = (float*)(F.ws + WS_RS);
      for (int mb = gw; mb < M; mb += 4 * NGW) {
        f32x4 vb[4][4];
#pragma unroll
        for (int rr = 0; rr < 4; ++rr) { const int mm = mb + rr * NGW; const GAS f32x4* xr = (const GAS f32x4*)(F.in[0] + (size_t)(mm < M ? mm : mb) * D) + lane;
#pragma unroll
            for (int j = 0; j < 4; ++j) vb[rr][j] = xr[64 * j]; }
#pragma unroll
        for (int rr = 0; rr < 4; ++rr) { const int m = mb + rr * NGW; if (m >= M) break; float s = 0.f;
#pragma unroll
            for (int j = 0; j < 4; ++j) { const f32x4 v = vb[rr][j]; s += (v.x * v.x + v.y * v.y) + (v.z * v.z + v.w * v.w); }
            s = wave_sum(s);
            GAS unsigned long long* o8 = (GAS unsigned long long*)(XB + (size_t)m * D) + lane;
#pragma unroll
            for (int j = 0; j < 4; ++j) { const f32x4 v = vb[rr][j]; o8[64 * j] = (unsigned long long)pk2(v.x, v.y) | ((unsigned long long)pk2(v.z, v.w) << 32); }
            if (lane < 4) RS0[(size_t)m * 4 + lane] = (lane == 0) ? s : 0.f; }
      } }
    { const size_t n4 = (size_t)2 * M * PLE / 4, gt4 = (size_t)F.vcu * (NWAVES * 64) + F.tid, NGT4 = (size_t)F.G * NWAVES * 64; GAS unsigned long long* po = (GAS unsigned long long*)(F.ws + WS_PB);
      for (size_t i = gt4; i < n4; i += NGT4) { const f32x4 x = ((const GAS f32x4*)F.in[1])[i]; po[i] = (unsigned long long)pk2(x.x, x.y) | ((unsigned long long)pk2(x.z, x.w) << 32); } }
}


__device__ __forceinline__ float rs_of(const float* RS, int row) { const f32x4 a = *(const f32x4*)(RS + (size_t)row * 4);
    return 1.0f / sqrtf(((a[0] + a[1]) + (a[2] + a[3])) * (1.f / D) + EPS); }

typedef float f32x4_t __attribute__((ext_vector_type(4)));
template <int MODE>
__device__ __forceinline__ void gate_pass(Frame& F, const bf16_t* H, const float* RS, int which) {
    LAS unsigned char* wl = F.lds;
    LAS int* rinfo = (LAS int*)(F.lds + 98304);
    { const bf16_t* wb = (const bf16_t*)(F.ws + WS_WSM + 131072) + (size_t)which * 2 * 16 * D;
      for (int i = F.tid; i < 2 * 16 * 128; i += NWAVES * 64) { const int pc = i >> 7, ch = i & 127; *(LAS u32x4*)(wl + pc * 2064 + ch * 16) = *(const GAS u32x4*)(wb + (size_t)pc * D + ch * 8); } }
    __syncthreads();
    const int gw = F.vcu * NWAVES + F.wave, NGW = F.G * NWAVES, lane = F.lane, col = lane & 15, q4 = lane >> 4;
    const bf16_t* hrow = H + (size_t)(gw + col * NGW) * D + 8 * q4;
    f32x4 acc = (f32x4){0.f, 0.f, 0.f, 0.f};
#pragma unroll
    for (int kb = 0; kb < 2; ++kb) {
        bf16x8 af[16];
#pragma unroll
        for (int ks = 0; ks < 16; ++ks) af[ks] = *(const GAS bf16x8*)(hrow + 32 * (16 * kb + ks));
#pragma unroll
        for (int ks = 0; ks < 16; ++ks) { const int ko = (32 * (16 * kb + ks) + 8 * q4) * 2;
            const bf16x8 bh = *(const LAS bf16x8*)(wl + col * 2064 + ko), bl = *(const LAS bf16x8*)(wl + (16 + col) * 2064 + ko);
            acc = __builtin_amdgcn_mfma_f32_16x16x32_bf16(af[ks], bh, acc, 0, 0, 0); acc = __builtin_amdgcn_mfma_f32_16x16x32_bf16(af[ks], bl, acc, 0, 0, 0); }
    }
    float dv[4]; int mr[4];
#pragma unroll
    for (int r = 0; r < 4; ++r) { mr[r] = gw + (4 * q4 + r) * NGW; dv[r] = acc[r] * rs_of(RS, mr[r]); }
    if (MODE == 1) { if (col < 8) {
#pragma unroll
        for (int r = 0; r < 4; ++r) ((float*)(F.ws + WS_GATE))[(size_t)mr[r] * 8 + col] = dv[r]; } }
    if (MODE == 2) {
#pragma unroll
        for (int r = 0; r < 4; ++r) {
            float v1 = (col < 8) ? dv[r] : -INFINITY; int i1 = col;
#pragma unroll
            for (int o = 1; o < 8; o <<= 1) { const float ov = __shfl_xor(v1, o); const int oi = __shfl_xor(i1, o); if (ov > v1 || (ov == v1 && oi < i1)) { v1 = ov; i1 = oi; } }
            float v2 = (col < 8 && col != i1) ? dv[r] : -INFINITY; int i2 = col;
#pragma unroll
            for (int o = 1; o < 8; o <<= 1) { const float ov = __shfl_xor(v2, o); const int oi = __shfl_xor(i2, o); if (ov > v2 || (ov == v2 && oi < i2)) { v2 = ov; i2 = oi; } }
            if (col == 0) { const float e1 = __expf(v2 - v1), g0 = 1.f / (1.f + e1), g1 = e1 / (1.f + e1); const int m = mr[r];
                float* gv = (float*)(F.ws + WS_MOE + MOE_GATEV); gv[m] = g0; gv[M + m] = g1; ((int*)(F.ws + WS_MOE + MOE_EIDX))[m] = i1 | (i2 << 4);
                rinfo[(F.wave * 16 + 4 * q4 + r) * 2] = i1; rinfo[(F.wave * 16 + 4 * q4 + r) * 2 + 1] = i2; }
        }
    }
    if (MODE == 2) {
        __syncthreads();
        if (F.tid < 64) { const int i = F.tid >> 3, j = F.tid & 7; int n = 0;
#pragma unroll 1
            for (int wr_ = 0; wr_ < 128; ++wr_) n += (rinfo[wr_ * 2] == i && rinfo[wr_ * 2 + 1] == j) ? 1 : 0;
            ((int*)(F.ws + WS_MOE + MOE_CNTW))[F.vcu * 64 + F.tid] = n; }
    }
    __syncthreads();
}

__device__ __forceinline__ void moe_orient_phase(Frame& F) {
    LAS int* NT = (LAS int*)F.lds;
    LAS int* PP = NT + 512;
    LAS int* Nij = PP + 512;
    LAS int* Pij = Nij + 64;
    LAS int* fl = Pij + 64;
    LAS int* tp = fl + 64;
    LAS int* rk = tp + 128;
    LAS int* ex = rk + 128;
    const int* CNTW = (const int*)(F.ws + WS_MOE + MOE_CNTW);
    const int tid = F.tid, NGW = F.G * NWAVES;
    { const int ij = tid & 63, part = tid >> 6; int tot = 0, pre = 0;
#pragma unroll 4
      for (int w = part * 32; w < part * 32 + 32; ++w) { const int c = CNTW[w * 64 + ij]; tot += c; pre += (w < F.vcu) ? c : 0; }
      NT[part * 64 + ij] = tot; PP[part * 64 + ij] = pre; }
    __syncthreads();
    if (tid < 64) { int a = 0, b = 0;
#pragma unroll
        for (int p = 0; p < 8; ++p) { a += NT[p * 64 + tid]; b += PP[p * 64 + tid]; }
        Nij[tid] = a; Pij[tid] = b; fl[tid] = 0; }
    __syncthreads();
    if (tid == 0) {
        int n0[8], dl[8], rem[8]; int k = 0;
        for (int e = 0; e < 8; ++e) { int n = 0; for (int j = 0; j < 8; ++j) n += Nij[e * 8 + j]; n0[e] = n; rem[e] = n & 255; k += rem[e]; dl[e] = -rem[e]; }
        k >>= 8;
        for (int t = 0; t < k; ++t) { int best = -1; for (int e = 0; e < 8; ++e) if (dl[e] <= 0 && rem[e] > 0 && dl[e] == -rem[e] && (best < 0 || rem[e] > rem[best])) best = e; if (best >= 0) dl[best] += 256; }
        for (int i = 0; i < 8; ++i) for (int j = 0; j < 8 && dl[i] < 0; ++j) if (j != i && dl[j] > 0) { int amt = -dl[i]; if (dl[j] < amt) amt = dl[j]; if (Nij[i * 8 + j] < amt) amt = Nij[i * 8 + j]; fl[i * 8 + j] = amt; dl[i] += amt; dl[j] -= amt; }
        (void)n0;
    }
    if (tid < 128) tp[tid] = ((const int*)(F.ws + WS_MOE + MOE_EIDX))[(F.vcu * NWAVES + (tid >> 4)) + (tid & 15) * NGW];
    __syncthreads();
    if (tid < 64) { const int i = tid >> 3, j = tid & 7, code = i | (j << 4); int r = 0;
#pragma unroll 1
        for (int t = 0; t < 128; ++t) if (tp[t] == code) { rk[t] = r; ++r; } }
    __syncthreads();
    if (tid < 128) { const int code = tp[tid], i = code & 15, j = code >> 4, m = (F.vcu * NWAVES + (tid >> 4)) + (tid & 15) * NGW;
        const bool flip = (Pij[i * 8 + j] + rk[tid]) < fl[i * 8 + j];
        ex[tid * 2] = flip ? j : i; ex[tid * 2 + 1] = flip ? i : j;
        if (flip) { float* gv = (float*)(F.ws + WS_MOE + MOE_GATEV); const float a = gv[m], b = gv[M + m]; gv[m] = b; gv[M + m] = a; } }
    __syncthreads();
    if (tid < 16) {
        const int s = tid >> 3, e = tid & 7; int n = 0;
#pragma unroll 1
        for (int t = 0; t < 128; ++t) n += (ex[t * 2 + s] == e) ? 1 : 0;
        unsigned base = 0; if (n) base = __hip_atomic_fetch_add((unsigned*)(F.ctl + CW_CNT + s * 8 + e), (unsigned)n, RLX_AGENT);
        int* list = (int*)(F.ws + WS_MOE + MOE_LIST) + ((size_t)(s * 8 + e)) * M;
        int k = 0;
#pragma unroll 1
        for (int t = 0; t < 128; ++t) if (ex[t * 2 + s] == e) { list[base + k] = (F.vcu * NWAVES + (t >> 4)) + (t & 15) * NGW; ++k; }
    }
    __syncthreads();
}

#ifndef EPI_NT
#define EPI_NT 0
#endif
#if EPI_NT
#define ST16(p, v) __builtin_nontemporal_store((v), (u32x4*)(p))
#else
#define ST16(p, v) (*(u32x4*)(p) = (v))
#endif
typedef f32x4 AccT[2][2][4][2];
__device__ __forceinline__ u32x4 pack8(const f32x4& a, const f32x4& b) { u32x4 w; w.x = cvt_pk_bf16(a[0], a[1]); w.y = cvt_pk_bf16(a[2], a[3]); w.z = cvt_pk_bf16(b[0], b[1]); w.w = cvt_pk_bf16(b[2], b[3]); return w; }
__device__ __forceinline__ f32x4 unpack4(const u32x2 w) { return (f32x4){bflo(w.x), bfhi(w.x), bflo(w.y), bfhi(w.y)}; }
__device__ __forceinline__ u32x2 pack4(const f32x4& a) { u32x2 w; w.x = cvt_pk_bf16(a[0], a[1]); w.y = cvt_pk_bf16(a[2], a[3]); return w; }
template <class GRow>
__device__ __forceinline__ void rs_commit(LAS float* red, float* RSO, int pn, int wr, int wc, int fr, int fq, const float (&ss)[2][4], const GRow& grow) {
#pragma unroll
    for (int ai = 0; ai < 2; ++ai)
#pragma unroll
        for (int m = 0; m < 4; ++m) { float s_ = ss[ai][m]; s_ += __shfl_xor(s_, 16); s_ += __shfl_xor(s_, 32); if (fq == 0) red[(ai * 128 + wr * 64 + m * 16 + fr) * 4 + wc] = s_; }
    asm volatile("s_waitcnt lgkmcnt(0)" ::: "memory"); __builtin_amdgcn_s_barrier(); asm volatile("" ::: "memory");
    const int t = (wr * 4 + wc) * 64 + fq * 16 + fr;
    if (t < 256) { const f32x4 a = *(const LAS f32x4*)(red + t * 4); const int g = grow(t); if (g >= 0) RSO[(size_t)g * 4 + pn] = (a[0] + a[1]) + (a[2] + a[3]); }
    asm volatile("s_waitcnt lgkmcnt(0)" ::: "memory"); __builtin_amdgcn_s_barrier(); asm volatile("" ::: "memory");
}
__device__ __forceinline__ void unpack8(const u32x4 w, f32x4& a, f32x4& b) { a = (f32x4){bflo(w.x), bfhi(w.x), bflo(w.y), bfhi(w.y)}; b = (f32x4){bflo(w.z), bfhi(w.z), bflo(w.w), bfhi(w.w)}; }
__device__ __forceinline__ float sq4(const f32x4& v) { return (v[0] * v[0] + v[1] * v[1]) + (v[2] * v[2] + v[3] * v[3]); }

struct EpiIn {
    bf16_t* U; const float* gq; const float* gk; const LAS float* rstab;
    __device__ __forceinline__ void operator()(const AccT& acc, const pg8::Unit& u, int wr, int wc, int fr, int fq) const {
        const int row0 = u.pm * 256 + wr * 64 + fr, pn = u.pn;
        float rsv[2][4];
#pragma unroll
        for (int ai = 0; ai < 2; ++ai)
#pragma unroll
            for (int m = 0; m < 4; ++m) rsv[ai][m] = rstab[u.ui * 256 + ai * 128 + wr * 64 + m * 16 + fr];
        if (pn < 4 || pn >= 10) {
            const int cb = (pn < 4 ? 256 * pn : UC_V + 256 * (pn - 10)) + wc * 32 + 8 * fq;
#pragma unroll
            for (int ai = 0; ai < 2; ++ai)
#pragma unroll
                for (int m = 0; m < 4; ++m) { bf16_t* rp = U + (size_t)(row0 + ai * 128 + m * 16) * UW + cb; const float r = rsv[ai][m];
#pragma unroll
                    for (int bj = 0; bj < 2; ++bj) ST16(rp + bj * 128, pack8(acc[ai][bj][m][0] * r, acc[ai][bj][m][1] * r)); }
        } else if (pn < 6) {
            const int cb = UC_Z + 128 * (pn - 4) + wc * 32 + 8 * fq;
#pragma unroll
            for (int ai = 0; ai < 2; ++ai)
#pragma unroll
                for (int m = 0; m < 4; ++m) { f32x4 z0, z1; const float r = rsv[ai][m];
#pragma unroll
                    for (int i = 0; i < 4; ++i) { z0[i] = acc[ai][0][m][0][i] * r * fast_sigmoid(acc[ai][1][m][0][i] * r); z1[i] = acc[ai][0][m][1][i] * r * fast_sigmoid(acc[ai][1][m][1][i] * r); }
                    ST16(U + (size_t)(row0 + ai * 128 + m * 16) * UW + cb, pack8(z0, z1)); }
        } else {
            const bool isq = pn < 8; const int j = 4 * (pn - (isq ? 6 : 8)) + wc;
            const float* g = isq ? gq : gk; const float sc = isq ? C2 : 1.f;
            f32x4 gv[2][2];
#pragma unroll
            for (int bj = 0; bj < 2; ++bj)
#pragma unroll
                for (int n = 0; n < 2; ++n) gv[bj][n] = *(const f32x4*)(g + 32 * bj + 8 * fq + 4 * n) * sc;
            const int cb = (isq ? UC_Q : UC_K) + 64 * j + 8 * fq;
#pragma unroll
            for (int ai = 0; ai < 2; ++ai)
#pragma unroll
                for (int m = 0; m < 4; ++m) { float ss = 0.f; const float r = rsv[ai][m];
#pragma unroll
                    for (int bj = 0; bj < 2; ++bj)
#pragma unroll
                        for (int n = 0; n < 2; ++n) ss += sq4(acc[ai][bj][m][n]);
                    ss += __shfl_xor(ss, 16); ss += __shfl_xor(ss, 32);
                    const float rs = r / sqrtf(ss * r * r * (1.f / 64.f) + EPS);
                    bf16_t* rp = U + (size_t)(row0 + ai * 128 + m * 16) * UW + cb;
#pragma unroll
                    for (int bj = 0; bj < 2; ++bj) ST16(rp + 32 * bj, pack8(acc[ai][bj][m][0] * gv[bj][0] * rs, acc[ai][bj][m][1] * gv[bj][1] * rs)); }
        }
    }
};
template <bool RESF32, bool W8 = false>
struct EpiRes {
    const void* res; bf16_t* out; float* RSO; LAS float* red; unsigned char* h8;
    __device__ __forceinline__ void operator()(const AccT& acc, const pg8::Unit& u, int wr, int wc, int fr, int fq) const {
        const int row0 = u.pm * 256 + wr * 64 + fr, col0 = u.pn * 256 + wc * 32 + 8 * fq; float ssa[2][4];
#pragma unroll
        for (int ai = 0; ai < 2; ++ai)
#pragma unroll
            for (int m = 0; m < 4; ++m) { const int row = row0 + ai * 128 + m * 16; const size_t ro = (size_t)row * D + col0; float ss = 0.f;
#pragma unroll
                for (int bj = 0; bj < 2; ++bj) { const size_t o = ro + bj * 128; f32x4 r0, r1;
                    if (RESF32) { r0 = *(const f32x4*)((const float*)res + o); r1 = *(const f32x4*)((const float*)res + o + 4); } else unpack8(*(const u32x4*)((const bf16_t*)res + o), r0, r1);
                    const f32x4 h0 = r0 + acc[ai][bj][m][0], h1 = r1 + acc[ai][bj][m][1]; ss += sq4(h0) + sq4(h1); *(u32x4*)(out + o) = pack8(h0, h1);
                    if (W8) { u32x2 q; q.x = pk4_fp8(h0[0] * F8S_H, h0[1] * F8S_H, h0[2] * F8S_H, h0[3] * F8S_H); q.y = pk4_fp8(h1[0] * F8S_H, h1[1] * F8S_H, h1[2] * F8S_H, h1[3] * F8S_H); *(u32x2*)(h8 + o) = q; } }
                ssa[ai][m] = ss; }
        const int pm256 = u.pm * 256; rs_commit(red, RSO, u.pn, wr, wc, fr, fq, ssa, [pm256](int t) { return pm256 + t; });
    }
};
template <bool CONV, bool O8 = false>
struct EpiGluT {
    bf16_t* O; int ldc; const LAS float* rstab; unsigned char* ws;
    __device__ __forceinline__ void operator()(const AccT& acc, const pg8::Unit& u, int wr, int wc, int fr, int fq) const {
        const int row0 = u.pm * 256 + wr * 64 + fr, cb = 128 * u.pn + wc * 32 + 8 * fq;
#pragma unroll
        for (int ai = 0; ai < 2; ++ai)
#pragma unroll
            for (int m = 0; m < 4; ++m) { f32x4 z0, z1; const float r = rstab[u.ui * 256 + ai * 128 + wr * 64 + m * 16 + fr];
#pragma unroll
                for (int i = 0; i < 4; ++i) { const float g0 = acc[ai][0][m][0][i] * r, g1 = acc[ai][0][m][1][i] * r; z0[i] = g0 * fast_sigmoid(g0) * acc[ai][1][m][0][i] * r; z1[i] = g1 * fast_sigmoid(g1) * acc[ai][1][m][1][i] * r; }
                if (O8) { u32x2 q; q.x = pk4_fp8(z0[0] * F8S_ACT, z0[1] * F8S_ACT, z0[2] * F8S_ACT, z0[3] * F8S_ACT); q.y = pk4_fp8(z1[0] * F8S_ACT, z1[1] * F8S_ACT, z1[2] * F8S_ACT, z1[3] * F8S_ACT);
                    *(u32x2*)((unsigned char*)O + (size_t)(row0 + ai * 128 + m * 16) * ldc + cb) = q; }
                else ST16(O + (size_t)(row0 + ai * 128 + m * 16) * ldc + cb, pack8(z0, z1)); }
        if (CONV) { if (u.ui == (int)(blockIdx.x % 11u)) { const int wave = wr * 4 + wc, lane = fq * 16 + fr;
            typedef const float* const __attribute__((address_space(4))) * kin_t; const kin_t kin = (kin_t)__builtin_amdgcn_kernarg_segment_ptr();
            const float* q_wg = kin[25]; const float* q_wu = kin[26]; const float* q_wd = kin[27]; const float* q_gain = kin[20] + D;
#pragma unroll 1
            for (int k = 0; k < 21; k += 3) {
                const int it0 = ((int)blockIdx.x * NWAVES + wave) * 21 + k;
                const PrepP P0 = moe_prep_decode(q_wg, q_wu, q_wd, q_gain, (bf16_t*)(ws + WS_WMGU), (bf16_t*)(ws + WS_WMD), it0);
                const PrepP P1 = moe_prep_decode(q_wg, q_wu, q_wd, q_gain, (bf16_t*)(ws + WS_WMGU), (bf16_t*)(ws + WS_WMD), it0 + 1);
                const PrepP P2 = moe_prep_decode(q_wg, q_wu, q_wd, q_gain, (bf16_t*)(ws + WS_WMGU), (bf16_t*)(ws + WS_WMD), it0 + 2);
                f32x4 v0[8], v1[8], v2[8]; prep_reg_load(P0, lane, v0); prep_reg_load(P1, lane, v1); prep_reg_load(P2, lane, v2);
                prep_reg_store(P0, lane, v0); prep_reg_store(P1, lane, v1); prep_reg_store(P2, lane, v2); } } }
    }
};
typedef EpiGluT<false> EpiGlu;
typedef EpiGluT<false, true> EpiGlu8;
template <int PASS>
struct EpiScatter {
    const bf16_t* res; bf16_t* out; float* RSO; const int* list_s; const float* gatev_s; const LAS int* rt_info; LAS float* red;
    __device__ __forceinline__ void operator()(const AccT& acc, const pg8::Unit& u, int wr, int wc, int fr, int fq) const {
        const int e = rt_info[3 * u.pm], i0 = rt_info[3 * u.pm + 1], nv = rt_info[3 * u.pm + 2];
        const int col0 = u.pn * 256 + wc * 32 + 8 * fq;
        const int* lst = list_s + (size_t)e * M + i0; float ssa[2][4];
#pragma unroll
        for (int ai = 0; ai < 2; ++ai)
#pragma unroll
            for (int m = 0; m < 4; ++m) { const int r = ai * 128 + wr * 64 + m * 16 + fr; const bool ok = r < nv;
                const int tok = ok ? lst[r] : 0; const float g = ok ? gatev_s[tok] * (1.f / (F8S_ACT * F8S_WD)) : 0.f;   const size_t ro = (size_t)tok * D + col0; float ss = 0.f;
#pragma unroll
                for (int bj = 0; bj < 2; ++bj) { const size_t o = ro + bj * 128;
                    if (ok) { f32x4 r0, r1; unpack8(*(const u32x4*)((PASS ? out : res) + o), r0, r1); const f32x4 h0 = r0 + acc[ai][bj][m][0] * g, h1 = r1 + acc[ai][bj][m][1] * g; ss += sq4(h0) + sq4(h1); *(u32x4*)(out + o) = pack8(h0, h1); } }
                ssa[ai][m] = ss; }
        if (PASS == 1) rs_commit(red, RSO, u.pn, wr, wc, fr, fq, ssa, [lst, nv](int t) { return t < nv ? lst[t] : -1; });
    }
};
struct EpiPe {
    bf16_t* O;
    __device__ __forceinline__ void operator()(const AccT& acc, const pg8::Unit& u, int wr, int wc, int fr, int fq) const {
        const int row0 = u.pm * 256 + wr * 64 + fr, col0 = u.pn * 256 + wc * 32 + 8 * fq;
#pragma unroll
        for (int ai = 0; ai < 2; ++ai)
#pragma unroll
            for (int m = 0; m < 4; ++m) { const size_t ro = (size_t)(row0 + ai * 128 + m * 16) * D + col0;
#pragma unroll
                for (int bj = 0; bj < 2; ++bj) *(u32x4*)(O + ro + bj * 128) = pack8(acc[ai][bj][m][0], acc[ai][bj][m][1]); }
    }
};
template <bool FINAL>
struct EpiPle {
    const bf16_t* H; const LAS float* rstab; const bf16_t* PE; bf16_t* outb; float* outf; float* RSO; LAS float* red;
    __device__ __forceinline__ void operator()(const AccT& acc, const pg8::Unit& u, int wr, int wc, int fr, int fq) const {
        const int row0 = u.pm * 256 + wr * 64 + fr, col0 = u.pn * 256 + wc * 32 + 8 * fq; float ssa[2][4];
#pragma unroll
        for (int ai = 0; ai < 2; ++ai)
#pragma unroll
            for (int m = 0; m < 4; ++m) { const int row = row0 + ai * 128 + m * 16; const size_t ro = (size_t)row * D + col0; const float r = rstab[u.ui * 256 + ai * 128 + wr * 64 + m * 16 + fr]; float ss = 0.f;
#pragma unroll
                for (int bj = 0; bj < 2; ++bj) { const size_t o = ro + bj * 128; f32x4 p0, p1, h0, h1; unpack8(*(const u32x4*)(PE + o), p0, p1); unpack8(*(const u32x4*)(H + o), h0, h1);
                    const f32x4 x0 = acc[ai][bj][m][0], x1 = acc[ai][bj][m][1];
#pragma unroll
                    for (int i = 0; i < 4; ++i) { h0[i] += fast_sigmoid(x0[i] * r) * p0[i]; h1[i] += fast_sigmoid(x1[i] * r) * p1[i]; }
                    if (FINAL) { *(f32x4*)(outf + o) = h0; *(f32x4*)(outf + o + 4) = h1; } else { ss += sq4(h0) + sq4(h1); *(u32x4*)(outb + o) = pack8(h0, h1); } }
                ssa[ai][m] = ss; }
        if (!FINAL) { const int pm256 = u.pm * 256; rs_commit(red, RSO, u.pn, wr, wc, fr, fq, ssa, [pm256](int t) { return pm256 + t; }); }
    }
};

template <class Sched>
__device__ __forceinline__ void build_rstab(Frame& F, const Sched& S, const float* RS, LAS float* rstab, LAS int* upm) {
    if (F.tid < 16) { pg8::Unit u; upm[F.tid] = S.next(F.tid, u) ? u.pm : -1; }
    __syncthreads();
#pragma unroll 4
    for (int idx = F.tid; idx < 16 * 256; idx += NWAVES * 64) { const int pm = upm[idx >> 8]; if (pm >= 0) rstab[idx] = rs_of(RS, pm * 256 + (idx & 255)); }
    __syncthreads();
}
struct MoeSched {
    pg8::StaticOrder so; const LAS int* rt_info; int ntn;
    const LAS int* map;
    __device__ __forceinline__ bool next(int i, pg8::Unit& u) const { if (!so.tile(i, u.pm, u.pn)) return false; if (map) u.pm = __builtin_amdgcn_readfirstlane(map[u.pm]); u.pb = __builtin_amdgcn_readfirstlane(rt_info[3 * u.pm]) * ntn + u.pn; u.kb = 0; u.aux = 0; return true; }
};
__device__ __forceinline__ int moe_build_tiles(Frame& F, int s, LAS int* rt_info) {
    int RT = 0;
    int cnt[8];
#pragma unroll
    for (int e = 0; e < 8; ++e) cnt[e] = (int)__hip_atomic_load((unsigned*)(F.ctl + CW_CNT + s * 8 + e), RLX_AGENT);
    if (F.tid == 0) { int rt = 0; for (int e = 0; e < 8; ++e) for (int i0 = 0; i0 < cnt[e]; i0 += 256) { rt_info[3 * rt] = e; rt_info[3 * rt + 1] = i0; rt_info[3 * rt + 2] = (cnt[e] - i0) < 256 ? (cnt[e] - i0) : 256; ++rt; } }
#pragma unroll
    for (int e = 0; e < 8; ++e) RT += (cnt[e] + 255) >> 8;
    __syncthreads();
    return RT;
}

constexpr int TAIL_KS = 2, TAIL_KLEN = FFE / 2 / TAIL_KS;
static_assert(TAIL_KLEN % 128 == 0, "even number of K-tiles per slice");
__device__ __forceinline__ void moe_split_tiles(Frame& F, const LAS int* rt_info, int RT, LAS int* mainidx, LAS int* tailidx, LAS int* cntw) {
    if (F.tid == 0) { int nm = 0, nt = 0; for (int t = 0; t < RT; ++t) { if (rt_info[3 * t + 2] == 256) mainidx[nm++] = t; else tailidx[nt++] = t; } cntw[0] = nm; cntw[1] = nt; }
    __syncthreads();
}
struct TailSched {
    const LAS int* rt_info; const LAS int* tailidx; int ntail, G, c;
    __device__ __forceinline__ bool next(int i, pg8::Unit& u) const { const int L = i * G + c; if (L >= ntail * 4 * TAIL_KS) return false;
        const int ti = L >> 3, pn = (L >> 1) & 3, ks = L & 1, t = __builtin_amdgcn_readfirstlane(tailidx[ti]); u.pm = t; u.pn = pn; u.pb = rt_info[3 * t] * 4 + pn; u.kb = ks * TAIL_KLEN * 2; u.aux = ti * 4 + ks; return true; }
};
struct EpiSide {
    float* SIDE;
    __device__ __forceinline__ void operator()(const AccT& acc, const pg8::Unit& u, int wr, int wc, int fr, int fq) const {
        const int ti = u.aux >> 2, ks = u.aux & 3; const int col0 = u.pn * 256 + wc * 32 + 8 * fq;
        float* base = SIDE + ((size_t)ks * 2048 + ti * 256) * D;
#pragma unroll
        for (int ai = 0; ai < 2; ++ai)
#pragma unroll
            for (int m = 0; m < 4; ++m) { float* rp = base + (size_t)(ai * 128 + wr * 64 + m * 16 + fr) * D + col0;
#pragma unroll
                for (int bj = 0; bj < 2; ++bj) { *(f32x4*)(rp + bj * 128) = acc[ai][bj][m][0]; *(f32x4*)(rp + bj * 128 + 4) = acc[ai][bj][m][1]; } }
    }
};
__device__ __forceinline__ void moe_tail_merge(Frame& F, int s, bf16_t* Hc, float* RSO, const float* SIDE, LAS int* rt_info, LAS int* mainidx, LAS int* tailidx, LAS int* cntw) {
    const int RT = moe_build_tiles(F, s, rt_info);
    moe_split_tiles(F, rt_info, RT, mainidx, tailidx, cntw);
    const int ntail = cntw[1];
    const int* list_s = (const int*)(F.ws + WS_MOE + MOE_LIST) + (size_t)s * 8 * M;
    const float* gatev_s = (const float*)(F.ws + WS_MOE + MOE_GATEV) + (size_t)s * M;
    for (int w = F.vcu * NWAVES + F.wave; w < ntail * 256; w += F.G * NWAVES) {
        const int ti = w >> 8, r = w & 255, t = tailidx[ti], e = rt_info[3 * t], i0 = rt_info[3 * t + 1], nv = rt_info[3 * t + 2];
        if (r >= nv) continue;
        const int tok = list_s[(size_t)e * M + i0 + r]; const float g = gatev_s[tok] * (1.f / (F8S_ACT * F8S_WD));
        f32x4 a[4];
#pragma unroll
        for (int q = 0; q < 4; ++q) a[q] = (f32x4){0.f, 0.f, 0.f, 0.f};
#pragma unroll
        for (int ks = 0; ks < TAIL_KS; ++ks) { const f32x4* sp = (const f32x4*)(SIDE + ((size_t)ks * 2048 + ti * 256 + r) * D + 16 * F.lane);
#pragma unroll
            for (int q = 0; q < 4; ++q) a[q] = a[q] + sp[q]; }
        u32x4* hp = (u32x4*)(Hc + (size_t)tok * D + 16 * F.lane);
        f32x4 h0, h1, h2, h3; unpack8(hp[0], h0, h1); unpack8(hp[1], h2, h3);
        h0 = h0 + a[0] * g; h1 = h1 + a[1] * g; h2 = h2 + a[2] * g; h3 = h3 + a[3] * g;
        hp[0] = pack8(h0, h1); hp[1] = pack8(h2, h3);
        const float ss = wave_sum((sq4(h0) + sq4(h1)) + (sq4(h2) + sq4(h3)));
        if (F.lane < 4) RSO[(size_t)tok * 4 + F.lane] = (F.lane == 0) ? ss : 0.f;
    }
}
typedef float f32x16 __attribute__((ext_vector_type(16)));
typedef short s16x4 __attribute__((ext_vector_type(4)));
typedef short v4i16_t __attribute__((ext_vector_type(4)));
#define MFMA32(a, b, c) __builtin_amdgcn_mfma_f32_32x32x16_bf16((a), (b), (c), 0, 0, 0)
__device__ __forceinline__ int crow(int r, int hi) { return (r & 3) + 8 * (r >> 2) + 4 * hi; }
__device__ __forceinline__ float fast_silu(float x) { return x * fast_sigmoid(x); }
__device__ __forceinline__ s16x4 tr_read(const LAS unsigned char* p) { return __builtin_bit_cast(s16x4, __builtin_amdgcn_ds_read_tr16_b64_v4i16((LAS v4i16_t*)p)); }
__device__ __forceinline__ bf16x8 tr_frag(const LAS unsigned char* T, int row0, int step2, int c0, int lane) {
    const int q = (lane & 15) >> 2, p = lane & 3, cg = (lane >> 4) & 1;
    const LAS unsigned char* a = T + (row0 + q) * 128 + (c0 + 16 * cg + 4 * p) * 2;
    const s16x4 lo = tr_read(a), hi = tr_read(a + step2 * 128);
    return (bf16x8){lo[0], lo[1], lo[2], lo[3], hi[0], hi[1], hi[2], hi[3]};
}

template <class Next>
__device__ __forceinline__ void conformer_units(Frame& F, int L, int firstu, const Next& next) {
    const bf16_t* U = (const bf16_t*)(F.ws + WS_BIG); bf16_t* Y = (bf16_t*)(F.ws + WS_AY);
    const float* cw = F.in[8] + L * 31 * 256; const float* cb = F.in[9] + L * 256; const float* lg = F.in[10] + L * 256; const float* lb = F.in[11] + L * 256;
    LAS unsigned char* zt = F.lds;
    LAS float* ot = (LAS float*)(F.lds + 49152);
    const int tid = F.tid, c = tid & 255, hf = tid >> 8;
    float w[31];
#pragma unroll
    for (int j = 0; j < 31; ++j) w[j] = cw[j * 256 + c];
    const float bias = cb[c];
    for (int unit = firstu; unit < M / 64; unit = next(unit)) {
        const int row0 = unit * 64, t0 = row0 & (SEQ - 1);
        __syncthreads();
#pragma unroll
        for (int i0 = 0; i0 < 6; ++i0) { const int i = tid + i0 * NWAVES * 64; if (i < 94 * 32) { const int r = i >> 5, ch = i & 31; const bool ok = t0 - 30 + r >= 0;
            u32x4 v = *(const GAS u32x4*)(U + (size_t)(row0 + (ok ? r - 30 : 0)) * UW + UC_Z + ch * 8);
            v.x = ok ? v.x : 0u; v.y = ok ? v.y : 0u; v.z = ok ? v.z : 0u; v.w = ok ? v.w : 0u;
            *(LAS u32x4*)(zt + r * 512 + ch * 16) = v; } }
        __syncthreads();
        float x[62];
#pragma unroll
        for (int i = 0; i < 62; ++i) x[i] = bf2f(*(const LAS unsigned short*)(zt + (32 * hf + i) * 512 + c * 2));
#pragma unroll
        for (int o = 0; o < 32; ++o) { float a = bias;
#pragma unroll
            for (int j = 0; j < 31; ++j) a += w[j] * x[o + j];
            ot[(32 * hf + o) * 260 + c] = a; }
        __syncthreads();
        const f32x4 g4 = *(const f32x4*)(lg + 4 * F.lane), b4 = *(const f32x4*)(lb + 4 * F.lane);
#pragma unroll 2
        for (int tt = 0; tt < 8; ++tt) { const int t = F.wave * 8 + tt;
            const f32x4 x = *(const LAS f32x4*)(ot + t * 260 + 4 * F.lane);
            const float mu = wave_sum((x[0] + x[1]) + (x[2] + x[3])) * (1.f / 256.f);
            const f32x4 dv = x - mu;
            const float var = wave_sum((dv[0] * dv[0] + dv[1] * dv[1]) + (dv[2] * dv[2] + dv[3] * dv[3])) * (1.f / 256.f);
            const float rstd = 1.0f / sqrtf(var + EPS);
            f32x4 y = dv * rstd * g4 + b4;
#pragma unroll
            for (int i = 0; i < 4; ++i) y[i] = fast_silu(y[i]);
            u32x2 o; o.x = cvt_pk_bf16(y[0], y[1]); o.y = cvt_pk_bf16(y[2], y[3]);
            *(GAS u32x2*)(Y + (size_t)(row0 + t) * D + 256 + 4 * F.lane) = o; }
    }
    __syncthreads();
}
__device__ __forceinline__ void conformer_phase(Frame& F, int L) { const int G = F.G; conformer_units(F, L, F.vcu, [G](int u) { return u + G; }); }

constexpr size_t MST_N = (size_t)2048 * 4096 * 4, MST_MG = MST_N + (size_t)2048 * 64 * 4, MST_MP = MST_MG + (size_t)2048 * 2 * 4;
template <bool NEEDQ, bool TOREG = false>
__device__ __forceinline__ void mlstm_load(const bf16_t* U, const float* cw, int row0, int t0, int h, int lane, float kscale, float qscale, LAS unsigned char* qt, LAS unsigned char* kt, LAS unsigned char* vt, u32x4* qr = nullptr, u32x4* kr = nullptr) {
    { const GAS u32x4* vp = (const GAS u32x4*)(U + (size_t)(row0 + lane) * UW + UC_MV + h * 64);
#pragma unroll
      for (int i = 0; i < 8; ++i) *(LAS u32x4*)(vt + lane * 128 + i * 16) = vp[i]; }
#pragma unroll
    for (int which = NEEDQ ? 0 : 1; which < 2; ++which) {
        const int col = (which ? UC_MK : UC_MQ) + h * 64; const float* wv = cw + (which ? 256 : 0) + h * 64; LAS unsigned char* dst = which ? kt : qt; const float sc = which ? kscale : qscale;
#pragma unroll
        for (int i = 0; i < 8; ++i) {
            float acc[8];
#pragma unroll
            for (int d = 0; d < 8; ++d) acc[d] = 0.f;
#pragma unroll
            for (int j = 0; j < 4; ++j) { const bool ok = t0 + lane - 3 + j >= 0;
                u32x4 x = *(const GAS u32x4*)(U + (size_t)(row0 + (ok ? lane - 3 + j : 0)) * UW + col + i * 8);
                x.x = ok ? x.x : 0u; x.y = ok ? x.y : 0u; x.z = ok ? x.z : 0u; x.w = ok ? x.w : 0u;
                const float* wj = wv + j * 512 + i * 8;
                acc[0] += wj[0] * bflo(x.x); acc[1] += wj[1] * bfhi(x.x); acc[2] += wj[2] * bflo(x.y); acc[3] += wj[3] * bfhi(x.y);
                acc[4] += wj[4] * bflo(x.z); acc[5] += wj[5] * bfhi(x.z); acc[6] += wj[6] * bflo(x.w); acc[7] += wj[7] * bfhi(x.w); }
#pragma unroll
            for (int d = 0; d < 8; ++d) acc[d] = fast_silu(acc[d]) * sc;
            u32x4 o; o.x = cvt_pk_bf16(acc[0], acc[1]); o.y = cvt_pk_bf16(acc[2], acc[3]); o.z = cvt_pk_bf16(acc[4], acc[5]); o.w = cvt_pk_bf16(acc[6], acc[7]);
            if (TOREG) { if (which) kr[i] = o; else qr[i] = o; } else *(LAS u32x4*)(dst + lane * 128 + i * 16) = o; }
    }
}
constexpr int MRAW = 72 * 144;
__device__ __forceinline__ void mlstm_raw_load(const bf16_t* U, int row0, int t0, int col, int lane, LAS unsigned char* raw) {
#pragma unroll
    for (int i = 0; i < 9; ++i) { const int r = 8 * i + (lane >> 3), ch = lane & 7; const bool ok = (t0 - 3 + r >= 0);
        const int gr = row0 - 3 + r; u32x4 x = *(const GAS u32x4*)(U + (size_t)(ok ? gr : row0) * UW + col + ch * 8);
        x.x = ok ? x.x : 0u; x.y = ok ? x.y : 0u; x.z = ok ? x.z : 0u; x.w = ok ? x.w : 0u;
        *(LAS u32x4*)(raw + r * 144 + ch * 16) = x; }
}
__device__ __forceinline__ void mlstm_conv_row(const LAS unsigned char* raw, const float* wv  , int lane, float sc, u32x4 (&out)[8]) {
#pragma unroll
    for (int i = 0; i < 8; ++i) { float acc[8];
#pragma unroll
        for (int d = 0; d < 8; ++d) acc[d] = 0.f;
#pragma unroll
        for (int j = 0; j < 4; ++j) { const u32x4 x = *(const LAS u32x4*)(raw + (lane + j) * 144 + i * 16); const float* wj = wv + j * 512 + i * 8;
            acc[0] += wj[0] * bflo(x.x); acc[1] += wj[1] * bfhi(x.x); acc[2] += wj[2] * bflo(x.y); acc[3] += wj[3] * bfhi(x.y);
            acc[4] += wj[4] * bflo(x.z); acc[5] += wj[5] * bfhi(x.z); acc[6] += wj[6] * bflo(x.w); acc[7] += wj[7] * bfhi(x.w); }
#pragma unroll
        for (int d = 0; d < 8; ++d) acc[d] = fast_silu(acc[d]) * sc;
        u32x4 o; o.x = cvt_pk_bf16(acc[0], acc[1]); o.y = cvt_pk_bf16(acc[2], acc[3]); o.z = cvt_pk_bf16(acc[4], acc[5]); o.w = cvt_pk_bf16(acc[6], acc[7]); out[i] = o; }
}
__device__ __forceinline__ void tile64_load(const bf16_t* U, int row0, int col, int lane, LAS unsigned char* dst, int stride) {
#pragma unroll
    for (int i = 0; i < 8; ++i) { const int r = 8 * i + (lane >> 3), ch = lane & 7; *(LAS u32x4*)(dst + r * stride + ch * 16) = *(const GAS u32x4*)(U + (size_t)(row0 + r) * UW + col + ch * 8); }
}
__device__ __forceinline__ void mlstm_gates(const float* GATE, const float* bi, const float* bfg, int row0, int h, int lane, float& ig, float& bcum, float& g) {
    ig = GATE[(size_t)(row0 + lane) * 8 + h] + bi[h];
    const float f = GATE[(size_t)(row0 + lane) * 8 + 4 + h] + bfg[h];
    float lf = fminf(f, 0.f) - log1pf(__expf(-fabsf(f)));
#pragma unroll
    for (int o = 1; o < 64; o <<= 1) { const float t = __shfl_up(lf, o); if (lane >= o) lf += t; }
    bcum = lf; g = __shfl(lf, 63);
}

__device__ __forceinline__ void mlstm_local_phase(Frame& F, int L) {
    const bf16_t* U = (const bf16_t*)(F.ws + WS_BIG); const float* GATE = (const float*)(F.ws + WS_GATE);
    float* Cst = (float*)(F.ws + WS_MST); float* Nst = (float*)(F.ws + WS_MST + MST_N); float* MG = (float*)(F.ws + WS_MST + MST_MG);
    const float* cw = F.in[6] + L * 2048; const float* bi = F.in[4] + L * 4; const float* bfg = F.in[5] + L * 4;
    LAS unsigned char* kt = F.lds + F.wave * 19584; LAS unsigned char* vt = kt + 8192;
    const int lane = F.lane, r32 = lane & 31, half = lane >> 5;
    for (int unit = F.vcu * NWAVES + F.wave; unit < 2048; unit += F.G * NWAVES) {
        const int h = unit & 3, bc = unit >> 2, row0 = bc * 64, t0 = row0 & (SEQ - 1);
        mlstm_raw_load(U, row0, t0, UC_MK + h * 64, lane, vt);
        float ig, bcum, g; mlstm_gates(GATE, bi, bfg, row0, h, lane, ig, bcum, g);
        const float wl = g - bcum + ig, ml = wave_max(wl), el = __expf(wl - ml);
        LDS_WAIT(); asm volatile("" ::: "memory");
        { u32x4 kr[8]; mlstm_conv_row(vt, cw + 256 + h * 64, lane, el, kr);
#pragma unroll
          for (int i = 0; i < 8; ++i) *(LAS u32x4*)(kt + lane * 128 + i * 16) = kr[i]; }
        LDS_WAIT(); asm volatile("" ::: "memory");
        tile64_load(U, row0, UC_MV + h * 64, lane, vt, 128);
        LDS_WAIT(); asm volatile("" ::: "memory");
        f32x16 acc[2][2], nacc[2];
#pragma unroll
        for (int db = 0; db < 2; ++db) { nacc[db] = f32x16{};
#pragma unroll
            for (int eb = 0; eb < 2; ++eb) acc[db][eb] = f32x16{}; }
        const bf16x8 ones = (bf16x8){0x3F80, 0x3F80, 0x3F80, 0x3F80, 0x3F80, 0x3F80, 0x3F80, 0x3F80};
#pragma unroll
        for (int ks = 0; ks < 4; ++ks) {
            bf16x8 a[2], b[2];
#pragma unroll
            for (int db = 0; db < 2; ++db) a[db] = tr_frag(kt, 16 * ks + 8 * half, 4, 32 * db, lane);
#pragma unroll
            for (int eb = 0; eb < 2; ++eb) b[eb] = tr_frag(vt, 16 * ks + 8 * half, 4, 32 * eb, lane);
#pragma unroll
            for (int db = 0; db < 2; ++db) { nacc[db] = MFMA32(a[db], ones, nacc[db]);
#pragma unroll
                for (int eb = 0; eb < 2; ++eb) acc[db][eb] = MFMA32(a[db], b[eb], acc[db][eb]); }
        }
        float* Cu = Cst + (size_t)unit * 4096;
#pragma unroll
        for (int db = 0; db < 2; ++db)
#pragma unroll
            for (int eb = 0; eb < 2; ++eb)
#pragma unroll
                for (int r = 0; r < 16; ++r) Cu[(32 * db + crow(r, half)) * 64 + 32 * eb + r32] = acc[db][eb][r];
        if (r32 == 0) {
#pragma unroll
            for (int db = 0; db < 2; ++db)
#pragma unroll
                for (int r = 0; r < 16; ++r) Nst[(size_t)unit * 64 + 32 * db + crow(r, half)] = nacc[db][r];
        }
        if (lane == 0) { MG[unit * 2] = ml; MG[unit * 2 + 1] = g; }
        LDS_WAIT(); asm volatile("" ::: "memory");
    }
}

__device__ __forceinline__ void mlstm_scan_phase(Frame& F) {
    float* Cst = (float*)(F.ws + WS_MST); float* Nst = (float*)(F.ws + WS_MST + MST_N); float* MG = (float*)(F.ws + WS_MST + MST_MG);
    float* MP = (float*)(F.ws + WS_MST + MST_MP);
    const int gw = F.vcu * NWAVES + F.wave; if (gw >= 1024 + 16) return;
    const bool isn = gw >= 1024;
    const int bh = isn ? gw - 1024 : gw >> 6, b = bh >> 2, h = bh & 3, el = isn ? F.lane : (gw & 63) * 64 + F.lane;
    float st = 0.f, m = 0.f;
    for (int c0 = 0; c0 < 128; c0 += 32) {
        float x[32], ml[32], gg[32];
#pragma unroll
        for (int i = 0; i < 32; ++i) { const int unit = (b * 128 + c0 + i) * 4 + h;
            x[i] = isn ? Nst[(size_t)unit * 64 + el] : Cst[(size_t)unit * 4096 + el]; ml[i] = MG[unit * 2]; gg[i] = MG[unit * 2 + 1]; }
#pragma unroll
        for (int i = 0; i < 32; ++i) { const int unit = (b * 128 + c0 + i) * 4 + h;
            const float mn = fmaxf(gg[i] + m, ml[i]), a = __expf(gg[i] + m - mn), bb = __expf(ml[i] - mn);
            if (isn) { Nst[(size_t)unit * 64 + el] = st; } else Cst[(size_t)unit * 4096 + el] = st;
            st = a * st + bb * x[i];
            if (isn && F.lane == 0) MP[unit] = m;
            m = mn; }
    }
}

__device__ __forceinline__ void mlstm_out_phase(Frame& F, int L) {
    const bf16_t* U = (const bf16_t*)(F.ws + WS_BIG); const float* GATE = (const float*)(F.ws + WS_GATE); bf16_t* Y = (bf16_t*)(F.ws + WS_AY);
    const float* Cst = (const float*)(F.ws + WS_MST); const float* Nst = (const float*)(F.ws + WS_MST + MST_N); const float* MP = (const float*)(F.ws + WS_MST + MST_MP);
    const float* cw = F.in[6] + L * 2048; const float* bi = F.in[4] + L * 4; const float* bfg = F.in[5] + L * 4; const float* gm = F.in[7] + L * 256;
    LAS unsigned char* vt = F.lds + F.wave * 19584; LAS unsigned char* ct = vt + 8192;
    LAS float* sc = (LAS float*)(vt + 18560);
    const int lane = F.lane, r32 = lane & 31, half = lane >> 5;
    for (int unit = F.vcu * NWAVES + F.wave; unit < 2048; unit += F.G * NWAVES) {
        const int h = unit & 3, bc = unit >> 2, row0 = bc * 64, t0 = row0 & (SEQ - 1);
        float ig, bcum, g; mlstm_gates(GATE, bi, bfg, row0, h, lane, ig, bcum, g);
        const float mprev = MP[unit];
        const float wv = ig - bcum; float pm = wv;
#pragma unroll
        for (int o = 1; o < 64; o <<= 1) { const float t = __shfl_up(pm, o); if (lane >= o) pm = fmaxf(pm, t); }
        const float mml = fmaxf(mprev, pm);
        bf16x8 qf[2][4], kf[2][4];
        float d2 = 0.f;
        const int ln = lane_id_v();
        mlstm_raw_load(U, row0, t0, UC_MQ + h * 64, ln, ct); tile64_load(U, row0, UC_MV + h * 64, ln, vt, 128);
        LDS_WAIT(); asm volatile("" ::: "memory");
        { u32x4 qr[8];
          mlstm_conv_row(ct, cw + h * 64, lane, 0.125f, qr);
#pragma unroll
          for (int i = 0; i < 8; ++i) { const u32x4 qv = qr[i]; const float* np = Nst + (size_t)unit * 64 + i * 8;
              d2 += bflo(qv.x) * np[0] + bfhi(qv.x) * np[1] + bflo(qv.y) * np[2] + bfhi(qv.y) * np[3] + bflo(qv.z) * np[4] + bfhi(qv.z) * np[5] + bflo(qv.w) * np[6] + bfhi(qv.w) * np[7]; }
#pragma unroll
          for (int ks = 0; ks < 4; ++ks) { u32x4 f0, f1;
#pragma unroll
              for (int r = 0; r < 4; ++r) { auto x = __builtin_amdgcn_permlane32_swap(qr[2 * ks][r], qr[2 * ks + 1][r], false, false); f0[r] = x[0]; f1[r] = x[1]; }
              qf[0][ks] = __builtin_bit_cast(bf16x8, f0); qf[1][ks] = __builtin_bit_cast(bf16x8, f1); } }
        LDS_WAIT(); asm volatile("" ::: "memory");
        mlstm_raw_load(U, row0, t0, UC_MK + h * 64, ln, ct);
        LDS_WAIT(); asm volatile("" ::: "memory");
        { u32x4 kr[8];
          mlstm_conv_row(ct, cw + 256 + h * 64, lane, 1.f, kr);
#pragma unroll
          for (int ks = 0; ks < 4; ++ks) { u32x4 g0, g1;
#pragma unroll
              for (int r = 0; r < 4; ++r) { auto y = __builtin_amdgcn_permlane32_swap(kr[2 * ks][r], kr[2 * ks + 1][r], false, false); g0[r] = y[0]; g1[r] = y[1]; }
              kf[0][ks] = __builtin_bit_cast(bf16x8, g0); kf[1][ks] = __builtin_bit_cast(bf16x8, g1); } }
        LDS_WAIT(); asm volatile("" ::: "memory");
        { const GAS f32x4* cp = (const GAS f32x4*)(Cst + (size_t)unit * 4096) + lane;
#pragma unroll
          for (int i = 0; i < 16; ++i) { const f32x4 a = cp[64 * i]; *(LAS u32x2*)(ct + (4 * i + (lane >> 4)) * 128 + (lane & 15) * 8) = pack4(a); } }
        sc[lane] = mml; sc[64 + lane] = bcum; sc[128 + lane] = wv; sc[192 + lane] = d2;
        LDS_WAIT(); asm volatile("" ::: "memory");
        f32x16 Mx[2][2];
#pragma unroll
        for (int eb = 0; eb < 2; ++eb)
#pragma unroll
            for (int lb = 0; lb < 2; ++lb) Mx[eb][lb] = f32x16{};
#pragma unroll
        for (int ks = 0; ks < 4; ++ks) {
#pragma unroll
            for (int eb = 0; eb < 2; ++eb) { const bf16x8 cf = tr_frag(ct, 16 * ks + 8 * half, 4, 32 * eb, lane);
                Mx[eb][0] = MFMA32(cf, qf[0][ks], Mx[eb][0]); Mx[eb][1] = MFMA32(cf, qf[1][ks], Mx[eb][1]); }
        }
        f32x16 S00 = f32x16{}, S01 = f32x16{}, S11 = f32x16{};
#pragma unroll
        for (int ks = 0; ks < 4; ++ks) { S00 = MFMA32(kf[0][ks], qf[0][ks], S00); S01 = MFMA32(kf[0][ks], qf[1][ks], S01); S11 = MFMA32(kf[1][ks], qf[1][ks], S11); }
        const float mm0 = sc[r32], mm1 = sc[32 + r32];
        float dn0 = 0.f, dn1 = 0.f;
#pragma unroll
        for (int r = 0; r < 16; ++r) { const int s0 = crow(r, half); const float w0 = sc[128 + s0], w1 = sc[128 + 32 + s0];
            const float a = (s0 <= r32) ? S00[r] * __expf(w0 - mm0) : 0.f; S00[r] = a; dn0 += a;
            const float b = S01[r] * __expf(w0 - mm1); S01[r] = b; dn1 += b;
            const float c = (s0 <= r32) ? S11[r] * __expf(w1 - mm1) : 0.f; S11[r] = c; dn1 += c; }
        dn0 += __shfl_xor(dn0, 32); dn1 += __shfl_xor(dn1, 32);
        f32x16 N[2][2];
#pragma unroll
        for (int eb = 0; eb < 2; ++eb)
#pragma unroll
            for (int lb = 0; lb < 2; ++lb) N[eb][lb] = f32x16{};
#pragma unroll
        for (int kk = 0; kk < 2; ++kk) {
            bf16x8 p00, p01, p11;
            { u32x4 t; t.x = cvt_pk_bf16(S00[8 * kk], S00[8 * kk + 1]); t.y = cvt_pk_bf16(S00[8 * kk + 2], S00[8 * kk + 3]); t.z = cvt_pk_bf16(S00[8 * kk + 4], S00[8 * kk + 5]); t.w = cvt_pk_bf16(S00[8 * kk + 6], S00[8 * kk + 7]); p00 = __builtin_bit_cast(bf16x8, t); }
            { u32x4 t; t.x = cvt_pk_bf16(S01[8 * kk], S01[8 * kk + 1]); t.y = cvt_pk_bf16(S01[8 * kk + 2], S01[8 * kk + 3]); t.z = cvt_pk_bf16(S01[8 * kk + 4], S01[8 * kk + 5]); t.w = cvt_pk_bf16(S01[8 * kk + 6], S01[8 * kk + 7]); p01 = __builtin_bit_cast(bf16x8, t); }
            { u32x4 t; t.x = cvt_pk_bf16(S11[8 * kk], S11[8 * kk + 1]); t.y = cvt_pk_bf16(S11[8 * kk + 2], S11[8 * kk + 3]); t.z = cvt_pk_bf16(S11[8 * kk + 4], S11[8 * kk + 5]); t.w = cvt_pk_bf16(S11[8 * kk + 6], S11[8 * kk + 7]); p11 = __builtin_bit_cast(bf16x8, t); }
#pragma unroll
            for (int eb = 0; eb < 2; ++eb) {
                const bf16x8 v0 = tr_frag(vt, 16 * kk + 4 * half, 8, 32 * eb, lane), v1 = tr_frag(vt, 32 + 16 * kk + 4 * half, 8, 32 * eb, lane);
                N[eb][0] = MFMA32(v0, p00, N[eb][0]); N[eb][1] = MFMA32(v0, p01, N[eb][1]); N[eb][1] = MFMA32(v1, p11, N[eb][1]);
            }
        }
        LDS_WAIT(); asm volatile("" ::: "memory");
        LAS unsigned char* mot = vt; LAS unsigned char* yt = vt + 9216;
        tile64_load(U, row0, UC_MO + h * 64, ln, mot, 136);
        LDS_WAIT(); asm volatile("" ::: "memory");
#pragma unroll
        for (int lb = 0; lb < 2; ++lb) {
            const int l = 32 * lb + r32; const float mm = lb ? mm1 : mm0, is = __expf(mprev - mm), den = (lb ? dn1 : dn0) + is * sc[192 + l];
            const float mout = sc[64 + l] + mm, rden = 1.0f / fmaxf(fabsf(den), __expf(-mout));
            float o[2][16]; float ss = 0.f;
#pragma unroll
            for (int eb = 0; eb < 2; ++eb)
#pragma unroll
                for (int r = 0; r < 16; ++r) { const float x = (N[eb][lb][r] + is * Mx[eb][lb][r]) * rden; o[eb][r] = x; ss += x * x; }
            ss += __shfl_xor(ss, 32);
            const float rs = 1.0f / sqrtf(ss * (1.f / 64.f) + EPS);
#pragma unroll
            for (int eb = 0; eb < 2; ++eb)
#pragma unroll
                for (int gq = 0; gq < 4; ++gq) { const int e0 = 32 * eb + 8 * gq + 4 * half;
                    const f32x4 gv = *(const f32x4*)(gm + h * 64 + e0); const u32x2 mv = *(const LAS u32x2*)(mot + l * 136 + e0 * 2);
                    const float y0 = o[eb][4 * gq] * rs * gv[0] * fast_sigmoid(bflo(mv.x)), y1 = o[eb][4 * gq + 1] * rs * gv[1] * fast_sigmoid(bfhi(mv.x));
                    const float y2 = o[eb][4 * gq + 2] * rs * gv[2] * fast_sigmoid(bflo(mv.y)), y3 = o[eb][4 * gq + 3] * rs * gv[3] * fast_sigmoid(bfhi(mv.y));
                    u32x2 w; w.x = cvt_pk_bf16(y0, y1); w.y = cvt_pk_bf16(y2, y3); *(LAS u32x2*)(yt + l * 136 + e0 * 2) = w; }
        }
        LDS_WAIT(); asm volatile("" ::: "memory");
#pragma unroll
        for (int i = 0; i < 8; ++i) { const int r = 8 * i + (lane >> 3), ch = lane & 7; const LAS unsigned char* sp = yt + r * 136 + ch * 16;
            u32x4 w; w.x = *(const LAS unsigned*)(sp); w.y = *(const LAS unsigned*)(sp + 4); w.z = *(const LAS unsigned*)(sp + 8); w.w = *(const LAS unsigned*)(sp + 12);
            *(GAS u32x4*)(Y + (size_t)(row0 + r) * D + h * 64 + ch * 8) = w; }
        LDS_WAIT(); asm volatile("" ::: "memory");
    }
}
constexpr int AT_SLOT = 32768, AT_K2 = 8192, AT_V = 16384;
#ifndef ATT_LAG
#define ATT_LAG 0
#endif
#ifndef ATT_PRIO
#define ATT_PRIO 0
#endif
#ifndef ATT_PAIR
#define ATT_PAIR 0
#endif
__device__ __forceinline__ void glds16(const void* gsrc, unsigned lds_dst) { unsigned keep;
    asm volatile("s_mov_b32 %0, m0\n\ts_mov_b32 m0, %2\n\ts_nop 0\n\tglobal_load_lds_dwordx4 %1, off\n\ts_mov_b32 m0, %0" : "=&s"(keep) : "v"(gsrc), "s"(lds_dst) : "memory"); }
__device__ __forceinline__ void attn_dma_tile(const bf16_t* Ub  , int hd, int k0, LAS unsigned char* slot, int wave, int lane) {
#pragma unroll
    for (int i = 0; i < 4; ++i) {
        const int id = 4 * wave + i;
        const bf16_t* src; LAS unsigned char* dst;
        if (id < 16) { const int m = id >> 3, g = id & 7, r = 8 * g + (lane >> 3);
            src = Ub + (size_t)(k0 + r) * UW + UC_K + (2 * hd + m) * 64 + 8 * ((lane & 7) ^ (r & 7)); dst = slot + m * AT_K2 + g * 1024; }
        else { const int db = (id - 16) >> 2, rq = (id - 16) & 3; src = Ub + (size_t)(k0 + 16 * rq + (lane >> 2)) * UW + UC_V + hd * 128 + 32 * db + 8 * (lane & 3); dst = slot + AT_V + db * 4096 + rq * 1024; }
        glds16(src, (unsigned)__builtin_amdgcn_readfirstlane((int)(unsigned)(uintptr_t)dst));
    }
}
#define ATT_VRD(DST, VIM, KS) do { _Pragma("unroll") for (int db_ = 0; db_ < 4; ++db_) { const LAS unsigned char* a_ = (VIM) + db_ * 4096 + (KS) * 1024; DST[db_][0] = tr_read(a_); DST[db_][1] = tr_read(a_ + 512); } } while (0)
#define ATT_VMM(PFK, SRC) do { if (ATT_PRIO) __builtin_amdgcn_s_setprio(1); _Pragma("unroll") for (int db_ = 0; db_ < 4; ++db_) { \
        const bf16x8 vf_ = (bf16x8){SRC[db_][0][0], SRC[db_][0][1], SRC[db_][0][2], SRC[db_][0][3], SRC[db_][1][0], SRC[db_][1][1], SRC[db_][1][2], SRC[db_][1][3]}; o[db_] = MFMA32((PFK), vf_, o[db_]); } if (ATT_PRIO) __builtin_amdgcn_s_setprio(0); } while (0)
#define ATT_SB() __builtin_amdgcn_sched_barrier(0)
#define ATT_PV(PF, VIM) do { s16x4 va_[4][2], vb_[4][2]; ATT_SB(); ATT_VRD(va_, VIM, 0); ATT_VRD(vb_, VIM, 1); ATT_SB(); ATT_VMM((PF)[0], va_); ATT_SB(); ATT_VRD(va_, VIM, 2); ATT_SB(); ATT_VMM((PF)[1], vb_); ATT_SB(); \
    ATT_VRD(vb_, VIM, 3); ATT_SB(); ATT_VMM((PF)[2], va_); ATT_SB(); ATT_VMM((PF)[3], vb_); ATT_SB(); } while (0)
#ifndef ATT_XQ
#define ATT_XQ 1
#endif
__device__ __forceinline__ int attn_fetch(gu32* qbase, int& xq, int& tries) {
    for (;;) {
        if (tries >= 8) return 1024;
        const int v = (int)__hip_atomic_fetch_add((unsigned*)(qbase + 64 * xq), 1u, RLX_AGENT);
        if (v < 128) return xq * 128 + v;
        xq = (xq + 1) & 7; ++tries;
    }
}
__device__ __forceinline__ int attn_phase(Frame& F, int L) {
    const bf16_t* U = (const bf16_t*)(F.ws + WS_BIG); bf16_t* Y = (bf16_t*)(F.ws + WS_AY);
    const int lane = F.lane, r32 = lane & 31, half = lane >> 5, wave = F.wave, mi = wave >> 2, sb = wave & 3;
    const bool lag = ATT_LAG && (mi == 1);
    const float lam_init = 0.8f - 0.6f * __expf(-0.3f * (float)L);
    const float lam = __builtin_bit_cast(float, __builtin_amdgcn_readfirstlane(__builtin_bit_cast(int, __expf(wave_sum(F.in[14][L * 64 + lane] * F.in[15][L * 64 + lane])) - __expf(wave_sum(F.in[16][L * 64 + lane] * F.in[17][L * 64 + lane])) + lam_init)));
    const float M2 = __builtin_bit_cast(float, __builtin_amdgcn_readfirstlane(__builtin_bit_cast(int, 64.f * C2 * 1.01f * wave_max(fabsf(F.in[12][L * 64 + lane])) * wave_max(fabsf(F.in[13][L * 64 + lane])))));
    const float* gsub = F.in[18] + L * 128;
    LAS float* lsc = (LAS float*)(F.lds + TAB_OFF) + wave * 32;
    int koff[4];
#pragma unroll
    for (int ks = 0; ks < 4; ++ks) koff[ks] = (((2 * ks + half) ^ (r32 & 7)) * 16);
    LAS float* xch = (LAS float*)F.lds;
    const float Sb = M2;
    unsigned* queue = (unsigned*)(F.ctl + CW_QATT + L);
    gu32* qbase = F.ctl + CW_QX + L * 8 * 64;
    LAS int* qslot = (LAS int*)(F.lds + TAB_OFF + 2048);
    int xq = (int)(xb_xcc_id() & 7u), tries = 0;
    if (F.tid == 0) qslot[0] = ATT_XQ ? attn_fetch(qbase, xq, tries) : (int)__hip_atomic_fetch_add(queue, 1u, RLX_AGENT);
    __syncthreads();
    int u = __builtin_amdgcn_readfirstlane(qslot[0]);
    while (u < 1024) {
#if ATT_XQ
        const int hd = 3 - ((u & 127) >> 5), qb = 2 * (31 - (u & 31)) + (u >> 9), b = (u >> 7) & 3;
#else
        const int hd = 3 - (u >> 8), qb = 63 - ((u & 255) >> 2), b = u & 3;
#endif
        const int q0 = qb * 128, qs = q0 + 32 * sb, nkt = 2 * qb + 2;
        const float slope2 = exp2f(-2.f * (float)(hd + 1)) * 1.4426950408889634f;
        const float Wf = ceilf((2.f * Sb + 24.f - log2f(1.f - exp2f(-slope2))) / slope2);
        int kt_lo = 0; if ((float)q0 > Wf) kt_lo = (q0 - (int)Wf) >> 6;
        const bf16_t* Ub = U + (size_t)b * SEQ * UW;
        bf16x8 qf[4];
#pragma unroll
        for (int ks = 0; ks < 4; ++ks) qf[ks] = *(const GAS bf16x8*)(Ub + (size_t)(qs + r32) * UW + UC_Q + (2 * hd + mi) * 64 + 16 * ks + 8 * half);
        attn_dma_tile(Ub, hd, kt_lo * 64, F.lds, wave, lane);
        attn_dma_tile(Ub, hd, kt_lo * 64 + 64, F.lds + AT_SLOT, wave, lane);
        f32x16 o[4];
#pragma unroll
        for (int db = 0; db < 4; ++db) o[db] = f32x16{};
        float lsum = 0.f;
        const float rowc = -slope2 * (float)(qs + r32) - M2;
        int slot = 0; bool pend = false; bf16x8 pfp[4]; const LAS unsigned char* vprev = F.lds;
#if ATT_PAIR
        for (int kt = kt_lo; kt < nkt; ++kt) {
            if (((kt - kt_lo) & 1) == 0) {
                asm volatile("s_waitcnt vmcnt(0)" ::: "memory");
                __builtin_amdgcn_s_barrier();
                asm volatile("" ::: "memory");
                if (kt + 2 < nkt) attn_dma_tile(Ub, hd, (kt + 2) * 64, F.lds + ((slot + 2) & 3) * AT_SLOT, wave, lane);
                if (kt + 3 < nkt) attn_dma_tile(Ub, hd, (kt + 3) * 64, F.lds + ((slot + 3) & 3) * AT_SLOT, wave, lane);
            }
            const LAS unsigned char* sl = F.lds + slot * AT_SLOT;
            slot = (slot + 1) & 3;
#else
        for (int kt = kt_lo; kt < nkt; ++kt) {
            if (kt + 1 < nkt) asm volatile("s_waitcnt vmcnt(4)" ::: "memory"); else asm volatile("s_waitcnt vmcnt(0)" ::: "memory");
            __builtin_amdgcn_s_barrier();
            asm volatile("" ::: "memory");
            if (kt + 2 < nkt) attn_dma_tile(Ub, hd, (kt + 2) * 64, F.lds + ((slot + 2) & 3) * AT_SLOT, wave, lane);
            const LAS unsigned char* sl = F.lds + slot * AT_SLOT;
            slot = (slot + 1) & 3;
#endif
            if (lag && pend) { ATT_PV(pfp, vprev); pend = false; }
            const int k0 = kt * 64;
            if (k0 > qs + 31) continue;
            f32x16 p0, p1;
            { const float base = rowc + slope2 * (float)(k0 + 4 * half);
#pragma unroll
              for (int r = 0; r < 16; ++r) { p0[r] = base + slope2 * (float)((r & 3) + 8 * (r >> 2)); p1[r] = p0[r] + 32.f * slope2; } }
            const LAS unsigned char* kim = sl + mi * AT_K2 + r32 * 128;
#pragma unroll
            for (int ks = 0; ks < 4; ++ks) {
                const bf16x8 kf0 = *(const LAS bf16x8*)(kim + koff[ks]), kf1 = *(const LAS bf16x8*)(kim + koff[ks] + 4096);
                p0 = MFMA32(kf0, qf[ks], p0); p1 = MFMA32(kf1, qf[ks], p1);
            }
            if (k0 + 63 > qs) {
                const int qrel = qs + r32 - k0 - 4 * half;
#pragma unroll
                for (int r = 0; r < 16; ++r) { const int kr = (r & 3) + 8 * (r >> 2); if (kr > qrel) p0[r] = -INFINITY; if (kr + 32 > qrel) p1[r] = -INFINITY; }
            }
            float ls = 0.f;
#pragma unroll
            for (int r = 0; r < 16; ++r) { p0[r] = __builtin_amdgcn_exp2f(p0[r]); p1[r] = __builtin_amdgcn_exp2f(p1[r]); ls += p0[r] + p1[r]; }
            lsum += ls;
            const LAS unsigned char* vim = sl + AT_V + (4 * half + ((lane & 15) >> 2)) * 64 + (16 * ((lane >> 4) & 1) + 4 * (lane & 3)) * 2;
#pragma unroll
            for (int ks = 0; ks < 4; ++ks) {
                u32x4 t;
                if (ks < 2) { t.x = cvt_pk_bf16(p0[8 * ks], p0[8 * ks + 1]); t.y = cvt_pk_bf16(p0[8 * ks + 2], p0[8 * ks + 3]); t.z = cvt_pk_bf16(p0[8 * ks + 4], p0[8 * ks + 5]); t.w = cvt_pk_bf16(p0[8 * ks + 6], p0[8 * ks + 7]); }
                else { const int k2 = ks - 2; t.x = cvt_pk_bf16(p1[8 * k2], p1[8 * k2 + 1]); t.y = cvt_pk_bf16(p1[8 * k2 + 2], p1[8 * k2 + 3]); t.z = cvt_pk_bf16(p1[8 * k2 + 4], p1[8 * k2 + 5]); t.w = cvt_pk_bf16(p1[8 * k2 + 6], p1[8 * k2 + 7]); }
                pfp[ks] = __builtin_bit_cast(bf16x8, t);
            }
            if (!lag) { ATT_PV(pfp, vim); }
            else { vprev = vim; pend = true; }
        }
        if (lag && pend) { ATT_PV(pfp, vprev); }
        lsum += __shfl_xor(lsum, 32);
        asm volatile("s_waitcnt vmcnt(0) lgkmcnt(0)" ::: "memory");
        __builtin_amdgcn_s_barrier();
        asm volatile("" ::: "memory");
        if (half == 0) lsc[r32] = lsum;
        LDS_WAIT(); asm volatile("" ::: "memory");
        float rl[16];
#pragma unroll
        for (int r = 0; r < 16; ++r) rl[r] = __builtin_amdgcn_rcpf(lsc[crow(r, half)]);
        if (mi == 1) {
#pragma unroll
            for (int db = 0; db < 4; ++db)
#pragma unroll
                for (int r = 0; r < 16; ++r) xch[((sb * 4 + db) * 16 + r) * 64 + lane] = o[db][r] * rl[r] * lam;
        }
        asm volatile("s_waitcnt lgkmcnt(0)" ::: "memory");
        __builtin_amdgcn_s_barrier();
        asm volatile("" ::: "memory");
        if (mi == 0) {
            float ss[16];
#pragma unroll
            for (int r = 0; r < 16; ++r) ss[r] = 0.f;
#pragma unroll
            for (int db = 0; db < 4; ++db)
#pragma unroll
                for (int r = 0; r < 16; ++r) { const float y = o[db][r] * rl[r] - xch[((sb * 4 + db) * 16 + r) * 64 + lane]; o[db][r] = y; ss[r] += y * y; }
#pragma unroll
            for (int r = 0; r < 16; ++r) {
#pragma unroll
                for (int m = 1; m < 32; m <<= 1) ss[r] += __shfl_xor(ss[r], m);
                ss[r] = (1.f - lam_init) / sqrtf(ss[r] * (1.f / 128.f) + EPS);
            }
            LAS unsigned char* stg = F.lds + 65536 + sb * 8192;
#pragma unroll
            for (int db = 0; db < 4; ++db) { const float gsv = gsub[32 * db + r32];
#pragma unroll
                for (int r = 0; r < 16; ++r) *(LAS unsigned short*)(stg + crow(r, half) * 256 + (32 * db + r32) * 2) = (unsigned short)f2bf(o[db][r] * ss[r] * gsv); }
            LDS_WAIT(); asm volatile("" ::: "memory");
            { const int row = lane >> 1, hc = lane & 1; bf16_t* yo = Y + (size_t)(b * SEQ + qs + row) * D + 512 + hd * 128 + hc * 64;
#pragma unroll
              for (int i = 0; i < 8; ++i) *(GAS u32x4*)(yo + i * 8) = *(const LAS u32x4*)(stg + row * 256 + hc * 128 + i * 16); }
        }
        if (F.tid == 0) qslot[0] = ATT_XQ ? attn_fetch(qbase, xq, tries) : (int)__hip_atomic_fetch_add(queue, 1u, RLX_AGENT);
        asm volatile("s_waitcnt vmcnt(0) lgkmcnt(0)" ::: "memory");
        __builtin_amdgcn_s_barrier();
        asm volatile("" ::: "memory");
        u = __builtin_amdgcn_readfirstlane(qslot[0]);
    }
    return u;
}
__device__ __forceinline__ void conformer_queue(Frame& F, int L, int u) {
    unsigned* queue = (unsigned*)(F.ctl + CW_QATT + L);
    LAS int* qslot = (LAS int*)(F.lds + TAB_OFF + 2048);
    conformer_units(F, L, u - 1024, [&F, queue, qslot](int) {
        __syncthreads();
        if (F.wave == 0 && lane_id_v() == 0) qslot[0] = (int)__hip_atomic_fetch_add(queue, 1u, RLX_AGENT);
        __syncthreads();
        return __builtin_amdgcn_readfirstlane(qslot[0]) - 1024; });
}
#define ONE_LAUNCH 1
#define NAIVE_MASK 0
#define MIX_PHASE_A do { mlstm_local_phase(F, L); conformer_phase(F, L); } while (0)
#define MIX_PHASE_B do { mlstm_scan_phase(F); (void)attn_phase(F, L); } while (0)
#define MIX_PHASE_C do { mlstm_out_phase(F, L); } while (0)
#ifndef REP_NORM3
#define REP_NORM3 1
#endif
#ifndef REP_MIXAC
#define REP_MIXAC 1
#endif
#ifndef REP_WIN
#define REP_WIN 1
#endif
#ifndef REP_PRO
#define REP_PRO 1
#endif
#ifndef REP_FFN1D
#define REP_FFN1D 1
#endif
__device__ __forceinline__ int bxl() { int b = blockIdx.x; asm volatile("" : "+s"(b)); return b; }
constexpr int PH_PER_LAYER = 13, NPHASE = 1 + 2 * PH_PER_LAYER;
struct Args { const float* in[31]; float* out; unsigned char* ws; int ph_lo, ph_hi; };

#define PH(k) (lo <= (k) && (k) < hi && (F.lane = lane_id_v(), F.tid = F.wave * 64 + F.lane, true))
#ifndef ALIGN_PE
#define ALIGN_PE false
#endif
#ifndef ALIGN_MULTI
#define ALIGN_MULTI true
#endif
#ifndef PROBE_MASK
#define PROBE_MASK 0
#endif
#ifndef PROBE_AMP
#define PROBE_AMP 10
#endif
#if PROBE_MASK
#define SEAM(k, kind) do { const unsigned long long t1_ = __builtin_amdgcn_s_memrealtime(); if ((k) + 1 < hi) xcd_barrier(bar, F.wave); const unsigned long long t2_ = __builtin_amdgcn_s_memrealtime(); \
    if (F.wave == 0 && lane_id_v() == 0) { volatile LAS unsigned long long* pp_ = (volatile LAS unsigned long long*)(F.lds + MISC_OFF + 64); unsigned long long a_ = pp_[0]; \
        if (PROBE_MASK & (1 << (kind))) a_ += t1_ - pp_[1]; if (PROBE_MASK & (1 << 10)) a_ += t2_ - t1_; pp_[0] = a_; pp_[1] = t2_; } } while (0)
#else
#define SEAM(k, kind) do { if ((k) + 1 < hi) xcd_barrier(bar, F.wave); } while (0)
#endif
template <int L>
__device__ __forceinline__ void layer_phases(Frame& F, const XcdBarrier& bar, int lo, int hi) {
    bf16_t* const AY = (bf16_t*)(F.ws + WS_AY);
    bf16_t* const BIGB = (bf16_t*)(F.ws + WS_BIG);
    bf16_t* const HA = (bf16_t*)F.out;
    bf16_t* const HB = (bf16_t*)F.out + (size_t)M * D;
    bf16_t* const HC = AY;
    float* const wsm = (float*)(F.ws + WS_WSM);
    float* const RSB = (float*)(F.ws + WS_RS);
    LAS int* const rt_info = (LAS int*)(F.lds + TAB_OFF); LAS unsigned short* const rowtab = (LAS unsigned short*)(F.lds + TAB_OFF + 1664);
    LAS float* const rstab = (LAS float*)(F.lds + TAB_OFF + 9344); LAS int* const upm = (LAS int*)(F.lds + TAB_OFF + 25728);
    LAS float* const red = (LAS float*)(F.lds + TAB_OFF + 26112);
    const int pb = 1 + PH_PER_LAYER * L;
    if (pb + PH_PER_LAYER <= lo || pb >= hi) return;
    const bf16_t* Hin = (L == 0) ? HB : HA; const float* RSin = RSB + (size_t)(L == 0 ? 0 : 3) * M * 4;
    bf16_t* H1 = (L == 0) ? HA : HB; float* RS1 = RSB + (size_t)(L == 0 ? 1 : 4) * M * 4;
    float* RS2 = RSB + (size_t)(L == 0 ? 2 : 5) * M * 4;
    if (PH(pb + 0)) {
        gate_pass<1>(F, Hin, RSin, L);
        pg8::StaticOrder S; S.init(M / 256, NIN / 256, F.G, bxl());
        build_rstab(F, S, RSin, rstab, upm);
        EpiIn E{BIGB, F.in[12] + L * 64, F.in[13] + L * 64, rstab};
        pg8::gemm_phase<EpiIn, pg8::StaticOrder, pg8::AOffDense, ALIGN_MULTI>(F.lds, F.wave, Hin, (const bf16_t*)(F.ws + WS_WIN) + (size_t)L * NIN * D, D, S, E, pg8::AOffDense{D});
        SEAM(pb + 0, 2);
    }
    if (PH(pb + 1)) { MIX_PHASE_A; SEAM(pb + 1, 3); }
    if (PH(pb + 2)) { MIX_PHASE_B; SEAM(pb + 2, 4); }
    if (PH(pb + 3)) { MIX_PHASE_C; SEAM(pb + 3, 5); }
    if (PH(pb + 4)) {
        pg8::StaticOrder S; S.init(M / 256, D / 256, F.G, bxl());
        if (L == 0) { EpiRes<true> E{(const void*)F.in[0], H1, RS1, red};
            pg8::gemm_phase<EpiRes<true>, pg8::StaticOrder, pg8::AOffDense, true>(F.lds, F.wave, AY, (const bf16_t*)(F.ws + WS_WOUT) + (size_t)L * D * D, D, S, E, pg8::AOffDense{D}); }
        else { EpiRes<false, true> E{(const void*)Hin, H1, RS1, red, F.ws + WS_H8};
            pg8::gemm_phase<EpiRes<false, true>, pg8::StaticOrder, pg8::AOffDense, true>(F.lds, F.wave, AY, (const bf16_t*)(F.ws + WS_WOUT) + (size_t)L * D * D, D, S, E, pg8::AOffDense{D}); }
        SEAM(pb + 4, 6);
    }
    const bf16_t* H2;
    if (L == 0) {
        H2 = HB;
        if (PH(pb + 7)) {
            pg8::StaticOrder S; S.init(M / 256, 2 * FFD / 256, F.G, bxl());
            build_rstab(F, S, RS1, rstab, upm);
            EpiGluT<(DEFER_MOE_CONV != 0)> E{BIGB, FFD, rstab, F.ws};
            pg8::gemm_phase<EpiGluT<(DEFER_MOE_CONV != 0)>, pg8::StaticOrder, pg8::AOffDense, ALIGN_MULTI>(F.lds, F.wave, H1, (const bf16_t*)(F.ws + WS_WDGU), D, S, E, pg8::AOffDense{D});
            SEAM(pb + 7, 7);
        }
        if (PH(pb + 8)) {
            pg8::StaticOrder S; S.init(M / 256, D / 256, F.G, bxl());
            EpiRes<false> E{(const void*)H1, HB, RS2, red};
            pg8::gemm_phase<EpiRes<false>, pg8::StaticOrder, pg8::AOffDense, true>(F.lds, F.wave, BIGB, (const bf16_t*)(F.ws + WS_WDD), FFD, S, E, pg8::AOffDense{FFD});
            SEAM(pb + 8, 8);
        }
    } else {
        H2 = HC;
        if (PH(pb + 5)) { gate_pass<2>(F, H1, RS1, 2); SEAM(pb + 5, 1); }
        if (PH(pb + 6)) { moe_orient_phase(F); SEAM(pb + 6, 1); }
        for (int s = 0; s < 2; ++s) {
            const int* list_s = (const int*)(F.ws + WS_MOE + MOE_LIST) + (size_t)s * 8 * M;
            const float* gatev_s = (const float*)(F.ws + WS_MOE + MOE_GATEV) + (size_t)s * M;
            if (PH(pb + 7 + 2 * s)) {
                const int RT = moe_build_tiles(F, s, rt_info);
                MoeSched S; S.so.init(RT, 2 * FFE / 256, F.G, bxl()); S.rt_info = rt_info; S.ntn = 2 * FFE / 256; S.map = nullptr;
                if (F.tid < 16) { pg8::Unit u; upm[F.tid] = S.next(F.tid, u) ? u.pm : -1; }
                __syncthreads();
#pragma unroll 4
                for (int idx = F.tid; idx < 16 * 256; idx += NWAVES * 64) { const int pm = upm[idx >> 8]; if (pm >= 0) { const int e = rt_info[3 * pm], i0 = rt_info[3 * pm + 1], nv = rt_info[3 * pm + 2], r = idx & 255;
                    const int tok = r < nv ? list_s[(size_t)e * M + i0 + r] : 0; rowtab[idx] = (unsigned short)tok; rstab[idx] = rs_of(RS1, tok) * (1.f / (F8S_H * F8S_WGU)); } }
                __syncthreads();
                EpiGlu8 E{BIGB, FFE, rstab, F.ws};
                pg8::gemm_phase<EpiGlu8, MoeSched, pg8::AOffGather, ALIGN_MULTI, true>(F.lds, F.wave, (const bf16_t*)(F.ws + WS_H8), (const bf16_t*)(F.ws + WS_WMGU), D / 2, S, E, pg8::AOffGather{D / 2, rowtab});
                SEAM(pb + 7 + 2 * s, 7);
            }
            if (PH(pb + 8 + 2 * s)) {
                const int RT = moe_build_tiles(F, s, rt_info);
                LAS int* const mainidx = (LAS int*)(F.lds + TAB_OFF + 1664); LAS int* const tailidx = mainidx + 160; LAS int* const cntw = tailidx + 16;
                if (s == 0) { MoeSched S; S.so.init(RT, D / 256, F.G, bxl()); S.rt_info = rt_info; S.ntn = D / 256; S.map = nullptr;
                    EpiScatter<0> E{H1, HC, RS2, list_s, gatev_s, rt_info, red};
                    pg8::gemm_phase<EpiScatter<0>, MoeSched, pg8::AOffDense, true, true>(F.lds, F.wave, BIGB, (const bf16_t*)(F.ws + WS_WMD), FFE / 2, S, E, pg8::AOffDense{FFE / 2}); }
                else {
                    moe_split_tiles(F, rt_info, RT, mainidx, tailidx, cntw);
                    const int nmain = cntw[0], ntail = cntw[1];
                    { MoeSched S; S.so.init(nmain, D / 256, F.G, bxl()); S.rt_info = rt_info; S.ntn = D / 256; S.map = mainidx;
                      EpiScatter<1> E{H1, HC, RS2, list_s, gatev_s, rt_info, red};
                      pg8::gemm_phase<EpiScatter<1>, MoeSched, pg8::AOffDense, true, true>(F.lds, F.wave, BIGB, (const bf16_t*)(F.ws + WS_WMD), FFE / 2, S, E, pg8::AOffDense{FFE / 2}); }
                    { TailSched S{rt_info, tailidx, ntail, F.G, bxl()};
                      EpiSide E{(float*)F.out};
                      pg8::gemm_phase<EpiSide, TailSched, pg8::AOffDense, true, true>(F.lds, F.wave, BIGB, (const bf16_t*)(F.ws + WS_WMD), FFE / 2, S, E, pg8::AOffDense{FFE / 2}, TAIL_KLEN); } }
                SEAM(pb + 8 + 2 * s, 8);
            }
        }
    }
    if (L == 1) { if (PH(pb + 11)) { LAS int* const mainidx = (LAS int*)(F.lds + TAB_OFF + 1664); moe_tail_merge(F, 1, HC, RS2, (const float*)F.out, rt_info, mainidx, mainidx + 160, mainidx + 176); SEAM(pb + 11, 8); } }
    if (PH(pb + 12)) {
        bf16_t* const PEB = BIGB;
        pg8::StaticOrder S; S.init(M / 256, D / 256, F.G, bxl());
        build_rstab(F, S, RS2, rstab, upm);
        EpiPe E1{PEB};
        pg8::gemm_phase<EpiPe, pg8::StaticOrder, pg8::AOffDense, ALIGN_PE>(F.lds, F.wave, (const bf16_t*)(F.ws + WS_PB) + (size_t)L * M * PLE, (const bf16_t*)(F.ws + WS_WPP) + (size_t)L * D * PLE, PLE, S, E1, pg8::AOffDense{PLE});
        if (L == 0) { EpiPle<false> E2{H2, rstab, PEB, HA, nullptr, RSB + (size_t)3 * M * 4, red};
            pg8::gemm_phase<EpiPle<false>, pg8::StaticOrder, pg8::AOffDense, true>(F.lds, F.wave, H2, (const bf16_t*)(F.ws + WS_WPG) + (size_t)L * D * D, D, S, E2, pg8::AOffDense{D}); }
        else { EpiPle<true> E2{H2, rstab, PEB, nullptr, F.out, nullptr, red};
            pg8::gemm_phase<EpiPle<true>, pg8::StaticOrder, pg8::AOffDense, true>(F.lds, F.wave, H2, (const bf16_t*)(F.ws + WS_WPG) + (size_t)L * D * D, D, S, E2, pg8::AOffDense{D}); }
        SEAM(pb + 12, 9);
    }
}
__global__ void __launch_bounds__(NWAVES * 64, 2) fwd(Args args) {
    extern __shared__ __attribute__((aligned(16))) unsigned char lds[];
    Frame F;
    F.lds = (LAS unsigned char*)lds;
    F.MISC = (volatile LAS unsigned*)(F.lds + MISC_OFF);
    F.wave = __builtin_amdgcn_readfirstlane(threadIdx.x >> 6); F.lane = lane_id_v(); F.tid = F.wave * 64 + F.lane;
    F.G = gridDim.x; { const int bx = blockIdx.x; F.vcu = (F.G % 8 == 0) ? (bx % 8) * (F.G / 8) + bx / 8 : bx; }
    F.ws = args.ws; F.ctl = (gu32*)(args.ws + WS_CTL); F.out = args.out;
#pragma unroll
    for (int i = 0; i < 31; ++i) F.in[i] = args.in[i];
    for (int u = F.tid; u < 256; u += NWAVES * 64) ((LAS unsigned*)(F.lds + LDSCTL_OFF))[u] = 0u;
    __syncthreads();
    const int lo = args.ph_lo, hi = args.ph_hi;
#if PROBE_MASK
    if (F.wave == 0 && lane_id_v() == 0) { volatile LAS unsigned long long* pp_ = (volatile LAS unsigned long long*)(F.lds + MISC_OFF + 64); pp_[0] = 0; pp_[1] = __builtin_amdgcn_s_memrealtime(); }
#endif
    XcdBarrier bar; bar.bar = (unsigned*)(F.ctl + CW_BAR); bar.x = 0; bar.st = nullptr;
    if (hi - lo > 1) bar = xcd_barrier_post((unsigned*)(F.ctl + CW_BAR), F.MISC + 8);

    bf16_t* const AY = (bf16_t*)(F.ws + WS_AY);
    bf16_t* const BIGB = (bf16_t*)(F.ws + WS_BIG);
    float* const wsm = (float*)(F.ws + WS_WSM);

    if (PH(0)) { for (int rep_ = 0; rep_ < REP_PRO; ++rep_) { p0_prologue(F); __syncthreads(); } SEAM(0, 0); }

    layer_phases<0>(F, bar, lo, hi);
    layer_phases<1>(F, bar, lo, hi);
#if PROBE_MASK
    if (blockIdx.x == 0 && F.wave == 0 && lane_id_v() == 0) { const unsigned long long tend_ = __builtin_amdgcn_s_memrealtime() + (unsigned long long)PROBE_AMP * ((volatile LAS unsigned long long*)(F.lds + MISC_OFF + 64))[0]; while (__builtin_amdgcn_s_memrealtime() < tend_) __builtin_amdgcn_s_sleep(32); }
#endif
#undef PH
#undef SEAM
}

extern "C" void kernel_launch(void* const* d_in, const int* in_sizes, int n_in, void* d_out, int out_size, void* d_ws, size_t ws_size, hipStream_t stream) {
    static int grid = 0;
    if (grid == 0) {
        int dev = 0, cus = 0;
        grid = -1;
        if (hipGetDevice(&dev) == hipSuccess && hipDeviceGetAttribute(&cus, hipDeviceAttributeMultiprocessorCount, dev) == hipSuccess && cus == 256 && ws_size >= WS_END && n_in == 31 &&
            hipFuncSetAttribute((const void*)fwd, hipFuncAttributeMaxDynamicSharedMemorySize, LDS_BYTES) == hipSuccess) grid = cus;
        (void)hipGetLastError();
    }
    if (grid < 0) { nv::forward(d_in, (float*)d_out, (unsigned char*)d_ws, stream); return; }
    (void)hipMemsetAsync((char*)d_ws + WS_CTL, 0, CTL_ZERO_BYTES, stream);
    Args a{};
    for (int i = 0; i < 31; ++i) a.in[i] = (const float*)d_in[i];
    a.out = (float*)d_out; a.ws = (unsigned char*)d_ws;
#if ONE_LAUNCH
    a.ph_lo = 0; a.ph_hi = NPHASE;
    hipLaunchKernelGGL(fwd, dim3(grid), dim3(NWAVES * 64), LDS_BYTES, stream, a);
#else
    for (int p = 0; p < NPHASE; ++p) {
        const int L = (p - 1) / PH_PER_LAYER, k = (p - 1) % PH_PER_LAYER;
        if (p > 0 && L == 0 && (k == 5 || k == 6 || k == 9 || k == 10 || k == 11)) continue;
        a.ph_lo = p; a.ph_hi = p + 1;
        hipLaunchKernelGGL(fwd, dim3(grid), dim3(NWAVES * 64), LDS_BYTES, stream, a);
    }
#endif
}
```

```cpp
#include <hip/hip_runtime.h>
#include <cstdio>
#include <cstdint>
#include <cmath>
#define DENSE_F8 2
#define PRO_NTL 1
#define MOE_2ACT 1
namespace nv {
constexpr int S = 8192, D = 1024, DIN = 3080, NB = 4;
constexpr int FFD = 2816, FFE = 3584, NE = 8, PLE = 256;
constexpr int OFF_MQ = 0, OFF_MK = 256, OFF_MV = 512, OFF_MO = 768, OFF_MI = 1024, OFF_MF = 1028, OFF_CA = 1032, OFF_CG = 1288, OFF_AQ = 1544, OFF_AK = 2056, OFF_AV = 2568;

__device__ __forceinline__ float sigmoidf_(float x) { return 1.f / (1.f + expf(-x)); }
__device__ __forceinline__ float siluf_(float x) { return x / (1.f + expf(-x)); }
__device__ __forceinline__ float wsum(float v) { for (int o = 32; o > 0; o >>= 1) v += __shfl_xor(v, o); return v; }
__device__ __forceinline__ float wmax(float v) { for (int o = 32; o > 0; o >>= 1) v = fmaxf(v, __shfl_xor(v, o)); return v; }

__global__ void groupnorm(const float* in, int ldi, float* out, int ldo, int ngroups, int gdim, const float* gain, int gain_stride, float scale) {
    const int rg = blockIdx.x, row = rg / ngroups, g = rg % ngroups, lane = threadIdx.x;
    const float* x = in + (size_t)row * ldi + g * gdim;
    float s = 0.f;
    for (int i = lane; i < gdim; i += 64) s += x[i] * x[i];
    s = wsum(s);
    const float r = rsqrtf(s / (float)gdim + 1e-6f);
    float* o = out + (size_t)row * ldo + g * gdim;
    for (int i = lane; i < gdim; i += 64) o[i] = x[i] * r * gain[g * gain_stride + i] * scale;
}

template <bool ACC>
__global__ void gemm(const float* A, int lda, const float* B, int ldb, float* C, int ldc, int M, int N, int K, const int* rowlist, const int* nrows_dev) {
    __shared__ float As[16][65];
    __shared__ float Bs[16][64];
    const int Meff = nrows_dev ? *nrows_dev : M;
    const int m0 = blockIdx.y * 64, n0 = blockIdx.x * 64;
    if (m0 >= Meff) return;
    const int tid = threadIdx.x, ty = tid >> 4, tx = tid & 15;
    float acc[4][4];
    for (int i = 0; i < 4; ++i) for (int j = 0; j < 4; ++j) acc[i][j] = 0.f;
    for (int k0 = 0; k0 < K; k0 += 16) {
        for (int i = 0; i < 4; ++i) {
            const int idx = tid + i * 256, r = idx >> 4, kk = idx & 15;
            float v = 0.f;
            if (m0 + r < Meff) { const int ar = rowlist ? rowlist[m0 + r] : (m0 + r); v = A[(size_t)ar * lda + k0 + kk]; }
            As[kk][r] = v;
        }
        for (int i = 0; i < 4; ++i) {
            const int idx = tid + i * 256, kk = idx >> 6, c = idx & 63;
            Bs[kk][c] = (n0 + c < N) ? B[(size_t)(k0 + kk) * ldb + n0 + c] : 0.f;
        }
        __syncthreads();
#pragma unroll
        for (int kk = 0; kk < 16; ++kk) {
            float a[4], b[4];
            for (int i = 0; i < 4; ++i) a[i] = As[kk][ty * 4 + i];
            for (int j = 0; j < 4; ++j) b[j] = Bs[kk][tx * 4 + j];
            for (int i = 0; i < 4; ++i) for (int j = 0; j < 4; ++j) acc[i][j] += a[i] * b[j];
        }
        __syncthreads();
    }
    for (int i = 0; i < 4; ++i) {
        const int r = m0 + ty * 4 + i;
        if (r >= Meff) continue;
        for (int j = 0; j < 4; ++j) {
            const int c = n0 + tx * 4 + j;
            if (c < N) { float* p = C + (size_t)r * ldc + c; *p = ACC ? (*p + acc[i][j]) : acc[i][j]; }
        }
    }
}

__global__ void mprep(const float* U, const float* cw  , const float* bi, const float* bf, float* QK, float* IG, float* LF) {
    const int t = blockIdx.x, c = threadIdx.x;
    float acc = 0.f;
    for (int j = 0; j < 4; ++j) { const int tt = t - 3 + j; if (tt >= 0) acc += cw[j * 512 + c] * U[(size_t)tt * DIN + c]; }
    QK[(size_t)t * 512 + c] = siluf_(acc);
    if (c < 4) {
        IG[t * 4 + c] = U[(size_t)t * DIN + OFF_MI + c] + bi[c];
        const float f = U[(size_t)t * DIN + OFF_MF + c] + bf[c];
        LF[t * 4 + c] = fminf(f, 0.f) - log1pf(expf(-fabsf(f)));
    }
}

__global__ void mlstm_rec(const float* QK, const float* U, const float* IG, const float* LF, float* HM) {
    __shared__ float sq[64][64], sk[64][64], sv[64][64];
    __shared__ float sig[64], slf[64];
    __shared__ float red[2][4][64], redd[2][4][64];
    const int h = blockIdx.x, tid = threadIdx.x, e = tid & 63, dq = tid >> 6;
    float C[16], n[16]; float m = 0.f;
    for (int i = 0; i < 16; ++i) { C[i] = 0.f; n[i] = 0.f; }
    for (int t0 = 0; t0 < S; t0 += 64) {
        __syncthreads();
        for (int i = tid; i < 64 * 64; i += 256) {
            const int tt = i >> 6, d = i & 63;
            sq[tt][d] = QK[(size_t)(t0 + tt) * 512 + h * 64 + d] * 0.125f;
            sk[tt][d] = QK[(size_t)(t0 + tt) * 512 + 256 + h * 64 + d];
            sv[tt][d] = U[(size_t)(t0 + tt) * DIN + OFF_MV + h * 64 + d];
        }
        if (tid < 64) { sig[tid] = IG[(t0 + tid) * 4 + h]; slf[tid] = LF[(t0 + tid) * 4 + h]; }
        __syncthreads();
        for (int tt = 0; tt < 64; ++tt) {
            const float ig = sig[tt], lf = slf[tt];
            const float mn = fmaxf(lf + m, ig), a = expf(lf + m - mn), bb = expf(ig - mn);
            m = mn;
            const float v = sv[tt][e];
            float num = 0.f, den = 0.f;
#pragma unroll
            for (int i = 0; i < 16; ++i) {
                const int d = dq * 16 + i; const float k = sk[tt][d], q = sq[tt][d];
                C[i] = a * C[i] + bb * k * v; n[i] = a * n[i] + bb * k;
                num += q * C[i]; den += q * n[i];
            }
            red[tt & 1][dq][e] = num; redd[tt & 1][dq][e] = den;
            __syncthreads();
            if (dq == 0) {
                const float nu = red[tt & 1][0][e] + red[tt & 1][1][e] + red[tt & 1][2][e] + red[tt & 1][3][e];
                const float de = redd[tt & 1][0][e] + redd[tt & 1][1][e] + redd[tt & 1][2][e] + redd[tt & 1][3][e];
                HM[(size_t)(t0 + tt) * 256 + h * 64 + e] = nu / fmaxf(fabsf(de), expf(-m));
            }
        }
    }
}

__global__ void mgate(const float* HMN, const float* U, float* Y) {
    const int t = blockIdx.x, c = threadIdx.x;
    Y[(size_t)t * D + c] = HMN[(size_t)t * 256 + c] * sigmoidf_(U[(size_t)t * DIN + OFF_MO + c]);
}

__global__ void cglu(const float* U, float* Z) {
    const int t = blockIdx.x, c = threadIdx.x;
    Z[(size_t)t * 256 + c] = U[(size_t)t * DIN + OFF_CA + c] * sigmoidf_(U[(size_t)t * DIN + OFF_CG + c]);
}
__global__ void cconv(const float* Z, const float* w  , const float* b, const float* lg, const float* lb, float* Y) {
    __shared__ float sm[4], sv2[4];
    const int t = blockIdx.x, c = threadIdx.x;
    float acc = b[c];
    for (int j = 0; j < 31; ++j) { const int tt = t - 30 + j; if (tt >= 0) acc += w[j * 256 + c] * Z[(size_t)tt * 256 + c]; }
    float s = wsum(acc);
    if ((c & 63) == 0) sm[c >> 6] = s;
    __syncthreads();
    const float mu = (sm[0] + sm[1] + sm[2] + sm[3]) * (1.f / 256.f);
    const float dv = acc - mu;
    float s2 = wsum(dv * dv);
    if ((c & 63) == 0) sv2[c >> 6] = s2;
    __syncthreads();
    const float var = (sv2[0] + sv2[1] + sv2[2] + sv2[3]) * (1.f / 256.f);
    const float yv = dv * rsqrtf(var + 1e-6f) * lg[c] + lb[c];
    Y[(size_t)t * D + 256 + c] = siluf_(yv);
}

__global__ void attn(const float* QN  , const float* KN  , const float* U, float* O  ) {
    __shared__ float sK[64][65];
    __shared__ float sV[64][128];
    __shared__ float sQ[16][64];
    __shared__ float sP[16][64];
    const int j = blockIdx.y, hd = j >> 1, q0 = blockIdx.x * 16, tid = threadIdx.x, w = tid >> 6, lane = tid & 63;
    const int qpos = q0 + w;
    const float slope = exp2f(-8.f * (float)(hd + 1) / 4.f);
    sQ[w][lane] = QN[(size_t)qpos * 512 + j * 64 + lane];
    float m = -INFINITY, l = 0.f, o0 = 0.f, o1 = 0.f;
    const int ntile = (q0 + 15) / 64 + 1;
    for (int kt = 0; kt < ntile; ++kt) {
        __syncthreads();
        for (int i = tid; i < 64 * 64; i += 1024) { const int r = i >> 6, d = i & 63; sK[r][d] = KN[(size_t)(kt * 64 + r) * 512 + j * 64 + d]; }
        for (int i = tid; i < 64 * 128; i += 1024) { const int r = i >> 7, d = i & 127; sV[r][d] = U[(size_t)(kt * 64 + r) * DIN + OFF_AV + hd * 128 + d]; }
        __syncthreads();
        const int kpos = kt * 64 + lane;
        float s = 0.f;
        for (int d = 0; d < 64; ++d) s += sQ[w][d] * sK[lane][d];
        s = s * 0.125f - slope * (float)(qpos - kpos);
        if (kpos > qpos) s = -INFINITY;
        const float tm = wmax(s), mn = fmaxf(m, tm), corr = expf(m - mn), p = expf(s - mn);
        l = l * corr + wsum(p); o0 *= corr; o1 *= corr; m = mn;
        sP[w][lane] = p;
        __syncthreads();
        for (int k = 0; k < 64; ++k) { const float pk = sP[w][k]; o0 += pk * sV[k][lane]; o1 += pk * sV[k][64 + lane]; }
    }
    O[((size_t)qpos * 8 + j) * 128 + lane] = o0 / l;
    O[((size_t)qpos * 8 + j) * 128 + 64 + lane] = o1 / l;
}
__device__ __forceinline__ float lam_of(const float* q1, const float* k1, const float* q2, const float* k2, float lam_init) {
    float a = 0.f, b = 0.f;
    for (int i = 0; i < 64; ++i) { a += q1[i] * k1[i]; b += q2[i] * k2[i]; }
    return expf(a) - expf(b) + lam_init;
}
__global__ void acomb(const float* O, const float* q1, const float* k1, const float* q2, const float* k2, float lam_init, float* YA  ) {
    const int t = blockIdx.x, c = threadIdx.x;
    const float lam = lam_of(q1, k1, q2, k2, lam_init);
    const int hd = c >> 7, e = c & 127;
    YA[(size_t)t * 512 + c] = O[((size_t)t * 8 + 2 * hd) * 128 + e] - lam * O[((size_t)t * 8 + 2 * hd + 1) * 128 + e];
}
__global__ void swiglu_act(float* G, const float* Uu, int ld, const int* nrows_dev) {
    const int r = blockIdx.x; if (nrows_dev && r >= *nrows_dev) return;
    for (int c = threadIdx.x; c < ld; c += blockDim.x) { const size_t i = (size_t)r * ld + c; G[i] = siluf_(G[i]) * Uu[i]; }
}
__global__ void route(const float* LG  , int* cnt  , int* list  , float* gl  ) {
    const int t = blockIdx.x * blockDim.x + threadIdx.x; if (t >= S) return;
    float v[8]; for (int e = 0; e < 8; ++e) v[e] = LG[t * 8 + e];
    int i0 = 0; for (int e = 1; e < 8; ++e) if (v[e] > v[i0]) i0 = e;
    int i1 = (i0 == 0) ? 1 : 0; for (int e = 0; e < 8; ++e) if (e != i0 && v[e] > v[i1]) i1 = e;
    const float e1 = expf(v[i1] - v[i0]), g0 = 1.f / (1.f + e1), g1 = e1 / (1.f + e1);
    int p0 = atomicAdd(&cnt[i0], 1); list[i0 * S + p0] = t; gl[i0 * S + p0] = g0;
    int p1 = atomicAdd(&cnt[i1], 1); list[i1 * S + p1] = t; gl[i1 * S + p1] = g1;
}
__global__ void scatter_add(const float* Dn  , const int* list, const float* gl, const int* nrows_dev, float* H) {
    const int r = blockIdx.x; if (r >= *nrows_dev) return;
    const int t = list[r]; const float g = gl[r];
    for (int c = threadIdx.x; c < D; c += blockDim.x) H[(size_t)t * D + c] += g * Dn[(size_t)r * D + c];
}
__global__ void ple_apply(const float* GT, const float* PE, float* H) {
    const int t = blockIdx.x;
    for (int c = threadIdx.x; c < D; c += blockDim.x) H[(size_t)t * D + c] += sigmoidf_(GT[(size_t)t * D + c]) * PE[(size_t)t * D + c];
}

static void gemm_l(hipStream_t st, bool acc, const float* A, int lda, const float* B, int ldb, float* C, int ldc, int M, int N, int K, const int* rowlist = nullptr, const int* nrows = nullptr) {
    dim3 g((N + 63) / 64, M / 64);
    if (acc) hipLaunchKernelGGL(gemm<true>, g, dim3(256), 0, st, A, lda, B, ldb, C, ldc, M, N, K, rowlist, nrows);
    else hipLaunchKernelGGL(gemm<false>, g, dim3(256), 0, st, A, lda, B, ldb, C, ldc, M, N, K, rowlist, nrows);
}

static void forward(void* const* d_in, float* out, unsigned char* ws, hipStream_t st) {
    const float* const* in = (const float* const*)d_in;
    size_t off = 0;
    auto take = [&](size_t bytes) { unsigned char* p = ws + off; off += (bytes + 255) & ~(size_t)255; return p; };
    float* A = (float*)take((size_t)S * D * 4);
    float* U = (float*)take((size_t)S * DIN * 4);
    float* QK = (float*)take((size_t)S * 512 * 4);
    float* Y = (float*)take((size_t)S * D * 4);
    float* G = (float*)take((size_t)S * FFE * 4);
    float* U2 = (float*)take((size_t)S * FFE * 4);
    float* IG = (float*)take((size_t)S * 4 * 4);
    float* LF = (float*)take((size_t)S * 4 * 4);
    int* cnt = (int*)take(256);
    int* list = (int*)take((size_t)NE * S * 4);
    float* gl = (float*)take((size_t)NE * S * 4);
    float* HM = G;
    float* HMN = G + (size_t)S * 256;
    float* Z = G + (size_t)S * 512;
    float* QN = G + (size_t)S * 768;
    float* KN = G + (size_t)S * 1280;
    float* YA = G + (size_t)S * 1792;
    float* AO = U2;
    hipMemcpyAsync(out, in[0], (size_t)NB * S * D * 4, hipMemcpyDeviceToDevice, st);
    for (int b = 0; b < NB; ++b) {
        float* H = out + (size_t)b * S * D;
        for (int L = 0; L < 2; ++L) {
            const float lam_init = 0.8f - 0.6f * expf(-0.3f * (float)L);
            hipLaunchKernelGGL(groupnorm, dim3(S), dim3(64), 0, st, H, D, A, D, 1, D, in[2] + L * D, 0, 1.f);
            gemm_l(st, false, A, D, in[3] + (size_t)L * D * DIN, DIN, U, DIN, S, DIN, D);
            hipLaunchKernelGGL(mprep, dim3(S), dim3(512), 0, st, U, in[6] + L * 2048, in[4] + L * 4, in[5] + L * 4, QK, IG, LF);
            hipLaunchKernelGGL(mlstm_rec, dim3(4), dim3(256), 0, st, QK, U, IG, LF, HM);
            hipLaunchKernelGGL(groupnorm, dim3(S * 4), dim3(64), 0, st, HM, 256, HMN, 256, 4, 64, in[7] + L * 256, 64, 1.f);
            hipLaunchKernelGGL(mgate, dim3(S), dim3(256), 0, st, HMN, U, Y);
            hipLaunchKernelGGL(cglu, dim3(S), dim3(256), 0, st, U, Z);
            hipLaunchKernelGGL(cconv, dim3(S), dim3(256), 0, st, Z, in[8] + L * 31 * 256, in[9] + L * 256, in[10] + L * 256, in[11] + L * 256, Y);
            hipLaunchKernelGGL(groupnorm, dim3(S * 8), dim3(64), 0, st, U + OFF_AQ, DIN, QN, 512, 8, 64, in[12] + L * 64, 0, 1.f);
            hipLaunchKernelGGL(groupnorm, dim3(S * 8), dim3(64), 0, st, U + OFF_AK, DIN, KN, 512, 8, 64, in[13] + L * 64, 0, 1.f);
            hipLaunchKernelGGL(attn, dim3(S / 16, 8), dim3(1024), 0, st, QN, KN, U, AO);
            hipLaunchKernelGGL(acomb, dim3(S), dim3(512), 0, st, AO, in[14] + L * 64, in[15] + L * 64, in[16] + L * 64, in[17] + L * 64, lam_init, YA);
            hipLaunchKernelGGL(groupnorm, dim3(S * 4), dim3(64), 0, st, YA, 512, Y + 512, D, 4, 128, in[18] + L * 128, 0, 1.f - lam_init);
            gemm_l(st, true, Y, D, in[19] + (size_t)L * D * D, D, H, D, S, D, D);
            hipLaunchKernelGGL(groupnorm, dim3(S), dim3(64), 0, st, H, D, A, D, 1, D, in[20] + L * D, 0, 1.f);
            if (L == 0) {
                gemm_l(st, false, A, D, in[21], FFD, G, FFD, S, FFD, D);
                gemm_l(st, false, A, D, in[22], FFD, U2, FFD, S, FFD, D);
                hipLaunchKernelGGL(swiglu_act, dim3(S), dim3(256), 0, st, G, U2, FFD, (const int*)nullptr);
                gemm_l(st, true, G, FFD, in[23], D, H, D, S, D, FFD);
            } else {
                float* LG = Y;
                gemm_l(st, false, A, D, in[24], NE, LG, NE, S, NE, D);
                hipMemsetAsync(cnt, 0, 256, st);
                hipLaunchKernelGGL(route, dim3(S / 256), dim3(256), 0, st, LG, cnt, list, gl);
                float* Dn = Y;
                for (int e = 0; e < NE; ++e) {
                    gemm_l(st, false, A, D, in[25] + (size_t)e * D * FFE, FFE, G, FFE, S, FFE, D, list + e * S, cnt + e);
                    gemm_l(st, false, A, D, in[26] + (size_t)e * D * FFE, FFE, U2, FFE, S, FFE, D, list + e * S, cnt + e);
                    hipLaunchKernelGGL(swiglu_act, dim3(S), dim3(256), 0, st, G, U2, FFE, (const int*)(cnt + e));
                    gemm_l(st, false, G, FFE, in[27] + (size_t)e * FFE * D, D, Dn, D, S, D, FFE, nullptr, cnt + e);
                    hipLaunchKernelGGL(scatter_add, dim3(S), dim3(256), 0, st, Dn, list + e * S, gl + e * S, (const int*)(cnt + e), H);
                }
            }
            hipLaunchKernelGGL(groupnorm, dim3(S), dim3(64), 0, st, H, D, A, D, 1, D, in[28] + L * D, 0, 1.f);
            gemm_l(st, false, A, D, in[29] + (size_t)L * D * D, D, G, D, S, D, D);
            gemm_l(st, false, in[1] + ((size_t)L * NB + b) * S * PLE, PLE, in[30] + (size_t)L * PLE * D, D, U2, D, S, D, PLE);
            hipLaunchKernelGGL(ple_apply, dim3(S), dim3(256), 0, st, G, U2, H);
        }
    }
}
}
#define GAS __attribute__((address_space(1)))
#define LAS __attribute__((address_space(3)))
typedef unsigned short bf16_t;
typedef unsigned u32x4 __attribute__((ext_vector_type(4)));
typedef unsigned u32x2 __attribute__((ext_vector_type(2)));
typedef float f32x4 __attribute__((ext_vector_type(4)));
typedef float f32x2 __attribute__((ext_vector_type(2)));
typedef short bf16x8 __attribute__((ext_vector_type(8)));
typedef GAS unsigned gu32;
#define RLX_AGENT __ATOMIC_RELAXED, __HIP_MEMORY_SCOPE_AGENT

constexpr int NB = 4, SEQ = 8192, M = NB * SEQ, D = 1024, DIN = 3080;
constexpr int FFD = 2816, FFE = 3584, NE = 8, PLE = 256;
constexpr int UW = 2816;
constexpr int UC_MQ = 0, UC_MK = 256, UC_MV = 512, UC_MO = 768, UC_Z = 1024, UC_Q = 1280, UC_K = 1792, UC_V = 2304;
constexpr int NIN = 3072;
constexpr float EPS = 1e-6f;
constexpr float C2 = 0.125f * 1.4426950408889634f;
constexpr int MOE_MAXROWS = M + NE * 256;

#ifndef MOE_2ACT
#define MOE_2ACT 0
#endif
constexpr size_t MiB = 1u << 20;
constexpr size_t WS_CTL = 0, CTL_ZERO_BYTES = 1 * MiB;
constexpr size_t WS_WIN = 1 * MiB;
constexpr size_t WS_WOUT = WS_WIN + 12 * MiB;
constexpr size_t WS_WDGU = WS_WOUT + 4 * MiB;
constexpr size_t WS_WDD = WS_WDGU + 11 * MiB;
constexpr size_t WS_WMGU = WS_WDD + 6 * MiB;
constexpr size_t WS_WMD = WS_WMGU + 112 * MiB;
constexpr size_t WS_WPG = WS_WMD + 56 * MiB;
constexpr size_t WS_WPP = WS_WPG + 4 * MiB;
constexpr size_t WS_WSM = WS_WPP + 1 * MiB;
constexpr size_t WS_GATE = WS_WSM + 1 * MiB;
constexpr size_t WS_MOE = WS_GATE + 1 * MiB;
constexpr size_t WS_MST = WS_MOE + 3 * MiB;
constexpr size_t WS_AY = WS_MST + 34 * MiB;
constexpr size_t WS_BIG = WS_AY + 64 * MiB;
constexpr size_t WS_PB = WS_BIG + 238 * MiB;
constexpr size_t WS_RS = WS_PB + 32 * MiB;
constexpr size_t WS_END = WS_RS + 3 * MiB;
constexpr size_t WS_H8 = MOE_2ACT ? WS_WMGU + 56 * MiB : WS_BIG + 160 * MiB;
constexpr size_t ACT8_BYTES = 119 * MiB;
static_assert((size_t)MOE_MAXROWS * FFE <= ACT8_BYTES, "fp8 act fits");
constexpr float F8S_H = 16.f, F8S_WGU = 512.f, F8S_ACT = 16.f, F8S_WD = 1024.f;
static_assert((size_t)MOE_MAXROWS * FFE * 2 <= 238 * MiB, "act fits");
static_assert((size_t)M * UW * 2 <= 176 * MiB, "u fits");

constexpr int CW_TMO = 0, CW_CODE = 1;
constexpr int CW_BAR = 4096;
constexpr int CW_CNT = 16384;
constexpr int CW_RS = 32768;
constexpr int CW_QX = 16640;
constexpr int CW_QCONV = 16512;
constexpr int CW_QATT = 16448;
constexpr size_t MOE_GATEV = 0;
constexpr size_t MOE_EIDX = 2 * (size_t)M * 4;
constexpr size_t MOE_LIST = 4 * (size_t)M * 4;
constexpr size_t MOE_CNTW = MOE_LIST + 16 * (size_t)M * 4;
static_assert(MOE_CNTW + 256 * 64 * 4 <= 3 * MiB, "moe region");

constexpr int RING_BYTES = 131072;
constexpr int LDS_BYTES = 163840;
constexpr int LDSCTL_OFF = LDS_BYTES - 1024, MISC_OFF = LDSCTL_OFF + 320;
constexpr int TAB_OFF = RING_BYTES;
constexpr int NWAVES = 8;

__device__ __forceinline__ int lane_id_v() { int l; asm volatile("v_mbcnt_lo_u32_b32 %0, -1, 0\n\tv_mbcnt_hi_u32_b32 %0, -1, %0" : "=v"(l)); return l; }
__device__ __forceinline__ unsigned f2bf(float f) { unsigned u = __builtin_bit_cast(unsigned, f); return (u + 0x7fffu + ((u >> 16) & 1u)) >> 16; }
__device__ __forceinline__ unsigned pk2(float lo, float hi) { return f2bf(lo) | (f2bf(hi) << 16); }
__device__ __forceinline__ float bf2f(unsigned short b) { return __builtin_bit_cast(float, (unsigned)b << 16); }
__device__ __forceinline__ float bflo(unsigned w) { return __builtin_bit_cast(float, w << 16); }
__device__ __forceinline__ float bfhi(unsigned w) { return __builtin_bit_cast(float, w & 0xffff0000u); }
__device__ __forceinline__ unsigned pk4_fp8(float a, float b, float c, float d) {
    int w = 0;
    w = __builtin_amdgcn_cvt_pk_fp8_f32(__builtin_amdgcn_fmed3f(a, -448.f, 448.f), __builtin_amdgcn_fmed3f(b, -448.f, 448.f), w, false);
    w = __builtin_amdgcn_cvt_pk_fp8_f32(__builtin_amdgcn_fmed3f(c, -448.f, 448.f), __builtin_amdgcn_fmed3f(d, -448.f, 448.f), w, true);
    return (unsigned)w; }
__device__ __forceinline__ unsigned cvt_pk_bf16(float lo, float hi) { unsigned r; asm volatile("v_cvt_pk_bf16_f32 %0, %1, %2" : "=v"(r) : "v"(lo), "v"(hi)); return r; }
__device__ __forceinline__ float fast_sigmoid(float x) { return __builtin_amdgcn_rcpf(1.f + __builtin_amdgcn_exp2f(-1.4426950408889634f * x)); }
template <class T> __device__ __forceinline__ T shflx(T v, int m) { return __builtin_bit_cast(T, __builtin_amdgcn_ds_bpermute((lane_id_v() ^ m) << 2, __builtin_bit_cast(int, v))); }
#define __shfl_xor(v, m) shflx((v), (m))
#define DPPF_(v, ctrl, rmask) __builtin_bit_cast(float, __builtin_amdgcn_update_dpp(0, __builtin_bit_cast(int, (v)), (ctrl), (rmask), 0xF, false))
__device__ __forceinline__ float wave_sum(float v) {
    v += DPPF_(v, 0xB1, 0xF); v += DPPF_(v, 0x4E, 0xF); v += DPPF_(v, 0x141, 0xF); v += DPPF_(v, 0x140, 0xF);
    v += DPPF_(v, 0x142, 0xA); v += DPPF_(v, 0x143, 0xC);
    return __builtin_bit_cast(float, __builtin_amdgcn_readlane(__builtin_bit_cast(int, v), 63));
}
__device__ __forceinline__ float wave_max(float v) {
#pragma unroll
    for (int o = 1; o < 64; o <<= 1) v = fmaxf(v, __shfl_xor(v, o));
    return v;
}

#define XB_TMO      128
#define XB_XCNT(j)  (256  + 64 * (j))
#define XB_XSUB(j)  (1280 + 64 * (j))
#define XB_XGEN(j)  (2304 + 64 * (j))
#define XB_TOP      3328
#define XB_TOPGEN   3392
#define XCD_BAR_WORDS 3456
#define XB_SPIN_CAP (1u << 22)
__device__ __forceinline__ unsigned xb_ld(unsigned* p)              { return __hip_atomic_load(p, __ATOMIC_RELAXED, __HIP_MEMORY_SCOPE_AGENT); }
__device__ __forceinline__ unsigned xb_add(unsigned* p, unsigned v) { return __hip_atomic_fetch_add(p, v, __ATOMIC_RELAXED, __HIP_MEMORY_SCOPE_AGENT); }
__device__ __forceinline__ unsigned xb_xcc_id() { return (unsigned)__builtin_amdgcn_s_getreg((3 << 11) | 20) & 0xFu; }
#define XB_SPIN(cond, bar) do { unsigned _sp = 0; while (cond) { __builtin_amdgcn_s_sleep(1); \
    if ((++_sp & 255u) == 0u) { if (xb_ld(&(bar)[XB_TMO])) break; if (_sp > XB_SPIN_CAP) { atomicAdd(&(bar)[XB_TMO], 1u); break; } } } } while (0)
struct XcdBarrier { unsigned* bar; unsigned x; volatile LAS unsigned* st; };
__device__ __forceinline__ XcdBarrier xcd_barrier_post(unsigned* bar, volatile LAS unsigned* st) {
    XcdBarrier b; b.bar = bar; b.x = xb_xcc_id(); b.st = st;
    if (threadIdx.x == 0) (void)xb_add(&bar[XB_XCNT(b.x)], 1u);
    return b;
}
__device__ __forceinline__ void xcd_barrier_complete(unsigned* bar, unsigned x, unsigned& nloc, unsigned& nx) {
    const unsigned G = gridDim.x * gridDim.y * gridDim.z;
    unsigned sum, cnt, mine, sp = 0u;
    for (;;) {
        sum = 0u; cnt = 0u; mine = 0u;
#pragma unroll
        for (unsigned j = 0; j < 16; ++j) { const unsigned c = xb_ld(&bar[XB_XCNT(j)]); sum += c; cnt += (c > 0u) ? 1u : 0u; mine = (j == x) ? c : mine; }
        if (sum == G) break;
        __builtin_amdgcn_s_sleep(1);
        if ((++sp & 255u) == 0u) { if (xb_ld(&bar[XB_TMO])) break; if (sp > XB_SPIN_CAP) { atomicAdd(&bar[XB_TMO], 1u); break; } }
    }
    nloc = mine > 0u ? mine : 1u; nx = cnt > 0u ? cnt : 1u;
}
__device__ __forceinline__ void xcd_barrier(const XcdBarrier& b, int wave) {
    asm volatile("s_waitcnt vmcnt(0)" ::: "memory");
    __syncthreads();
    if (wave == 0 && lane_id_v() == 0) {
        unsigned* bar = b.bar;
        __builtin_amdgcn_s_waitcnt(0);
        unsigned nloc = b.st[0], nx = b.st[1];
        if (nloc == 0u) { xcd_barrier_complete(bar, b.x, nloc, nx); b.st[0] = nloc; b.st[1] = nx; }
        const unsigned old = xb_add(&bar[XB_XSUB(b.x)], 1u);
        const unsigned gen = old / nloc;
        if (old + 1u == (gen + 1u) * nloc) {
            __builtin_amdgcn_fence(__ATOMIC_RELEASE, "agent");
            asm volatile("s_waitcnt vmcnt(0)" ::: "memory");
            const unsigned og = xb_add(&bar[XB_TOP], 1u);
            const unsigned tg = og / nx;
            if (og + 1u == (tg + 1u) * nx) xb_add(&bar[XB_TOPGEN], 1u);
            else XB_SPIN(xb_ld(&bar[XB_TOPGEN]) == tg, bar);
            __builtin_amdgcn_fence(__ATOMIC_ACQUIRE, "agent");
            xb_add(&bar[XB_XGEN(b.x)], 1u);
            asm volatile("s_waitcnt vmcnt(0)" ::: "memory");
        } else {
            XB_SPIN(xb_ld(&bar[XB_XGEN(b.x)]) == gen, bar);
            __builtin_amdgcn_fence(__ATOMIC_ACQUIRE, "agent");
            asm volatile("s_waitcnt vmcnt(0)" ::: "memory");
        }
    }
    __syncthreads();
}

#ifndef PG8_WGM
#define PG8_WGM 8
#endif
namespace pg8 {
constexpr int BM = 256, BK = 64, HALF = 128, HTB = HALF * BK * 2, STAGE_BYTES = 8 * HTB, NXCD = 8, WGM = PG8_WGM;
__host__ __device__ __forceinline__ int lds_byte(int r, int c) { const int st = (r >> 4) * 2 + (c >> 5), rr = r & 15, cc = c & 31, ob = rr * 64 + cc * 2; return st * 1024 + (ob ^ (((ob >> 9) & 1) << 5)); }
__host__ __device__ __forceinline__ void stage_rc(int b, int& R, int& C) { const int st = b / 1024, sb = b % 1024, swz = sb ^ (((sb >> 9) & 1) << 5); R = (st >> 1) * 16 + swz / 64; C = (st & 1) * 32 + (swz % 64) / 2; }
__host__ __device__ __forceinline__ int perm32(int rho) { const int n = rho >> 4, i = rho & 15; return 8 * (i >> 2) + 4 * n + (i & 3); }

struct Unit { int pm, pn, pb, ui, kb, aux; };

struct StaticOrder {
    int nM, nN, nwg, G, c;
    __device__ void init(int nM_, int nN_, int G_, int c_) { nM = nM_; nN = nN_; nwg = nM * nN; G = G_; c = c_; }
    __device__ __forceinline__ bool tile(int i, int& pm, int& pn) const {
        const long L = (long)i * G + c; if (L >= nwg) return false;
        int wgid = (int)L; { const int q = nwg / NXCD, r = nwg % NXCD, xcd = wgid % NXCD, off = wgid / NXCD; wgid = (xcd < r ? xcd * (q + 1) : r * (q + 1) + (xcd - r) * q) + off; }
        const int nig = WGM * nN, gid = wgid / nig, fm = gid * WGM, gsz = (nM - fm) < WGM ? (nM - fm) : WGM;
        pm = fm + ((wgid % nig) % gsz); pn = (wgid % nig) / gsz; return true;
    }
    __device__ __forceinline__ bool next(int i, Unit& u) const { if (!tile(i, u.pm, u.pn)) return false; u.pb = u.pn; u.kb = 0; u.aux = 0; return true; }
};

typedef int i32x8 __attribute__((ext_vector_type(8)));
typedef int i32x4 __attribute__((ext_vector_type(4)));
__device__ __forceinline__ i32x8 cat8(const bf16x8& lo, const bf16x8& hi) { return __builtin_shufflevector(__builtin_bit_cast(i32x4, lo), __builtin_bit_cast(i32x4, hi), 0, 1, 2, 3, 4, 5, 6, 7); }
template <class Epi, class Sched, class AOff, bool ALIGN_EPI, bool F8 = false>
__device__ __forceinline__ void gemm_phase(LAS unsigned char* lds, int wave, const bf16_t* A, const bf16_t* Bt, int K, const Sched& S, const Epi& E, const AOff& AO, int klen = 0) {
    asm volatile("" : "+s"(A), "+s"(Bt), "+s"(K), "+s"(wave));
    const int lane = lane_id_v(), wid = wave, tid = wid * 64 + lane, wr = wid >> 2, wc = wid & 3, fr = lane & 15, fq = lane >> 4;
    const int nt = (klen ? klen : K) / BK;
    int R0, C0, R1, C1; stage_rc(tid * 16, R0, C0); stage_rc(tid * 16 + 8192, R1, C1);
    unsigned voffB[2]; voffB[0] = (unsigned)(R0 * K + C0) * 2u; voffB[1] = (unsigned)(R1 * K + C1) * 2u;
    const size_t kstep = (size_t)(BK * 2);
    const size_t hstep = (size_t)HALF * K * 2;
    const size_t tstep = 2 * hstep;
    const unsigned ldsw = (unsigned)wid * 1024u;
    const int aoff = lds_byte(wr * 64 + fr, fq * 8), boff = lds_byte(wc * 32 + fr, fq * 8);
    const char* Ab = (const char*)A;
    constexpr int H1I = (F8 && AOff::dense) ? 0 : 1;
    const size_t ah1 = (F8 && AOff::dense) ? (size_t)HALF * K * 2 : 0;
#define PG8_SA(b, h) (((b) * 2 + (h)) * HTB)
#define PG8_SB(b, h) ((4 + (b) * 2 + (h)) * HTB)
#define PG8_STAGE_(bufoff, gbase, voff, SH) do { _Pragma("unroll") for (int _i = 0; _i < 2; ++_i) { unsigned o_ = (voff)[(SH) ? 0 : _i]; if constexpr (F8) asm volatile("" : "+v"(o_));        \
        __builtin_amdgcn_global_load_lds((const unsigned*)((const char*)(gbase) + (((SH) && _i) ? p1off : (size_t)0) + o_), (LAS unsigned*)(lds + (bufoff) + ldsw + _i * 8192), 16, 0, 0); } } while (0)
    const size_t p1off = (size_t)64 * K * 2;
#define PG8_STAGE(bufoff, gbase, voff) PG8_STAGE_(bufoff, gbase, voff, F8)
#define PG8_STAGEA(bufoff, gbase, voff) PG8_STAGE_(bufoff, gbase, voff, (F8 && AOff::dense))
#define PG8_LDA(dst, b, h) do { _Pragma("unroll") for (int m = 0; m < 4; ++m) _Pragma("unroll") for (int k = 0; k < 2; ++k) dst[m][k] = *(const LAS bf16x8*)(lds + PG8_SA(b, h) + aoff + m * 2048 + k * 1024); } while (0)
#define PG8_LDB(dst, b, h) do { _Pragma("unroll") for (int n = 0; n < 2; ++n) _Pragma("unroll") for (int k = 0; k < 2; ++k) dst[n][k] = *(const LAS bf16x8*)(lds + PG8_SB(b, h) + boff + n * 2048 + k * 1024); } while (0)
#define PG8_MMA(ai, bj, At, Bt_) do { __builtin_amdgcn_s_setprio(1); _Pragma("unroll") for (int m = 0; m < 4; ++m) _Pragma("unroll") for (int n = 0; n < 2; ++n) { \
        if constexpr (F8) acc[ai][bj][m][n] = __builtin_amdgcn_mfma_scale_f32_16x16x128_f8f6f4(cat8(Bt_[n][0], Bt_[n][1]), cat8(At[m][0], At[m][1]), acc[ai][bj][m][n], 0, 0, 0, 0, 0, 0); \
        else { _Pragma("unroll") for (int k = 0; k < 2; ++k) acc[ai][bj][m][n] = __builtin_amdgcn_mfma_f32_16x16x32_bf16(Bt_[n][k], At[m][k], acc[ai][bj][m][n], 0, 0, 0); } } __builtin_amdgcn_s_setprio(0); } while (0)
#define PG8_WAIT_V(n) asm volatile("s_waitcnt vmcnt(" #n ")" ::: "memory")
#define PG8_WAIT_L(n) asm volatile("s_waitcnt lgkmcnt(" #n ")" ::: "memory")
#define PG8_BAR __builtin_amdgcn_s_barrier()
#define PG8_SCHED __builtin_amdgcn_sched_barrier(0)
    Unit cur, nxt; int ui = 0;
    if (!S.next(0, cur)) return;
    cur.ui = 0;
    f32x4 acc[2][2][4][2];
#pragma unroll
    for (int a = 0; a < 2; ++a)
#pragma unroll
        for (int b = 0; b < 2; ++b)
#pragma unroll
            for (int m = 0; m < 4; ++m)
#pragma unroll
                for (int n = 0; n < 2; ++n) acc[a][b][m][n] = (f32x4){0.f, 0.f, 0.f, 0.f};
    bf16x8 At[4][2], B0[2][2], B1[2][2];
    unsigned va[2][2], vn[2][2];
    AO(cur, 0, R0, C0, R1, C1, va);
    const char* cB = (const char*)Bt + (size_t)cur.pb * tstep + cur.kb;
    PG8_STAGE(PG8_SB(0, 0), cB, voffB); PG8_STAGE(PG8_SB(0, 1), cB + hstep, voffB); PG8_STAGEA(PG8_SA(0, 0), Ab, va[0]); PG8_STAGEA(PG8_SA(0, 1), Ab + ah1, va[H1I]);
    if (wr == 1) PG8_BAR;
    PG8_WAIT_V(2); PG8_BAR;
    PG8_STAGE(PG8_SB(1, 0), cB + kstep, voffB); PG8_STAGEA(PG8_SA(1, 0), Ab + kstep, va[0]); PG8_STAGE(PG8_SB(1, 1), cB + hstep + kstep, voffB);
    PG8_WAIT_V(6); PG8_BAR;
    for (;;) {
        const bool has_next = S.next(ui + 1, nxt); nxt.ui = ui + 1;
        if constexpr (F8) { const int t_ = wid * 64 + lane_id_v(); stage_rc(t_ * 16, R0, C0); stage_rc(t_ * 16 + 8192, R1, C1); }
        if (has_next) AO(nxt, ui + 1, R0, C0, R1, C1, vn);
        else { vn[0][0] = va[0][0]; vn[0][1] = va[0][1]; vn[1][0] = va[1][0]; vn[1][1] = va[1][1]; }
        const char* nB = has_next ? (const char*)Bt + (size_t)nxt.pb * tstep + nxt.kb : cB;
        for (int t = 0; t < nt; t += 2) {
            const bool last = (t == nt - 2);
            const size_t ka1 = (size_t)(t + 1) * kstep;
            const size_t ka2 = last ? 0 : (size_t)(t + 2) * kstep, ka3 = ka2 + kstep;
            const char* b2 = last ? nB : cB + (size_t)(t + 2) * kstep; const char* b3 = b2 + kstep;
            unsigned w0[2], w1[2];
            w0[0] = last ? vn[0][0] : va[0][0]; w0[1] = last ? vn[0][1] : va[0][1]; w1[0] = last ? vn[H1I][0] : va[H1I][0]; w1[1] = last ? vn[H1I][1] : va[H1I][1];
            PG8_LDB(B0, 0, 0); PG8_LDB(B1, 0, 1); PG8_SCHED; PG8_LDA(At, 0, 0); PG8_STAGEA(PG8_SA(1, 1), Ab + ah1 + ka1, va[H1I]);
            PG8_WAIT_V(8); PG8_WAIT_L(0); PG8_BAR; PG8_MMA(0, 0, At, B0); PG8_MMA(0, 1, At, B1); PG8_BAR; PG8_SCHED;
            PG8_LDA(At, 0, 1); PG8_STAGE(PG8_SB(0, 0), b2, voffB); PG8_STAGE(PG8_SB(0, 1), b2 + hstep, voffB); PG8_STAGEA(PG8_SA(0, 0), Ab + ka2, w0);
            PG8_WAIT_V(8); PG8_WAIT_L(0); PG8_BAR; PG8_MMA(1, 0, At, B0); PG8_MMA(1, 1, At, B1); PG8_BAR; PG8_SCHED;
            PG8_LDB(B0, 1, 0); PG8_LDB(B1, 1, 1); PG8_SCHED; PG8_LDA(At, 1, 0); PG8_STAGEA(PG8_SA(0, 1), Ab + ah1 + ka2, w1);
            PG8_WAIT_V(8); PG8_WAIT_L(0); PG8_BAR; PG8_MMA(0, 0, At, B0); PG8_MMA(0, 1, At, B1); PG8_BAR; PG8_SCHED;
            PG8_LDA(At, 1, 1); PG8_STAGE(PG8_SB(1, 0), b3, voffB); PG8_STAGE(PG8_SB(1, 1), b3 + hstep, voffB); PG8_STAGEA(PG8_SA(1, 0), Ab + ka3, w0);
            PG8_WAIT_V(8); PG8_WAIT_L(0); PG8_BAR; PG8_MMA(1, 0, At, B0); PG8_MMA(1, 1, At, B1); PG8_BAR; PG8_SCHED;
        }
        if constexpr (ALIGN_EPI) { if (wr == 0) PG8_BAR; }
        { int fr_ = fr, fq_ = fq; if constexpr (F8) { const int l_ = lane_id_v(); fr_ = l_ & 15; fq_ = l_ >> 4; } asm volatile("" : "+v"(fr_), "+v"(fq_));
          E(acc, cur, wr, wc, fr_, fq_); }
        if (!has_next) break;
#pragma unroll
        for (int a = 0; a < 2; ++a)
#pragma unroll
            for (int b = 0; b < 2; ++b)
#pragma unroll
                for (int m = 0; m < 4; ++m)
#pragma unroll
                    for (int n = 0; n < 2; ++n) acc[a][b][m][n] = (f32x4){0.f, 0.f, 0.f, 0.f};
        cur = nxt; cB = nB; ++ui;
        va[0][0] = vn[0][0]; va[0][1] = vn[0][1]; va[1][0] = vn[1][0]; va[1][1] = vn[1][1];
        if constexpr (ALIGN_EPI) { if (wr == 1) PG8_BAR; }
    }
    PG8_WAIT_V(0);
    if constexpr (!ALIGN_EPI) { if (wr == 0) PG8_BAR; }
    PG8_BAR;
#undef PG8_SA
#undef PG8_SB
#undef PG8_STAGE
#undef PG8_STAGEA
#undef PG8_STAGE_
#undef PG8_LDA
#undef PG8_LDB
#undef PG8_MMA
#undef PG8_WAIT_V
#undef PG8_WAIT_L
#undef PG8_BAR
#undef PG8_SCHED
}

struct AOffDense { static constexpr bool dense = true; int K; __device__ __forceinline__ void operator()(const Unit& u, int, int R0, int C0, int R1, int C1, unsigned (&vo)[2][2]) const {
#pragma unroll
    for (int h = 0; h < 2; ++h) { vo[h][0] = (unsigned)((u.pm * 256 + h * 128 + R0) * K + C0) * 2u + (unsigned)u.kb; vo[h][1] = (unsigned)((u.pm * 256 + h * 128 + R1) * K + C1) * 2u + (unsigned)u.kb; } } };
struct AOffGather { static constexpr bool dense = false; int K; const LAS unsigned short* tab; __device__ __forceinline__ void operator()(const Unit&, int ui, int R0, int C0, int R1, int C1, unsigned (&vo)[2][2]) const {
#pragma unroll
    for (int h = 0; h < 2; ++h) { vo[h][0] = (unsigned)((int)tab[ui * 256 + h * 128 + R0] * K + C0) * 2u; vo[h][1] = (unsigned)((int)tab[ui * 256 + h * 128 + R1] * K + C1) * 2u; } } };
}
struct Frame {
    LAS unsigned char* lds;
    volatile LAS unsigned* MISC;
    gu32* ctl;
    int tid, lane, wave, vcu, G;
    const float* in[31];
    float* out;
    unsigned char* ws;
};
#define LDS_WAIT() asm volatile("s_waitcnt lgkmcnt(0)" ::: "memory")
#define VM_WAIT() asm volatile("s_waitcnt vmcnt(0)" ::: "memory")

#ifndef PRO_NTL
#define PRO_NTL 0
#endif
struct PrepP { const float* W; const float* gain; bf16_t* WT; int ldw, c0s, K, n0d, k0; bool perm; float scl; };
__device__ __forceinline__ void prep_load(const PrepP& P, int lane, f32x4 (&v)[8], float (&g)[8]) {
#pragma unroll
    for (int i = 0; i < 8; ++i) { const int kk = 8 * i + (lane >> 3); v[i] = PRO_NTL ? __builtin_nontemporal_load((const GAS f32x4*)(P.W + (size_t)(P.k0 + kk) * P.ldw + P.c0s + 4 * (lane & 7))) : *(const GAS f32x4*)(P.W + (size_t)(P.k0 + kk) * P.ldw + P.c0s + 4 * (lane & 7)); g[i] = (P.gain ? P.gain[P.k0 + kk] : 1.f) * (P.scl != 0.f ? P.scl : 1.f); }
}
__device__ __forceinline__ void prep_finish(const PrepP& P, const f32x4 (&v)[8], const float (&g)[8], LAS float* scr, int lane) {
#pragma unroll
    for (int i = 0; i < 8; ++i) { const int kk = 8 * i + (lane >> 3); LAS float* d = scr + kk * 33 + 4 * (lane & 7);
        d[0] = v[i][0] * g[i]; d[1] = v[i][1] * g[i]; d[2] = v[i][2] * g[i]; d[3] = v[i][3] * g[i]; }
    LDS_WAIT(); asm volatile("" ::: "memory");
    const int c = lane & 7;
#pragma unroll
    for (int j = 0; j < 4; ++j) { const int n = (lane >> 3) + 8 * j; const int ns = P.perm ? pg8::perm32(n) : n; const LAS float* s = scr + (8 * c) * 33 + ns;
        if (P.scl != 0.f) { u32x2 o8; o8.x = pk4_fp8(s[0 * 33], s[1 * 33], s[2 * 33], s[3 * 33]); o8.y = pk4_fp8(s[4 * 33], s[5 * 33], s[6 * 33], s[7 * 33]);
            *(GAS u32x2*)((GAS unsigned char*)P.WT + (size_t)(P.n0d + n) * P.K + P.k0 + 8 * c) = o8; }
        else { u32x4 o; o.x = pk2(s[0 * 33], s[1 * 33]); o.y = pk2(s[2 * 33], s[3 * 33]); o.z = pk2(s[4 * 33], s[5 * 33]); o.w = pk2(s[6 * 33], s[7 * 33]);
            *(GAS u32x4*)(P.WT + (size_t)(P.n0d + n) * P.K + P.k0 + 8 * c) = o; } }
    LDS_WAIT(); asm volatile("" ::: "memory");
}

#ifndef PLE1_F8
#define PLE1_F8 1
#endif
#ifndef DENSE_F8
#define DENSE_F8 0
#endif
#ifndef DEFER_MOE_CONV
#define DEFER_MOE_CONV 0
#endif
__device__ __forceinline__ void prep_reg_load(const PrepP& P, int lane, f32x4 (&v)[8]) {
    const int kg = lane >> 3, n4 = lane & 7;
#pragma unroll
    for (int i = 0; i < 8; ++i) { const int k = P.k0 + 8 * kg + i; v[i] = *(const GAS f32x4*)(P.W + (size_t)k * P.ldw + P.c0s + 4 * n4) * (P.gain ? P.gain[k] : 1.f); }
}
__device__ __forceinline__ void prep_reg_store(const PrepP& P, int lane, const f32x4 (&v)[8]) {
    const int kg = lane >> 3, n4 = lane & 7;
#pragma unroll
    for (int j = 0; j < 4; ++j) { const int sc_ = 4 * n4 + j; const int rho = P.perm ? (16 * ((sc_ >> 2) & 1) + 4 * (sc_ >> 3) + (sc_ & 3)) : sc_;
        u32x4 o; o.x = pk2(v[0][j], v[1][j]); o.y = pk2(v[2][j], v[3][j]); o.z = pk2(v[4][j], v[5][j]); o.w = pk2(v[6][j], v[7][j]);
        *(GAS u32x4*)(P.WT + (size_t)(P.n0d + rho) * P.K + P.k0 + 8 * kg) = o; }
}
__device__ __forceinline__ PrepP moe_prep_decode(const float* q_wg, const float* q_wu, const float* q_wd, const float* q_gain, bf16_t* q_WMGU, bf16_t* q_WMD, int r) {
    constexpr int I_MGU = 16 * 224, I_MD = 56 * 32;
    PrepP P; P.gain = nullptr; P.perm = false; P.scl = 0.f;
    if (r < 8 * I_MGU) { const int e = r / I_MGU; r %= I_MGU; const int gd = r % 224, kb = r / 224, tile = gd >> 3, bj = (gd >> 2) & 1, wc = gd & 3;
        const unsigned long long a_ = (unsigned long long)q_wg, b_ = (unsigned long long)q_wu;
        P.W = (const float*)(bj ? b_ : a_) + (size_t)e * D * FFE; P.ldw = FFE; P.c0s = 128 * tile + 32 * wc; P.gain = q_gain; P.WT = q_WMGU + (size_t)e * 2 * FFE * D; P.K = D; P.perm = true; P.n0d = 32 * gd; P.k0 = 64 * kb; }
    else { r -= 8 * I_MGU; const int e = r / I_MD; r %= I_MD; const int gd = r % 32, kb = r / 32;
        P.W = q_wd + (size_t)e * FFE * D; P.ldw = D; P.c0s = 32 * gd; P.WT = q_WMD + (size_t)e * D * FFE; P.K = FFE; P.perm = true; P.n0d = 32 * gd; P.k0 = 64 * kb; }
    return P;
}
__device__ __forceinline__ int win_src_col(int gd) {
    const int tile = gd >> 3, bj = (gd >> 2) & 1, wc = gd & 3;
    if (tile < 4) return 256 * tile + 128 * bj + 32 * wc;
    if (tile < 6) return (bj ? 1288 : 1032) + 128 * (tile - 4) + 32 * wc;
    if (tile < 8) return 1544 + 256 * (tile - 6) + 64 * wc + 32 * bj;
    if (tile < 10) return 2056 + 256 * (tile - 8) + 64 * wc + 32 * bj;
    return 2568 + 256 * (tile - 10) + 128 * bj + 32 * wc;
}
__device__ __forceinline__ PrepP prep_decode(Frame& F, int it) {
    constexpr int I_IN = 16 * 96, I_OUT = 16 * 32, I_DGU = 16 * 176, I_DD = 44 * 32, I_MGU = 16 * 224, I_MD = 56 * 32, I_PG = 16 * 32, I_PP = 4 * 32;
        int r = it;
        const float* W; const float* gain = nullptr; bf16_t* WT; int ldw, c0s, K, gd, kb; bool perm = false; float scl = 0.f;
        if (r < 2 * I_IN) { const int L = r / I_IN; r %= I_IN; gd = r % 96; kb = r / 96;
            W = F.in[3] + (size_t)L * D * DIN; ldw = DIN; c0s = win_src_col(gd); gain = F.in[2] + L * D; WT = (bf16_t*)(F.ws + WS_WIN) + (size_t)L * NIN * D; K = D; perm = true; }
        else if ((r -= 2 * I_IN) < 2 * I_OUT) { const int L = r / I_OUT; r %= I_OUT; gd = r % 32; kb = r / 32;
            W = F.in[19] + (size_t)L * D * D; ldw = D; c0s = 32 * gd; WT = (bf16_t*)(F.ws + WS_WOUT) + (size_t)L * D * D; K = D; perm = true; }
        else if ((r -= 2 * I_OUT) < I_DGU) { gd = r % 176; kb = r / 176; const int tile = gd >> 3, bj = (gd >> 2) & 1, wc = gd & 3;
            W = bj ? F.in[22] : F.in[21]; ldw = FFD; c0s = 128 * tile + 32 * wc; gain = F.in[20]; WT = (bf16_t*)(F.ws + WS_WDGU); K = D; perm = true; scl = (DENSE_F8 == 1) ? F8S_WGU : 0.f; }
        else if ((r -= I_DGU) < I_DD) { gd = r % 32; kb = r / 32;
            W = F.in[23]; ldw = D; c0s = 32 * gd; WT = (bf16_t*)(F.ws + WS_WDD); K = FFD; perm = true; scl = DENSE_F8 ? F8S_WD : 0.f; }
        else if ((r -= I_DD) < 8 * I_MGU) { const int e = r / I_MGU; r %= I_MGU; gd = r % 224; kb = r / 224; const int tile = gd >> 3, bj = (gd >> 2) & 1, wc = gd & 3;
            W = (bj ? F.in[26] : F.in[25]) + (size_t)e * D * FFE; ldw = FFE; c0s = 128 * tile + 32 * wc; gain = F.in[20] + D; WT = (bf16_t*)(F.ws + WS_WMGU + (size_t)e * 2 * FFE * D); K = D; perm = true; scl = F8S_WGU; }
        else if ((r -= 8 * I_MGU) < 8 * I_MD) { const int e = r / I_MD; r %= I_MD; gd = r % 32; kb = r / 32;
            W = F.in[27] + (size_t)e * FFE * D; ldw = D; c0s = 32 * gd; WT = (bf16_t*)(F.ws + WS_WMD + (size_t)e * D * FFE); K = FFE; perm = true; scl = F8S_WD; }
        else if ((r -= 8 * I_MD) < 2 * I_PG) { const int L = r / I_PG; r %= I_PG; gd = r % 32; kb = r / 32;
            W = F.in[29] + (size_t)L * D * D; ldw = D; c0s = 32 * gd; gain = F.in[28] + L * D; WT = (bf16_t*)(F.ws + WS_WPG) + (size_t)L * D * D; K = D; perm = true; scl = (PLE1_F8 && L == 1) ? F8S_WGU : 0.f; }
        else { r -= 2 * I_PG; const int L = r / I_PP; r %= I_PP; gd = r % 32; kb = r / 32;
            W = F.in[30] + (size_t)L * PLE * D; ldw = D; c0s = 32 * gd; WT = (bf16_t*)(F.ws + WS_WPP) + (size_t)L * D * PLE; K = PLE; perm = true; }
        PrepP P; P.W = W; P.gain = gain; P.WT = WT; P.ldw = ldw; P.c0s = c0s; P.K = K; P.n0d = 32 * gd; P.k0 = 64 * kb; P.perm = perm; P.scl = scl; return P;
}
constexpr int PREP_I_IN = 16 * 96, PREP_I_OUT = 16 * 32, PREP_I_DGU = 16 * 176, PREP_I_DD = 44 * 32, PREP_I_MGU = 16 * 224, PREP_I_MD = 56 * 32, PREP_I_PG = 16 * 32, PREP_I_PP = 4 * 32;
constexpr int PREP_MOE_LO = 2 * PREP_I_IN + 2 * PREP_I_OUT + PREP_I_DGU + PREP_I_DD, PREP_MOE_HI = PREP_MOE_LO + 8 * PREP_I_MGU + 8 * PREP_I_MD, PREP_NITEMS = PREP_MOE_HI + 2 * PREP_I_PG + 2 * PREP_I_PP;
#ifndef PRO_ONE
#define PRO_ONE 0
#endif
__device__ __forceinline__ void p0_prologue(Frame& F) {
    LAS float* scr = (LAS float*)(F.lds + F.wave * 16384);
    const int gw = F.vcu * NWAVES + F.wave, NGW = F.G * NWAVES, lane = F.lane;
    bf16_t* ws16 = (bf16_t*)F.ws;
    {
        f32x4 va[8], vb[8]; float ga[8], gb[8]; PrepP Pa, Pb;
#if DEFER_MOE_CONV
        constexpr int NEARLY = PREP_NITEMS - (PREP_MOE_HI - PREP_MOE_LO);
#define PREP_MAP(i_) ((i_) < PREP_MOE_LO ? (i_) : (i_) + (PREP_MOE_HI - PREP_MOE_LO))
#else
        constexpr int NEARLY = PREP_NITEMS;
#define PREP_MAP(i_) (i_)
#endif
        int it = gw;
#if PRO_ONE
        for (; it < NEARLY; it += NGW) { Pa = prep_decode(F, PREP_MAP(it)); prep_load(Pa, lane, va, ga); prep_finish(Pa, va, ga, scr, lane); }
#endif
        if (it < NEARLY) { Pa = prep_decode(F, PREP_MAP(it)); prep_load(Pa, lane, va, ga); }
        while (it < NEARLY) {
            const int it1 = it + NGW; const bool h1 = it1 < NEARLY;
            if (h1) { Pb = prep_decode(F, PREP_MAP(it1)); prep_load(Pb, lane, vb, gb); }
            prep_finish(Pa, va, ga, scr, lane);
            if (!h1) break;
            const int it2 = it1 + NGW; const bool h2 = it2 < NEARLY;
            if (h2) { Pa = prep_decode(F, PREP_MAP(it2)); prep_load(Pa, lane, va, ga); }
            prep_finish(Pb, vb, gb, scr, lane);
            if (!h2) break;
            it = it2;
        }
    }
    (void)ws16;
    float* wsm = (float*)(F.ws + WS_WSM);
    const int gt = F.vcu * (NWAVES * 64) + F.tid, NGT = F.G * NWAVES * 64;
    for (int i = gt; i < 3 * 8 * D; i += NGT) {
        const int which = i / (8 * D), j = (i / D) % 8, k = i % D;
        float v;
        if (which < 2) v = F.in[2][which * D + k] * F.in[3][(size_t)which * D * DIN + (size_t)k * DIN + 1024 + j];
        else v = F.in[20][D + k] * F.in[24][k * NE + j];
        wsm[i] = v;
        bf16_t* wb = (bf16_t*)(F.ws + WS_WSM + 131072) + (size_t)which * 2 * 16 * D;
        const unsigned hi = f2bf(v); const float lo = v - __builtin_bit_cast(float, hi << 16);
        wb[(0 * 16 + j) * D + k] = (bf16_t)hi; wb[(1 * 16 + j) * D + k] = (bf16_t)f2bf(lo);
        wb[(0 * 16 + 8 + j) * D + k] = 0; wb[(1 * 16 + 8 + j) * D + k] = 0;
    }
#ifndef XROWS
#define XROWS 8
#endif
    { bf16_t* XB = (bf16_t*)F.out + (size_t)M * D; float* RS0 = (float*)(F.ws + WS_RS);
      for (int mb = gw; mb < M; mb += XROWS * NGW) {
        f32x4 vb[XROWS][4];
#pragma unroll
        for (int rr = 0; rr < XROWS; ++rr) { const int mm = mb + rr * NGW; const GAS f32x4* xr = (const GAS f32x4*)(F.in[0] + (size_t)(mm < M ? mm : mb) * D) + lane;
#pragma unroll
            for (int j = 0; j < 4; ++j) vb[rr][j] = PRO_NTL ? __builtin_nontemporal_load(xr + 64 * j) : xr[64 * j]; }
#pragma unroll
        for (int rr = 0; rr < XROWS; ++rr) { const int m = mb + rr * NGW; if (m >= M) break; float s = 0.f;
#pragma unroll
            for (int j = 0; j < 4; ++j) { const f32x4 v = vb[rr][j]; s += (v.x * v.x + v.y * v.y) + (v.z * v.z + v.w * v.w); }
            s = wave_sum(s);
            GAS unsigned long long* o8 = (GAS unsigned long long*)(XB + (size_t)m * D) + lane;
#pragma unroll
            for (int j = 0; j < 4; ++j) { const f32x4 v = vb[rr][j]; o8[64 * j] = (unsigned long long)pk2(v.x, v.y) | ((unsigned long long)pk2(v.z, v.w) << 32); }
            if (lane < 4) RS0[(size_t)m * 4 + lane] = (lane == 0) ? s : 0.f; }
      } }
    { const size_t n4 = (size_t)2 * M * PLE / 4, gt4 = (size_t)F.vcu * (NWAVES * 64) + F.tid, NGT4 = (size_t)F.G * NWAVES * 64; GAS unsigned long long* po = (GAS unsigned long long*)(F.ws + WS_PB);
      for (size_t i = gt4; i < n4; i += 4 * NGT4) {
        f32x4 x[4];
#pragma unroll
        for (int j = 0; j < 4; ++j) { const size_t ii = i + (size_t)j * NGT4; x[j] = PRO_NTL ? __builtin_nontemporal_load((const GAS f32x4*)F.in[1] + (ii < n4 ? ii : i)) : ((const GAS f32x4*)F.in[1])[ii < n4 ? ii : i]; }
#pragma unroll
        for (int j = 0; j < 4; ++j) { const size_t ii = i + (size_t)j * NGT4; if (ii < n4) po[ii] = (unsigned long long)pk2(x[j].x, x[j].y) | ((unsigned long long)pk2(x[j].z, x[j].w) << 32); } } }
}


__device__ __forceinline__ float rs_of(const float* RS, int row) { const f32x4 a = *(const f32x4*)(RS + (size_t)row * 4);
    return 1.0f / sqrtf(((a[0] + a[1]) + (a[2] + a[3])) * (1.f / D) + EPS); }

typedef float f32x4_t __attribute__((ext_vector_type(4)));
template <int MODE>
__device__ __forceinline__ void gate_pass(Frame& F, const bf16_t* H, const float* RS, int which) {
    LAS unsigned char* wl = F.lds;
    LAS int* rinfo = (LAS int*)(F.lds + 98304);
    const int gw = F.vcu * NWAVES + F.wave, NGW = F.G * NWAVES, lane = F.lane, col = lane & 15, q4 = lane >> 4;
    const bf16_t* hrow = H + (size_t)(gw + col * NGW) * D + 8 * q4;
    f32x4 acc = (f32x4){0.f, 0.f, 0.f, 0.f};
    {
        bf16x8 af[32];
#pragma unroll
        for (int ks = 0; ks < 32; ++ks) af[ks] = *(const GAS bf16x8*)(hrow + 32 * ks);
        { const bf16_t* wb = (const bf16_t*)(F.ws + WS_WSM + 131072) + (size_t)which * 2 * 16 * D;
#pragma unroll 8
          for (int i = F.tid; i < 2 * 16 * 128; i += NWAVES * 64) { const int pc = i >> 7, ch = i & 127; *(LAS u32x4*)(wl + pc * 2064 + ch * 16) = *(const GAS u32x4*)(wb + (size_t)pc * D + ch * 8); } }
        __syncthreads();
#pragma unroll
        for (int ks = 0; ks < 32; ++ks) { const int ko = (32 * ks + 8 * q4) * 2;
            const bf16x8 bh = *(const LAS bf16x8*)(wl + col * 2064 + ko), bl = *(const LAS bf16x8*)(wl + (16 + col) * 2064 + ko);
            acc = __builtin_amdgcn_mfma_f32_16x16x32_bf16(af[ks], bh, acc, 0, 0, 0); acc = __builtin_amdgcn_mfma_f32_16x16x32_bf16(af[ks], bl, acc, 0, 0, 0); }
    }
    float dv[4]; int mr[4];
#pragma unroll
    for (int r = 0; r < 4; ++r) { mr[r] = gw + (4 * q4 + r) * NGW; dv[r] = acc[r] * rs_of(RS, mr[r]); }
    if (MODE == 1) { if (col < 8) {
#pragma unroll
        for (int r = 0; r < 4; ++r) ((float*)(F.ws + WS_GATE))[(size_t)mr[r] * 8 + col] = dv[r]; } }
    if (MODE == 2) {
#pragma unroll
        for (int r = 0; r < 4; ++r) {
            float v1 = (col < 8) ? dv[r] : -INFINITY; int i1 = col;
#pragma unroll
            for (int o = 1; o < 8; o <<= 1) { const float ov = __shfl_xor(v1, o); const int oi = __shfl_xor(i1, o); if (ov > v1 || (ov == v1 && oi < i1)) { v1 = ov; i1 = oi; } }
            float v2 = (col < 8 && col != i1) ? dv[r] : -INFINITY; int i2 = col;
#pragma unroll
            for (int o = 1; o < 8; o <<= 1) { const float ov = __shfl_xor(v2, o); const int oi = __shfl_xor(i2, o); if (ov > v2 || (ov == v2 && oi < i2)) { v2 = ov; i2 = oi; } }
            if (col == 0) { const float e1 = __expf(v2 - v1), g0 = 1.f / (1.f + e1), g1 = e1 / (1.f + e1); const int m = mr[r];
                float* gv = (float*)(F.ws + WS_MOE + MOE_GATEV); gv[m] = g0; gv[M + m] = g1; ((int*)(F.ws + WS_MOE + MOE_EIDX))[m] = i1 | (i2 << 4);
                rinfo[(F.wave * 16 + 4 * q4 + r) * 2] = i1; rinfo[(F.wave * 16 + 4 * q4 + r) * 2 + 1] = i2; }
        }
    }
    if (MODE == 2) {
        LAS int* cl = rinfo + 256;
        if (F.tid < 64) cl[F.tid] = 0;
        __syncthreads();
        if (F.tid < 128) __hip_atomic_fetch_add(cl + (rinfo[F.tid * 2] * 8 + rinfo[F.tid * 2 + 1]), 1, __ATOMIC_RELAXED, __HIP_MEMORY_SCOPE_WORKGROUP);
        __syncthreads();
        if (F.tid < 64) ((int*)(F.ws + WS_MOE + MOE_CNTW))[F.vcu * 64 + F.tid] = cl[F.tid];
    }
    __syncthreads();
}

__device__ __forceinline__ void moe_orient_phase(Frame& F) {
    LAS int* NT = (LAS int*)F.lds;
    LAS int* PP = NT + 512;
    LAS int* Nij = PP + 512;
    LAS int* Pij = Nij + 64;
    LAS int* fl = Pij + 64;
    LAS int* tp = fl + 64;
    LAS int* rk = tp + 128;
    LAS int* ex = rk + 128;
    const int* CNTW = (const int*)(F.ws + WS_MOE + MOE_CNTW);
    const int tid = F.tid, NGW = F.G * NWAVES;
    { const int ij = tid & 63, part = tid >> 6; int tot = 0, pre = 0;
#pragma unroll 16
      for (int w = part * 32; w < part * 32 + 32; ++w) { const int c = CNTW[w * 64 + ij]; tot += c; pre += (w < F.vcu) ? c : 0; }
      NT[part * 64 + ij] = tot; PP[part * 64 + ij] = pre; }
    __syncthreads();
    if (tid < 64) { int a = 0, b = 0;
#pragma unroll
        for (int p = 0; p < 8; ++p) { a += NT[p * 64 + tid]; b += PP[p * 64 + tid]; }
        Nij[tid] = a; Pij[tid] = b; fl[tid] = 0; }
    __syncthreads();
    if (tid == 0) {
        int n0[8], dl[8], rem[8]; int k = 0;
        for (int e = 0; e < 8; ++e) { int n = 0; for (int j = 0; j < 8; ++j) n += Nij[e * 8 + j]; n0[e] = n; rem[e] = n & 255; k += rem[e]; dl[e] = -rem[e]; }
        k >>= 8;
        for (int t = 0; t < k; ++t) { int best = -1; for (int e = 0; e < 8; ++e) if (dl[e] <= 0 && rem[e] > 0 && dl[e] == -rem[e] && (best < 0 || rem[e] > rem[best])) best = e; if (best >= 0) dl[best] += 256; }
        for (int i = 0; i < 8; ++i) for (int j = 0; j < 8 && dl[i] < 0; ++j) if (j != i && dl[j] > 0) { int amt = -dl[i]; if (dl[j] < amt) amt = dl[j]; if (Nij[i * 8 + j] < amt) amt = Nij[i * 8 + j]; fl[i * 8 + j] = amt; dl[i] += amt; dl[j] -= amt; }
        (void)n0;
    }
    if (tid < 128) tp[tid] = ((const int*)(F.ws + WS_MOE + MOE_EIDX))[(F.vcu * NWAVES + (tid >> 4)) + (tid & 15) * NGW];
    __syncthreads();
    LAS int* bse = ex + 256;
    if (tid < 128) { const int code = tp[tid], i = code & 15, j = code >> 4, m = (F.vcu * NWAVES + (tid >> 4)) + (tid & 15) * NGW; int r = 0;
#pragma unroll 16
        for (int t = 0; t < 128; ++t) r += (tp[t] == code && t < tid) ? 1 : 0;
        const bool flip = (Pij[i * 8 + j] + r) < fl[i * 8 + j];
        ex[tid * 2] = flip ? j : i; ex[tid * 2 + 1] = flip ? i : j;
        if (flip) { float* gv = (float*)(F.ws + WS_MOE + MOE_GATEV); const float a = gv[m], b = gv[M + m]; gv[m] = b; gv[M + m] = a; } }
    __syncthreads();
    int lr = 0, le = 0;
    if (tid < 256) {
        const int s = tid >> 7, t = tid & 127; le = ex[t * 2 + s]; int n = 0;
#pragma unroll 16
        for (int t2 = 0; t2 < 128; ++t2) { const bool same = ex[t2 * 2 + s] == le; lr += (same && t2 < t) ? 1 : 0; n += same ? 1 : 0; }
        if (lr == 0) bse[s * 8 + le] = (int)__hip_atomic_fetch_add((unsigned*)(F.ctl + CW_CNT + s * 8 + le), (unsigned)n, RLX_AGENT);
    }
    __syncthreads();
    if (tid < 256) { const int s = tid >> 7, t = tid & 127;
        int* list = (int*)(F.ws + WS_MOE + MOE_LIST) + ((size_t)(s * 8 + le)) * M;
        list[bse[s * 8 + le] + lr] = (F.vcu * NWAVES + (t >> 4)) + (t & 15) * NGW; }
    __syncthreads();
}

#ifndef EPI_NT
#define EPI_NT 0
#endif
#if EPI_NT
#define ST16(p, v) __builtin_nontemporal_store((v), (u32x4*)(p))
#else
#define ST16(p, v) (*(u32x4*)(p) = (v))
#endif
typedef f32x4 AccT[2][2][4][2];
__device__ __forceinline__ u32x4 pack8(const f32x4& a, const f32x4& b) { u32x4 w; w.x = cvt_pk_bf16(a[0], a[1]); w.y = cvt_pk_bf16(a[2], a[3]); w.z = cvt_pk_bf16(b[0], b[1]); w.w = cvt_pk_bf16(b[2], b[3]); return w; }
__device__ __forceinline__ f32x4 unpack4(const u32x2 w) { return (f32x4){bflo(w.x), bfhi(w.x), bflo(w.y), bfhi(w.y)}; }
__device__ __forceinline__ u32x2 pack4(const f32x4& a) { u32x2 w; w.x = cvt_pk_bf16(a[0], a[1]); w.y = cvt_pk_bf16(a[2], a[3]); return w; }
template <class GRow>
__device__ __forceinline__ void rs_commit(LAS float* red, float* RSO, int pn, int wr, int wc, int fr, int fq, const float (&ss)[2][4], const GRow& grow) {
#pragma unroll
    for (int ai = 0; ai < 2; ++ai)
#pragma unroll
        for (int m = 0; m < 4; ++m) { float s_ = ss[ai][m]; s_ += __shfl_xor(s_, 16); s_ += __shfl_xor(s_, 32); if (fq == 0) red[(ai * 128 + wr * 64 + m * 16 + fr) * 4 + wc] = s_; }
    asm volatile("s_waitcnt lgkmcnt(0)" ::: "memory"); __builtin_amdgcn_s_barrier(); asm volatile("" ::: "memory");
    const int t = (wr * 4 + wc) * 64 + fq * 16 + fr;
    if (t < 256) { const f32x4 a = *(const LAS f32x4*)(red + t * 4); const int g = grow(t); if (g >= 0) RSO[(size_t)g * 4 + pn] = (a[0] + a[1]) + (a[2] + a[3]); }
    asm volatile("s_waitcnt lgkmcnt(0)" ::: "memory"); __builtin_amdgcn_s_barrier(); asm volatile("" ::: "memory");
}
__device__ __forceinline__ void unpack8(const u32x4 w, f32x4& a, f32x4& b) { a = (f32x4){bflo(w.x), bfhi(w.x), bflo(w.y), bfhi(w.y)}; b = (f32x4){bflo(w.z), bfhi(w.z), bflo(w.w), bfhi(w.w)}; }
__device__ __forceinline__ float sq4(const f32x4& v) { return (v[0] * v[0] + v[1] * v[1]) + (v[2] * v[2] + v[3] * v[3]); }

struct EpiIn {
    bf16_t* U; const float* gq; const float* gk; const LAS float* rstab;
    __device__ __forceinline__ void operator()(const AccT& acc, const pg8::Unit& u, int wr, int wc, int fr, int fq) const {
        const int row0 = u.pm * 256 + wr * 64 + fr, pn = u.pn;
        float rsv[2][4];
#pragma unroll
        for (int ai = 0; ai < 2; ++ai)
#pragma unroll
            for (int m = 0; m < 4; ++m) rsv[ai][m] = rstab[u.ui * 256 + ai * 128 + wr * 64 + m * 16 + fr];
        if (pn < 4 || pn >= 10) {
            const int cb = (pn < 4 ? 256 * pn : UC_V + 256 * (pn - 10)) + wc * 32 + 8 * fq;
#pragma unroll
            for (int ai = 0; ai < 2; ++ai)
#pragma unroll
                for (int m = 0; m < 4; ++m) { bf16_t* rp = U + (size_t)(row0 + ai * 128 + m * 16) * UW + cb; const float r = rsv[ai][m];
#pragma unroll
                    for (int bj = 0; bj < 2; ++bj) ST16(rp + bj * 128, pack8(acc[ai][bj][m][0] * r, acc[ai][bj][m][1] * r)); }
        } else if (pn < 6) {
            const int cb = UC_Z + 128 * (pn - 4) + wc * 32 + 8 * fq;
#pragma unroll
            for (int ai = 0; ai < 2; ++ai)
#pragma unroll
                for (int m = 0; m < 4; ++m) { f32x4 z0, z1; const float r = rsv[ai][m];
#pragma unroll
                    for (int i = 0; i < 4; ++i) { z0[i] = acc[ai][0][m][0][i] * r * fast_sigmoid(acc[ai][1][m][0][i] * r); z1[i] = acc[ai][0][m][1][i] * r * fast_sigmoid(acc[ai][1][m][1][i] * r); }
                    ST16(U + (size_t)(row0 + ai * 128 + m * 16) * UW + cb, pack8(z0, z1)); }
        } else {
            const bool isq = pn < 8; const int j = 4 * (pn - (isq ? 6 : 8)) + wc;
            const float* g = isq ? gq : gk; const float sc = isq ? C2 : 1.f;
            f32x4 gv[2][2];
#pragma unroll
            for (int bj = 0; bj < 2; ++bj)
#pragma unroll
                for (int n = 0; n < 2; ++n) gv[bj][n] = *(const f32x4*)(g + 32 * bj + 8 * fq + 4 * n) * sc;
            const int cb = (isq ? UC_Q : UC_K) + 64 * j + 8 * fq;
#pragma unroll
            for (int ai = 0; ai < 2; ++ai)
#pragma unroll
                for (int m = 0; m < 4; ++m) { float ss = 0.f; const float r = rsv[ai][m];
#pragma unroll
                    for (int bj = 0; bj < 2; ++bj)
#pragma unroll
                        for (int n = 0; n < 2; ++n) ss += sq4(acc[ai][bj][m][n]);
                    ss += __shfl_xor(ss, 16); ss += __shfl_xor(ss, 32);
                    const float rs = r / sqrtf(ss * r * r * (1.f / 64.f) + EPS);
                    bf16_t* rp = U + (size_t)(row0 + ai * 128 + m * 16) * UW + cb;
#pragma unroll
                    for (int bj = 0; bj < 2; ++bj) ST16(rp + 32 * bj, pack8(acc[ai][bj][m][0] * gv[bj][0] * rs, acc[ai][bj][m][1] * gv[bj][1] * rs)); }
        }
    }
};
template <bool RESF32, bool W8 = false, bool A8 = false>
struct EpiRes {
    const void* res; bf16_t* out; float* RSO; LAS float* red; unsigned char* h8;
    __device__ __forceinline__ void operator()(const AccT& acc, const pg8::Unit& u, int wr, int wc, int fr, int fq) const {
        const int row0 = u.pm * 256 + wr * 64 + fr, col0 = u.pn * 256 + wc * 32 + 8 * fq; float ssa[2][4];
        const float as_ = A8 ? 1.f / (F8S_ACT * F8S_WD) : 1.f;
#pragma unroll
        for (int ah = 0; ah < (RESF32 ? 2 : 1); ++ah) {
            f32x4 rf[RESF32 ? 1 : 2][4][2][2];
            u32x4 rb[2][4][2];
#pragma unroll
            for (int ai = (RESF32 ? ah : 0); ai < (RESF32 ? ah + 1 : 2); ++ai)
#pragma unroll
                for (int m = 0; m < 4; ++m)
#pragma unroll
                    for (int bj = 0; bj < 2; ++bj) { const size_t o = (size_t)(row0 + ai * 128 + m * 16) * D + col0 + bj * 128;
                        if (RESF32) { rf[0][m][bj][0] = *(const f32x4*)((const float*)res + o); rf[0][m][bj][1] = *(const f32x4*)((const float*)res + o + 4); } else rb[ai][m][bj] = *(const u32x4*)((const bf16_t*)res + o); }
#pragma unroll
            for (int ai = (RESF32 ? ah : 0); ai < (RESF32 ? ah + 1 : 2); ++ai)
#pragma unroll
                for (int m = 0; m < 4; ++m) { float ss = 0.f;
#pragma unroll
                    for (int bj = 0; bj < 2; ++bj) { const size_t o = (size_t)(row0 + ai * 128 + m * 16) * D + col0 + bj * 128; f32x4 r0, r1;
                        if (RESF32) { r0 = rf[0][m][bj][0]; r1 = rf[0][m][bj][1]; } else unpack8(rb[ai][m][bj], r0, r1);
                        const f32x4 h0 = r0 + acc[ai][bj][m][0] * as_, h1 = r1 + acc[ai][bj][m][1] * as_; ss += sq4(h0) + sq4(h1); *(u32x4*)(out + o) = pack8(h0, h1);
                        if (W8) { u32x2 q; q.x = pk4_fp8(h0[0] * F8S_H, h0[1] * F8S_H, h0[2] * F8S_H, h0[3] * F8S_H); q.y = pk4_fp8(h1[0] * F8S_H, h1[1] * F8S_H, h1[2] * F8S_H, h1[3] * F8S_H); *(u32x2*)(h8 + o) = q; } }
                    ssa[ai][m] = ss; }
        }
        const int pm256 = u.pm * 256; rs_commit(red, RSO, u.pn, wr, wc, fr, fq, ssa, [pm256](int t) { return pm256 + t; });
    }
};
typedef float f32x2 __attribute__((ext_vector_type(2)));
__device__ __forceinline__ void glu4(const f32x4& g, const f32x4& u, float rn, float c, f32x4& z) {
    const f32x2 g0 = {g[0], g[1]}, g1 = {g[2], g[3]}, u0 = {u[0], u[1]}, u1 = {u[2], u[3]};
    const f32x2 t0 = g0 * rn, t1 = g1 * rn;
    const f32x2 d0 = (f32x2){__builtin_amdgcn_exp2f(t0.x), __builtin_amdgcn_exp2f(t0.y)} + 1.f, d1 = (f32x2){__builtin_amdgcn_exp2f(t1.x), __builtin_amdgcn_exp2f(t1.y)} + 1.f;
    const f32x2 s0 = {__builtin_amdgcn_rcpf(d0.x), __builtin_amdgcn_rcpf(d0.y)}, s1 = {__builtin_amdgcn_rcpf(d1.x), __builtin_amdgcn_rcpf(d1.y)};
    const f32x2 z0 = (g0 * u0) * s0 * c, z1 = (g1 * u1) * s1 * c;
    z = (f32x4){z0.x, z0.y, z1.x, z1.y};
}
template <bool CONV, bool O8 = false>
struct EpiGluT {
    bf16_t* O; int ldc; const LAS float* rstab; unsigned char* ws;
    __device__ __forceinline__ void operator()(const AccT& acc, const pg8::Unit& u, int wr, int wc, int fr, int fq) const {
        const int row0 = u.pm * 256 + wr * 64 + fr, cb = 128 * u.pn + wc * 32 + 8 * fq;
#pragma unroll
        for (int ai = 0; ai < 2; ++ai)
#pragma unroll
            for (int m = 0; m < 4; ++m) { f32x4 z0, z1; const float r = rstab[u.ui * 256 + ai * 128 + wr * 64 + m * 16 + fr];
                const float rn = -1.4426950408889634f * r, c = r * r * (O8 ? F8S_ACT : 1.f);
                glu4(acc[ai][0][m][0], acc[ai][1][m][0], rn, c, z0); glu4(acc[ai][0][m][1], acc[ai][1][m][1], rn, c, z1);
                if (O8) { u32x2 q; q.x = pk4_fp8(z0[0], z0[1], z0[2], z0[3]); q.y = pk4_fp8(z1[0], z1[1], z1[2], z1[3]);
                    *(u32x2*)((unsigned char*)O + (size_t)(row0 + ai * 128 + m * 16) * ldc + cb) = q; }
                else ST16(O + (size_t)(row0 + ai * 128 + m * 16) * ldc + cb, pack8(z0, z1)); }
        if (CONV) { if (u.ui == (int)(blockIdx.x % 11u)) { const int wave = wr * 4 + wc, lane = fq * 16 + fr;
            typedef const float* const __attribute__((address_space(4))) * kin_t; const kin_t kin = (kin_t)__builtin_amdgcn_kernarg_segment_ptr();
            const float* q_wg = kin[25]; const float* q_wu = kin[26]; const float* q_wd = kin[27]; const float* q_gain = kin[20] + D;
#pragma unroll 1
            for (int k = 0; k < 21; k += 3) {
                const int it0 = ((int)blockIdx.x * NWAVES + wave) * 21 + k;
                const PrepP P0 = moe_prep_decode(q_wg, q_wu, q_wd, q_gain, (bf16_t*)(ws + WS_WMGU), (bf16_t*)(ws + WS_WMD), it0);
                const PrepP P1 = moe_prep_decode(q_wg, q_wu, q_wd, q_gain, (bf16_t*)(ws + WS_WMGU), (bf16_t*)(ws + WS_WMD), it0 + 1);
                const PrepP P2 = moe_prep_decode(q_wg, q_wu, q_wd, q_gain, (bf16_t*)(ws + WS_WMGU), (bf16_t*)(ws + WS_WMD), it0 + 2);
                f32x4 v0[8], v1[8], v2[8]; prep_reg_load(P0, lane, v0); prep_reg_load(P1, lane, v1); prep_reg_load(P2, lane, v2);
                prep_reg_store(P0, lane, v0); prep_reg_store(P1, lane, v1); prep_reg_store(P2, lane, v2); } } }
    }
};
typedef EpiGluT<false> EpiGlu;
typedef EpiGluT<false, true> EpiGlu8;
template <int PASS>
struct EpiScatter {
    const bf16_t* res; bf16_t* out; float* RSO; const int* list_s; const float* gatev_s; const LAS int* rt_info; LAS float* red; unsigned char* h8;
    __device__ __forceinline__ void operator()(const AccT& acc, const pg8::Unit& u, int wr, int wc, int fr, int fq) const {
        const int e = rt_info[3 * u.pm], i0 = rt_info[3 * u.pm + 1], nv = rt_info[3 * u.pm + 2];
        const int col0 = u.pn * 256 + wc * 32 + 8 * fq;
        const int* lst = list_s + (size_t)e * M + i0; float ssa[2][4];
        int tokv[2][4];
#pragma unroll
        for (int ai = 0; ai < 2; ++ai)
#pragma unroll
            for (int m = 0; m < 4; ++m) { const int r = ai * 128 + wr * 64 + m * 16 + fr; tokv[ai][m] = (r < nv) ? lst[r] : 0; }
#pragma unroll
        for (int ai = 0; ai < 2; ++ai) {
            float gvv[4]; u32x4 rb[4][2];
#pragma unroll
            for (int m = 0; m < 4; ++m) { const int r = ai * 128 + wr * 64 + m * 16 + fr; const int tok = tokv[ai][m];
                gvv[m] = (r < nv) ? gatev_s[tok] * (1.f / (F8S_ACT * F8S_WD)) : 0.f;
#pragma unroll
                for (int bj = 0; bj < 2; ++bj) rb[m][bj] = *(const u32x4*)((PASS ? out : res) + (size_t)tok * D + col0 + bj * 128); }
#pragma unroll
            for (int m = 0; m < 4; ++m) { const int r = ai * 128 + wr * 64 + m * 16 + fr; const bool ok = r < nv; const float g = gvv[m]; const size_t ro = (size_t)tokv[ai][m] * D + col0; float ss = 0.f;
#pragma unroll
                for (int bj = 0; bj < 2; ++bj) { const size_t o = ro + bj * 128;
                    if (ok) { f32x4 r0, r1; unpack8(rb[m][bj], r0, r1); const f32x4 h0 = r0 + acc[ai][bj][m][0] * g, h1 = r1 + acc[ai][bj][m][1] * g; ss += sq4(h0) + sq4(h1); *(u32x4*)(out + o) = pack8(h0, h1);
                        if (PASS == 1 && PLE1_F8) { const f32x4 a0 = h0 * F8S_H, a1 = h1 * F8S_H; u32x2 q; q.x = pk4_fp8(a0[0], a0[1], a0[2], a0[3]); q.y = pk4_fp8(a1[0], a1[1], a1[2], a1[3]); *(u32x2*)(h8 + o) = q; } } }
                ssa[ai][m] = ss; }
        }
        if (PASS == 1) rs_commit(red, RSO, u.pn, wr, wc, fr, fq, ssa, [lst, nv](int t) { return t < nv ? lst[t] : -1; });
    }
};
struct EpiPe {
    bf16_t* O;
    __device__ __forceinline__ void operator()(const AccT& acc, const pg8::Unit& u, int wr, int wc, int fr, int fq) const {
        const int row0 = u.pm * 256 + wr * 64 + fr, col0 = u.pn * 256 + wc * 32 + 8 * fq;
#pragma unroll
        for (int ai = 0; ai < 2; ++ai)
#pragma unroll
            for (int m = 0; m < 4; ++m) { const size_t ro = (size_t)(row0 + ai * 128 + m * 16) * D + col0;
#pragma unroll
                for (int bj = 0; bj < 2; ++bj) *(u32x4*)(O + ro + bj * 128) = pack8(acc[ai][bj][m][0], acc[ai][bj][m][1]); }
    }
};
template <bool FINAL>
struct EpiPle {
    const bf16_t* H; const LAS float* rstab; const bf16_t* PE; bf16_t* outb; float* outf; float* RSO; LAS float* red;
    __device__ __forceinline__ void operator()(const AccT& acc, const pg8::Unit& u, int wr, int wc, int fr, int fq) const {
        const int row0 = u.pm * 256 + wr * 64 + fr, col0 = u.pn * 256 + wc * 32 + 8 * fq; float ssa[2][4];
#pragma unroll
        for (int ai = 0; ai < 2; ++ai) {
            u32x4 pv[4][2], hv[4][2];
#pragma unroll
            for (int m = 0; m < 4; ++m)
#pragma unroll
                for (int bj = 0; bj < 2; ++bj) { const size_t o = (size_t)(row0 + ai * 128 + m * 16) * D + col0 + bj * 128; pv[m][bj] = *(const u32x4*)(PE + o); hv[m][bj] = *(const u32x4*)(H + o); }
#pragma unroll
            for (int m = 0; m < 4; ++m) { const int row = row0 + ai * 128 + m * 16; const size_t ro = (size_t)row * D + col0; const float r = rstab[u.ui * 256 + ai * 128 + wr * 64 + m * 16 + fr]; float ss = 0.f;
#pragma unroll
                for (int bj = 0; bj < 2; ++bj) { const size_t o = ro + bj * 128; f32x4 p0, p1, h0, h1; unpack8(pv[m][bj], p0, p1); unpack8(hv[m][bj], h0, h1);
                    const f32x4 x0 = acc[ai][bj][m][0], x1 = acc[ai][bj][m][1];
#pragma unroll
                    for (int i = 0; i < 4; ++i) { h0[i] += fast_sigmoid(x0[i] * r) * p0[i]; h1[i] += fast_sigmoid(x1[i] * r) * p1[i]; }
                    if (FINAL) { *(f32x4*)(outf + o) = h0; *(f32x4*)(outf + o + 4) = h1; } else { ss += sq4(h0) + sq4(h1); *(u32x4*)(outb + o) = pack8(h0, h1); } }
                ssa[ai][m] = ss; }
        }
        if (!FINAL) { const int pm256 = u.pm * 256; rs_commit(red, RSO, u.pn, wr, wc, fr, fq, ssa, [pm256](int t) { return pm256 + t; }); }
    }
};

template <class Sched>
__device__ __forceinline__ void build_rstab(Frame& F, const Sched& S, const float* RS, LAS float* rstab, LAS int* upm, float mul = 1.f) {
    if (F.tid < 16) { pg8::Unit u; upm[F.tid] = S.next(F.tid, u) ? u.pm : -1; }
    __syncthreads();
#pragma unroll 8
    for (int idx = F.tid; idx < 16 * 256; idx += NWAVES * 64) { const int pm = upm[idx >> 8]; if (pm >= 0) rstab[idx] = rs_of(RS, pm * 256 + (idx & 255)) * mul; }
    __syncthreads();
}
struct MoeSched {
    pg8::StaticOrder so; const LAS int* rt_info; int ntn;
    const LAS int* map;
    __device__ __forceinline__ bool next(int i, pg8::Unit& u) const { if (!so.tile(i, u.pm, u.pn)) return false; if (map) u.pm = __builtin_amdgcn_readfirstlane(map[u.pm]); u.pb = __builtin_amdgcn_readfirstlane(rt_info[3 * u.pm]) * ntn + u.pn; u.kb = 0; u.aux = 0; return true; }
};
__device__ __forceinline__ int moe_build_tiles(Frame& F, int s, LAS int* rt_info) {
    int RT = 0;
    int cnt[8];
#pragma unroll
    for (int e = 0; e < 8; ++e) cnt[e] = (int)__hip_atomic_load((unsigned*)(F.ctl + CW_CNT + s * 8 + e), RLX_AGENT);
    {
        int e_ = 0, st_ = 0, c_ = cnt[0];
#pragma unroll
        for (int e = 0; e < 8; ++e) { const int nx = RT + ((cnt[e] + 255) >> 8); if (e > 0 && F.tid >= RT) { e_ = e; st_ = RT; c_ = cnt[e]; } RT = nx; }
        if (F.tid < RT) { const int i0 = (F.tid - st_) * 256; rt_info[3 * F.tid] = e_; rt_info[3 * F.tid + 1] = i0; rt_info[3 * F.tid + 2] = (c_ - i0) < 256 ? (c_ - i0) : 256; } }
    __syncthreads();
    return RT;
}

constexpr int TAIL_KS = 2, TAIL_KLEN = FFE / 2 / TAIL_KS;
static_assert(TAIL_KLEN % 128 == 0, "even number of K-tiles per slice");
__device__ __forceinline__ void moe_split_tiles(Frame& F, const LAS int* rt_info, int RT, LAS int* mainidx, LAS int* tailidx, LAS int* cntw) {
    if (F.tid == 0) { int nm = 0, nt = 0; for (int t = 0; t < RT; ++t) { if (rt_info[3 * t + 2] == 256) mainidx[nm++] = t; else tailidx[nt++] = t; } cntw[0] = nm; cntw[1] = nt; }
    __syncthreads();
}
struct TailSched {
    const LAS int* rt_info; const LAS int* tailidx; int ntail, G, c;
    __device__ __forceinline__ bool next(int i, pg8::Unit& u) const { const int L = i * G + c; if (L >= ntail * 4 * TAIL_KS) return false;
        const int ti = L >> 3, pn = (L >> 1) & 3, ks = L & 1, t = __builtin_amdgcn_readfirstlane(tailidx[ti]); u.pm = t; u.pn = pn; u.pb = rt_info[3 * t] * 4 + pn; u.kb = ks * TAIL_KLEN * 2; u.aux = ti * 4 + ks; return true; }
};
struct PeSched { int lo, nl, c;
    __device__ __forceinline__ bool next(int i, pg8::Unit& u) const { if (c < lo) return false; const int j = (c - lo) + i * nl; if (j >= (M / 256) * 4) return false; u.pm = j >> 2; u.pn = j & 3; u.pb = u.pn; u.kb = 0; u.aux = 0; return true; } };
struct EpiSide {
    float* SIDE;
    __device__ __forceinline__ void operator()(const AccT& acc, const pg8::Unit& u, int wr, int wc, int fr, int fq) const {
        const int ti = u.aux >> 2, ks = u.aux & 3; const int col0 = u.pn * 256 + wc * 32 + 8 * fq;
        float* base = SIDE + ((size_t)ks * 2048 + ti * 256) * D;
#pragma unroll
        for (int ai = 0; ai < 2; ++ai)
#pragma unroll
            for (int m = 0; m < 4; ++m) { float* rp = base + (size_t)(ai * 128 + wr * 64 + m * 16 + fr) * D + col0;
#pragma unroll
                for (int bj = 0; bj < 2; ++bj) { *(f32x4*)(rp + bj * 128) = acc[ai][bj][m][0]; *(f32x4*)(rp + bj * 128 + 4) = acc[ai][bj][m][1]; } }
    }
};
__device__ __forceinline__ void moe_tail_merge(Frame& F, int s, bf16_t* Hc, float* RSO, const float* SIDE, LAS int* rt_info, LAS int* mainidx, LAS int* tailidx, LAS int* cntw, unsigned char* h8) {
    const int RT = moe_build_tiles(F, s, rt_info);
    moe_split_tiles(F, rt_info, RT, mainidx, tailidx, cntw);
    const int ntail = cntw[1];
    const int* list_s = (const int*)(F.ws + WS_MOE + MOE_LIST) + (size_t)s * 8 * M;
    const float* gatev_s = (const float*)(F.ws + WS_MOE + MOE_GATEV) + (size_t)s * M;
    for (int w = F.vcu * NWAVES + F.wave; w < ntail * 256; w += F.G * NWAVES) {
        const int ti = w >> 8, r = w & 255, t = tailidx[ti], e = rt_info[3 * t], i0 = rt_info[3 * t + 1], nv = rt_info[3 * t + 2];
        if (r >= nv) continue;
        const int tok = list_s[(size_t)e * M + i0 + r]; const float g = gatev_s[tok] * (1.f / (F8S_ACT * F8S_WD));
        f32x4 a[4];
#pragma unroll
        for (int q = 0; q < 4; ++q) a[q] = (f32x4){0.f, 0.f, 0.f, 0.f};
#pragma unroll
        for (int ks = 0; ks < TAIL_KS; ++ks) { const f32x4* sp = (const f32x4*)(SIDE + ((size_t)ks * 2048 + ti * 256 + r) * D + 16 * F.lane);
#pragma unroll
            for (int q = 0; q < 4; ++q) a[q] = a[q] + sp[q]; }
        u32x4* hp = (u32x4*)(Hc + (size_t)tok * D + 16 * F.lane);
        f32x4 h0, h1, h2, h3; unpack8(hp[0], h0, h1); unpack8(hp[1], h2, h3);
        h0 = h0 + a[0] * g; h1 = h1 + a[1] * g; h2 = h2 + a[2] * g; h3 = h3 + a[3] * g;
        hp[0] = pack8(h0, h1); hp[1] = pack8(h2, h3);
        if (PLE1_F8) { h0 = h0 * F8S_H; h1 = h1 * F8S_H; h2 = h2 * F8S_H; h3 = h3 * F8S_H; u32x4 q; q.x = pk4_fp8(h0[0], h0[1], h0[2], h0[3]); q.y = pk4_fp8(h1[0], h1[1], h1[2], h1[3]); q.z = pk4_fp8(h2[0], h2[1], h2[2], h2[3]); q.w = pk4_fp8(h3[0], h3[1], h3[2], h3[3]);
            *(u32x4*)(h8 + (size_t)tok * D + 16 * F.lane) = q; h0 = h0 * (1.f / F8S_H); h1 = h1 * (1.f / F8S_H); h2 = h2 * (1.f / F8S_H); h3 = h3 * (1.f / F8S_H); }
        const float ss = wave_sum((sq4(h0) + sq4(h1)) + (sq4(h2) + sq4(h3)));
        if (F.lane < 4) RSO[(size_t)tok * 4 + F.lane] = (F.lane == 0) ? ss : 0.f;
    }
}
typedef float f32x16 __attribute__((ext_vector_type(16)));
typedef short s16x4 __attribute__((ext_vector_type(4)));
typedef short v4i16_t __attribute__((ext_vector_type(4)));
#define MFMA32(a, b, c) __builtin_amdgcn_mfma_f32_32x32x16_bf16((a), (b), (c), 0, 0, 0)
__device__ __forceinline__ int crow(int r, int hi) { return (r & 3) + 8 * (r >> 2) + 4 * hi; }
__device__ __forceinline__ float fast_silu(float x) { return x * fast_sigmoid(x); }
__device__ __forceinline__ s16x4 tr_read(const LAS unsigned char* p) { return __builtin_bit_cast(s16x4, __builtin_amdgcn_ds_read_tr16_b64_v4i16((LAS v4i16_t*)p)); }
__device__ __forceinline__ bf16x8 tr_frag(const LAS unsigned char* T, int row0, int step2, int c0, int lane) {
    const int q = (lane & 15) >> 2, p = lane & 3, cg = (lane >> 4) & 1;
    const LAS unsigned char* a = T + (row0 + q) * 128 + (c0 + 16 * cg + 4 * p) * 2;
    const s16x4 lo = tr_read(a), hi = tr_read(a + step2 * 128);
    return (bf16x8){lo[0], lo[1], lo[2], lo[3], hi[0], hi[1], hi[2], hi[3]};
}

template <class Next>
__device__ __forceinline__ void conformer_units(Frame& F, int L, int firstu, const Next& next) {
    const bf16_t* U = (const bf16_t*)(F.ws + WS_BIG); bf16_t* Y = (bf16_t*)(F.ws + WS_AY);
    const float* cw = F.in[8] + L * 31 * 256; const float* cb = F.in[9] + L * 256; const float* lg = F.in[10] + L * 256; const float* lb = F.in[11] + L * 256;
    LAS unsigned char* zt = F.lds;
    LAS float* ot = (LAS float*)(F.lds + 49152);
    const int lane_ = lane_id_v(), tid = F.wave * 64 + lane_, c = tid & 255, hf = tid >> 8;
    float w[31];
#pragma unroll
    for (int j = 0; j < 31; ++j) w[j] = cw[j * 256 + c];
    const float bias = cb[c];
    u32x4 zp[6];
    auto zload = [&](int un) { const int row0 = un * 64, t0 = row0 & (SEQ - 1);
#pragma unroll
        for (int i0 = 0; i0 < 6; ++i0) { const int i = tid + i0 * NWAVES * 64; const int r = (i < 94 * 32) ? (i >> 5) : 0, ch = i & 31; const bool ok = t0 - 30 + r >= 0;
            u32x4 v = *(const GAS u32x4*)(U + (size_t)(row0 + (ok ? r - 30 : 0)) * UW + UC_Z + ch * 8);
            v.x = ok ? v.x : 0u; v.y = ok ? v.y : 0u; v.z = ok ? v.z : 0u; v.w = ok ? v.w : 0u; zp[i0] = v; } };
    if (firstu < M / 64) zload(firstu);
    for (int unit = firstu; unit < M / 64; ) {
        const int row0 = unit * 64;
        const int nu = next(unit);
        __syncthreads();
#pragma unroll
        for (int i0 = 0; i0 < 6; ++i0) { const int i = tid + i0 * NWAVES * 64; if (i < 94 * 32) { const int r = i >> 5, ch = i & 31; *(LAS u32x4*)(zt + r * 512 + ch * 16) = zp[i0]; } }
        if (nu < M / 64) zload(nu);
        __syncthreads();
        float x[62];
#pragma unroll
        for (int i = 0; i < 62; ++i) x[i] = bf2f(*(const LAS unsigned short*)(zt + (32 * hf + i) * 512 + c * 2));
#pragma unroll
        for (int o = 0; o < 32; ++o) { float a = bias;
#pragma unroll
            for (int j = 0; j < 31; ++j) a += w[j] * x[o + j];
            ot[(32 * hf + o) * 260 + c] = a; }
        __syncthreads();
        const f32x4 g4 = *(const f32x4*)(lg + 4 * lane_), b4 = *(const f32x4*)(lb + 4 * lane_);
#pragma unroll 4
        for (int tt = 0; tt < 8; ++tt) { const int t = F.wave * 8 + tt;
            const f32x4 x = *(const LAS f32x4*)(ot + t * 260 + 4 * lane_);
            const float mu = wave_sum((x[0] + x[1]) + (x[2] + x[3])) * (1.f / 256.f);
            const f32x4 dv = x - mu;
            const float var = wave_sum((dv[0] * dv[0] + dv[1] * dv[1]) + (dv[2] * dv[2] + dv[3] * dv[3])) * (1.f / 256.f);
            const float rstd = 1.0f / sqrtf(var + EPS);
            f32x4 y = dv * rstd * g4 + b4;
#pragma unroll
            for (int i = 0; i < 4; ++i) y[i] = fast_silu(y[i]);
            u32x2 o; o.x = cvt_pk_bf16(y[0], y[1]); o.y = cvt_pk_bf16(y[2], y[3]);
            *(GAS u32x2*)(Y + (size_t)(row0 + t) * D + 256 + 4 * lane_) = o; }
        unit = nu;
    }
    __syncthreads();
}
__device__ __forceinline__ void conformer_phase(Frame& F, int L) { const int G = F.G; conformer_units(F, L, F.vcu, [G](int u) { return u + G; }); }

constexpr size_t MST_N = (size_t)2048 * 4096 * 4, MST_MG = MST_N + (size_t)2048 * 64 * 4, MST_MP = MST_MG + (size_t)2048 * 2 * 4;
template <bool NEEDQ, bool TOREG = false>
__device__ __forceinline__ void mlstm_load(const bf16_t* U, const float* cw, int row0, int t0, int h, int lane, float kscale, float qscale, LAS unsigned char* qt, LAS unsigned char* kt, LAS unsigned char* vt, u32x4* qr = nullptr, u32x4* kr = nullptr) {
    { const GAS u32x4* vp = (const GAS u32x4*)(U + (size_t)(row0 + lane) * UW + UC_MV + h * 64);
#pragma unroll
      for (int i = 0; i < 8; ++i) *(LAS u32x4*)(vt + lane * 128 + i * 16) = vp[i]; }
#pragma unroll
    for (int which = NEEDQ ? 0 : 1; which < 2; ++which) {
        const int col = (which ? UC_MK : UC_MQ) + h * 64; const float* wv = cw + (which ? 256 : 0) + h * 64; LAS unsigned char* dst = which ? kt : qt; const float sc = which ? kscale : qscale;
#pragma unroll
        for (int i = 0; i < 8; ++i) {
            float acc[8];
#pragma unroll
            for (int d = 0; d < 8; ++d) acc[d] = 0.f;
#pragma unroll
            for (int j = 0; j < 4; ++j) { const bool ok = t0 + lane - 3 + j >= 0;
                u32x4 x = *(const GAS u32x4*)(U + (size_t)(row0 + (ok ? lane - 3 + j : 0)) * UW + col + i * 8);
                x.x = ok ? x.x : 0u; x.y = ok ? x.y : 0u; x.z = ok ? x.z : 0u; x.w = ok ? x.w : 0u;
                const float* wj = wv + j * 512 + i * 8;
                acc[0] += wj[0] * bflo(x.x); acc[1] += wj[1] * bfhi(x.x); acc[2] += wj[2] * bflo(x.y); acc[3] += wj[3] * bfhi(x.y);
                acc[4] += wj[4] * bflo(x.z); acc[5] += wj[5] * bfhi(x.z); acc[6] += wj[6] * bflo(x.w); acc[7] += wj[7] * bfhi(x.w); }
#pragma unroll
            for (int d = 0; d < 8; ++d) acc[d] = fast_silu(acc[d]) * sc;
            u32x4 o; o.x = cvt_pk_bf16(acc[0], acc[1]); o.y = cvt_pk_bf16(acc[2], acc[3]); o.z = cvt_pk_bf16(acc[4], acc[5]); o.w = cvt_pk_bf16(acc[6], acc[7]);
            if (TOREG) { if (which) kr[i] = o; else qr[i] = o; } else *(LAS u32x4*)(dst + lane * 128 + i * 16) = o; }
    }
}
constexpr int MRAW = 72 * 144;
__device__ __forceinline__ void mlstm_raw_load(const bf16_t* U, int row0, int t0, int col, int lane, LAS unsigned char* raw) {
#pragma unroll
    for (int i = 0; i < 9; ++i) { const int r = 8 * i + (lane >> 3), ch = lane & 7; const bool ok = (t0 - 3 + r >= 0);
        const int gr = row0 - 3 + r; u32x4 x = *(const GAS u32x4*)(U + (size_t)(ok ? gr : row0) * UW + col + ch * 8);
        x.x = ok ? x.x : 0u; x.y = ok ? x.y : 0u; x.z = ok ? x.z : 0u; x.w = ok ? x.w : 0u;
        *(LAS u32x4*)(raw + r * 144 + ch * 16) = x; }
}
__device__ __forceinline__ void mlstm_raw_ld(const bf16_t* U, int row0, int t0, int col, int lane, u32x4 (&x)[9]) {
#pragma unroll
    for (int i = 0; i < 9; ++i) { const int r = 8 * i + (lane >> 3), ch = lane & 7; const bool ok = (t0 - 3 + r >= 0);
        const int gr = row0 - 3 + r; u32x4 v = *(const GAS u32x4*)(U + (size_t)(ok ? gr : row0) * UW + col + ch * 8);
        v.x = ok ? v.x : 0u; v.y = ok ? v.y : 0u; v.z = ok ? v.z : 0u; v.w = ok ? v.w : 0u; x[i] = v; }
}
__device__ __forceinline__ void mlstm_raw_st(LAS unsigned char* raw, int lane, const u32x4 (&x)[9]) {
#pragma unroll
    for (int i = 0; i < 9; ++i) { const int r = 8 * i + (lane >> 3), ch = lane & 7; *(LAS u32x4*)(raw + r * 144 + ch * 16) = x[i]; }
}
__device__ __forceinline__ void tile64_ld(const bf16_t* U, int row0, int col, int lane, u32x4 (&x)[8]) {
#pragma unroll
    for (int i = 0; i < 8; ++i) { const int r = 8 * i + (lane >> 3), ch = lane & 7; x[i] = *(const GAS u32x4*)(U + (size_t)(row0 + r) * UW + col + ch * 8); }
}
__device__ __forceinline__ void tile64_st(LAS unsigned char* dst, int stride, int lane, const u32x4 (&x)[8]) {
#pragma unroll
    for (int i = 0; i < 8; ++i) { const int r = 8 * i + (lane >> 3), ch = lane & 7; *(LAS u32x4*)(dst + r * stride + ch * 16) = x[i]; }
}
__device__ __forceinline__ void mlstm_conv_row(const LAS unsigned char* raw, const float* wv  , int lane, float sc, u32x4 (&out)[8]) {
#pragma unroll
    for (int i = 0; i < 8; ++i) { float acc[8];
#pragma unroll
        for (int d = 0; d < 8; ++d) acc[d] = 0.f;
#pragma unroll
        for (int j = 0; j < 4; ++j) { const u32x4 x = *(const LAS u32x4*)(raw + (lane + j) * 144 + i * 16); const float* wj = wv + j * 512 + i * 8;
            acc[0] += wj[0] * bflo(x.x); acc[1] += wj[1] * bfhi(x.x); acc[2] += wj[2] * bflo(x.y); acc[3] += wj[3] * bfhi(x.y);
            acc[4] += wj[4] * bflo(x.z); acc[5] += wj[5] * bfhi(x.z); acc[6] += wj[6] * bflo(x.w); acc[7] += wj[7] * bfhi(x.w); }
#pragma unroll
        for (int d = 0; d < 8; ++d) acc[d] = fast_silu(acc[d]) * sc;
        u32x4 o; o.x = cvt_pk_bf16(acc[0], acc[1]); o.y = cvt_pk_bf16(acc[2], acc[3]); o.z = cvt_pk_bf16(acc[4], acc[5]); o.w = cvt_pk_bf16(acc[6], acc[7]); out[i] = o; }
}
__device__ __forceinline__ void tile64_load(const bf16_t* U, int row0, int col, int lane, LAS unsigned char* dst, int stride) {
#pragma unroll
    for (int i = 0; i < 8; ++i) { const int r = 8 * i + (lane >> 3), ch = lane & 7; *(LAS u32x4*)(dst + r * stride + ch * 16) = *(const GAS u32x4*)(U + (size_t)(row0 + r) * UW + col + ch * 8); }
}
__device__ __forceinline__ void mlstm_gates(const float* GATE, const float* bi, const float* bfg, int row0, int h, int lane, float& ig, float& bcum, float& g) {
    ig = GATE[(size_t)(row0 + lane) * 8 + h] + bi[h];
    const float f = GATE[(size_t)(row0 + lane) * 8 + 4 + h] + bfg[h];
    float lf = fminf(f, 0.f) - log1pf(__expf(-fabsf(f)));
#pragma unroll
    for (int o = 1; o < 64; o <<= 1) { const float t = __shfl_up(lf, o); if (lane >= o) lf += t; }
    bcum = lf; g = __shfl(lf, 63);
}

__device__ __forceinline__ void mlstm_local_phase(Frame& F, int L) {
    const bf16_t* U = (const bf16_t*)(F.ws + WS_BIG); const float* GATE = (const float*)(F.ws + WS_GATE);
    float* Cst = (float*)(F.ws + WS_MST); float* Nst = (float*)(F.ws + WS_MST + MST_N); float* MG = (float*)(F.ws + WS_MST + MST_MG);
    const float* cw = F.in[6] + L * 2048; const float* bi = F.in[4] + L * 4; const float* bfg = F.in[5] + L * 4;
    LAS unsigned char* kt = F.lds + F.wave * 19584; LAS unsigned char* vt = kt + 8192;
    const int lane = F.lane, r32 = lane & 31, half = lane >> 5;
    for (int unit = F.vcu * NWAVES + F.wave; unit < 2048; unit += F.G * NWAVES) {
        const int h = unit & 3, bc = unit >> 2, row0 = bc * 64, t0 = row0 & (SEQ - 1);
        mlstm_raw_load(U, row0, t0, UC_MK + h * 64, lane, vt);
        u32x4 vpre[8]; tile64_ld(U, row0, UC_MV + h * 64, lane, vpre);
        float ig, bcum, g; mlstm_gates(GATE, bi, bfg, row0, h, lane, ig, bcum, g);
        const float wl = g - bcum + ig, ml = wave_max(wl), el = __expf(wl - ml);
        LDS_WAIT(); asm volatile("" ::: "memory");
        { u32x4 kr[8]; mlstm_conv_row(vt, cw + 256 + h * 64, lane, el, kr);
#pragma unroll
          for (int i = 0; i < 8; ++i) *(LAS u32x4*)(kt + lane * 128 + i * 16) = kr[i]; }
        LDS_WAIT(); asm volatile("" ::: "memory");
        tile64_st(vt, 128, lane, vpre);
        LDS_WAIT(); asm volatile("" ::: "memory");
        f32x16 acc[2][2], nacc[2];
#pragma unroll
        for (int db = 0; db < 2; ++db) { nacc[db] = f32x16{};
#pragma unroll
            for (int eb = 0; eb < 2; ++eb) acc[db][eb] = f32x16{}; }
        const bf16x8 ones = (bf16x8){0x3F80, 0x3F80, 0x3F80, 0x3F80, 0x3F80, 0x3F80, 0x3F80, 0x3F80};
#pragma unroll
        for (int ks = 0; ks < 4; ++ks) {
            bf16x8 a[2], b[2];
#pragma unroll
            for (int db = 0; db < 2; ++db) a[db] = tr_frag(kt, 16 * ks + 8 * half, 4, 32 * db, lane);
#pragma unroll
            for (int eb = 0; eb < 2; ++eb) b[eb] = tr_frag(vt, 16 * ks + 8 * half, 4, 32 * eb, lane);
#pragma unroll
            for (int db = 0; db < 2; ++db) { nacc[db] = MFMA32(a[db], ones, nacc[db]);
#pragma unroll
                for (int eb = 0; eb < 2; ++eb) acc[db][eb] = MFMA32(a[db], b[eb], acc[db][eb]); }
        }
        float* Cu = Cst + (size_t)unit * 4096;
#pragma unroll
        for (int db = 0; db < 2; ++db)
#pragma unroll
            for (int eb = 0; eb < 2; ++eb)
#pragma unroll
                for (int r = 0; r < 16; ++r) Cu[(32 * db + crow(r, half)) * 64 + 32 * eb + r32] = acc[db][eb][r];
        if (r32 == 0) {
#pragma unroll
            for (int db = 0; db < 2; ++db)
#pragma unroll
                for (int r = 0; r < 16; ++r) Nst[(size_t)unit * 64 + 32 * db + crow(r, half)] = nacc[db][r];
        }
        if (lane == 0) { MG[unit * 2] = ml; MG[unit * 2 + 1] = g; }
        LDS_WAIT(); asm volatile("" ::: "memory");
    }
}

__device__ __forceinline__ void mlstm_scan_phase(Frame& F) {
    float* Cst = (float*)(F.ws + WS_MST); float* Nst = (float*)(F.ws + WS_MST + MST_N); float* MG = (float*)(F.ws + WS_MST + MST_MG);
    float* MP = (float*)(F.ws + WS_MST + MST_MP);
    const int gw = F.vcu * NWAVES + F.wave; if (gw >= 1024 + 16) return;
    const bool isn = gw >= 1024;
    const int bh = isn ? gw - 1024 : gw >> 6, b = bh >> 2, h = bh & 3, el = isn ? F.lane : (gw & 63) * 64 + F.lane;
    float st = 0.f, m = 0.f;
    for (int c0 = 0; c0 < 128; c0 += 32) {
        float x[32], ml[32], gg[32];
#pragma unroll
        for (int i = 0; i < 32; ++i) { const int unit = (b * 128 + c0 + i) * 4 + h;
            x[i] = isn ? Nst[(size_t)unit * 64 + el] : Cst[(size_t)unit * 4096 + el]; ml[i] = MG[unit * 2]; gg[i] = MG[unit * 2 + 1]; }
#pragma unroll
        for (int i = 0; i < 32; ++i) { const int unit = (b * 128 + c0 + i) * 4 + h;
            const float mn = fmaxf(gg[i] + m, ml[i]), a = __expf(gg[i] + m - mn), bb = __expf(ml[i] - mn);
            if (isn) { Nst[(size_t)unit * 64 + el] = st; } else Cst[(size_t)unit * 4096 + el] = st;
            st = a * st + bb * x[i];
            if (isn && F.lane == 0) MP[unit] = m;
            m = mn; }
    }
}

__device__ __forceinline__ void mlstm_out_phase(Frame& F, int L) {
    const bf16_t* U = (const bf16_t*)(F.ws + WS_BIG); const float* GATE = (const float*)(F.ws + WS_GATE); bf16_t* Y = (bf16_t*)(F.ws + WS_AY);
    const float* Cst = (const float*)(F.ws + WS_MST); const float* Nst = (const float*)(F.ws + WS_MST + MST_N); const float* MP = (const float*)(F.ws + WS_MST + MST_MP);
    const float* cw = F.in[6] + L * 2048; const float* bi = F.in[4] + L * 4; const float* bfg = F.in[5] + L * 4; const float* gm = F.in[7] + L * 256;
    LAS unsigned char* vt = F.lds + F.wave * 19584; LAS unsigned char* ct = vt + 8192;
    LAS float* sc = (LAS float*)(vt + 18560);
    const int lane = F.lane, r32 = lane & 31, half = lane >> 5;
    for (int unit = F.vcu * NWAVES + F.wave; unit < 2048; unit += F.G * NWAVES) {
        const int h = unit & 3, bc = unit >> 2, row0 = bc * 64, t0 = row0 & (SEQ - 1);
        float ig, bcum, g; mlstm_gates(GATE, bi, bfg, row0, h, lane, ig, bcum, g);
        const float mprev = MP[unit];
        const float wv = ig - bcum; float pm = wv;
#pragma unroll
        for (int o = 1; o < 64; o <<= 1) { const float t = __shfl_up(pm, o); if (lane >= o) pm = fmaxf(pm, t); }
        const float mml = fmaxf(mprev, pm);
        bf16x8 qf[2][4], kf[2][4];
        float d2 = 0.f;
        const int ln = lane_id_v();
        mlstm_raw_load(U, row0, t0, UC_MQ + h * 64, ln, ct); tile64_load(U, row0, UC_MV + h * 64, ln, vt, 128);
        u32x4 kraw[9]; mlstm_raw_ld(U, row0, t0, UC_MK + h * 64, ln, kraw);
        f32x4 cpre[16]; { const GAS f32x4* cp = (const GAS f32x4*)(Cst + (size_t)unit * 4096) + ln;
#pragma unroll
          for (int i = 0; i < 16; ++i) cpre[i] = cp[64 * i]; }
        u32x4 mor[8]; tile64_ld(U, row0, UC_MO + h * 64, ln, mor);
        LDS_WAIT(); asm volatile("" ::: "memory");
        { u32x4 qr[8];
          mlstm_conv_row(ct, cw + h * 64, lane, 0.125f, qr);
#pragma unroll
          for (int i = 0; i < 8; ++i) { const u32x4 qv = qr[i]; const float* np = Nst + (size_t)unit * 64 + i * 8;
              d2 += bflo(qv.x) * np[0] + bfhi(qv.x) * np[1] + bflo(qv.y) * np[2] + bfhi(qv.y) * np[3] + bflo(qv.z) * np[4] + bfhi(qv.z) * np[5] + bflo(qv.w) * np[6] + bfhi(qv.w) * np[7]; }
#pragma unroll
          for (int ks = 0; ks < 4; ++ks) { u32x4 f0, f1;
#pragma unroll
              for (int r = 0; r < 4; ++r) { auto x = __builtin_amdgcn_permlane32_swap(qr[2 * ks][r], qr[2 * ks + 1][r], false, false); f0[r] = x[0]; f1[r] = x[1]; }
              qf[0][ks] = __builtin_bit_cast(bf16x8, f0); qf[1][ks] = __builtin_bit_cast(bf16x8, f1); } }
        LDS_WAIT(); asm volatile("" ::: "memory");
        mlstm_raw_st(ct, ln, kraw);
        LDS_WAIT(); asm volatile("" ::: "memory");
        { u32x4 kr[8];
          mlstm_conv_row(ct, cw + 256 + h * 64, lane, 1.f, kr);
#pragma unroll
          for (int ks = 0; ks < 4; ++ks) { u32x4 g0, g1;
#pragma unroll
              for (int r = 0; r < 4; ++r) { auto y = __builtin_amdgcn_permlane32_swap(kr[2 * ks][r], kr[2 * ks + 1][r], false, false); g0[r] = y[0]; g1[r] = y[1]; }
              kf[0][ks] = __builtin_bit_cast(bf16x8, g0); kf[1][ks] = __builtin_bit_cast(bf16x8, g1); } }
        LDS_WAIT(); asm volatile("" ::: "memory");
        {
#pragma unroll
          for (int i = 0; i < 16; ++i) { *(LAS u32x2*)(ct + (4 * i + (ln >> 4)) * 128 + (ln & 15) * 8) = pack4(cpre[i]); } }
        sc[lane] = mml; sc[64 + lane] = bcum; sc[128 + lane] = wv; sc[192 + lane] = d2;
        LDS_WAIT(); asm volatile("" ::: "memory");
        f32x16 Mx[2][2];
#pragma unroll
        for (int eb = 0; eb < 2; ++eb)
#pragma unroll
            for (int lb = 0; lb < 2; ++lb) Mx[eb][lb] = f32x16{};
#pragma unroll
        for (int ks = 0; ks < 4; ++ks) {
#pragma unroll
            for (int eb = 0; eb < 2; ++eb) { const bf16x8 cf = tr_frag(ct, 16 * ks + 8 * half, 4, 32 * eb, lane);
                Mx[eb][0] = MFMA32(cf, qf[0][ks], Mx[eb][0]); Mx[eb][1] = MFMA32(cf, qf[1][ks], Mx[eb][1]); }
        }
        f32x16 S00 = f32x16{}, S01 = f32x16{}, S11 = f32x16{};
#pragma unroll
        for (int ks = 0; ks < 4; ++ks) { S00 = MFMA32(kf[0][ks], qf[0][ks], S00); S01 = MFMA32(kf[0][ks], qf[1][ks], S01); S11 = MFMA32(kf[1][ks], qf[1][ks], S11); }
        const float mm0 = sc[r32], mm1 = sc[32 + r32];
        float dn0 = 0.f, dn1 = 0.f;
#pragma unroll
        for (int r = 0; r < 16; ++r) { const int s0 = crow(r, half); const float w0 = sc[128 + s0], w1 = sc[128 + 32 + s0];
            const float a = (s0 <= r32) ? S00[r] * __expf(w0 - mm0) : 0.f; S00[r] = a; dn0 += a;
            const float b = S01[r] * __expf(w0 - mm1); S01[r] = b; dn1 += b;
            const float c = (s0 <= r32) ? S11[r] * __expf(w1 - mm1) : 0.f; S11[r] = c; dn1 += c; }
        dn0 += __shfl_xor(dn0, 32); dn1 += __shfl_xor(dn1, 32);
        f32x16 N[2][2];
#pragma unroll
        for (int eb = 0; eb < 2; ++eb)
#pragma unroll
            for (int lb = 0; lb < 2; ++lb) N[eb][lb] = f32x16{};
#pragma unroll
        for (int kk = 0; kk < 2; ++kk) {
            bf16x8 p00, p01, p11;
            { u32x4 t; t.x = cvt_pk_bf16(S00[8 * kk], S00[8 * kk + 1]); t.y = cvt_pk_bf16(S00[8 * kk + 2], S00[8 * kk + 3]); t.z = cvt_pk_bf16(S00[8 * kk + 4], S00[8 * kk + 5]); t.w = cvt_pk_bf16(S00[8 * kk + 6], S00[8 * kk + 7]); p00 = __builtin_bit_cast(bf16x8, t); }
            { u32x4 t; t.x = cvt_pk_bf16(S01[8 * kk], S01[8 * kk + 1]); t.y = cvt_pk_bf16(S01[8 * kk + 2], S01[8 * kk + 3]); t.z = cvt_pk_bf16(S01[8 * kk + 4], S01[8 * kk + 5]); t.w = cvt_pk_bf16(S01[8 * kk + 6], S01[8 * kk + 7]); p01 = __builtin_bit_cast(bf16x8, t); }
            { u32x4 t; t.x = cvt_pk_bf16(S11[8 * kk], S11[8 * kk + 1]); t.y = cvt_pk_bf16(S11[8 * kk + 2], S11[8 * kk + 3]); t.z = cvt_pk_bf16(S11[8 * kk + 4], S11[8 * kk + 5]); t.w = cvt_pk_bf16(S11[8 * kk + 6], S11[8 * kk + 7]); p11 = __builtin_bit_cast(bf16x8, t); }
#pragma unroll
            for (int eb = 0; eb < 2; ++eb) {
                const bf16x8 v0 = tr_frag(vt, 16 * kk + 4 * half, 8, 32 * eb, lane), v1 = tr_frag(vt, 32 + 16 * kk + 4 * half, 8, 32 * eb, lane);
                N[eb][0] = MFMA32(v0, p00, N[eb][0]); N[eb][1] = MFMA32(v0, p01, N[eb][1]); N[eb][1] = MFMA32(v1, p11, N[eb][1]);
            }
        }
        LDS_WAIT(); asm volatile("" ::: "memory");
        LAS unsigned char* mot = vt; LAS unsigned char* yt = vt + 9216;
        tile64_st(mot, 136, ln, mor);
        LDS_WAIT(); asm volatile("" ::: "memory");
#pragma unroll
        for (int lb = 0; lb < 2; ++lb) {
            const int l = 32 * lb + r32; const float mm = lb ? mm1 : mm0, is = __expf(mprev - mm), den = (lb ? dn1 : dn0) + is * sc[192 + l];
            const float mout = sc[64 + l] + mm, rden = 1.0f / fmaxf(fabsf(den), __expf(-mout));
            float o[2][16]; float ss = 0.f;
#pragma unroll
            for (int eb = 0; eb < 2; ++eb)
#pragma unroll
                for (int r = 0; r < 16; ++r) { const float x = (N[eb][lb][r] + is * Mx[eb][lb][r]) * rden; o[eb][r] = x; ss += x * x; }
            ss += __shfl_xor(ss, 32);
            const float rs = 1.0f / sqrtf(ss * (1.f / 64.f) + EPS);
#pragma unroll
            for (int eb = 0; eb < 2; ++eb)
#pragma unroll
                for (int gq = 0; gq < 4; ++gq) { const int e0 = 32 * eb + 8 * gq + 4 * half;
                    const f32x4 gv = *(const f32x4*)(gm + h * 64 + e0); const u32x2 mv = *(const LAS u32x2*)(mot + l * 136 + e0 * 2);
                    const float y0 = o[eb][4 * gq] * rs * gv[0] * fast_sigmoid(bflo(mv.x)), y1 = o[eb][4 * gq + 1] * rs * gv[1] * fast_sigmoid(bfhi(mv.x));
                    const float y2 = o[eb][4 * gq + 2] * rs * gv[2] * fast_sigmoid(bflo(mv.y)), y3 = o[eb][4 * gq + 3] * rs * gv[3] * fast_sigmoid(bfhi(mv.y));
                    u32x2 w; w.x = cvt_pk_bf16(y0, y1); w.y = cvt_pk_bf16(y2, y3); *(LAS u32x2*)(yt + l * 136 + e0 * 2) = w; }
        }
        LDS_WAIT(); asm volatile("" ::: "memory");
#pragma unroll
        for (int i = 0; i < 8; ++i) { const int r = 8 * i + (lane >> 3), ch = lane & 7; const LAS unsigned char* sp = yt + r * 136 + ch * 16;
            u32x4 w; w.x = *(const LAS unsigned*)(sp); w.y = *(const LAS unsigned*)(sp + 4); w.z = *(const LAS unsigned*)(sp + 8); w.w = *(const LAS unsigned*)(sp + 12);
            *(GAS u32x4*)(Y + (size_t)(row0 + r) * D + h * 64 + ch * 8) = w; }
        LDS_WAIT(); asm volatile("" ::: "memory");
    }
}
constexpr int AT_SLOT = 32768, AT_K2 = 8192, AT_V = 16384;
#ifndef ATT_LAG
#define ATT_LAG 0
#endif
#ifndef ATT_PRIO
#define ATT_PRIO 0
#endif
#ifndef ATT_PAIR
#define ATT_PAIR 0
#endif
__device__ __forceinline__ void glds16(const void* gsrc, unsigned lds_dst) { unsigned keep;
    asm volatile("s_mov_b32 %0, m0\n\ts_mov_b32 m0, %2\n\ts_nop 0\n\tglobal_load_lds_dwordx4 %1, off\n\ts_mov_b32 m0, %0" : "=&s"(keep) : "v"(gsrc), "s"(lds_dst) : "memory"); }
__device__ __forceinline__ void attn_dma_tile(const bf16_t* Ub  , int hd, int k0, LAS unsigned char* slot, int wave, int lane) {
#pragma unroll
    for (int i = 0; i < 4; ++i) {
        const int id = 4 * wave + i;
        const bf16_t* src; LAS unsigned char* dst;
        if (id < 16) { const int m = id >> 3, g = id & 7, r = 8 * g + (lane >> 3);
            src = Ub + (size_t)(k0 + r) * UW + UC_K + (2 * hd + m) * 64 + 8 * ((lane & 7) ^ (r & 7)); dst = slot + m * AT_K2 + g * 1024; }
        else { const int db = (id - 16) >> 2, rq = (id - 16) & 3; src = Ub + (size_t)(k0 + 16 * rq + (lane >> 2)) * UW + UC_V + hd * 128 + 32 * db + 8 * (lane & 3); dst = slot + AT_V + db * 4096 + rq * 1024; }
        glds16(src, (unsigned)__builtin_amdgcn_readfirstlane((int)(unsigned)(uintptr_t)dst));
    }
}
#define ATT_VRD(DST, VIM, KS) do { _Pragma("unroll") for (int db_ = 0; db_ < 4; ++db_) { const LAS unsigned char* a_ = (VIM) + db_ * 4096 + (KS) * 1024; DST[db_][0] = tr_read(a_); DST[db_][1] = tr_read(a_ + 512); } } while (0)
#define ATT_VMM(PFK, SRC) do { if (ATT_PRIO) __builtin_amdgcn_s_setprio(1); _Pragma("unroll") for (int db_ = 0; db_ < 4; ++db_) { \
        const bf16x8 vf_ = (bf16x8){SRC[db_][0][0], SRC[db_][0][1], SRC[db_][0][2], SRC[db_][0][3], SRC[db_][1][0], SRC[db_][1][1], SRC[db_][1][2], SRC[db_][1][3]}; o[db_] = MFMA32((PFK), vf_, o[db_]); } if (ATT_PRIO) __builtin_amdgcn_s_setprio(0); } while (0)
#define ATT_SB() __builtin_amdgcn_sched_barrier(0)
#define ATT_PV(PF, VIM) do { s16x4 va_[4][2], vb_[4][2]; ATT_SB(); ATT_VRD(va_, VIM, 0); ATT_VRD(vb_, VIM, 1); ATT_SB(); ATT_VMM((PF)[0], va_); ATT_SB(); ATT_VRD(va_, VIM, 2); ATT_SB(); ATT_VMM((PF)[1], vb_); ATT_SB(); \
    ATT_VRD(vb_, VIM, 3); ATT_SB(); ATT_VMM((PF)[2], va_); ATT_SB(); ATT_VMM((PF)[3], vb_); ATT_SB(); } while (0)
#ifndef ATT_XQ
#define ATT_XQ 1
#endif
__device__ __forceinline__ int attn_fetch(gu32* qbase, int& xq, int& tries) {
    for (;;) {
        if (tries >= 8) return 1024;
        const int v = (int)__hip_atomic_fetch_add((unsigned*)(qbase + 64 * xq), 1u, RLX_AGENT);
        if (v < 128) return xq * 128 + v;
        xq = (xq + 1) & 7; ++tries;
    }
}
__device__ __forceinline__ int attn_phase(Frame& F, int L) {
    const bf16_t* U = (const bf16_t*)(F.ws + WS_BIG); bf16_t* Y = (bf16_t*)(F.ws + WS_AY);
    const int lane = F.lane, r32 = lane & 31, half = lane >> 5, wave = F.wave, mi = wave >> 2, sb = wave & 3;
    const bool lag = ATT_LAG && (mi == 1);
    const float lam_init = 0.8f - 0.6f * __expf(-0.3f * (float)L);
    const float lam = __builtin_bit_cast(float, __builtin_amdgcn_readfirstlane(__builtin_bit_cast(int, __expf(wave_sum(F.in[14][L * 64 + lane] * F.in[15][L * 64 + lane])) - __expf(wave_sum(F.in[16][L * 64 + lane] * F.in[17][L * 64 + lane])) + lam_init)));
    const float M2 = __builtin_bit_cast(float, __builtin_amdgcn_readfirstlane(__builtin_bit_cast(int, 64.f * C2 * 1.01f * wave_max(fabsf(F.in[12][L * 64 + lane])) * wave_max(fabsf(F.in[13][L * 64 + lane])))));
    const float* gsub = F.in[18] + L * 128;
    LAS float* lsc = (LAS float*)(F.lds + TAB_OFF) + wave * 32;
    int koff[4];
#pragma unroll
    for (int ks = 0; ks < 4; ++ks) koff[ks] = (((2 * ks + half) ^ (r32 & 7)) * 16);
    LAS float* xch = (LAS float*)F.lds;
    const float Sb = M2;
    unsigned* queue = (unsigned*)(F.ctl + CW_QATT + L);
    gu32* qbase = F.ctl + CW_QX + L * 8 * 64;
    LAS int* qslot = (LAS int*)(F.lds + TAB_OFF + 2048);
    int xq = (int)(xb_xcc_id() & 7u), tries = 0;
    if (F.tid == 0) qslot[0] = ATT_XQ ? attn_fetch(qbase, xq, tries) : (int)__hip_atomic_fetch_add(queue, 1u, RLX_AGENT);
    __syncthreads();
    int u = __builtin_amdgcn_readfirstlane(qslot[0]);
    while (u < 1024) {
#if ATT_XQ
        const int hd = 3 - ((u & 127) >> 5), qb = 2 * (31 - (u & 31)) + (u >> 9), b = (u >> 7) & 3;
#else
        const int hd = 3 - (u >> 8), qb = 63 - ((u & 255) >> 2), b = u & 3;
#endif
        const int q0 = qb * 128, qs = q0 + 32 * sb, nkt = 2 * qb + 2;
        const float slope2 = exp2f(-2.f * (float)(hd + 1)) * 1.4426950408889634f;
        const float Wf = ceilf((2.f * Sb + 24.f - log2f(1.f - exp2f(-slope2))) / slope2);
        int kt_lo = 0; if ((float)q0 > Wf) kt_lo = (q0 - (int)Wf) >> 6;
        const bf16_t* Ub = U + (size_t)b * SEQ * UW;
        bf16x8 qf[4];
#pragma unroll
        for (int ks = 0; ks < 4; ++ks) qf[ks] = *(const GAS bf16x8*)(Ub + (size_t)(qs + r32) * UW + UC_Q + (2 * hd + mi) * 64 + 16 * ks + 8 * half);
        attn_dma_tile(Ub, hd, kt_lo * 64, F.lds, wave, lane);
        attn_dma_tile(Ub, hd, kt_lo * 64 + 64, F.lds + AT_SLOT, wave, lane);
        f32x16 o[4];
#pragma unroll
        for (int db = 0; db < 4; ++db) o[db] = f32x16{};
        float lsum = 0.f;
        const float rowc = -slope2 * (float)(qs + r32) - M2;
        int slot = 0; bool pend = false; bf16x8 pfp[4]; const LAS unsigned char* vprev = F.lds;
#if ATT_PAIR
        for (int kt = kt_lo; kt < nkt; ++kt) {
            if (((kt - kt_lo) & 1) == 0) {
                asm volatile("s_waitcnt vmcnt(0)" ::: "memory");
                __builtin_amdgcn_s_barrier();
                asm volatile("" ::: "memory");
                if (kt + 2 < nkt) attn_dma_tile(Ub, hd, (kt + 2) * 64, F.lds + ((slot + 2) & 3) * AT_SLOT, wave, lane);
                if (kt + 3 < nkt) attn_dma_tile(Ub, hd, (kt + 3) * 64, F.lds + ((slot + 3) & 3) * AT_SLOT, wave, lane);
            }
            const LAS unsigned char* sl = F.lds + slot * AT_SLOT;
            slot = (slot + 1) & 3;
#else
        for (int kt = kt_lo; kt < nkt; ++kt) {
            if (kt + 1 < nkt) asm volatile("s_waitcnt vmcnt(4)" ::: "memory"); else asm volatile("s_waitcnt vmcnt(0)" ::: "memory");
            __builtin_amdgcn_s_barrier();
            asm volatile("" ::: "memory");
            if (kt + 2 < nkt) attn_dma_tile(Ub, hd, (kt + 2) * 64, F.lds + ((slot + 2) & 3) * AT_SLOT, wave, lane);
            const LAS unsigned char* sl = F.lds + slot * AT_SLOT;
            slot = (slot + 1) & 3;
#endif
            if (lag && pend) { ATT_PV(pfp, vprev); pend = false; }
            const int k0 = kt * 64;
            if (k0 > qs + 31) continue;
            f32x16 p0, p1;
            { const float base = rowc + slope2 * (float)(k0 + 4 * half);
#pragma unroll
              for (int r = 0; r < 16; ++r) { p0[r] = base + slope2 * (float)((r & 3) + 8 * (r >> 2)); p1[r] = p0[r] + 32.f * slope2; } }
            const LAS unsigned char* kim = sl + mi * AT_K2 + r32 * 128;
#pragma unroll
            for (int ks = 0; ks < 4; ++ks) {
                const bf16x8 kf0 = *(const LAS bf16x8*)(kim + koff[ks]), kf1 = *(const LAS bf16x8*)(kim + koff[ks] + 4096);
                p0 = MFMA32(kf0, qf[ks], p0); p1 = MFMA32(kf1, qf[ks], p1);
            }
            if (k0 + 63 > qs) {
                const int qrel = qs + r32 - k0 - 4 * half;
#pragma unroll
                for (int r = 0; r < 16; ++r) { const int kr = (r & 3) + 8 * (r >> 2); if (kr > qrel) p0[r] = -INFINITY; if (kr + 32 > qrel) p1[r] = -INFINITY; }
            }
            float ls = 0.f;
#pragma unroll
            for (int r = 0; r < 16; ++r) { p0[r] = __builtin_amdgcn_exp2f(p0[r]); p1[r] = __builtin_amdgcn_exp2f(p1[r]); ls += p0[r] + p1[r]; }
            lsum += ls;
            const LAS unsigned char* vim = sl + AT_V + (4 * half + ((lane & 15) >> 2)) * 64 + (16 * ((lane >> 4) & 1) + 4 * (lane & 3)) * 2;
#pragma unroll
            for (int ks = 0; ks < 4; ++ks) {
                u32x4 t;
                if (ks < 2) { t.x = cvt_pk_bf16(p0[8 * ks], p0[8 * ks + 1]); t.y = cvt_pk_bf16(p0[8 * ks + 2], p0[8 * ks + 3]); t.z = cvt_pk_bf16(p0[8 * ks + 4], p0[8 * ks + 5]); t.w = cvt_pk_bf16(p0[8 * ks + 6], p0[8 * ks + 7]); }
                else { const int k2 = ks - 2; t.x = cvt_pk_bf16(p1[8 * k2], p1[8 * k2 + 1]); t.y = cvt_pk_bf16(p1[8 * k2 + 2], p1[8 * k2 + 3]); t.z = cvt_pk_bf16(p1[8 * k2 + 4], p1[8 * k2 + 5]); t.w = cvt_pk_bf16(p1[8 * k2 + 6], p1[8 * k2 + 7]); }
                pfp[ks] = __builtin_bit_cast(bf16x8, t);
            }
            if (!lag) { ATT_PV(pfp, vim); }
            else { vprev = vim; pend = true; }
        }
        if (lag && pend) { ATT_PV(pfp, vprev); }
        lsum += __shfl_xor(lsum, 32);
        asm volatile("s_waitcnt vmcnt(0) lgkmcnt(0)" ::: "memory");
        __builtin_amdgcn_s_barrier();
        asm volatile("" ::: "memory");
        if (half == 0) lsc[r32] = lsum;
        LDS_WAIT(); asm volatile("" ::: "memory");
        float rl[16];
#pragma unroll
        for (int r = 0; r < 16; ++r) rl[r] = __builtin_amdgcn_rcpf(lsc[crow(r, half)]);
        if (mi == 1) {
#pragma unroll
            for (int db = 0; db < 4; ++db)
#pragma unroll
                for (int r = 0; r < 16; ++r) xch[((sb * 4 + db) * 16 + r) * 64 + lane] = o[db][r] * rl[r] * lam;
        }
        asm volatile("s_waitcnt lgkmcnt(0)" ::: "memory");
        __builtin_amdgcn_s_barrier();
        asm volatile("" ::: "memory");
        if (mi == 0) {
            float ss[16];
#pragma unroll
            for (int r = 0; r < 16; ++r) ss[r] = 0.f;
#pragma unroll
            for (int db = 0; db < 4; ++db)
#pragma unroll
                for (int r = 0; r < 16; ++r) { const float y = o[db][r] * rl[r] - xch[((sb * 4 + db) * 16 + r) * 64 + lane]; o[db][r] = y; ss[r] += y * y; }
#pragma unroll
            for (int r = 0; r < 16; ++r) {
#pragma unroll
                for (int m = 1; m < 32; m <<= 1) ss[r] += __shfl_xor(ss[r], m);
                ss[r] = (1.f - lam_init) / sqrtf(ss[r] * (1.f / 128.f) + EPS);
            }
            LAS unsigned char* stg = F.lds + 65536 + sb * 8192;
#pragma unroll
            for (int db = 0; db < 4; ++db) { const float gsv = gsub[32 * db + r32];
#pragma unroll
                for (int r = 0; r < 16; ++r) *(LAS unsigned short*)(stg + crow(r, half) * 256 + (32 * db + r32) * 2) = (unsigned short)f2bf(o[db][r] * ss[r] * gsv); }
            LDS_WAIT(); asm volatile("" ::: "memory");
            { const int row = lane >> 1, hc = lane & 1; bf16_t* yo = Y + (size_t)(b * SEQ + qs + row) * D + 512 + hd * 128 + hc * 64;
#pragma unroll
              for (int i = 0; i < 8; ++i) *(GAS u32x4*)(yo + i * 8) = *(const LAS u32x4*)(stg + row * 256 + hc * 128 + i * 16); }
        }
        if (F.tid == 0) qslot[0] = ATT_XQ ? attn_fetch(qbase, xq, tries) : (int)__hip_atomic_fetch_add(queue, 1u, RLX_AGENT);
        asm volatile("s_waitcnt vmcnt(0) lgkmcnt(0)" ::: "memory");
        __builtin_amdgcn_s_barrier();
        asm volatile("" ::: "memory");
        u = __builtin_amdgcn_readfirstlane(qslot[0]);
    }
    return u;
}
__device__ __forceinline__ void conformer_queue(Frame& F, int L, int u) {
    unsigned* queue = (unsigned*)(F.ctl + CW_QATT + L);
    LAS int* qslot = (LAS int*)(F.lds + TAB_OFF + 2048);
    conformer_units(F, L, u - 1024, [&F, queue, qslot](int) {
        __syncthreads();
        if (F.wave == 0 && lane_id_v() == 0) qslot[0] = (int)__hip_atomic_fetch_add(queue, 1u, RLX_AGENT);
        __syncthreads();
        return __builtin_amdgcn_readfirstlane(qslot[0]) - 1024; });
}

__device__ __forceinline__ void scan_publish(Frame& F, int L) {
    if (F.vcu * NWAVES < 1040) {
        asm volatile("s_waitcnt vmcnt(0)" ::: "memory");
        __syncthreads();
        if (F.wave == 0 && lane_id_v() == 0) { __builtin_amdgcn_fence(__ATOMIC_RELEASE, "agent"); asm volatile("s_waitcnt vmcnt(0)" ::: "memory"); (void)xb_add((unsigned*)(F.ctl + CW_QCONV + 16 * L), 1u); }
    }
}
__device__ __forceinline__ void scan_wait(Frame& F, int L) {
    if (F.wave == 0 && lane_id_v() == 0) { unsigned* bar = (unsigned*)(F.ctl + CW_BAR); unsigned* c = (unsigned*)(F.ctl + CW_QCONV + 16 * L);
        XB_SPIN(xb_ld(c) < 130u, bar);
        __builtin_amdgcn_fence(__ATOMIC_ACQUIRE, "agent"); asm volatile("s_waitcnt vmcnt(0)" ::: "memory"); }
    __syncthreads();
}

__device__ __forceinline__ void local_publish(Frame& F, int L) {
    asm volatile("s_waitcnt vmcnt(0)" ::: "memory");
    __syncthreads();
    if (F.wave == 0 && lane_id_v() == 0) { __builtin_amdgcn_fence(__ATOMIC_RELEASE, "agent"); asm volatile("s_waitcnt vmcnt(0)" ::: "memory"); (void)xb_add((unsigned*)(F.ctl + CW_QCONV + 32 + 16 * L), 1u); }
}
__device__ __forceinline__ void local_wait(Frame& F, int L) {
    if (F.vcu * NWAVES < 1040) {
        if (F.wave == 0 && lane_id_v() == 0) { unsigned* bar = (unsigned*)(F.ctl + CW_BAR); unsigned* c = (unsigned*)(F.ctl + CW_QCONV + 32 + 16 * L);
            XB_SPIN(xb_ld(c) < (unsigned)F.G, bar);
            __builtin_amdgcn_fence(__ATOMIC_ACQUIRE, "agent"); asm volatile("s_waitcnt vmcnt(0)" ::: "memory"); }
        __syncthreads();
    }
}
#define ONE_LAUNCH 1
#define NAIVE_MASK 0
#define FUSE_MIXC 1
#define MIX_PHASE_A do { mlstm_local_phase(F, L); conformer_phase(F, L); } while (0)
#define MIX_PHASE_B do { mlstm_scan_phase(F); scan_publish(F, L); (void)attn_phase(F, L); scan_wait(F, L); mlstm_out_phase(F, L); } while (0)
#define MIX_PHASE_C do { } while (0)
#ifndef REP_NORM3
#define REP_NORM3 1
#endif
#ifndef REP_MIXAC
#define REP_MIXAC 1
#endif
#ifndef REP_WIN
#define REP_WIN 1
#endif
#ifndef REP_PRO
#define REP_PRO 1
#endif
#ifndef REP_FFN1D
#define REP_FFN1D 1
#endif
__device__ __forceinline__ int bxl() { int b = blockIdx.x; asm volatile("" : "+s"(b)); return b; }
constexpr int PH_PER_LAYER = 13, NPHASE = 1 + 2 * PH_PER_LAYER;
struct Args { const float* in[31]; float* out; unsigned char* ws; int ph_lo, ph_hi; };

#define PH(k) (lo <= (k) && (k) < hi && (F.lane = lane_id_v(), F.tid = F.wave * 64 + F.lane, true))
#ifndef ALIGN_PE
#define ALIGN_PE false
#endif
#ifndef FUSE_MIXC
#define FUSE_MIXC 0
#endif
#ifndef ALIGN_MULTI
#define ALIGN_MULTI true
#endif
#ifndef PROBE_MASK
#define PROBE_MASK 0
#endif
#ifndef PROBE_AMP
#define PROBE_AMP 10
#endif
#if PROBE_MASK
#define SEAM(k, kind) do { const unsigned long long t1_ = __builtin_amdgcn_s_memrealtime(); if ((k) + 1 < hi) xcd_barrier(bar, F.wave); const unsigned long long t2_ = __builtin_amdgcn_s_memrealtime(); \
    if (F.wave == 0 && lane_id_v() == 0) { volatile LAS unsigned long long* pp_ = (volatile LAS unsigned long long*)(F.lds + MISC_OFF + 64); unsigned long long a_ = pp_[0]; \
        if (PROBE_MASK & (1 << (kind))) a_ += t1_ - pp_[1]; if (PROBE_MASK & (1 << 10)) a_ += t2_ - t1_; pp_[0] = a_; pp_[1] = t2_; } } while (0)
#else
#define SEAM(k, kind) do { if ((k) + 1 < hi) xcd_barrier(bar, F.wave); } while (0)
#endif
template <int L>
__device__ __forceinline__ void layer_phases(Frame& F, const XcdBarrier& bar, int lo, int hi) {
    bf16_t* const AY = (bf16_t*)(F.ws + WS_AY);
    bf16_t* const BIGB = (bf16_t*)(F.ws + WS_BIG);
    bf16_t* const HA = (bf16_t*)F.out;
    bf16_t* const HB = (bf16_t*)F.out + (size_t)M * D;
    bf16_t* const HC = AY;
    float* const wsm = (float*)(F.ws + WS_WSM);
    float* const RSB = (float*)(F.ws + WS_RS);
    LAS int* const rt_info = (LAS int*)(F.lds + TAB_OFF); LAS unsigned short* const rowtab = (LAS unsigned short*)(F.lds + TAB_OFF + 1664);
    LAS float* const rstab = (LAS float*)(F.lds + TAB_OFF + 9344); LAS int* const upm = (LAS int*)(F.lds + TAB_OFF + 25728);
    LAS float* const red = (LAS float*)(F.lds + TAB_OFF + 26112);
    const int pb = 1 + PH_PER_LAYER * L;
    if (pb + PH_PER_LAYER <= lo || pb >= hi) return;
    const bf16_t* Hin = (L == 0) ? HB : HA; const float* RSin = RSB + (size_t)(L == 0 ? 0 : 3) * M * 4;
    bf16_t* H1 = (L == 0) ? HA : HB; float* RS1 = RSB + (size_t)(L == 0 ? 1 : 4) * M * 4;
    float* RS2 = RSB + (size_t)(L == 0 ? 2 : 5) * M * 4;
    if (PH(pb + 0)) {
        gate_pass<1>(F, Hin, RSin, L);
        pg8::StaticOrder S; S.init(M / 256, NIN / 256, F.G, bxl());
        build_rstab(F, S, RSin, rstab, upm);
        EpiIn E{BIGB, F.in[12] + L * 64, F.in[13] + L * 64, rstab};
        pg8::gemm_phase<EpiIn, pg8::StaticOrder, pg8::AOffDense, ALIGN_MULTI>(F.lds, F.wave, Hin, (const bf16_t*)(F.ws + WS_WIN) + (size_t)L * NIN * D, D, S, E, pg8::AOffDense{D});
        SEAM(pb + 0, 2);
    }
#if FUSE_MIXC < 2
    if (PH(pb + 1)) { MIX_PHASE_A; SEAM(pb + 1, 3); }
#endif
    if (PH(pb + 2)) { MIX_PHASE_B; SEAM(pb + 2, 4); }
#if !FUSE_MIXC
    if (PH(pb + 3)) { MIX_PHASE_C; SEAM(pb + 3, 5); }
#endif
    if (PH(pb + 4)) {
        pg8::StaticOrder S; S.init(M / 256, D / 256, F.G, bxl());
        if (L == 0) { EpiRes<true, (DENSE_F8 == 1)> E{(const void*)F.in[0], H1, RS1, red, F.ws + WS_H8};
            pg8::gemm_phase<EpiRes<true, (DENSE_F8 == 1)>, pg8::StaticOrder, pg8::AOffDense, true>(F.lds, F.wave, AY, (const bf16_t*)(F.ws + WS_WOUT) + (size_t)L * D * D, D, S, E, pg8::AOffDense{D}); }
        else { EpiRes<false, true> E{(const void*)Hin, H1, RS1, red, F.ws + WS_H8};
            pg8::gemm_phase<EpiRes<false, true>, pg8::StaticOrder, pg8::AOffDense, true>(F.lds, F.wave, AY, (const bf16_t*)(F.ws + WS_WOUT) + (size_t)L * D * D, D, S, E, pg8::AOffDense{D}); }
        SEAM(pb + 4, 6);
    }
    const bf16_t* H2;
    if (L == 0) {
        H2 = HB;
        if (PH(pb + 7)) {
            pg8::StaticOrder S; S.init(M / 256, 2 * FFD / 256, F.G, bxl());
#if DENSE_F8 == 2
            build_rstab(F, S, RS1, rstab, upm);
            EpiGlu8 E{BIGB, FFD, rstab, F.ws};
            pg8::gemm_phase<EpiGlu8, pg8::StaticOrder, pg8::AOffDense, ALIGN_MULTI>(F.lds, F.wave, H1, (const bf16_t*)(F.ws + WS_WDGU), D, S, E, pg8::AOffDense{D});
#elif DENSE_F8
            build_rstab(F, S, RS1, rstab, upm, 1.f / (F8S_H * F8S_WGU));
            EpiGlu8 E{BIGB, FFD, rstab, F.ws};
            pg8::gemm_phase<EpiGlu8, pg8::StaticOrder, pg8::AOffDense, ALIGN_MULTI, true>(F.lds, F.wave, (const bf16_t*)(F.ws + WS_H8), (const bf16_t*)(F.ws + WS_WDGU), D / 2, S, E, pg8::AOffDense{D / 2});
#else
            build_rstab(F, S, RS1, rstab, upm);
            EpiGluT<(DEFER_MOE_CONV != 0)> E{BIGB, FFD, rstab, F.ws};
            pg8::gemm_phase<EpiGluT<(DEFER_MOE_CONV != 0)>, pg8::StaticOrder, pg8::AOffDense, ALIGN_MULTI>(F.lds, F.wave, H1, (const bf16_t*)(F.ws + WS_WDGU), D, S, E, pg8::AOffDense{D});
#endif
            SEAM(pb + 7, 7);
        }
        if (PH(pb + 8)) {
            pg8::StaticOrder S; S.init(M / 256, D / 256, F.G, bxl());
#if DENSE_F8
            EpiRes<false, false, true> E{(const void*)H1, HB, RS2, red};
            pg8::gemm_phase<EpiRes<false, false, true>, pg8::StaticOrder, pg8::AOffDense, true, true>(F.lds, F.wave, BIGB, (const bf16_t*)(F.ws + WS_WDD), FFD / 2, S, E, pg8::AOffDense{FFD / 2});
#else
            EpiRes<false> E{(const void*)H1, HB, RS2, red};
            pg8::gemm_phase<EpiRes<false>, pg8::StaticOrder, pg8::AOffDense, true>(F.lds, F.wave, BIGB, (const bf16_t*)(F.ws + WS_WDD), FFD, S, E, pg8::AOffDense{FFD});
#endif
            SEAM(pb + 8, 8);
        }
    } else {
        H2 = HC;
        if (PH(pb + 5)) { gate_pass<2>(F, H1, RS1, 2); SEAM(pb + 5, 1); }
        if (PH(pb + 6)) { moe_orient_phase(F); SEAM(pb + 6, 1); }
        for (int s = 0; s < 2; ++s) {
            const int* list_s = (const int*)(F.ws + WS_MOE + MOE_LIST) + (size_t)s * 8 * M;
            const float* gatev_s = (const float*)(F.ws + WS_MOE + MOE_GATEV) + (size_t)s * M;
            bf16_t* const actb = (bf16_t*)(F.ws + WS_BIG + ((MOE_2ACT && s) ? ACT8_BYTES : 0));
            if (PH(pb + 7 + 2 * s)) {
                const int RT = moe_build_tiles(F, s, rt_info);
                MoeSched S; S.so.init(RT, 2 * FFE / 256, F.G, bxl()); S.rt_info = rt_info; S.ntn = 2 * FFE / 256; S.map = nullptr;
                if (F.tid < 16) { pg8::Unit u; upm[F.tid] = S.next(F.tid, u) ? u.pm : -1; }
                __syncthreads();
#pragma unroll 8
                for (int idx = F.tid; idx < 16 * 256; idx += NWAVES * 64) { const int pm = upm[idx >> 8]; if (pm >= 0) { const int e = rt_info[3 * pm], i0 = rt_info[3 * pm + 1], nv = rt_info[3 * pm + 2], r = idx & 255;
                    const int tok = r < nv ? list_s[(size_t)e * M + i0 + r] : 0; rowtab[idx] = (unsigned short)tok; rstab[idx] = rs_of(RS1, tok) * (1.f / (F8S_H * F8S_WGU)); } }
                __syncthreads();
                EpiGlu8 E{actb, FFE, rstab, F.ws};
                pg8::gemm_phase<EpiGlu8, MoeSched, pg8::AOffGather, ALIGN_MULTI, true>(F.lds, F.wave, (const bf16_t*)(F.ws + WS_H8), (const bf16_t*)(F.ws + WS_WMGU), D / 2, S, E, pg8::AOffGather{D / 2, rowtab});
                SEAM(pb + 7 + 2 * s, 7);
            }
            if (PH(pb + 8 + 2 * s)) {
                const int RT = moe_build_tiles(F, s, rt_info);
                LAS int* const mainidx = (LAS int*)(F.lds + TAB_OFF + 1664); LAS int* const tailidx = mainidx + 160; LAS int* const cntw = tailidx + 16;
                if (s == 0) { MoeSched S; S.so.init(RT, D / 256, F.G, bxl()); S.rt_info = rt_info; S.ntn = D / 256; S.map = nullptr;
                    EpiScatter<0> E{H1, HC, RS2, list_s, gatev_s, rt_info, red, nullptr};
                    pg8::gemm_phase<EpiScatter<0>, MoeSched, pg8::AOffDense, true, true>(F.lds, F.wave, actb, (const bf16_t*)(F.ws + WS_WMD), FFE / 2, S, E, pg8::AOffDense{FFE / 2}); }
                else {
                    moe_split_tiles(F, rt_info, RT, mainidx, tailidx, cntw);
                    const int nmain = cntw[0], ntail = cntw[1];
                    { MoeSched S; S.so.init(nmain, D / 256, F.G, bxl()); S.rt_info = rt_info; S.ntn = D / 256; S.map = mainidx;
                      EpiScatter<1> E{H1, HC, RS2, list_s, gatev_s, rt_info, red, F.ws + WS_H8};
                      pg8::gemm_phase<EpiScatter<1>, MoeSched, pg8::AOffDense, true, true>(F.lds, F.wave, actb, (const bf16_t*)(F.ws + WS_WMD), FFE / 2, S, E, pg8::AOffDense{FFE / 2}); }
                    { TailSched S{rt_info, tailidx, ntail, F.G, bxl()};
                      EpiSide E{(float*)F.out};
                      pg8::gemm_phase<EpiSide, TailSched, pg8::AOffDense, true, true>(F.lds, F.wave, actb, (const bf16_t*)(F.ws + WS_WMD), FFE / 2, S, E, pg8::AOffDense{FFE / 2}, TAIL_KLEN); }
#if MOE_2ACT
                    {
                      PeSched S{ntail * 4 * TAIL_KS, F.G - ntail * 4 * TAIL_KS, bxl()};
                      EpiPe E1{BIGB};
                      pg8::gemm_phase<EpiPe, PeSched, pg8::AOffDense, ALIGN_PE>(F.lds, F.wave, (const bf16_t*)(F.ws + WS_PB) + (size_t)1 * M * PLE, (const bf16_t*)(F.ws + WS_WPP) + (size_t)1 * D * PLE, PLE, S, E1, pg8::AOffDense{PLE}); }
#endif
                }
                if (!(MOE_2ACT && s == 0)) SEAM(pb + 8 + 2 * s, 8); else __syncthreads();
            }
        }
    }
    if (L == 1) { if (PH(pb + 11)) { LAS int* const mainidx = (LAS int*)(F.lds + TAB_OFF + 1664); moe_tail_merge(F, 1, HC, RS2, (const float*)F.out, rt_info, mainidx, mainidx + 160, mainidx + 176, F.ws + WS_H8); SEAM(pb + 11, 8); } }
    if (PH(pb + 12)) {
        bf16_t* const PEB = BIGB;
        pg8::StaticOrder S; S.init(M / 256, D / 256, F.G, bxl());
        build_rstab(F, S, RS2, rstab, upm, (PLE1_F8 && L == 1) ? 1.f / (F8S_H * F8S_WGU) : 1.f);
        EpiPe E1{PEB};
        if (!(MOE_2ACT && L == 1)) pg8::gemm_phase<EpiPe, pg8::StaticOrder, pg8::AOffDense, ALIGN_PE>(F.lds, F.wave, (const bf16_t*)(F.ws + WS_PB) + (size_t)L * M * PLE, (const bf16_t*)(F.ws + WS_WPP) + (size_t)L * D * PLE, PLE, S, E1, pg8::AOffDense{PLE});
        if (L == 0) { EpiPle<false> E2{H2, rstab, PEB, HA, nullptr, RSB + (size_t)3 * M * 4, red};
            pg8::gemm_phase<EpiPle<false>, pg8::StaticOrder, pg8::AOffDense, true>(F.lds, F.wave, H2, (const bf16_t*)(F.ws + WS_WPG) + (size_t)L * D * D, D, S, E2, pg8::AOffDense{D}); }
        else { EpiPle<true> E2{H2, rstab, PEB, nullptr, F.out, nullptr, red};
#if PLE1_F8
            pg8::gemm_phase<EpiPle<true>, pg8::StaticOrder, pg8::AOffDense, true, true>(F.lds, F.wave, (const bf16_t*)(F.ws + WS_H8), (const bf16_t*)(F.ws + WS_WPG) + (size_t)L * D * D, D / 2, S, E2, pg8::AOffDense{D / 2}); }
#else
            pg8::gemm_phase<EpiPle<true>, pg8::StaticOrder, pg8::AOffDense, true>(F.lds, F.wave, H2, (const bf16_t*)(F.ws + WS_WPG) + (size_t)L * D * D, D, S, E2, pg8::AOffDense{D}); }
#endif
        SEAM(pb + 12, 9);
    }
}
__global__ void __launch_bounds__(NWAVES * 64, 2) fwd(Args args) {
    extern __shared__ __attribute__((aligned(16))) unsigned char lds[];
    Frame F;
    F.lds = (LAS unsigned char*)lds;
    F.MISC = (volatile LAS unsigned*)(F.lds + MISC_OFF);
    F.wave = __builtin_amdgcn_readfirstlane(threadIdx.x >> 6); F.lane = lane_id_v(); F.tid = F.wave * 64 + F.lane;
    F.G = gridDim.x; { const int bx = blockIdx.x; F.vcu = (F.G % 8 == 0) ? (bx % 8) * (F.G / 8) + bx / 8 : bx; }
    F.ws = args.ws; F.ctl = (gu32*)(args.ws + WS_CTL); F.out = args.out;
#pragma unroll
    for (int i = 0; i < 31; ++i) F.in[i] = args.in[i];
    for (int u = F.tid; u < 256; u += NWAVES * 64) ((LAS unsigned*)(F.lds + LDSCTL_OFF))[u] = 0u;
    __syncthreads();
    const int lo = args.ph_lo, hi = args.ph_hi;
#if PROBE_MASK
    if (F.wave == 0 && lane_id_v() == 0) { volatile LAS unsigned long long* pp_ = (volatile LAS unsigned long long*)(F.lds + MISC_OFF + 64); pp_[0] = 0; pp_[1] = __builtin_amdgcn_s_memrealtime(); }
#endif
    XcdBarrier bar; bar.bar = (unsigned*)(F.ctl + CW_BAR); bar.x = 0; bar.st = nullptr;
    if (hi - lo > 1) bar = xcd_barrier_post((unsigned*)(F.ctl + CW_BAR), F.MISC + 8);

    bf16_t* const AY = (bf16_t*)(F.ws + WS_AY);
    bf16_t* const BIGB = (bf16_t*)(F.ws + WS_BIG);
    float* const wsm = (float*)(F.ws + WS_WSM);

    if (PH(0)) { for (int rep_ = 0; rep_ < REP_PRO; ++rep_) { p0_prologue(F); __syncthreads(); } SEAM(0, 0); }

    layer_phases<0>(F, bar, lo, hi);
    layer_phases<1>(F, bar, lo, hi);
#if PROBE_MASK
    if (blockIdx.x == 0 && F.wave == 0 && lane_id_v() == 0) { const unsigned long long tend_ = __builtin_amdgcn_s_memrealtime() + (unsigned long long)PROBE_AMP * ((volatile LAS unsigned long long*)(F.lds + MISC_OFF + 64))[0]; while (__builtin_amdgcn_s_memrealtime() < tend_) __builtin_amdgcn_s_sleep(32); }
#endif
#undef PH
#undef SEAM
}

extern "C" void kernel_launch(void* const* d_in, const int* in_sizes, int n_in, void* d_out, int out_size, void* d_ws, size_t ws_size, hipStream_t stream) {
    static int grid = 0;
    if (grid == 0) {
        int dev = 0, cus = 0;
        grid = -1;
        if (hipGetDevice(&dev) == hipSuccess && hipDeviceGetAttribute(&cus, hipDeviceAttributeMultiprocessorCount, dev) == hipSuccess && cus == 256 && ws_size >= WS_END && n_in == 31 &&
            hipFuncSetAttribute((const void*)fwd, hipFuncAttributeMaxDynamicSharedMemorySize, LDS_BYTES) == hipSuccess) grid = cus;
        (void)hipGetLastError();
    }
    if (grid < 0) { nv::forward(d_in, (float*)d_out, (unsigned char*)d_ws, stream); return; }
    (void)hipMemsetAsync((char*)d_ws + WS_CTL, 0, CTL_ZERO_BYTES, stream);
    Args a{};
    for (int i = 0; i < 31; ++i) a.in[i] = (const float*)d_in[i];
    a.out = (float*)d_out; a.ws = (unsigned char*)d_ws;
#if ONE_LAUNCH
    a.ph_lo = 0; a.ph_hi = NPHASE;
    hipLaunchKernelGGL(fwd, dim3(grid), dim3(NWAVES * 64), LDS_BYTES, stream, a);
#else
    for (int p = 0; p < NPHASE; ++p) {
        const int L = (p - 1) / PH_PER_LAYER, k = (p - 1) % PH_PER_LAYER;
        if (p > 0 && L == 0 && (k == 5 || k == 6 || k == 9 || k == 10 || k == 11)) continue;
        a.ph_lo = p; a.ph_hi = p + 1;
        hipLaunchKernelGGL(fwd, dim3(grid), dim3(NWAVES * 64), LDS_BYTES, stream, a);
    }
#endif
}
```
